# Optimizing an MI355X kernel written in HIP

```python
import math
import jax, jax.numpy as jnp
from jax import lax
import numpy as np

D_MODEL = 1024
BATCH = 8
SEQ = 4096
DEPTH = 1

D_ATTN = D_MODEL // 2
D_LRU = D_MODEL - D_ATTN
DIFF_HEAD_DIM = 64
N_DIFF_HEADS = D_ATTN // (2 * DIFF_HEAD_DIM)
DIFF_V_DIM = 2 * DIFF_HEAD_DIM
Q_BLOCK = 128
NUM_BUCKETS = 32
MAX_DISTANCE = 128
LRU_BLOCKS = 8
LRU_BLOCK_DIM = D_LRU // LRU_BLOCKS
CONV_WIDTH = 4
LRU_C = 8.0
D_FF = int(math.ceil(D_MODEL * 8 / 3 / 256) * 256)
D_IN = 3 * D_ATTN + 2 * D_LRU
NORM_EPS = 1e-6

kernel_name = "hybrid_diffattn_rglru_encoder_layer"


def rms_norm(x, g):
    xf = x.astype(jnp.float32)
    y = xf * lax.rsqrt(jnp.mean(xf * xf, axis=-1, keepdims=True) + NORM_EPS)
    return (y * g.astype(jnp.float32)).astype(x.dtype)


def t5_bucket(rel):
    half = NUM_BUCKETS // 2
    ret = jnp.where(rel > 0, half, 0)
    n = jnp.abs(rel)
    max_exact = half // 2
    nf = jnp.maximum(n, 1).astype(jnp.float32)
    large = max_exact + (jnp.log(nf / max_exact) / math.log(MAX_DISTANCE / max_exact)
                         * (half - max_exact)).astype(jnp.int32)
    large = jnp.minimum(large, half - 1)
    return ret + jnp.where(n < max_exact, n, large)


def diff_attention(q, k, v, lam, rel_bias, subln_g, lambda_init):
    B, S, _ = q.shape
    H, Dh, Dv = N_DIFF_HEADS, DIFF_HEAD_DIM, DIFF_V_DIM
    nb = S // Q_BLOCK
    q = q.reshape(B, S, H, 2, Dh)
    k = k.reshape(B, S, H, 2, Dh)
    v = v.reshape(B, S, H, Dv).transpose(0, 2, 1, 3)
    k1 = k[:, :, :, 0].transpose(0, 2, 1, 3)
    k2 = k[:, :, :, 1].transpose(0, 2, 1, 3)
    q1b = q[:, :, :, 0].transpose(0, 2, 1, 3).reshape(B, H, nb, Q_BLOCK, Dh).transpose(2, 0, 1, 3, 4)
    q2b = q[:, :, :, 1].transpose(0, 2, 1, 3).reshape(B, H, nb, Q_BLOCK, Dh).transpose(2, 0, 1, 3, 4)
    starts = jnp.arange(nb, dtype=jnp.int32) * Q_BLOCK
    key_pos = jnp.arange(S, dtype=jnp.int32)
    scale = 1.0 / math.sqrt(Dh)
    table = rel_bias.astype(jnp.float32)

    def one_block(args):
        q1_blk, q2_blk, start = args
        q_pos = start + jnp.arange(Q_BLOCK, dtype=jnp.int32)
        bucket = t5_bucket(key_pos[None, :] - q_pos[:, None])
        bias = table[bucket].transpose(2, 0, 1)[None]
        s1 = jnp.einsum('bhqd,bhkd->bhqk', q1_blk, k1).astype(jnp.float32) * scale + bias
        s2 = jnp.einsum('bhqd,bhkd->bhqk', q2_blk, k2).astype(jnp.float32) * scale + bias
        attn = jax.nn.softmax(s1, axis=-1) - lam * jax.nn.softmax(s2, axis=-1)
        return jnp.einsum('bhqk,bhkd->bhqd', attn.astype(v.dtype), v)

    o = lax.map(one_block, (q1b, q2b, starts))
    o = o.transpose(1, 0, 3, 2, 4).reshape(B, S, H, Dv)
    o = rms_norm(o, subln_g) * (1.0 - lambda_init)
    return o.reshape(B, S, H * Dv)


def block_diag_linear(x, w, b):
    B, S, _ = x.shape
    xb = x.reshape(B, S, LRU_BLOCKS, LRU_BLOCK_DIM)
    return jnp.einsum('bsnd,nde->bsne', xb, w).reshape(B, S, D_LRU) + b


def centred_depthwise_conv(x, w, b):
    S = x.shape[1]
    xp = jnp.pad(x, ((0, 0), (CONV_WIDTH // 2, CONV_WIDTH - 1 - CONV_WIDTH // 2), (0, 0)))
    out = sum(xp[:, t:t + S] * w[t] for t in range(CONV_WIDTH))
    return out + b


def rglru_direction(xc, w_r, b_r, w_i, b_i, lam, reverse):
    r = jax.nn.sigmoid(block_diag_linear(xc, w_r, b_r))
    i = jax.nn.sigmoid(block_diag_linear(xc, w_i, b_i))
    log_a = -LRU_C * r * jax.nn.softplus(-lam)
    a = jnp.exp(log_a)
    u = jnp.sqrt(-jnp.expm1(2.0 * log_a)) * (i * xc)

    def combine(left, right):
        a1, b1 = left
        a2, b2 = right
        return a1 * a2, a2 * b1 + b2

    _, h = lax.associative_scan(combine, (a, u), reverse=reverse, axis=1)
    return h


def bidirectional_rglru_group(xr, gr, conv_w, conv_b, w_rg, b_rg, w_ig, b_ig, lru_lambda):
    xf = xr.astype(jnp.float32)
    xc = centred_depthwise_conv(xf, conv_w.astype(jnp.float32), conv_b.astype(jnp.float32))
    h_fwd = rglru_direction(xc, w_rg[0].astype(jnp.float32), b_rg[0].astype(jnp.float32),
                            w_ig[0].astype(jnp.float32), b_ig[0].astype(jnp.float32),
                            lru_lambda[0].astype(jnp.float32), reverse=False)
    h_bwd = rglru_direction(xc, w_rg[1].astype(jnp.float32), b_rg[1].astype(jnp.float32),
                            w_ig[1].astype(jnp.float32), b_ig[1].astype(jnp.float32),
                            lru_lambda[1].astype(jnp.float32), reverse=True)
    y = jax.nn.gelu(gr.astype(jnp.float32)) * (h_fwd + h_bwd)
    return y.astype(xr.dtype)


def setup_inputs(seed: int = 0) -> dict:
    key = jax.random.key(seed)
    ks = jax.random.split(key, 24)
    f32 = jnp.float32

    def nrm(k, shape, scale):
        return jax.random.normal(k, shape, f32) * scale

    def gain(k, shape):
        return 1.0 + 0.05 * jax.random.normal(k, shape, f32)

    u = jax.random.uniform(ks[13], (DEPTH, 2, D_LRU), f32, 0.9, 0.999)
    a0 = u ** (1.0 / LRU_C)
    lru_lambda = jnp.log(a0) - jnp.log1p(-a0)
    return {
        "x": jax.random.normal(ks[0], (BATCH, SEQ, D_MODEL), f32),
        "attn_norm_g": gain(ks[1], (DEPTH, D_MODEL)),
        "w_in": nrm(ks[2], (DEPTH, D_MODEL, D_IN), D_MODEL ** -0.5),
        "lambda_q1": nrm(ks[3], (DEPTH, DIFF_HEAD_DIM), 0.1),
        "lambda_k1": nrm(ks[4], (DEPTH, DIFF_HEAD_DIM), 0.1),
        "lambda_q2": nrm(ks[5], (DEPTH, DIFF_HEAD_DIM), 0.1),
        "lambda_k2": nrm(ks[6], (DEPTH, DIFF_HEAD_DIM), 0.1),
        "subln_g": gain(ks[7], (DEPTH, DIFF_V_DIM)),
        "rel_bias": nrm(ks[8], (NUM_BUCKETS, N_DIFF_HEADS), 0.5),
        "conv_w": nrm(ks[9], (DEPTH, CONV_WIDTH, D_LRU), CONV_WIDTH ** -0.5),
        "conv_b": nrm(ks[10], (DEPTH, D_LRU), 0.01),
        "w_rg": nrm(ks[11], (DEPTH, 2, LRU_BLOCKS, LRU_BLOCK_DIM, LRU_BLOCK_DIM), LRU_BLOCK_DIM ** -0.5),
        "b_rg": nrm(ks[12], (DEPTH, 2, D_LRU), 0.01),
        "w_ig": nrm(ks[14], (DEPTH, 2, LRU_BLOCKS, LRU_BLOCK_DIM, LRU_BLOCK_DIM), LRU_BLOCK_DIM ** -0.5),
        "b_ig": nrm(ks[15], (DEPTH, 2, D_LRU), 0.01),
        "lru_lambda": lru_lambda,
        "w_out": nrm(ks[16], (DEPTH, D_MODEL, D_MODEL), D_MODEL ** -0.5),
        "ffn_norm_g": gain(ks[17], (DEPTH, D_MODEL)),
        "w_gate": nrm(ks[18], (DEPTH, D_MODEL, D_FF), D_MODEL ** -0.5),
        "w_up": nrm(ks[19], (DEPTH, D_MODEL, D_FF), D_MODEL ** -0.5),
        "w_down": nrm(ks[20], (DEPTH, D_FF, D_MODEL), D_FF ** -0.5),
        "final_norm_g": gain(ks[21], (D_MODEL,)),
    }


def reference(x, attn_norm_g, w_in, lambda_q1, lambda_k1, lambda_q2, lambda_k2, subln_g,
              rel_bias, conv_w, conv_b, w_rg, b_rg, w_ig, b_ig, lru_lambda, w_out,
              ffn_norm_g, w_gate, w_up, w_down, final_norm_g):
    h = x
    for l in range(DEPTH):
        lambda_init = 0.8 - 0.6 * math.exp(-0.3 * l)
        n = rms_norm(h, attn_norm_g[l])
        proj = jnp.einsum('bsd,de->bse', n, w_in[l])
        q, k, v, xr, gr = jnp.split(
            proj, [D_ATTN, 2 * D_ATTN, 3 * D_ATTN, 3 * D_ATTN + D_LRU], axis=-1)
        lam = (jnp.exp(jnp.sum(lambda_q1[l].astype(jnp.float32) * lambda_k1[l].astype(jnp.float32)))
               - jnp.exp(jnp.sum(lambda_q2[l].astype(jnp.float32) * lambda_k2[l].astype(jnp.float32)))
               + lambda_init)
        y_attn = diff_attention(q, k, v, lam, rel_bias, subln_g[l], lambda_init)
        y_lru = bidirectional_rglru_group(xr, gr, conv_w[l], conv_b[l], w_rg[l], b_rg[l],
                                          w_ig[l], b_ig[l], lru_lambda[l])
        mixed = jnp.concatenate([y_attn, y_lru], axis=-1)
        h = h + jnp.einsum('bse,ed->bsd', mixed, w_out[l])
        n2 = rms_norm(h, ffn_norm_g[l])
        g = jnp.einsum('bsd,df->bsf', n2, w_gate[l])
        up = jnp.einsum('bsd,df->bsf', n2, w_up[l])
        h = h + jnp.einsum('bsf,fd->bsd', jax.nn.silu(g) * up, w_down[l])
    return rms_norm(h, final_norm_g)
```

```cpp
#include <hip/hip_runtime.h>
#include <cstdio>
#include <cstdint>
#include <cmath>

namespace nv {
constexpr int B = 8, S = 4096, D = 1024, M = B * S, DA = 512, DL = 512, H = 4, DH = 64, DV = 128, DFF = 2816, DIN = 2560;
constexpr float EPS = 1e-6f;

__device__ __forceinline__ float wave_sum(float v) {
#pragma unroll
    for (int o = 1; o < 64; o <<= 1) v += __shfl_xor(v, o);
    return v;
}

__global__ void __launch_bounds__(256) k_rmsnorm(const float* x, const float* g, float* out, int rows, int dim) {
    const int wave = (blockIdx.x * blockDim.x + threadIdx.x) >> 6, lane = threadIdx.x & 63;
    if (wave >= rows) return;
    const float* xr = x + (size_t)wave * dim; float* o = out + (size_t)wave * dim;
    float s = 0.f;
    for (int i = lane; i < dim; i += 64) { const float v = xr[i]; s += v * v; }
    s = wave_sum(s);
    const float r = rsqrtf(s / (float)dim + EPS);
    for (int i = lane; i < dim; i += 64) o[i] = xr[i] * r * g[i];
}

template <int MODE>
__global__ void __launch_bounds__(256) k_gemm(const float* A, int lda, const float* W, const float* W2, int ldw, float* C, int ldc, const float* R, int K) {
    __shared__ float As[16][68], Ws[16][68], Ws2[16][68];
    const int tid = threadIdx.x, tx = tid & 15, ty = tid >> 4;
    const int m0 = blockIdx.y * 64, n0 = blockIdx.x * 64;
    float acc[4][4], acc2[4][4];
#pragma unroll
    for (int i = 0; i < 4; ++i)
#pragma unroll
        for (int j = 0; j < 4; ++j) { acc[i][j] = 0.f; acc2[i][j] = 0.f; }
    for (int k0 = 0; k0 < K; k0 += 16) {
#pragma unroll
        for (int i = 0; i < 4; ++i) { const int e = tid + i * 256; const int mm = e >> 4, kk = e & 15; As[kk][mm] = A[(size_t)(m0 + mm) * lda + k0 + kk]; }
#pragma unroll
        for (int i = 0; i < 4; ++i) { const int e = tid + i * 256; const int kk = e >> 6, nn = e & 63; Ws[kk][nn] = W[(size_t)(k0 + kk) * ldw + n0 + nn];
            if (MODE == 2) Ws2[kk][nn] = W2[(size_t)(k0 + kk) * ldw + n0 + nn]; }
        __syncthreads();
#pragma unroll
        for (int kk = 0; kk < 16; ++kk) {
            float a[4], w[4], w2[4];
#pragma unroll
            for (int i = 0; i < 4; ++i) a[i] = As[kk][ty * 4 + i];
#pragma unroll
            for (int j = 0; j < 4; ++j) { w[j] = Ws[kk][tx * 4 + j]; if (MODE == 2) w2[j] = Ws2[kk][tx * 4 + j]; }
#pragma unroll
            for (int i = 0; i < 4; ++i)
#pragma unroll
                for (int j = 0; j < 4; ++j) { acc[i][j] += a[i] * w[j]; if (MODE == 2) acc2[i][j] += a[i] * w2[j]; }
        }
        __syncthreads();
    }
#pragma unroll
    for (int i = 0; i < 4; ++i)
#pragma unroll
        for (int j = 0; j < 4; ++j) {
            const size_t off = (size_t)(m0 + ty * 4 + i) * ldc + n0 + tx * 4 + j;
            float v = acc[i][j];
            if (MODE == 1) v += R[off];
            if (MODE == 2) { const float g = acc[i][j]; v = g / (1.f + __expf(-g)) * acc2[i][j]; }
            C[off] = v;
        }
}

__device__ __forceinline__ int t5_bucket(int rel) {
    const int ret = rel > 0 ? 16 : 0; const int n = rel < 0 ? -rel : rel;
    int b;
    if (n < 8) b = n; else { b = 2 + (31 - __clz(n * n)); if (b > 15) b = 15; }
    return ret + b;
}

__global__ void __launch_bounds__(256) k_attn(const float* q, const float* k, const float* v, const float* rel_bias, const float* subln_g,
                                               const float* lq1, const float* lk1, const float* lq2, const float* lk2, float* mixed) {
    __shared__ float Qs[2][16][64];
    __shared__ float Ks[2][32][65];
    __shared__ float Vs[32][128];
    __shared__ float Ps[2][16][32];
    __shared__ float bias_s[32];
    const int tid = threadIdx.x, r = tid >> 4, c = tid & 15;
    const int qb = blockIdx.x, h = blockIdx.y, b = blockIdx.z;
    const int q0 = qb * 16;
    const size_t rowbase = (size_t)b * S;
    if (tid < 32) bias_s[tid] = rel_bias[tid * H + h];
    for (int e = tid; e < 2 * 16 * 64; e += 256) { const int s = e >> 10, rr = (e >> 6) & 15, d = e & 63; Qs[s][rr][d] = q[(rowbase + q0 + rr) * 512 + h * 128 + s * 64 + d]; }
    float lam;
    { float s1 = 0.f, s2 = 0.f; for (int i = 0; i < 64; ++i) { s1 += lq1[i] * lk1[i]; s2 += lq2[i] * lk2[i]; } lam = expf(s1) - expf(s2) + 0.2f; }
    float m1 = -1e30f, m2 = -1e30f, l1 = 0.f, l2 = 0.f;
    float o1[8], o2[8];
#pragma unroll
    for (int j = 0; j < 8; ++j) { o1[j] = 0.f; o2[j] = 0.f; }
    __syncthreads();
    for (int t = 0; t < S / 32; ++t) {
        const int k0 = t * 32;
        for (int e = tid; e < 2 * 32 * 64; e += 256) { const int s = e >> 11, kk = (e >> 6) & 31, d = e & 63; Ks[s][kk][d] = k[(rowbase + k0 + kk) * 512 + h * 128 + s * 64 + d]; }
        for (int e = tid; e < 32 * 128; e += 256) { const int kk = e >> 7, d = e & 127; Vs[kk][d] = v[(rowbase + k0 + kk) * 512 + h * 128 + d]; }
        __syncthreads();
        float s1[2], s2[2];
#pragma unroll
        for (int j = 0; j < 2; ++j) {
            const int kk = c + 16 * j; float a1 = 0.f, a2 = 0.f;
            for (int d = 0; d < 64; ++d) { a1 += Qs[0][r][d] * Ks[0][kk][d]; a2 += Qs[1][r][d] * Ks[1][kk][d]; }
            const float bb = bias_s[t5_bucket((k0 + kk) - (q0 + r))];
            s1[j] = a1 * 0.125f + bb; s2[j] = a2 * 0.125f + bb;
        }
        float mx1 = fmaxf(s1[0], s1[1]), mx2 = fmaxf(s2[0], s2[1]);
#pragma unroll
        for (int o = 1; o < 16; o <<= 1) { mx1 = fmaxf(mx1, __shfl_xor(mx1, o)); mx2 = fmaxf(mx2, __shfl_xor(mx2, o)); }
        const float mn1 = fmaxf(m1, mx1), mn2 = fmaxf(m2, mx2);
        const float al1 = __expf(m1 - mn1), al2 = __expf(m2 - mn2);
        float ps1 = 0.f, ps2 = 0.f;
#pragma unroll
        for (int j = 0; j < 2; ++j) { const float p1 = __expf(s1[j] - mn1), p2 = __expf(s2[j] - mn2); ps1 += p1; ps2 += p2; Ps[0][r][c + 16 * j] = p1; Ps[1][r][c + 16 * j] = p2; }
#pragma unroll
        for (int o = 1; o < 16; o <<= 1) { ps1 += __shfl_xor(ps1, o); ps2 += __shfl_xor(ps2, o); }
        l1 = l1 * al1 + ps1; l2 = l2 * al2 + ps2; m1 = mn1; m2 = mn2;
#pragma unroll
        for (int j = 0; j < 8; ++j) { o1[j] *= al1; o2[j] *= al2; }
        __syncthreads();
        for (int kk = 0; kk < 32; ++kk) {
            const float p1 = Ps[0][r][kk], p2 = Ps[1][r][kk];
#pragma unroll
            for (int j = 0; j < 8; ++j) { const float vv = Vs[kk][c * 8 + j]; o1[j] += p1 * vv; o2[j] += p2 * vv; }
        }
        __syncthreads();
    }
    float d[8], ss = 0.f;
#pragma unroll
    for (int j = 0; j < 8; ++j) { d[j] = o1[j] / l1 - lam * (o2[j] / l2); ss += d[j] * d[j]; }
#pragma unroll
    for (int o = 1; o < 16; o <<= 1) ss += __shfl_xor(ss, o);
    const float rs = rsqrtf(ss / 128.f + EPS) * 0.8f;
#pragma unroll
    for (int j = 0; j < 8; ++j) mixed[(rowbase + q0 + r) * 1024 + h * 128 + c * 8 + j] = d[j] * rs * subln_g[c * 8 + j];
}

__global__ void __launch_bounds__(256) k_conv(const float* xr, const float* cw, const float* cb, float* xc) {
    const size_t idx = (size_t)blockIdx.x * 256 + threadIdx.x;
    const int c = (int)(idx & 511); const size_t row = idx >> 9; const int t = (int)(row & (S - 1));
    float acc = cb[c];
#pragma unroll
    for (int j = 0; j < 4; ++j) { const int tt = t + j - 2; if (tt >= 0 && tt < S) acc += cw[j * 512 + c] * xr[(row + j - 2) * 512 + c]; }
    xc[idx] = acc;
}
__global__ void __launch_bounds__(256) k_gates(const float* xc, const float* wr, const float* br, const float* wi, const float* bi, const float* lam, float* a, float* u) {
    const size_t idx = (size_t)blockIdx.x * 256 + threadIdx.x;
    const int c = (int)(idx & 511); const size_t row = idx >> 9; const int n = c >> 6, e = c & 63;
    const float* xb = xc + row * 512 + n * 64;
    float ar = br[c], ai = bi[c];
    for (int d = 0; d < 64; ++d) { const float xv = xb[d]; ar += xv * wr[(n * 64 + d) * 64 + e]; ai += xv * wi[(n * 64 + d) * 64 + e]; }
    const float r = 1.f / (1.f + expf(-ar)), ig = 1.f / (1.f + expf(-ai));
    const float lm = lam[c]; const float sp = (-lm > 20.f) ? -lm : log1pf(expf(-lm));
    const float la = -8.f * r * sp;
    const float av = expf(la);
    a[idx] = av; u[idx] = sqrtf(-expm1f(2.f * la)) * (ig * xc[idx]);
}
__global__ void __launch_bounds__(64) k_scan(const float* a, const float* u, float* mixed, int reverse, int accum) {
    const int idx = blockIdx.x * 64 + threadIdx.x;
    const int c = idx & 511, b = idx >> 9;
    float h = 0.f;
    for (int i = 0; i < S; ++i) {
        const int t = reverse ? S - 1 - i : i; const size_t row = (size_t)b * S + t;
        h = a[row * 512 + c] * h + u[row * 512 + c];
        float* o = mixed + row * 1024 + 512 + c;
        *o = accum ? (*o + h) : h;
    }
}
__global__ void __launch_bounds__(256) k_lru_out(const float* gr, float* mixed) {
    const size_t idx = (size_t)blockIdx.x * 256 + threadIdx.x;
    const int c = (int)(idx & 511); const size_t row = idx >> 9;
    const float x = gr[idx];
    const float g = 0.5f * x * (1.f + tanhf(0.7978845608028654f * (x + 0.044715f * x * x * x)));
    mixed[row * 1024 + 512 + c] *= g;
}
}

extern "C" void kernel_launch(void* const* d_in, const int* in_sizes, int n_in, void* d_out, int out_size, void* d_ws, size_t ws_size, hipStream_t stream) {
    using namespace nv;
    const float* x = (const float*)d_in[0]; const float* attn_g = (const float*)d_in[1]; const float* w_in = (const float*)d_in[2];
    const float* lq1 = (const float*)d_in[3]; const float* lk1 = (const float*)d_in[4]; const float* lq2 = (const float*)d_in[5]; const float* lk2 = (const float*)d_in[6];
    const float* subln_g = (const float*)d_in[7]; const float* rel_bias = (const float*)d_in[8]; const float* conv_w = (const float*)d_in[9]; const float* conv_b = (const float*)d_in[10];
    const float* w_rg = (const float*)d_in[11]; const float* b_rg = (const float*)d_in[12]; const float* w_ig = (const float*)d_in[13]; const float* b_ig = (const float*)d_in[14];
    const float* lru_lambda = (const float*)d_in[15]; const float* w_out = (const float*)d_in[16]; const float* ffn_g = (const float*)d_in[17];
    const float* w_gate = (const float*)d_in[18]; const float* w_up = (const float*)d_in[19]; const float* w_down = (const float*)d_in[20]; const float* final_g = (const float*)d_in[21];
    float* out = (float*)d_out; char* ws = (char*)d_ws;
    const size_t MiB = 1u << 20;
    if (ws_size < 448 * MiB) { fprintf(stderr, "ws too small: %zu\n", ws_size); return; }
    float* nbuf = (float*)(ws);
    float* qb = (float*)(ws + 128 * MiB), *kb = (float*)(ws + 192 * MiB), *vb = (float*)(ws + 256 * MiB), *xrb = (float*)(ws + 320 * MiB), *grb = (float*)(ws + 384 * MiB);
    float* mixed = nbuf;
    k_rmsnorm<<<M / 4, 256, 0, stream>>>(x, attn_g, nbuf, M, D);
    float* parts[5] = {qb, kb, vb, xrb, grb};
    for (int p = 0; p < 5; ++p) k_gemm<0><<<dim3(512 / 64, M / 64), 256, 0, stream>>>(nbuf, D, w_in + p * 512, nullptr, DIN, parts[p], 512, nullptr, D);
    k_attn<<<dim3(S / 16, H, B), 256, 0, stream>>>(qb, kb, vb, rel_bias, subln_g, lq1, lk1, lq2, lk2, mixed);
    float* xc = qb; float* ab = kb; float* ub = vb;
    k_conv<<<M * 512 / 256, 256, 0, stream>>>(xrb, conv_w, conv_b, xc);
    for (int dir = 0; dir < 2; ++dir) {
        k_gates<<<M * 512 / 256, 256, 0, stream>>>(xc, w_rg + dir * 8 * 64 * 64, b_rg + dir * 512, w_ig + dir * 8 * 64 * 64, b_ig + dir * 512, lru_lambda + dir * 512, ab, ub);
        k_scan<<<B * 512 / 64, 64, 0, stream>>>(ab, ub, mixed, dir, dir);
    }
    k_lru_out<<<M * 512 / 256, 256, 0, stream>>>(grb, mixed);
    k_gemm<1><<<dim3(D / 64, M / 64), 256, 0, stream>>>(mixed, D, w_out, nullptr, D, out, D, x, D);
    float* n2 = (float*)(ws + 448 * MiB - 0);
    n2 = nbuf;
    k_rmsnorm<<<M / 4, 256, 0, stream>>>(out, ffn_g, n2, M, D);
    float* act = (float*)(ws + 128 * MiB);
    if (ws_size < 480 * MiB) { fprintf(stderr, "ws too small for act: %zu\n", ws_size); return; }
    k_gemm<2><<<dim3(DFF / 64, M / 64), 256, 0, stream>>>(n2, D, w_gate, w_up, DFF, act, DFF, nullptr, D);
    k_gemm<1><<<dim3(D / 64, M / 64), 256, 0, stream>>>(act, DFF, w_down, nullptr, D, out, D, out, DFF);
    k_rmsnorm<<<M / 4, 256, 0, stream>>>(out, final_g, out, M, D);
}
```

```cpp
#include <hip/hip_runtime.h>
#include <hip/hip_cooperative_groups.h>
#include <cstdio>
#include <cstdint>
#include <cmath>
#define STAGE 4
namespace pg8 {
#define PG8_LAS __attribute__((address_space(3)))
typedef unsigned short bf16_t;
typedef short bf16x8 __attribute__((ext_vector_type(8)));
typedef float f32x4 __attribute__((ext_vector_type(4)));
typedef unsigned u32x4 __attribute__((ext_vector_type(4)));
constexpr int BM = 256, BK = 64, HALF = 128, HTB = HALF * BK * 2  , STAGE_BYTES = 8 * HTB, NXCD = 8, WGM = 8;

__host__ __device__ __forceinline__ int lds_byte(int r, int c) { const int st = (r >> 4) * 2 + (c >> 5), rr = r & 15, cc = c & 31, ob = rr * 64 + cc * 2; return st * 1024 + (ob ^ (((ob >> 9) & 1) << 5)); }
__host__ __device__ __forceinline__ void stage_rc(int b, int& R, int& C) { const int st = b / 1024, sb = b % 1024, swz = sb ^ (((sb >> 9) & 1) << 5); R = (st >> 1) * 16 + swz / 64; C = (st & 1) * 32 + (swz % 64) / 2; }
__host__ __device__ __forceinline__ int perm32(int rho) { const int n = rho >> 4, i = rho & 15; return 8 * (i >> 2) + 4 * n + (i & 3); }

struct Unit { int pm, pn; };
struct Gemm { const bf16_t* A; const bf16_t* Bt; int M, N, K; };

struct StaticOrder {
    int nM, nN, nwg, G, c;
    __host__ __device__ void init(int M, int N, int G_, int c_) { nM = M / BM; nN = N / BM; nwg = nM * nN; G = G_; c = c_; }
    __host__ __device__ bool next(int i, Unit& u) const {
        const long L = (long)i * G + c; if (L >= nwg) return false;
        int wgid = (int)L; { const int q = nwg / NXCD, r = nwg % NXCD, xcd = wgid % NXCD, off = wgid / NXCD; wgid = (xcd < r ? xcd * (q + 1) : r * (q + 1) + (xcd - r) * q) + off; }
        const int nig = WGM * nN, gid = wgid / nig, fm = gid * WGM, gsz = (nM - fm) < WGM ? (nM - fm) : WGM;
        u.pm = fm + ((wgid % nig) % gsz); u.pn = (wgid % nig) / gsz; return true;
    }
    __device__ __forceinline__ void a_ready(const Unit&) const {}
    __device__ __forceinline__ void done(const Unit&) const {}
};

__device__ __forceinline__ unsigned cvt_pk_bf16(float lo, float hi) { unsigned r; asm volatile("v_cvt_pk_bf16_f32 %0, %1, %2" : "=v"(r) : "v"(lo), "v"(hi)); return r; }
typedef float f32x2 __attribute__((ext_vector_type(2)));
typedef unsigned u32x2 __attribute__((ext_vector_type(2)));
__device__ __forceinline__ u32x4 pack8(f32x4 v0, f32x4 v1) { u32x4 w; w.x = cvt_pk_bf16(v0[0], v0[1]); w.y = cvt_pk_bf16(v0[2], v0[3]); w.z = cvt_pk_bf16(v1[0], v1[1]); w.w = cvt_pk_bf16(v1[2], v1[3]); return w; }
struct EpiInProj {
    static constexpr bool PERM = true, AFTER_DRAIN = false;
    bf16_t *Q, *KT, *VT, *XR, *GR; float qscale;
    __device__ __forceinline__ void operator()(const f32x4 (&acc)[2][2][4][2], const Unit& u, int wr, int wc, int fr, int fq) const {
        const int sec = u.pn >> 1, half = u.pn & 1;
#pragma unroll
        for (int ai = 0; ai < 2; ++ai)
#pragma unroll
            for (int m = 0; m < 4; ++m) {
                const int row = u.pm * BM + ai * HALF + wr * 64 + m * 16 + fr;
                const int b = row >> 12, tok = row & 4095, t = tok >> 6, rr = tok & 63;
#pragma unroll
                for (int bj = 0; bj < 2; ++bj) {
                    f32x4 v0 = acc[ai][bj][m][0], v1 = acc[ai][bj][m][1];
                    const int cs = half * 256 + bj * HALF + wc * 32 + 8 * fq;
                    if (sec == 0) { v0 = v0 * qscale; v1 = v1 * qscale; *(u32x4*)(Q + (size_t)row * 512 + cs) = pack8(v0, v1); }
                    else if (sec == 1) { const int h = half * 2 + bj, s = wc >> 1, chunk = 4 * (wc & 1) + fq;
                        *(u32x4*)(KT + ((((size_t)(b * 4 + h) * 2 + s) * 64 + t) * 8 + chunk) * 512 + rr * 8) = pack8(v0, v1); }
                    else if (sec == 2) { const int h = half * 2 + bj;
                        *(u32x4*)(VT + (((size_t)(b * 4 + h) * 64 + t) * 4 + wc) * 2048 + rr * 32 + 8 * fq) = pack8(v0, v1); }
                    else if (sec == 3) { *(u32x4*)(XR + (size_t)row * 512 + cs) = pack8(v0, v1); }
                    else { *(u32x4*)(GR + (size_t)row * 512 + cs) = pack8(v0, v1); }
                }
            }
    }
};
template <bool WRITE_HB> struct EpiResid {
    static constexpr bool PERM = false, AFTER_DRAIN = false;
    const float* base; float* out; bf16_t* hb; float* rss; int ldc;
    __device__ __forceinline__ void operator()(const f32x4 (&acc)[2][2][4][2], const Unit& u, int wr, int wc, int fr, int fq) const {
        const int col0 = u.pn * BM + wc * 32 + 4 * fq;
#pragma unroll
        for (int ai = 0; ai < 2; ++ai)
#pragma unroll
            for (int m = 0; m < 4; ++m) {
                const int row = u.pm * BM + ai * HALF + wr * 64 + m * 16 + fr; const size_t off = (size_t)row * ldc + col0; float ss = 0.f;
#pragma unroll
                for (int bj = 0; bj < 2; ++bj)
#pragma unroll
                    for (int n = 0; n < 2; ++n) {
                        const f32x4 bs = *(const f32x4*)(base + off + bj * HALF + n * 16); const f32x4 o = acc[ai][bj][m][n] + bs;
                        *(f32x4*)(out + off + bj * HALF + n * 16) = o;
                        if (WRITE_HB) { u32x2 w; w.x = cvt_pk_bf16(o[0], o[1]); w.y = cvt_pk_bf16(o[2], o[3]); *(u32x2*)(hb + off + bj * HALF + n * 16) = w; }
                        ss += (o[0] * o[0] + o[1] * o[1]) + (o[2] * o[2] + o[3] * o[3]);
                    }
                ss += __shfl_xor(ss, 16); ss += __shfl_xor(ss, 32);
                if (fq == 0) rss[(size_t)row * 16 + u.pn * 4 + wc] = ss;
            }
    }
};
struct EpiGateUp {
    static constexpr bool PERM = true, AFTER_DRAIN = false;
    bf16_t* act; const float* rss; int ldo; float eps;
    __device__ __forceinline__ void operator()(const f32x4 (&acc)[2][2][4][2], const Unit& u, int wr, int wc, int fr, int fq) const {
        const int col0 = u.pn * HALF + wc * 32 + 8 * fq;
#pragma unroll
        for (int ai = 0; ai < 2; ++ai)
#pragma unroll
            for (int m = 0; m < 4; ++m) {
                const int row = u.pm * BM + ai * HALF + wr * 64 + m * 16 + fr;
                const f32x4* rp = (const f32x4*)(rss + (size_t)row * 16); const f32x4 s0 = rp[0], s1 = rp[1], s2 = rp[2], s3 = rp[3];
                const float tot = ((s0[0] + s0[1]) + (s0[2] + s0[3])) + ((s1[0] + s1[1]) + (s1[2] + s1[3])) + ((s2[0] + s2[1]) + (s2[2] + s2[3])) + ((s3[0] + s3[1]) + (s3[2] + s3[3]));
                const float rstd = __builtin_amdgcn_rsqf(tot * (1.0f / 1024.0f) + eps);
                f32x4 o[2];
#pragma unroll
                for (int n = 0; n < 2; ++n) {
                    const f32x4 g = acc[ai][0][m][n] * rstd, up = acc[ai][1][m][n] * rstd;
#pragma unroll
                    for (int i = 0; i < 4; ++i) { const float e = __builtin_amdgcn_exp2f(g[i] * -1.4426950408889634f); o[n][i] = g[i] * __builtin_amdgcn_rcpf(1.0f + e) * up[i]; }
                }
                *(u32x4*)(act + (size_t)row * ldo + col0) = pack8(o[0], o[1]);
            }
    }
};
template <class Epi, class Sched, bool ALIGN_EPI = false, bool SP2 = false>
__device__ __forceinline__ void gemm_phase(PG8_LAS unsigned char* lds, const Gemm g, const Sched& S, const Epi& E) {
    const int tid = threadIdx.x, wid = __builtin_amdgcn_readfirstlane(tid >> 6), lane = tid & 63, wr = wid >> 2, wc = wid & 3, fr = lane & 15, fq = lane >> 4;
    const int K = g.K, nt = K / BK;
    unsigned voffA[2], voffB[2];
#pragma unroll
    for (int i = 0; i < 2; ++i) { int R, C; stage_rc(tid * 16 + i * 8192, R, C); const int Rb = Epi::PERM ? ((R & ~31) + perm32(R & 31)) : R;
        voffA[i] = (unsigned)(R * K + C) * 2u; voffB[i] = (unsigned)(Rb * K + C) * 2u; }
    const size_t kstep = (size_t)(BK * 2);
    const size_t hstep = (size_t)HALF * K * 2;
    const size_t tstep = 2 * hstep;
    const unsigned ldsw = (unsigned)wid * 1024u;
    const int aoff = lds_byte(wr * 64 + fr, fq * 8), boff = lds_byte(wc * 32 + fr, fq * 8);
#define PG8_SA(b, h) (((b) * 2 + (h)) * HTB)
#define PG8_SB(b, h) ((4 + (b) * 2 + (h)) * HTB)
#define PG8_STAGE(bufoff, gbase, voff) do { _Pragma("unroll") for (int _i = 0; _i < 2; ++_i) \
        __builtin_amdgcn_global_load_lds((const unsigned*)((const char*)(gbase) + (voff)[_i]), (PG8_LAS unsigned*)(lds + (bufoff) + ldsw + _i * 8192), 16, 0, 0); } while (0)
#define PG8_LDA(dst, b, h) do { _Pragma("unroll") for (int m = 0; m < 4; ++m) _Pragma("unroll") for (int k = 0; k < 2; ++k) dst[m][k] = *(const PG8_LAS bf16x8*)(lds + PG8_SA(b, h) + aoff + m * 2048 + k * 1024); } while (0)
#define PG8_LDB(dst, b, h) do { _Pragma("unroll") for (int n = 0; n < 2; ++n) _Pragma("unroll") for (int k = 0; k < 2; ++k) dst[n][k] = *(const PG8_LAS bf16x8*)(lds + PG8_SB(b, h) + boff + n * 2048 + k * 1024); } while (0)
#define PG8_MMA(ai, bj, At, Bt) do { __builtin_amdgcn_s_setprio(1); _Pragma("unroll") for (int m = 0; m < 4; ++m) _Pragma("unroll") for (int n = 0; n < 2; ++n) _Pragma("unroll") for (int k = 0; k < 2; ++k) \
        acc[ai][bj][m][n] = __builtin_amdgcn_mfma_f32_16x16x32_bf16(Bt[n][k], At[m][k], acc[ai][bj][m][n], 0, 0, 0); __builtin_amdgcn_s_setprio(0); } while (0)
#define PG8_WAIT_V(n) asm volatile("s_waitcnt vmcnt(" #n ")" ::: "memory")
#define PG8_WAIT_L(n) asm volatile("s_waitcnt lgkmcnt(" #n ")" ::: "memory")
#define PG8_BAR __builtin_amdgcn_s_barrier()
#define PG8_SCHED __builtin_amdgcn_sched_barrier(0)
    Unit cur, nxt; int ui = 0;
    if (!S.next(0, cur)) return;
    f32x4 acc[2][2][4][2];
#pragma unroll
    for (int a = 0; a < 2; ++a)
#pragma unroll
        for (int b = 0; b < 2; ++b)
#pragma unroll
            for (int m = 0; m < 4; ++m)
#pragma unroll
                for (int n = 0; n < 2; ++n) acc[a][b][m][n] = (f32x4){0.f, 0.f, 0.f, 0.f};
    bf16x8 At[4][2], B0[2][2], B1[2][2];
    const char* cA = (const char*)g.A + (size_t)cur.pm * tstep; const char* cB = (const char*)g.Bt + (size_t)cur.pn * tstep;
    S.a_ready(cur);
    if constexpr (SP2) {
        PG8_STAGE(PG8_SB(0, 0), cB, voffB); PG8_STAGE(PG8_SB(0, 1), cB + hstep, voffB); PG8_STAGE(PG8_SA(0, 0), cA, voffA); PG8_STAGE(PG8_SA(0, 1), cA + hstep, voffA);
        if (wr == 1) PG8_BAR;
        PG8_WAIT_V(2); PG8_BAR;
        PG8_STAGE(PG8_SB(1, 0), cB + kstep, voffB); PG8_STAGE(PG8_SA(1, 0), cA + kstep, voffA); PG8_STAGE(PG8_SB(1, 1), cB + hstep + kstep, voffB);
        PG8_WAIT_V(6); PG8_BAR;
    } else {
        PG8_STAGE(PG8_SB(0, 0), cB, voffB); PG8_STAGE(PG8_SA(0, 0), cA, voffA); PG8_STAGE(PG8_SB(0, 1), cB + hstep, voffB); PG8_STAGE(PG8_SA(0, 1), cA + hstep, voffA);
        if (wr == 1) PG8_BAR;
        PG8_WAIT_V(4); PG8_BAR;
        PG8_STAGE(PG8_SB(1, 0), cB + kstep, voffB); PG8_STAGE(PG8_SA(1, 0), cA + kstep, voffA); PG8_STAGE(PG8_SB(1, 1), cB + hstep + kstep, voffB);
        PG8_WAIT_V(6); PG8_BAR;
    }
    for (;;) {
        const bool has_next = S.next(ui + 1, nxt);
        const char* nA = has_next ? (const char*)g.A + (size_t)nxt.pm * tstep : cA; const char* nB = has_next ? (const char*)g.Bt + (size_t)nxt.pn * tstep : cB;
        for (int t = 0; t < nt; t += 2) {
            const bool last = (t == nt - 2);
            const char* a1 = cA + (size_t)(t + 1) * kstep;
            const char* a2 = last ? nA : cA + (size_t)(t + 2) * kstep; const char* b2 = last ? nB : cB + (size_t)(t + 2) * kstep;
            const char* a3 = a2 + kstep; const char* b3 = b2 + kstep;
            if (last && has_next) S.a_ready(nxt);
            if constexpr (SP2) {
            PG8_LDB(B0, 0, 0); PG8_LDB(B1, 0, 1); PG8_SCHED; PG8_LDA(At, 0, 0); PG8_STAGE(PG8_SA(1, 1), a1 + hstep, voffA);
            PG8_WAIT_V(8); PG8_WAIT_L(0); PG8_BAR; PG8_MMA(0, 0, At, B0); PG8_MMA(0, 1, At, B1); PG8_BAR; PG8_SCHED;
            PG8_LDA(At, 0, 1); PG8_STAGE(PG8_SB(0, 0), b2, voffB); PG8_STAGE(PG8_SB(0, 1), b2 + hstep, voffB); PG8_STAGE(PG8_SA(0, 0), a2, voffA);
            PG8_WAIT_V(8); PG8_WAIT_L(0); PG8_BAR; PG8_MMA(1, 0, At, B0); PG8_MMA(1, 1, At, B1); PG8_BAR; PG8_SCHED;
            PG8_LDB(B0, 1, 0); PG8_LDB(B1, 1, 1); PG8_SCHED; PG8_LDA(At, 1, 0); PG8_STAGE(PG8_SA(0, 1), a2 + hstep, voffA);
            PG8_WAIT_V(8); PG8_WAIT_L(0); PG8_BAR; PG8_MMA(0, 0, At, B0); PG8_MMA(0, 1, At, B1); PG8_BAR; PG8_SCHED;
            PG8_LDA(At, 1, 1); PG8_STAGE(PG8_SB(1, 0), b3, voffB); PG8_STAGE(PG8_SB(1, 1), b3 + hstep, voffB); PG8_STAGE(PG8_SA(1, 0), a3, voffA);
            PG8_WAIT_V(8); PG8_WAIT_L(0); PG8_BAR; PG8_MMA(1, 0, At, B0); PG8_MMA(1, 1, At, B1); PG8_BAR; PG8_SCHED;
            } else {
            PG8_LDB(B0, 0, 0); PG8_SCHED; PG8_LDA(At, 0, 0); PG8_STAGE(PG8_SA(1, 1), a1 + hstep, voffA);
            PG8_WAIT_L(8); PG8_BAR; PG8_WAIT_L(0); PG8_MMA(0, 0, At, B0); PG8_BAR; PG8_SCHED;
            PG8_LDB(B1, 0, 1); PG8_STAGE(PG8_SB(0, 0), b2, voffB);
            PG8_BAR; PG8_WAIT_L(0); PG8_MMA(0, 1, At, B1); PG8_BAR;
            PG8_LDA(At, 0, 1); PG8_STAGE(PG8_SA(0, 0), a2, voffA);
            PG8_BAR; PG8_WAIT_L(0); PG8_MMA(1, 0, At, B0); PG8_BAR; PG8_SCHED;
            PG8_STAGE(PG8_SB(0, 1), b2 + hstep, voffB);
            PG8_WAIT_V(6); PG8_BAR; PG8_MMA(1, 1, At, B1); PG8_BAR;
            PG8_LDB(B0, 1, 0); PG8_SCHED; PG8_LDA(At, 1, 0); PG8_STAGE(PG8_SA(0, 1), a2 + hstep, voffA);
            PG8_WAIT_L(8); PG8_BAR; PG8_WAIT_L(0); PG8_MMA(0, 0, At, B0); PG8_BAR; PG8_SCHED;
            PG8_LDB(B1, 1, 1); PG8_STAGE(PG8_SB(1, 0), b3, voffB);
            PG8_BAR; PG8_WAIT_L(0); PG8_MMA(0, 1, At, B1); PG8_BAR;
            PG8_LDA(At, 1, 1); PG8_STAGE(PG8_SA(1, 0), a3, voffA);
            PG8_BAR; PG8_WAIT_L(0); PG8_MMA(1, 0, At, B0); PG8_BAR; PG8_SCHED;
            PG8_STAGE(PG8_SB(1, 1), b3 + hstep, voffB);
            PG8_WAIT_V(6); PG8_BAR; PG8_MMA(1, 1, At, B1); PG8_BAR;
            }
        }
        if constexpr (ALIGN_EPI) { if (wr == 0) PG8_BAR; }
        if constexpr (!Epi::AFTER_DRAIN) { E(acc, cur, wr, wc, fr, fq); S.done(cur); }
        if (!has_next) break;
#pragma unroll
        for (int a = 0; a < 2; ++a)
#pragma unroll
            for (int b = 0; b < 2; ++b)
#pragma unroll
                for (int m = 0; m < 4; ++m)
#pragma unroll
                    for (int n = 0; n < 2; ++n) acc[a][b][m][n] = (f32x4){0.f, 0.f, 0.f, 0.f};
        cur = nxt; cA = nA; cB = nB; ++ui;
        if constexpr (ALIGN_EPI) { if (wr == 1) PG8_BAR; }
    }
    PG8_WAIT_V(0);
    if constexpr (!ALIGN_EPI) { if (wr == 0) PG8_BAR; }
    PG8_BAR;
    if constexpr (Epi::AFTER_DRAIN) { E.fused(acc, cur, wr, wc, fr, fq, lds, wid, lane); S.done(cur); }
#undef PG8_SA
#undef PG8_SB
#undef PG8_STAGE
#undef PG8_LDA
#undef PG8_LDB
#undef PG8_MMA
#undef PG8_WAIT_V
#undef PG8_WAIT_L
#undef PG8_BAR
#undef PG8_SCHED
}
}
namespace mk {
#define LAS __attribute__((address_space(3)))
typedef unsigned short bf16_t;
typedef short bf16x8 __attribute__((ext_vector_type(8)));
typedef short s16x4 __attribute__((ext_vector_type(4)));
typedef float f32x4 __attribute__((ext_vector_type(4)));
typedef float f32x16 __attribute__((ext_vector_type(16)));
typedef unsigned u32x4 __attribute__((ext_vector_type(4)));
typedef unsigned u32x2 __attribute__((ext_vector_type(2)));
constexpr int NB = 8, S = 4096, D = 1024, M = NB * S, NH = 4, DFF = 2816, DIN = 2560, NWAVES = 8;
constexpr float EPS = 1e-6f, LOG2E = 1.4426950408889634f;
constexpr float QSCALE = 0.125f * LOG2E;
constexpr size_t MiB = 1u << 20;
constexpr size_t WS_WIN = 1 * MiB, WS_WOUT = 6 * MiB, WS_WGU = 8 * MiB, WS_WDN = 19 * MiB, WS_RSS1 = 25 * MiB, WS_RSS2 = 27 * MiB;
constexpr size_t WS_XN = 32 * MiB, WS_Q = 96 * MiB, WS_KT = 128 * MiB, WS_VT = 160 * MiB, WS_XR = 192 * MiB, WS_GR = 224 * MiB, WS_HF = 256 * MiB, WS_MIXED = 320 * MiB, WS_ACT = 96 * MiB, WS_END = 384 * MiB;
static_assert(WS_ACT + (size_t)M * DFF * 2 <= WS_MIXED, "act overlays Q..HF only");
constexpr int RING_BYTES = 131072, LDS_MISC = 131072, LDS_BYTES = 147456;

__device__ __forceinline__ unsigned cvt_pk_bf16(float lo, float hi) { unsigned r; asm volatile("v_cvt_pk_bf16_f32 %0, %1, %2" : "=v"(r) : "v"(lo), "v"(hi)); return r; }
__device__ __forceinline__ float bf2f(unsigned short b) { return __uint_as_float(((unsigned)b) << 16); }
__device__ __forceinline__ float wave_sum(float v) {
#pragma unroll
    for (int o = 1; o < 64; o <<= 1) v += __shfl_xor(v, o);
    return v;
}
__device__ __forceinline__ float fast_sigmoid(float x) { return __builtin_amdgcn_rcpf(1.0f + __builtin_amdgcn_exp2f(-LOG2E * x)); }

template <int MAP  >
__device__ __forceinline__ void p0_transpose_item(const float* W, int K, int N, bf16_t* WT, const float* gk, LAS float* scr, int item, int lane) {
    const int nblk = N / 32, kb = item / nblk, nb = item % nblk, k0 = 64 * kb, n0 = 32 * nb;
#pragma unroll 8
    for (int i = 0; i < 32; ++i) { const int kk = 2 * i + (lane >> 5); float v = W[(size_t)(k0 + kk) * N + n0 + (lane & 31)]; if (gk) v *= gk[k0 + kk]; scr[kk * 33 + (lane & 31)] = v; }
    asm volatile("s_waitcnt lgkmcnt(0)" ::: "memory");
    const int c = lane & 7;
#pragma unroll
    for (int j = 0; j < 4; ++j) { const int n = (lane >> 3) + 8 * j; const LAS float* s = scr + (8 * c) * 33 + n;
        u32x4 o; o.x = cvt_pk_bf16(s[0 * 33], s[1 * 33]); o.y = cvt_pk_bf16(s[2 * 33], s[3 * 33]); o.z = cvt_pk_bf16(s[4 * 33], s[5 * 33]); o.w = cvt_pk_bf16(s[6 * 33], s[7 * 33]);
        const int f = n0 + n; const int drow = (MAP == 0) ? f : (256 * (f >> 7) + (f & 127) + (MAP == 2 ? 128 : 0));
        *(u32x4*)(WT + (size_t)drow * K + k0 + 8 * c) = o; }
    asm volatile("s_waitcnt lgkmcnt(0)" ::: "memory");
}
__device__ __forceinline__ void rms_row_to_bf16(const float* xrow, const float* g, bf16_t* orow, int lane) {
    const f32x4* xr = (const f32x4*)xrow + lane; const f32x4* gr = (const f32x4*)g + lane;
    f32x4 v[4]; float s = 0.f;
#pragma unroll
    for (int j = 0; j < 4; ++j) { v[j] = xr[64 * j]; s += (v[j][0] * v[j][0] + v[j][1] * v[j][1]) + (v[j][2] * v[j][2] + v[j][3] * v[j][3]); }
    const float rstd = 1.0f / sqrtf(wave_sum(s) * (1.f / D) + EPS);
    u32x2* o8 = (u32x2*)orow + lane;
#pragma unroll
    for (int j = 0; j < 4; ++j) { const f32x4 gg = gr[64 * j]; u32x2 w; w.x = cvt_pk_bf16(v[j][0] * rstd * gg[0], v[j][1] * rstd * gg[1]); w.y = cvt_pk_bf16(v[j][2] * rstd * gg[2], v[j][3] * rstd * gg[3]); o8[64 * j] = w; }
}

namespace att {
constexpr int NT = S / 64, SLOT = 16384, LDS_K = 0, LDS_V = 3 * SLOT, LDS_OST = 6 * SLOT, LDS_X = 0;
constexpr int LDS_WSF = LDS_MISC, LDS_BIAS = LDS_MISC + 2048, LDS_TOT = LDS_MISC + 3072;
constexpr int THR = 8;
typedef LAS const char* lds_cptr;
typedef short v4i16_t __attribute__((ext_vector_type(4)));
__device__ __forceinline__ int crow(int r, int hi) { return (r & 3) + 8 * (r >> 2) + 4 * hi; }
__device__ __forceinline__ void glds16(const void* gsrc, unsigned lds_dst) { unsigned keep;
    asm volatile("s_mov_b32 %0, m0\n\ts_mov_b32 m0, %2\n\ts_nop 0\n\tglobal_load_lds_dwordx4 %1, off\n\ts_mov_b32 m0, %0" : "=&s"(keep) : "v"(gsrc), "s"(lds_dst) : "memory"); }
__device__ __forceinline__ s16x4 vtr(lds_cptr p) { return __builtin_bit_cast(s16x4, __builtin_amdgcn_ds_read_tr16_b64_v4i16((LAS v4i16_t*)p)); }
#define ATT_MX3(a, b, c) __builtin_fmaxf(__builtin_fmaxf((a), (b)), (c))
__device__ __forceinline__ float rowmax(const f32x16& p0, const f32x16& p1) {
    float a = ATT_MX3(p0[0], p0[1], p1[0]), b = ATT_MX3(p0[2], p0[3], p1[1]); a = ATT_MX3(a, p1[2], p1[3]);
#pragma unroll
    for (int r = 4; r < 16; r += 4) { a = ATT_MX3(a, p0[r], p0[r + 1]); b = ATT_MX3(b, p0[r + 2], p0[r + 3]); a = ATT_MX3(a, p1[r], p1[r + 1]); b = ATT_MX3(b, p1[r + 2], p1[r + 3]); }
    float m = __builtin_fmaxf(a, b); auto rr = __builtin_amdgcn_permlane32_swap(__float_as_uint(m), __float_as_uint(m), false, false);
    return __builtin_fmaxf(__uint_as_float(rr[0]), __uint_as_float(rr[1]));
}
#define ATT_WAIT_BAR(N) asm volatile("s_waitcnt vmcnt(" #N ") lgkmcnt(0)\n\ts_barrier" ::: "memory")
#define ATT_MFMA(a, b, c) __builtin_amdgcn_mfma_f32_32x32x16_bf16(a, b, c, 0, 0, 0)

template <bool FIRST>
__device__ __forceinline__ void tile_step(int t, lds_cptr kp, lds_cptr vp, const bf16x8 (&qr)[4], f32x16 (&o)[4], float& mhat, float& l_reg,
                                          LAS float* wsf, const LAS float* btab, int qrow, int qw0, float c_left, float c_right, int r32, int hi) {
    const int relmin = 64 * t - qw0 - 31, relmax = 64 * t + 63 - qw0;
    const bool band = !(relmax <= -91 || relmin >= 91);
    const float cb = band ? 0.f : (relmin >= 91 ? c_right : c_left);
    f32x16 ci;
#pragma unroll
    for (int r = 0; r < 16; ++r) ci[r] = cb - mhat;
    f32x16 p0, p1;
#pragma unroll
    for (int d0 = 0; d0 < 4; ++d0) {
        const bf16x8 k0 = *(const LAS bf16x8*)(kp + d0 * 2048), k1 = *(const LAS bf16x8*)(kp + d0 * 2048 + 512);
        if (d0 == 0) { p0 = ATT_MFMA(k0, qr[0], ci); p1 = ATT_MFMA(k1, qr[0], ci); }
        else { p0 = ATT_MFMA(k0, qr[d0], p0); p1 = ATT_MFMA(k1, qr[d0], p1); }
    }
    if (band) {
        const int relb = 64 * t + 4 * hi - qrow + 128;
#pragma unroll
        for (int r = 0; r < 16; ++r) { const int i0 = relb + (r & 3) + 8 * (r >> 2); const int a0 = i0 < 0 ? 0 : (i0 > 255 ? 255 : i0); const int i1 = i0 + 32; const int a1 = i1 < 0 ? 0 : (i1 > 255 ? 255 : i1);
            p0[r] += btab[a0]; p1[r] += btab[a1]; }
    }
    const float rm = rowmax(p0, p1);
    if (FIRST) {
        mhat += rm;
#pragma unroll
        for (int r = 0; r < 16; ++r) { p0[r] -= rm; p1[r] -= rm; }
    } else if (__builtin_expect(__any(rm > (float)THR), 0)) {
        const float dl = __builtin_fmaxf(rm, 0.f); mhat += dl;
#pragma unroll
        for (int r = 0; r < 16; ++r) { p0[r] -= dl; p1[r] -= dl; }
        const float f = __builtin_amdgcn_exp2f(-dl); l_reg *= f;
        if (hi == 0) wsf[r32] = f;
        asm volatile("s_waitcnt lgkmcnt(0)" ::: "memory");
        float fr[16];
#pragma unroll
        for (int r = 0; r < 16; ++r) fr[r] = wsf[crow(r, hi)];
#pragma unroll
        for (int db = 0; db < 4; ++db)
#pragma unroll
            for (int r = 0; r < 16; ++r) o[db][r] *= fr[r];
        asm volatile("s_waitcnt lgkmcnt(0)" ::: "memory");
    }
    float sacc = 0.f;
#pragma unroll
    for (int r = 0; r < 16; ++r) { p0[r] = __builtin_amdgcn_exp2f(p0[r]); p1[r] = __builtin_amdgcn_exp2f(p1[r]); sacc += p0[r] + p1[r]; }
    l_reg += sacc;
    u32x4 pw[4];
#pragma unroll
    for (int ks = 0; ks < 4; ++ks) { const f32x16& P = (ks < 2) ? p0 : p1; const int b = 8 * (ks & 1);
        pw[ks] = (u32x4){cvt_pk_bf16(P[b], P[b + 1]), cvt_pk_bf16(P[b + 2], P[b + 3]), cvt_pk_bf16(P[b + 4], P[b + 5]), cvt_pk_bf16(P[b + 6], P[b + 7])}; }
#pragma unroll
    for (int ks = 0; ks < 4; ++ks)
#pragma unroll
        for (int db = 0; db < 4; ++db) {
            const s16x4 lo = vtr(vp + db * 4096 + ks * 1024), h4 = vtr(vp + db * 4096 + ks * 1024 + 512);
            const bf16x8 vf = (bf16x8){lo[0], lo[1], lo[2], lo[3], h4[0], h4[1], h4[2], h4[3]};
            o[db] = ATT_MFMA(__builtin_bit_cast(bf16x8, pw[ks]), vf, o[db]);
        }
}

__device__ __forceinline__ void attn_unit(int b, int h, int qb, const bf16_t* Q, const bf16_t* KT, const bf16_t* VT, bf16_t* MIXED, LAS unsigned char* lds, float lam, const float* subln_g, const float* rel_bias) {
    const int tid = threadIdx.x, lane = tid & 63, r32 = lane & 31, hi = lane >> 5; const int wid = __builtin_amdgcn_readfirstlane(tid >> 6);
    const int wq = wid & 3, mp = wid >> 2;
    const size_t rowbase = (size_t)b * S; const int q0 = qb * 128, qw0 = q0 + 32 * wq, qrow = qw0 + r32;
    LAS float* btab = (LAS float*)(lds + LDS_BIAS); LAS float* wsf = (LAS float*)(lds + LDS_WSF) + wid * 64;
    if (tid < 256) { const int rel = tid - 128; const int n = rel < 0 ? -rel : rel; int bk; if (n < 8) bk = n; else { bk = 2 + (31 - __clz(n * n)); if (bk > 15) bk = 15; } if (rel > 0) bk += 16;
        btab[tid] = rel_bias[bk * NH + h] * LOG2E; }
    const float c_left = rel_bias[15 * NH + h] * LOG2E, c_right = rel_bias[31 * NH + h] * LOG2E;
    const bf16_t* Qw = Q + (rowbase + qw0) * 512 + h * 128 + mp * 64;
    bf16x8 qr[4];
#pragma unroll
    for (int d0 = 0; d0 < 4; ++d0) qr[d0] = *(const bf16x8*)(Qw + (size_t)r32 * 512 + d0 * 16 + hi * 8);
    const char* k1src = (const char*)KT + ((size_t)((b * 4 + h) * 2) * 64) * 8192 + wid * 1024 + lane * 16;
    const char* k2src = k1src + (size_t)64 * 8192;
    const char* vsrc = (const char*)VT + ((size_t)(b * 4 + h) * 64) * 16384 + wid * 1024 + lane * 16;
    const unsigned lds0 = (unsigned)(uintptr_t)(unsigned char*)lds;
    const unsigned kdst = lds0 + LDS_K + wid * 1024, vdst = lds0 + LDS_V + wid * 1024;
#define ATT_DMA_TILE(t, sl) do { glds16(k1src + (size_t)(t) * 8192, (unsigned)__builtin_amdgcn_readfirstlane(kdst + (sl))); glds16(k2src + (size_t)(t) * 8192, (unsigned)__builtin_amdgcn_readfirstlane(kdst + (sl) + 8192)); \
        glds16(vsrc + (size_t)(t) * 16384, (unsigned)__builtin_amdgcn_readfirstlane(vdst + (sl))); glds16(vsrc + (size_t)(t) * 16384 + 8192, (unsigned)__builtin_amdgcn_readfirstlane(vdst + (sl) + 8192)); } while (0)
    const lds_cptr kp0 = (lds_cptr)lds + LDS_K + mp * 8192 + hi * 1024 + r32 * 16;
    const lds_cptr vp0 = (lds_cptr)lds + LDS_V + ((lane >> 4) & 1) * 32 + (lane & 3) * 8 + (4 * hi + ((lane & 15) >> 2)) * 64;
    ATT_DMA_TILE(0, 0); ATT_DMA_TILE(1, SLOT);
    float mhat = 0.f, l_reg = 0.f; f32x16 o[4];
#pragma unroll
    for (int db = 0; db < 4; ++db)
#pragma unroll
        for (int r = 0; r < 16; ++r) o[db][r] = 0.f;
    int sl = 0, sl2 = 2 * SLOT;
#define ATT_ROT() do { sl = (sl == 2 * SLOT) ? 0 : sl + SLOT; sl2 = (sl2 == 2 * SLOT) ? 0 : sl2 + SLOT; } while (0)
    ATT_WAIT_BAR(4); ATT_DMA_TILE(2, sl2);
    tile_step<true>(0, kp0 + sl, vp0 + sl, qr, o, mhat, l_reg, wsf, btab, qrow, qw0, c_left, c_right, r32, hi); ATT_ROT();
    for (int t = 1; t < NT - 2; ++t) {
        ATT_WAIT_BAR(4); ATT_DMA_TILE(t + 2, sl2);
        tile_step<false>(t, kp0 + sl, vp0 + sl, qr, o, mhat, l_reg, wsf, btab, qrow, qw0, c_left, c_right, r32, hi); ATT_ROT();
    }
    ATT_WAIT_BAR(4);
    tile_step<false>(NT - 2, kp0 + sl, vp0 + sl, qr, o, mhat, l_reg, wsf, btab, qrow, qw0, c_left, c_right, r32, hi); ATT_ROT();
    ATT_WAIT_BAR(0);
    tile_step<false>(NT - 1, kp0 + sl, vp0 + sl, qr, o, mhat, l_reg, wsf, btab, qrow, qw0, c_left, c_right, r32, hi);
    { auto rr = __builtin_amdgcn_permlane32_swap(__float_as_uint(l_reg), __float_as_uint(l_reg), false, false); l_reg = __uint_as_float(rr[0]) + __uint_as_float(rr[1]); }
    const float scale_q = (mp == 0 ? 1.0f : lam) * __builtin_amdgcn_rcpf(l_reg);
    if (hi == 0) wsf[r32] = scale_q;
    asm volatile("s_waitcnt lgkmcnt(0)" ::: "memory");
    float sc[16];
#pragma unroll
    for (int r = 0; r < 16; ++r) sc[r] = wsf[crow(r, hi)];
    asm volatile("s_waitcnt lgkmcnt(0)\n\ts_barrier" ::: "memory");
    LAS float* X = (LAS float*)(lds + LDS_X) + wq * 4096 + lane;
    if (mp == 1) {
#pragma unroll
        for (int db = 0; db < 4; ++db)
#pragma unroll
            for (int r = 0; r < 16; ++r) X[(db * 16 + r) * 64] = o[db][r] * sc[r];
    }
    asm volatile("s_waitcnt lgkmcnt(0)\n\ts_barrier" ::: "memory");
    if (mp == 0) {
        float ss[16];
#pragma unroll
        for (int r = 0; r < 16; ++r) ss[r] = 0.f;
#pragma unroll
        for (int db = 0; db < 4; ++db)
#pragma unroll
            for (int r = 0; r < 16; ++r) { const float d = o[db][r] * sc[r] - X[(db * 16 + r) * 64]; o[db][r] = d; ss[r] += d * d; }
#pragma unroll
        for (int r = 0; r < 16; ++r) {
#pragma unroll
            for (int x = 1; x < 32; x <<= 1) ss[r] += __shfl_xor(ss[r], x);
            ss[r] = __builtin_amdgcn_rsqf(ss[r] * (1.0f / 128.0f) + EPS) * 0.8f;
        }
        LAS bf16_t* stg = (LAS bf16_t*)(lds + LDS_OST) + wq * 4096;
#pragma unroll
        for (int db = 0; db < 4; ++db) { const float g = subln_g[db * 32 + r32];
#pragma unroll
            for (int r = 0; r < 16; ++r) { const unsigned w = cvt_pk_bf16(o[db][r] * ss[r] * g, 0.f); stg[crow(r, hi) * 128 + db * 32 + r32] = (bf16_t)(w & 0xffffu); } }
        asm volatile("s_waitcnt lgkmcnt(0)" ::: "memory");
        bf16_t* Ow = MIXED + (rowbase + qw0) * 1024 + h * 128;
#pragma unroll
        for (int i = 0; i < 8; ++i) { const int row = i * 4 + (lane >> 4), ch = lane & 15; const u32x4 v = *(const LAS u32x4*)(stg + row * 128 + ch * 8); *(u32x4*)(Ow + (size_t)row * 1024 + ch * 8) = v; }
    }
    asm volatile("s_waitcnt vmcnt(0) lgkmcnt(0)\n\ts_barrier" ::: "memory");
#undef ATT_DMA_TILE
#undef ATT_ROT
}
}

namespace lru {
template <int N> __device__ __forceinline__ float dpp_shr(float v, float ident) {
    return __int_as_float(__builtin_amdgcn_update_dpp(__float_as_int(ident), __float_as_int(v), 0x110 + N, 0xF, 0xF, false));
}
#define LRU_MFMA16(a, b, c) __builtin_amdgcn_mfma_f32_16x16x32_bf16(a, b, c, 0, 0, 0)
__device__ __forceinline__ void lru_item(int b, int cg, const bf16_t* XR, const bf16_t* GR, float* HF, bf16_t* MIXED, LAS unsigned char* lds,
                                         const float* conv_w, const float* conv_b, const float* w_rg, const float* b_rg, const float* w_ig, const float* b_ig, const float* lru_lambda) {
    const int tid = threadIdx.x, lane = tid & 63, p = lane & 15, g = lane >> 4; const int wid = __builtin_amdgcn_readfirstlane(tid >> 6);
    const int n = cg >> 2, e16 = cg & 3, c0 = n * 64 + e16 * 16;
    const size_t rowbase = (size_t)b * S;
    LAS float* tot = (LAS float*)(lds + att::LDS_TOT);
    bf16x8 idf;
#pragma unroll
    for (int j = 0; j < 8; ++j) idf[j] = ((8 * g + j) == (16 * (e16 & 1) + p)) ? (short)0x3f80 : (short)0;
    int par = 0;
    for (int dir = 0; dir < 2; ++dir) {
        bf16x8 wrf[2], wif[2];
#pragma unroll
        for (int ks = 0; ks < 2; ++ks) {
            unsigned wr_[4], wi_[4];
#pragma unroll
            for (int j2 = 0; j2 < 4; ++j2) { const int d = 32 * ks + 8 * g + 2 * j2; const size_t i0 = ((size_t)((dir * 8 + n) * 64 + d)) * 64 + e16 * 16 + p;
                wr_[j2] = cvt_pk_bf16(w_rg[i0], w_rg[i0 + 64]); wi_[j2] = cvt_pk_bf16(w_ig[i0], w_ig[i0 + 64]); }
            wrf[ks] = __builtin_bit_cast(bf16x8, (u32x4){wr_[0], wr_[1], wr_[2], wr_[3]}); wif[ks] = __builtin_bit_cast(bf16x8, (u32x4){wi_[0], wi_[1], wi_[2], wi_[3]});
        }
        float br[4], bi[4], sp8[4], carry[4];
#pragma unroll
        for (int r = 0; r < 4; ++r) { const int c = dir * 512 + c0 + 4 * g + r; br[r] = b_rg[c]; bi[r] = b_ig[c]; const float lm = lru_lambda[c]; sp8[r] = 8.0f * log1pf(expf(-lm)); carry[r] = 0.f; }
        for (int sc = 0; sc < 8; ++sc) {
            const int P0 = sc * 512 + wid * 64;
            f32x4 ar[4], ai[4], ax[4];
#pragma unroll
            for (int i = 0; i < 4; ++i) {
                const int P = P0 + 4 * p + i; const int tok = dir ? (S - 1 - P) : P;
                bf16x8 xf[2];
#pragma unroll
                for (int ks = 0; ks < 2; ++ks) {
                    const int c8 = n * 64 + 32 * ks + 8 * g;
                    float a8[8];
                    { const f32x4 b0 = *(const f32x4*)(conv_b + c8), b1 = *(const f32x4*)(conv_b + c8 + 4);
#pragma unroll
                      for (int e = 0; e < 4; ++e) { a8[e] = b0[e]; a8[4 + e] = b1[e]; } }
#pragma unroll
                    for (int j = 0; j < 4; ++j) {
                        const int tt = tok + j - 2;
                        if (tt >= 0 && tt < S) {
                            const bf16x8 xv = *(const bf16x8*)(XR + (rowbase + tt) * 512 + c8);
                            const f32x4 w0 = *(const f32x4*)(conv_w + j * 512 + c8), w1 = *(const f32x4*)(conv_w + j * 512 + c8 + 4);
#pragma unroll
                            for (int e = 0; e < 4; ++e) { a8[e] += w0[e] * bf2f((unsigned short)xv[e]); a8[4 + e] += w1[e] * bf2f((unsigned short)xv[4 + e]); }
                        }
                    }
                    xf[ks] = __builtin_bit_cast(bf16x8, (u32x4){cvt_pk_bf16(a8[0], a8[1]), cvt_pk_bf16(a8[2], a8[3]), cvt_pk_bf16(a8[4], a8[5]), cvt_pk_bf16(a8[6], a8[7])});
                }
                const f32x4 z = (f32x4){0.f, 0.f, 0.f, 0.f};
                ar[i] = LRU_MFMA16(wrf[0], xf[0], z); ar[i] = LRU_MFMA16(wrf[1], xf[1], ar[i]);
                ai[i] = LRU_MFMA16(wif[0], xf[0], z); ai[i] = LRU_MFMA16(wif[1], xf[1], ai[i]);
                ax[i] = LRU_MFMA16(idf, (e16 & 2) ? xf[1] : xf[0], z);
            }
            float hh[4][4], cpp[4][4], Al[4], Hl[4];
#pragma unroll
            for (int r = 0; r < 4; ++r) {
                float h = 0.f, cp = 1.f;
#pragma unroll
                for (int i = 0; i < 4; ++i) {
                    const float rg = fast_sigmoid(ar[i][r] + br[r]), ig = fast_sigmoid(ai[i][r] + bi[r]);
                    const float la = -rg * sp8[r]; const float a_ = __builtin_amdgcn_exp2f(la * LOG2E);
                    const float x2 = 2.0f * la;
                    const float om = -x2 * (1.0f + x2 * (0.5f + x2 * ((1.0f / 6.0f) + x2 * ((1.0f / 24.0f) + x2 * ((1.0f / 120.0f) + x2 * (1.0f / 720.0f))))));
                    const float u_ = __builtin_sqrtf(om) * (ig * ax[i][r]);
                    h = a_ * h + u_; cp = a_ * cp; hh[i][r] = h; cpp[i][r] = cp;
                }
                Al[r] = cp; Hl[r] = h;
            }
#define LRU_KS(NN) do { _Pragma("unroll") for (int r = 0; r < 4; ++r) { const float Ap = dpp_shr<NN>(Al[r], 1.0f), Hp = dpp_shr<NN>(Hl[r], 0.0f); Hl[r] = Al[r] * Hp + Hl[r]; Al[r] = Al[r] * Ap; } } while (0)
            LRU_KS(1); LRU_KS(2); LRU_KS(4); LRU_KS(8);
#undef LRU_KS
            float Aex[4], Hex[4];
#pragma unroll
            for (int r = 0; r < 4; ++r) { Aex[r] = dpp_shr<1>(Al[r], 1.0f); Hex[r] = dpp_shr<1>(Hl[r], 0.0f); }
            if (p == 15) {
#pragma unroll
                for (int r = 0; r < 4; ++r) { tot[((par * 8 + wid) * 16 + 4 * g + r) * 2] = Al[r]; tot[((par * 8 + wid) * 16 + 4 * g + r) * 2 + 1] = Hl[r]; }
            }
            asm volatile("s_waitcnt lgkmcnt(0)\n\ts_barrier" ::: "memory");
            float cin[4];
#pragma unroll
            for (int r = 0; r < 4; ++r) cin[r] = 0.f;
#pragma unroll
            for (int w = 0; w < 8; ++w) {
                const f32x4 t0 = *(const LAS f32x4*)(tot + ((par * 8 + w) * 16 + 4 * g) * 2), t1 = *(const LAS f32x4*)(tot + ((par * 8 + w) * 16 + 4 * g) * 2 + 4);
                const float Aw[4] = {t0[0], t0[2], t1[0], t1[2]}, Hw[4] = {t0[1], t0[3], t1[1], t1[3]};
#pragma unroll
                for (int r = 0; r < 4; ++r) { if (w == wid) cin[r] = carry[r]; carry[r] = Aw[r] * carry[r] + Hw[r]; }
            }
            par ^= 1;
            float cl[4];
#pragma unroll
            for (int r = 0; r < 4; ++r) cl[r] = Aex[r] * cin[r] + Hex[r];
#pragma unroll
            for (int i = 0; i < 4; ++i) {
                const int P = P0 + 4 * p + i; const int tok = dir ? (S - 1 - P) : P;
                f32x4 hv;
#pragma unroll
                for (int r = 0; r < 4; ++r) hv[r] = hh[i][r] + cpp[i][r] * cl[r];
                float* hfp = HF + (rowbase + tok) * 512 + c0 + 4 * g;
                if (dir == 0) *(f32x4*)hfp = hv;
                else {
                    const f32x4 hf = *(const f32x4*)hfp; const u32x2 gv = *(const u32x2*)(GR + (rowbase + tok) * 512 + c0 + 4 * g);
                    const float gr4[4] = {__uint_as_float(gv.x << 16), __uint_as_float(gv.x & 0xffff0000u), __uint_as_float(gv.y << 16), __uint_as_float(gv.y & 0xffff0000u)};
                    float y[4];
#pragma unroll
                    for (int r = 0; r < 4; ++r) { const float x = gr4[r]; const float gl = x * fast_sigmoid(1.5957691216057308f * (x + 0.044715f * x * x * x)); y[r] = gl * (hv[r] + hf[r]); }
                    u32x2 w; w.x = cvt_pk_bf16(y[0], y[1]); w.y = cvt_pk_bf16(y[2], y[3]);
                    *(u32x2*)(MIXED + (rowbase + tok) * 1024 + 512 + c0 + 4 * g) = w;
                }
            }
        }
        __syncthreads();
    }
}
}
struct Args { const float* in[22]; float* out; unsigned char* ws; int ph_lo, ph_hi; };
constexpr int N_PHASES = 7;

__global__ void __launch_bounds__(NWAVES * 64, 2) mk_fwd(Args args) {
    extern __shared__ __attribute__((aligned(16))) unsigned char lds_raw[];
    LAS unsigned char* lds = (LAS unsigned char*)lds_raw;
    const int tid = threadIdx.x, lane = tid & 63; const int wave = __builtin_amdgcn_readfirstlane(tid >> 6);
    const int G = gridDim.x, bx = blockIdx.x; const int vcu = (G % 8 == 0) ? (bx % 8) * (G / 8) + bx / 8 : bx;
    unsigned char* ws = args.ws;
    const float* x = args.in[0]; float* out = args.out;
    bf16_t* WIN = (bf16_t*)(ws + WS_WIN); bf16_t* WOUT = (bf16_t*)(ws + WS_WOUT); bf16_t* WGU = (bf16_t*)(ws + WS_WGU); bf16_t* WDN = (bf16_t*)(ws + WS_WDN);
    float* RSS1 = (float*)(ws + WS_RSS1); float* RSS2 = (float*)(ws + WS_RSS2);
    bf16_t* XN = (bf16_t*)(ws + WS_XN); bf16_t* HB = XN;
    bf16_t* Qb = (bf16_t*)(ws + WS_Q); bf16_t* KT = (bf16_t*)(ws + WS_KT); bf16_t* VT = (bf16_t*)(ws + WS_VT); bf16_t* XR = (bf16_t*)(ws + WS_XR); bf16_t* GR = (bf16_t*)(ws + WS_GR);
    float* HF = (float*)(ws + WS_HF); bf16_t* MIXED = (bf16_t*)(ws + WS_MIXED); bf16_t* ACT = (bf16_t*)(ws + WS_ACT);
    const int lo = args.ph_lo, hi = args.ph_hi;
#define IN(k) (lo <= (k) && (k) < hi)
#define SEAM(k) do { if (IN(k) && IN((k) + 1)) { cooperative_groups::this_grid().sync(); } } while (0)

    if (IN(0)) {
        LAS float* scr = (LAS float*)(lds + wave * 16384);
        const int gw = vcu * NWAVES + wave, NGW = G * NWAVES;
        constexpr int I_IN = (D / 64) * (DIN / 32), I_OUT = (D / 64) * (D / 32), I_G = (D / 64) * (DFF / 32), I_DN = (DFF / 64) * (D / 32);
        constexpr int NITEMS = I_IN + I_OUT + 2 * I_G + I_DN;
        for (int it = gw; it < NITEMS; it += NGW) {
            int r = it;
            if (r < I_IN) { p0_transpose_item<0>(args.in[2], D, DIN, WIN, nullptr, scr, r, lane); continue; } r -= I_IN;
            if (r < I_OUT) { p0_transpose_item<0>(args.in[16], D, D, WOUT, nullptr, scr, r, lane); continue; } r -= I_OUT;
            if (r < I_G) { p0_transpose_item<1>(args.in[18], D, DFF, WGU, args.in[17], scr, r, lane); continue; } r -= I_G;
            if (r < I_G) { p0_transpose_item<2>(args.in[19], D, DFF, WGU, args.in[17], scr, r, lane); continue; } r -= I_G;
            p0_transpose_item<0>(args.in[20], DFF, D, WDN, nullptr, scr, r, lane);
        }
        for (int m = gw; m < M; m += NGW) rms_row_to_bf16(x + (size_t)m * D, args.in[1], XN + (size_t)m * D, lane);
    }
    SEAM(0);
    if (IN(1)) {
        pg8::Gemm g{XN, WIN, M, DIN, D}; pg8::StaticOrder So; So.init(M, DIN, G, bx);
        pg8::EpiInProj E{Qb, KT, VT, XR, GR, QSCALE};
        pg8::gemm_phase<pg8::EpiInProj, pg8::StaticOrder, true, true>(lds, g, So, E);
    }
    SEAM(1);
    if (IN(2)) {
        float lam;
        { float s1 = 0.f, s2 = 0.f; for (int i = 0; i < 64; ++i) { s1 += args.in[3][i] * args.in[4][i]; s2 += args.in[5][i] * args.in[6][i]; } lam = expf(s1) - expf(s2) + 0.2f; }
        for (int rnd = 0; rnd * G + vcu < NB * NH * 32; ++rnd) {
            const int u = rnd * G + vcu; int b_, h_, qb_;
            if (G == 256) { b_ = vcu >> 5; h_ = rnd; qb_ = vcu & 31; } else { qb_ = u & 31; h_ = (u >> 5) & 3; b_ = u >> 7; }
            att::attn_unit(b_, h_, qb_, Qb, KT, VT, MIXED, lds, lam, args.in[7], args.in[8]);
        }
        for (int it = vcu; it < NB * 32; it += G) {
            const int b_ = it >> 5, cg = it & 31;
            lru::lru_item(b_, cg, XR, GR, HF, MIXED, lds, args.in[9], args.in[10], args.in[11], args.in[12], args.in[13], args.in[14], args.in[15]);
        }
    }
    SEAM(2);
    if (IN(3)) {
        pg8::Gemm g{MIXED, WOUT, M, D, D}; pg8::StaticOrder So; So.init(M, D, G, bx);
        pg8::EpiResid<true> E{x, out, HB, RSS1, D};
        pg8::gemm_phase<pg8::EpiResid<true>, pg8::StaticOrder, true, true>(lds, g, So, E);
    }
    SEAM(3);
    if (IN(4)) {
        pg8::Gemm g{HB, WGU, M, 2 * DFF, D}; pg8::StaticOrder So; So.init(M, 2 * DFF, G, bx);
        pg8::EpiGateUp E{ACT, RSS1, DFF, EPS};
        pg8::gemm_phase<pg8::EpiGateUp, pg8::StaticOrder, true, true>(lds, g, So, E);
    }
    SEAM(4);
    if (IN(5)) {
        pg8::Gemm g{ACT, WDN, M, D, DFF}; pg8::StaticOrder So; So.init(M, D, G, bx);
        pg8::EpiResid<false> E{out, out, nullptr, RSS2, D};
        pg8::gemm_phase<pg8::EpiResid<false>, pg8::StaticOrder, true, true>(lds, g, So, E);
    }
    SEAM(5);
    if (IN(6)) {
        const int gw = vcu * NWAVES + wave, NGW = G * NWAVES; const f32x4* gf = (const f32x4*)args.in[21] + lane;
        for (int m = gw; m < M; m += NGW) {
            const f32x4* rp = (const f32x4*)(RSS2 + (size_t)m * 16); const f32x4 s0 = rp[0], s1 = rp[1], s2 = rp[2], s3 = rp[3];
            const float tot = ((s0[0] + s0[1]) + (s0[2] + s0[3])) + ((s1[0] + s1[1]) + (s1[2] + s1[3])) + ((s2[0] + s2[1]) + (s2[2] + s2[3])) + ((s3[0] + s3[1]) + (s3[2] + s3[3]));
            const float rstd = 1.0f / sqrtf(tot * (1.0f / D) + EPS);
            f32x4* orow = (f32x4*)(out + (size_t)m * D) + lane;
#pragma unroll
            for (int j = 0; j < 4; ++j) { const f32x4 v = orow[64 * j], gg = gf[64 * j]; orow[64 * j] = v * rstd * gg; }
        }
    }
#undef IN
#undef SEAM
}
}
namespace dbg {
using namespace mk;
__global__ void __launch_bounds__(256) k_unpack_proj(const bf16_t* Qb, const bf16_t* KT, const bf16_t* VT, const bf16_t* XR, const bf16_t* GR, float* q, float* k, float* v, float* xr, float* gr) {
    const size_t idx = (size_t)blockIdx.x * 256 + threadIdx.x;
    const int c = (int)(idx & 511); const int row = (int)(idx >> 9); const int b = row >> 12, tok = row & 4095, t = tok >> 6, rr = tok & 63;
    q[idx] = bf2f(Qb[idx]) * (1.0f / QSCALE);
    { const int h = c >> 7, w = c & 127, s = w >> 6, d = w & 63, chunk = d >> 3, j = d & 7;
      k[idx] = bf2f(KT[((((size_t)(b * 4 + h) * 2 + s) * 64 + t) * 8 + chunk) * 512 + rr * 8 + j]); }
    { const int h = c >> 7, dv = c & 127, db = dv >> 5, cc = dv & 31;
      v[idx] = bf2f(VT[(((size_t)(b * 4 + h) * 64 + t) * 4 + db) * 2048 + rr * 32 + cc]); }
    xr[idx] = bf2f(XR[idx]); gr[idx] = bf2f(GR[idx]);
}
__global__ void __launch_bounds__(256) k_unpack_bf16(const bf16_t* src, float* dst) { const size_t idx = (size_t)blockIdx.x * 256 + threadIdx.x; dst[idx] = bf2f(src[idx]); }
}

#ifndef STAGE
#define STAGE 4
#endif
static void mk_launch_phases(const mk::Args& a0, int lo, int hi, int grid, hipStream_t stream, bool coop) {
    mk::Args a = a0; a.ph_lo = lo; a.ph_hi = hi;
    if (coop) { void* args[] = {&a}; hipError_t e = hipLaunchCooperativeKernel((const void*)mk::mk_fwd, dim3(grid), dim3(mk::NWAVES * 64), args, mk::LDS_BYTES, stream);
        if (e != hipSuccess) fprintf(stderr, "cooperative launch failed: %s (grid %d)\n", hipGetErrorString(e), grid); }
    else { hipLaunchKernelGGL(mk::mk_fwd, dim3(grid), dim3(mk::NWAVES * 64), mk::LDS_BYTES, stream, a); }
}

extern "C" void kernel_launch(void* const* d_in, const int* in_sizes, int n_in, void* d_out, int out_size, void* d_ws, size_t ws_size, hipStream_t stream) {
    static int grid = 0;
    if (grid == 0) {
        int dev = 0, cus = 0, per_cu = 0;
        hipGetDevice(&dev); hipDeviceGetAttribute(&cus, hipDeviceAttributeMultiprocessorCount, dev);
        if (hipFuncSetAttribute((const void*)mk::mk_fwd, hipFuncAttributeMaxDynamicSharedMemorySize, mk::LDS_BYTES) != hipSuccess) { fprintf(stderr, "hipFuncSetAttribute failed\n"); grid = -1; return; }
        if (hipOccupancyMaxActiveBlocksPerMultiprocessor(&per_cu, (const void*)mk::mk_fwd, mk::NWAVES * 64, mk::LDS_BYTES) != hipSuccess || per_cu < 1) { fprintf(stderr, "occupancy query: %d\n", per_cu); per_cu = 1; }
        (void)hipGetLastError();
        grid = cus * 1;
        if (n_in != 22 || ws_size < 512u * mk::MiB) fprintf(stderr, "kernel_launch: unexpected n_in %d / ws_size %zu\n", n_in, ws_size);
    }
    if (grid < 0) return;
    mk::Args a{};
    for (int i = 0; i < 22; ++i) a.in[i] = (const float*)d_in[i];
    a.out = (float*)d_out; a.ws = (unsigned char*)d_ws;
    char* ws = (char*)d_ws; const size_t MiB = 1u << 20;
#if STAGE == 4
    mk_launch_phases(a, 0, mk::N_PHASES, grid, stream, true);
#elif STAGE == 3
    for (int p = 0; p < mk::N_PHASES; ++p) mk_launch_phases(a, p, p + 1, grid, stream, false);
#elif STAGE == 1
    for (int p = 0; p < 2; ++p) mk_launch_phases(a, p, p + 1, grid, stream, false);
    float* q = (float*)(ws + 32 * MiB), *k = (float*)(ws + 256 * MiB), *v = (float*)(ws + 320 * MiB), *xr = (float*)(ws + 384 * MiB), *gr = (float*)(ws + 448 * MiB);
    dbg::k_unpack_proj<<<mk::M * 512 / 256, 256, 0, stream>>>((const mk::bf16_t*)(ws + mk::WS_Q), (const mk::bf16_t*)(ws + mk::WS_KT), (const mk::bf16_t*)(ws + mk::WS_VT), (const mk::bf16_t*)(ws + mk::WS_XR), (const mk::bf16_t*)(ws + mk::WS_GR), q, k, v, xr, gr);
    float* mixed = (float*)(ws + 96 * MiB);
    nv::naive_mid(d_in, q, k, v, xr, gr, mixed, stream);
    nv::naive_tail(d_in, mixed, (float*)d_out, (float*)(ws + 0), (float*)(ws + 128 * MiB), stream);
#elif STAGE == 2
    for (int p = 0; p < 3; ++p) mk_launch_phases(a, p, p + 1, grid, stream, false);
    float* mixed = (float*)(ws + 0);
    dbg::k_unpack_bf16<<<mk::M * 1024 / 256, 256, 0, stream>>>((const mk::bf16_t*)(ws + mk::WS_MIXED), mixed);
    nv::naive_tail(d_in, mixed, (float*)d_out, (float*)(ws + 0), (float*)(ws + 128 * MiB), stream);
#endif
}
```

```cpp
#include <hip/hip_runtime.h>
#include <hip/hip_cooperative_groups.h>
#include <cstdio>
#include <cstdint>
#include <cmath>
#define STAGE 4
namespace pg8 {
#define PG8_LAS __attribute__((address_space(3)))
typedef unsigned short bf16_t;
typedef short bf16x8 __attribute__((ext_vector_type(8)));
typedef float f32x4 __attribute__((ext_vector_type(4)));
typedef unsigned u32x4 __attribute__((ext_vector_type(4)));
constexpr int BM = 256, BK = 64, HALF = 128, HTB = HALF * BK * 2  , STAGE_BYTES = 8 * HTB, NXCD = 8, WGM = 8;

__host__ __device__ __forceinline__ int lds_byte(int r, int c) { const int st = (r >> 4) * 2 + (c >> 5), rr = r & 15, cc = c & 31, ob = rr * 64 + cc * 2; return st * 1024 + (ob ^ (((ob >> 9) & 1) << 5)); }
__host__ __device__ __forceinline__ void stage_rc(int b, int& R, int& C) { const int st = b / 1024, sb = b % 1024, swz = sb ^ (((sb >> 9) & 1) << 5); R = (st >> 1) * 16 + swz / 64; C = (st & 1) * 32 + (swz % 64) / 2; }
__host__ __device__ __forceinline__ int perm32(int rho) { const int n = rho >> 4, i = rho & 15; return 8 * (i >> 2) + 4 * n + (i & 3); }

struct Unit { int pm, pn; };
struct Gemm { const bf16_t* A; const bf16_t* Bt; int M, N, K; };

struct StaticOrder {
    int nM, nN, nwg, G, c;
    __host__ __device__ void init(int M, int N, int G_, int c_) { nM = M / BM; nN = N / BM; nwg = nM * nN; G = G_; c = c_; }
    __host__ __device__ bool next(int i, Unit& u) const {
        const long L = (long)i * G + c; if (L >= nwg) return false;
        int wgid = (int)L; { const int q = nwg / NXCD, r = nwg % NXCD, xcd = wgid % NXCD, off = wgid / NXCD; wgid = (xcd < r ? xcd * (q + 1) : r * (q + 1) + (xcd - r) * q) + off; }
        const int nig = WGM * nN, gid = wgid / nig, fm = gid * WGM, gsz = (nM - fm) < WGM ? (nM - fm) : WGM;
        u.pm = fm + ((wgid % nig) % gsz); u.pn = (wgid % nig) / gsz; return true;
    }
    __device__ __forceinline__ void a_ready(const Unit&) const {}
    __device__ __forceinline__ void done(const Unit&) const {}
};

typedef float f32x2_cv __attribute__((ext_vector_type(2))); typedef __bf16 bf16x2_cv __attribute__((ext_vector_type(2)));
__device__ __forceinline__ unsigned cvt_pk_bf16(float lo, float hi) { f32x2_cv v = {lo, hi}; bf16x2_cv b = __builtin_convertvector(v, bf16x2_cv); return __builtin_bit_cast(unsigned, b); }
typedef float f32x2 __attribute__((ext_vector_type(2)));
typedef unsigned u32x2 __attribute__((ext_vector_type(2)));
__device__ __forceinline__ u32x4 pack8(f32x4 v0, f32x4 v1) { u32x4 w; w.x = cvt_pk_bf16(v0[0], v0[1]); w.y = cvt_pk_bf16(v0[2], v0[3]); w.z = cvt_pk_bf16(v1[0], v1[1]); w.w = cvt_pk_bf16(v1[2], v1[3]); return w; }
struct EpiInProj {
    static constexpr bool PERM = true, AFTER_DRAIN = false;
    bf16_t *Q, *KT, *VT, *XR, *GR; float qscale;
    __device__ __forceinline__ void operator()(const f32x4 (&acc)[2][2][4][2], const Unit& u, int wr, int wc, int fr, int fq) const {
        const int sec = u.pn >> 1, half = u.pn & 1;
#pragma unroll
        for (int ai = 0; ai < 2; ++ai)
#pragma unroll
            for (int m = 0; m < 4; ++m) {
                const int row = u.pm * BM + ai * HALF + wr * 64 + m * 16 + fr;
                const int b = row >> 12, tok = row & 4095, t = tok >> 6, rr = tok & 63;
#pragma unroll
                for (int bj = 0; bj < 2; ++bj) {
                    f32x4 v0 = acc[ai][bj][m][0], v1 = acc[ai][bj][m][1];
                    const int cs = half * 256 + bj * HALF + wc * 32 + 8 * fq;
                    if (sec == 0) { v0 = v0 * qscale; v1 = v1 * qscale; *(u32x4*)(Q + (size_t)row * 512 + cs) = pack8(v0, v1); }
                    else if (sec == 1) { const int h = half * 2 + bj, s = wc >> 1, chunk = 4 * (wc & 1) + fq;
                        *(u32x4*)(KT + ((((size_t)(b * 4 + h) * 2 + s) * 64 + t) * 8 + chunk) * 512 + rr * 8) = pack8(v0, v1); }
                    else if (sec == 2) { const int h = half * 2 + bj;
                        *(u32x4*)(VT + (((size_t)(b * 4 + h) * 64 + t) * 4 + wc) * 2048 + rr * 32 + 8 * fq) = pack8(v0, v1); }
                    else if (sec == 3) { *(u32x4*)(XR + (size_t)row * 512 + cs) = pack8(v0, v1); }
                    else { *(u32x4*)(GR + (size_t)row * 512 + cs) = pack8(v0, v1); }
                }
            }
    }
};
template <bool WRITE_HB> struct EpiResid {
    static constexpr bool PERM = false, AFTER_DRAIN = false;
    const float* base; float* out; bf16_t* hb; float* rss; int ldc;
    __device__ __forceinline__ void operator()(const f32x4 (&acc)[2][2][4][2], const Unit& u, int wr, int wc, int fr, int fq) const {
        const int col0 = u.pn * BM + wc * 32 + 4 * fq;
#pragma unroll
        for (int ai = 0; ai < 2; ++ai)
#pragma unroll
            for (int m = 0; m < 4; ++m) {
                const int row = u.pm * BM + ai * HALF + wr * 64 + m * 16 + fr; const size_t off = (size_t)row * ldc + col0; float ss = 0.f;
#pragma unroll
                for (int bj = 0; bj < 2; ++bj)
#pragma unroll
                    for (int n = 0; n < 2; ++n) {
                        const f32x4 bs = *(const f32x4*)(base + off + bj * HALF + n * 16); const f32x4 o = acc[ai][bj][m][n] + bs;
                        *(f32x4*)(out + off + bj * HALF + n * 16) = o;
                        if (WRITE_HB) { u32x2 w; w.x = cvt_pk_bf16(o[0], o[1]); w.y = cvt_pk_bf16(o[2], o[3]); *(u32x2*)(hb + off + bj * HALF + n * 16) = w; }
                        ss += (o[0] * o[0] + o[1] * o[1]) + (o[2] * o[2] + o[3] * o[3]);
                    }
                ss += __shfl_xor(ss, 16); ss += __shfl_xor(ss, 32);
                if (fq == 0) rss[(size_t)row * 16 + u.pn * 4 + wc] = ss;
            }
    }
};
struct EpiGateUp {
    static constexpr bool PERM = true, AFTER_DRAIN = false;
    bf16_t* act; const float* rss; int ldo; float eps;
    __device__ __forceinline__ void operator()(const f32x4 (&acc)[2][2][4][2], const Unit& u, int wr, int wc, int fr, int fq) const {
        const int col0 = u.pn * HALF + wc * 32 + 8 * fq;
#pragma unroll
        for (int ai = 0; ai < 2; ++ai)
#pragma unroll
            for (int m = 0; m < 4; ++m) {
                const int row = u.pm * BM + ai * HALF + wr * 64 + m * 16 + fr;
                const f32x4* rp = (const f32x4*)(rss + (size_t)row * 16); const f32x4 s0 = rp[0], s1 = rp[1], s2 = rp[2], s3 = rp[3];
                const float tot = ((s0[0] + s0[1]) + (s0[2] + s0[3])) + ((s1[0] + s1[1]) + (s1[2] + s1[3])) + ((s2[0] + s2[1]) + (s2[2] + s2[3])) + ((s3[0] + s3[1]) + (s3[2] + s3[3]));
                const float rstd = __builtin_amdgcn_rsqf(tot * (1.0f / 1024.0f) + eps);
                f32x4 o[2];
#pragma unroll
                for (int n = 0; n < 2; ++n) {
                    const f32x4 g = acc[ai][0][m][n] * rstd, up = acc[ai][1][m][n] * rstd;
#pragma unroll
                    for (int i = 0; i < 4; ++i) { const float e = __builtin_amdgcn_exp2f(g[i] * -1.4426950408889634f); o[n][i] = g[i] * __builtin_amdgcn_rcpf(1.0f + e) * up[i]; }
                }
                *(u32x4*)(act + (size_t)row * ldo + col0) = pack8(o[0], o[1]);
            }
    }
};
template <class Epi, class Sched, bool ALIGN_EPI = false, bool SP2 = false>
__device__ __forceinline__ void gemm_phase(PG8_LAS unsigned char* lds, const Gemm g, const Sched& S, const Epi& E) {
    const int tid = threadIdx.x, wid = __builtin_amdgcn_readfirstlane(tid >> 6), lane = tid & 63, wr = wid >> 2, wc = wid & 3, fr = lane & 15, fq = lane >> 4;
    const int K = g.K, nt = K / BK;
    unsigned voffA[2], voffB[2];
#pragma unroll
    for (int i = 0; i < 2; ++i) { int R, C; stage_rc(tid * 16 + i * 8192, R, C); const int Rb = Epi::PERM ? ((R & ~31) + perm32(R & 31)) : R;
        voffA[i] = (unsigned)(R * K + C) * 2u; voffB[i] = (unsigned)(Rb * K + C) * 2u; }
    const size_t kstep = (size_t)(BK * 2);
    const size_t hstep = (size_t)HALF * K * 2;
    const size_t tstep = 2 * hstep;
    const unsigned ldsw = (unsigned)wid * 1024u;
    const int aoff = lds_byte(wr * 64 + fr, fq * 8), boff = lds_byte(wc * 32 + fr, fq * 8);
#define PG8_SA(b, h) (((b) * 2 + (h)) * HTB)
#define PG8_SB(b, h) ((4 + (b) * 2 + (h)) * HTB)
#define PG8_STAGE(bufoff, gbase, voff) do { _Pragma("unroll") for (int _i = 0; _i < 2; ++_i) \
        __builtin_amdgcn_global_load_lds((const unsigned*)((const char*)(gbase) + (voff)[_i]), (PG8_LAS unsigned*)(lds + (bufoff) + ldsw + _i * 8192), 16, 0, 0); } while (0)
#define PG8_LDA(dst, b, h) do { _Pragma("unroll") for (int m = 0; m < 4; ++m) _Pragma("unroll") for (int k = 0; k < 2; ++k) dst[m][k] = *(const PG8_LAS bf16x8*)(lds + PG8_SA(b, h) + aoff + m * 2048 + k * 1024); } while (0)
#define PG8_LDB(dst, b, h) do { _Pragma("unroll") for (int n = 0; n < 2; ++n) _Pragma("unroll") for (int k = 0; k < 2; ++k) dst[n][k] = *(const PG8_LAS bf16x8*)(lds + PG8_SB(b, h) + boff + n * 2048 + k * 1024); } while (0)
#define PG8_MMA(ai, bj, At, Bt) do { __builtin_amdgcn_s_setprio(1); _Pragma("unroll") for (int m = 0; m < 4; ++m) _Pragma("unroll") for (int n = 0; n < 2; ++n) _Pragma("unroll") for (int k = 0; k < 2; ++k) \
        acc[ai][bj][m][n] = __builtin_amdgcn_mfma_f32_16x16x32_bf16(Bt[n][k], At[m][k], acc[ai][bj][m][n], 0, 0, 0); __builtin_amdgcn_s_setprio(0); } while (0)
#define PG8_WAIT_V(n) asm volatile("s_waitcnt vmcnt(" #n ")" ::: "memory")
#define PG8_WAIT_L(n) asm volatile("s_waitcnt lgkmcnt(" #n ")" ::: "memory")
#define PG8_BAR __builtin_amdgcn_s_barrier()
#define PG8_SCHED __builtin_amdgcn_sched_barrier(0)
    Unit cur, nxt; int ui = 0;
    if (!S.next(0, cur)) return;
    f32x4 acc[2][2][4][2];
#pragma unroll
    for (int a = 0; a < 2; ++a)
#pragma unroll
        for (int b = 0; b < 2; ++b)
#pragma unroll
            for (int m = 0; m < 4; ++m)
#pragma unroll
                for (int n = 0; n < 2; ++n) acc[a][b][m][n] = (f32x4){0.f, 0.f, 0.f, 0.f};
    bf16x8 At[4][2], B0[2][2], B1[2][2];
    const char* cA = (const char*)g.A + (size_t)cur.pm * tstep; const char* cB = (const char*)g.Bt + (size_t)cur.pn * tstep;
    S.a_ready(cur);
    if constexpr (SP2) {
        PG8_STAGE(PG8_SB(0, 0), cB, voffB); PG8_STAGE(PG8_SB(0, 1), cB + hstep, voffB); PG8_STAGE(PG8_SA(0, 0), cA, voffA); PG8_STAGE(PG8_SA(0, 1), cA + hstep, voffA);
        if (wr == 1) PG8_BAR;
        PG8_WAIT_V(2); PG8_BAR;
        PG8_STAGE(PG8_SB(1, 0), cB + kstep, voffB); PG8_STAGE(PG8_SA(1, 0), cA + kstep, voffA); PG8_STAGE(PG8_SB(1, 1), cB + hstep + kstep, voffB);
        PG8_WAIT_V(6); PG8_BAR;
    } else {
        PG8_STAGE(PG8_SB(0, 0), cB, voffB); PG8_STAGE(PG8_SA(0, 0), cA, voffA); PG8_STAGE(PG8_SB(0, 1), cB + hstep, voffB); PG8_STAGE(PG8_SA(0, 1), cA + hstep, voffA);
        if (wr == 1) PG8_BAR;
        PG8_WAIT_V(4); PG8_BAR;
        PG8_STAGE(PG8_SB(1, 0), cB + kstep, voffB); PG8_STAGE(PG8_SA(1, 0), cA + kstep, voffA); PG8_STAGE(PG8_SB(1, 1), cB + hstep + kstep, voffB);
        PG8_WAIT_V(6); PG8_BAR;
    }
    for (;;) {
        const bool has_next = S.next(ui + 1, nxt);
        const char* nA = has_next ? (const char*)g.A + (size_t)nxt.pm * tstep : cA; const char* nB = has_next ? (const char*)g.Bt + (size_t)nxt.pn * tstep : cB;
        for (int t = 0; t < nt; t += 2) {
            const bool last = (t == nt - 2);
            const char* a1 = cA + (size_t)(t + 1) * kstep;
            const char* a2 = last ? nA : cA + (size_t)(t + 2) * kstep; const char* b2 = last ? nB : cB + (size_t)(t + 2) * kstep;
            const char* a3 = a2 + kstep; const char* b3 = b2 + kstep;
            if (last && has_next) S.a_ready(nxt);
            if constexpr (SP2) {
            PG8_LDB(B0, 0, 0); PG8_LDB(B1, 0, 1); PG8_SCHED; PG8_LDA(At, 0, 0); PG8_STAGE(PG8_SA(1, 1), a1 + hstep, voffA);
            PG8_WAIT_V(8); PG8_WAIT_L(0); PG8_BAR; PG8_MMA(0, 0, At, B0); PG8_MMA(0, 1, At, B1); PG8_BAR; PG8_SCHED;
            PG8_LDA(At, 0, 1); PG8_STAGE(PG8_SB(0, 0), b2, voffB); PG8_STAGE(PG8_SB(0, 1), b2 + hstep, voffB); PG8_STAGE(PG8_SA(0, 0), a2, voffA);
            PG8_WAIT_V(8); PG8_WAIT_L(0); PG8_BAR; PG8_MMA(1, 0, At, B0); PG8_MMA(1, 1, At, B1); PG8_BAR; PG8_SCHED;
            PG8_LDB(B0, 1, 0); PG8_LDB(B1, 1, 1); PG8_SCHED; PG8_LDA(At, 1, 0); PG8_STAGE(PG8_SA(0, 1), a2 + hstep, voffA);
            PG8_WAIT_V(8); PG8_WAIT_L(0); PG8_BAR; PG8_MMA(0, 0, At, B0); PG8_MMA(0, 1, At, B1); PG8_BAR; PG8_SCHED;
            PG8_LDA(At, 1, 1); PG8_STAGE(PG8_SB(1, 0), b3, voffB); PG8_STAGE(PG8_SB(1, 1), b3 + hstep, voffB); PG8_STAGE(PG8_SA(1, 0), a3, voffA);
            PG8_WAIT_V(8); PG8_WAIT_L(0); PG8_BAR; PG8_MMA(1, 0, At, B0); PG8_MMA(1, 1, At, B1); PG8_BAR; PG8_SCHED;
            } else {
            PG8_LDB(B0, 0, 0); PG8_SCHED; PG8_LDA(At, 0, 0); PG8_STAGE(PG8_SA(1, 1), a1 + hstep, voffA);
            PG8_WAIT_L(8); PG8_BAR; PG8_WAIT_L(0); PG8_MMA(0, 0, At, B0); PG8_BAR; PG8_SCHED;
            PG8_LDB(B1, 0, 1); PG8_STAGE(PG8_SB(0, 0), b2, voffB);
            PG8_BAR; PG8_WAIT_L(0); PG8_MMA(0, 1, At, B1); PG8_BAR;
            PG8_LDA(At, 0, 1); PG8_STAGE(PG8_SA(0, 0), a2, voffA);
            PG8_BAR; PG8_WAIT_L(0); PG8_MMA(1, 0, At, B0); PG8_BAR; PG8_SCHED;
            PG8_STAGE(PG8_SB(0, 1), b2 + hstep, voffB);
            PG8_WAIT_V(6); PG8_BAR; PG8_MMA(1, 1, At, B1); PG8_BAR;
            PG8_LDB(B0, 1, 0); PG8_SCHED; PG8_LDA(At, 1, 0); PG8_STAGE(PG8_SA(0, 1), a2 + hstep, voffA);
            PG8_WAIT_L(8); PG8_BAR; PG8_WAIT_L(0); PG8_MMA(0, 0, At, B0); PG8_BAR; PG8_SCHED;
            PG8_LDB(B1, 1, 1); PG8_STAGE(PG8_SB(1, 0), b3, voffB);
            PG8_BAR; PG8_WAIT_L(0); PG8_MMA(0, 1, At, B1); PG8_BAR;
            PG8_LDA(At, 1, 1); PG8_STAGE(PG8_SA(1, 0), a3, voffA);
            PG8_BAR; PG8_WAIT_L(0); PG8_MMA(1, 0, At, B0); PG8_BAR; PG8_SCHED;
            PG8_STAGE(PG8_SB(1, 1), b3 + hstep, voffB);
            PG8_WAIT_V(6); PG8_BAR; PG8_MMA(1, 1, At, B1); PG8_BAR;
            }
        }
        if constexpr (ALIGN_EPI) { if (wr == 0) PG8_BAR; }
        if constexpr (!Epi::AFTER_DRAIN) { E(acc, cur, wr, wc, fr, fq); S.done(cur); }
        if (!has_next) break;
#pragma unroll
        for (int a = 0; a < 2; ++a)
#pragma unroll
            for (int b = 0; b < 2; ++b)
#pragma unroll
                for (int m = 0; m < 4; ++m)
#pragma unroll
                    for (int n = 0; n < 2; ++n) acc[a][b][m][n] = (f32x4){0.f, 0.f, 0.f, 0.f};
        cur = nxt; cA = nA; cB = nB; ++ui;
        if constexpr (ALIGN_EPI) { if (wr == 1) PG8_BAR; }
    }
    PG8_WAIT_V(0);
    if constexpr (!ALIGN_EPI) { if (wr == 0) PG8_BAR; }
    PG8_BAR;
    if constexpr (Epi::AFTER_DRAIN) { E.fused(acc, cur, wr, wc, fr, fq, lds, wid, lane); S.done(cur); }
#undef PG8_SA
#undef PG8_SB
#undef PG8_STAGE
#undef PG8_LDA
#undef PG8_LDB
#undef PG8_MMA
#undef PG8_WAIT_V
#undef PG8_WAIT_L
#undef PG8_BAR
#undef PG8_SCHED
}
}
namespace xb {
#define LAS __attribute__((address_space(3)))
#define XB_TMO      128
#define XB_XCNT(j)  (256  + 64 * (j))
#define XB_XSUB(j)  (1280 + 64 * (j))
#define XB_XGEN(j)  (2304 + 64 * (j))
#define XB_TOP      3328
#define XB_TOPGEN   3392
#define XCD_BAR_WORDS 3456
#define XB_SPIN_CAP (1u << 18)

__device__ __forceinline__ unsigned xb_ld(unsigned* p)              { return __hip_atomic_load(p, __ATOMIC_RELAXED, __HIP_MEMORY_SCOPE_AGENT); }
__device__ __forceinline__ unsigned xb_add(unsigned* p, unsigned v) { return __hip_atomic_fetch_add(p, v, __ATOMIC_RELAXED, __HIP_MEMORY_SCOPE_AGENT); }
__device__ __forceinline__ unsigned xb_xcc_id() { return (unsigned)__builtin_amdgcn_s_getreg((3 << 11) | 20) & 0xFu; }
#define XB_SPIN(cond, bar) do { unsigned _sp = 0; while (cond) { __builtin_amdgcn_s_sleep(1); \
    if ((++_sp & 255u) == 0u) { if (xb_ld(&(bar)[XB_TMO])) break; if (_sp > XB_SPIN_CAP) { atomicAdd(&(bar)[XB_TMO], 1u); break; } } } } while (0)

struct XcdBarrier {
    unsigned* bar; unsigned x;
    volatile LAS unsigned* st;
};

__device__ __forceinline__ XcdBarrier xcd_barrier_post(unsigned* bar, volatile LAS unsigned* st) {
    XcdBarrier b; b.bar = bar; b.x = xb_xcc_id(); b.st = st;
    if (threadIdx.x == 0) (void)xb_add(&bar[XB_XCNT(b.x)], 1u);
    return b;
}
__device__ __forceinline__ void xcd_barrier_complete(unsigned* bar, unsigned x, unsigned& nloc, unsigned& nx) {
    const unsigned G = gridDim.x * gridDim.y * gridDim.z;
    unsigned sum, cnt, mine, sp = 0u;
    for (;;) {
        sum = 0u; cnt = 0u; mine = 0u;
#pragma unroll
        for (unsigned j = 0; j < 16; ++j) { const unsigned c = xb_ld(&bar[XB_XCNT(j)]); sum += c; cnt += (c > 0u) ? 1u : 0u; mine = (j == x) ? c : mine; }
        if (sum == G) break;
        __builtin_amdgcn_s_sleep(1);
        if ((++sp & 255u) == 0u) { if (xb_ld(&bar[XB_TMO])) break; if (sp > XB_SPIN_CAP) { atomicAdd(&bar[XB_TMO], 1u); break; } }
    }
    nloc = mine > 0u ? mine : 1u; nx = cnt > 0u ? cnt : 1u;
}

__device__ __forceinline__ void xcd_barrier(const XcdBarrier& b) {
    asm volatile("s_waitcnt vmcnt(0)" ::: "memory");
    __syncthreads();
    if (threadIdx.x == 0) {
        unsigned* bar = b.bar;
        __builtin_amdgcn_s_waitcnt(0);
        unsigned nloc = b.st[0], nx = b.st[1];
        if (nloc == 0u) { xcd_barrier_complete(bar, b.x, nloc, nx); b.st[0] = nloc; b.st[1] = nx; }
        const unsigned old = xb_add(&bar[XB_XSUB(b.x)], 1u);
        const unsigned gen = old / nloc;
        if (old + 1u == (gen + 1u) * nloc) {
            __builtin_amdgcn_fence(__ATOMIC_RELEASE, "agent");
            asm volatile("s_waitcnt vmcnt(0)" ::: "memory");
            const unsigned og = xb_add(&bar[XB_TOP], 1u);
            const unsigned tg = og / nx;
            if (og + 1u == (tg + 1u) * nx) xb_add(&bar[XB_TOPGEN], 1u);
            else XB_SPIN(xb_ld(&bar[XB_TOPGEN]) == tg, bar);
            __builtin_amdgcn_fence(__ATOMIC_ACQUIRE, "agent");
            xb_add(&bar[XB_XGEN(b.x)], 1u);
            asm volatile("s_waitcnt vmcnt(0)" ::: "memory");
        } else {
            XB_SPIN(xb_ld(&bar[XB_XGEN(b.x)]) == gen, bar);
            __builtin_amdgcn_fence(__ATOMIC_ACQUIRE, "agent");
            asm volatile("s_waitcnt vmcnt(0)" ::: "memory");
        }
    }
    __syncthreads();
}

}
namespace mk {
#define LAS __attribute__((address_space(3)))
typedef unsigned short bf16_t;
typedef short bf16x8 __attribute__((ext_vector_type(8)));
typedef short s16x4 __attribute__((ext_vector_type(4)));
typedef float f32x4 __attribute__((ext_vector_type(4)));
typedef float f32x16 __attribute__((ext_vector_type(16)));
typedef unsigned u32x4 __attribute__((ext_vector_type(4)));
typedef unsigned u32x2 __attribute__((ext_vector_type(2)));
constexpr int NB = 8, S = 4096, D = 1024, M = NB * S, NH = 4, DFF = 2816, DIN = 2560, NWAVES = 8;
constexpr float EPS = 1e-6f, LOG2E = 1.4426950408889634f;
constexpr float QSCALE = 0.125f * LOG2E;
constexpr size_t MiB = 1u << 20;
constexpr size_t WS_WIN = 1 * MiB, WS_WOUT = 6 * MiB, WS_WGU = 8 * MiB, WS_WDN = 19 * MiB, WS_RSS1 = 25 * MiB, WS_RSS2 = 27 * MiB;
constexpr size_t WS_XN = 32 * MiB, WS_Q = 96 * MiB, WS_KT = 128 * MiB, WS_VT = 160 * MiB, WS_XR = 192 * MiB, WS_GR = 224 * MiB, WS_HF = 256 * MiB, WS_MIXED = 320 * MiB, WS_ACT = 96 * MiB, WS_END = 384 * MiB;
static_assert(WS_ACT + (size_t)M * DFF * 2 <= WS_MIXED, "act overlays Q..HF only");
constexpr int RING_BYTES = 131072, LDS_MISC = 131072, LDS_BYTES = 147456;

__device__ __forceinline__ unsigned cvt_pk_bf16(float lo, float hi) { return pg8::cvt_pk_bf16(lo, hi); }
__device__ __forceinline__ float bf2f(unsigned short b) { return __uint_as_float(((unsigned)b) << 16); }
__device__ __forceinline__ float wave_sum(float v) {
#pragma unroll
    for (int o = 1; o < 64; o <<= 1) v += __shfl_xor(v, o);
    return v;
}
__device__ __forceinline__ float fast_sigmoid(float x) { return __builtin_amdgcn_rcpf(1.0f + __builtin_amdgcn_exp2f(-LOG2E * x)); }

template <int MAP  >
__device__ __forceinline__ void p0_transpose_item(const float* W, int K, int N, bf16_t* WT, const float* gk, LAS float* scr, int item, int lane) {
    const int nblk = N / 32, kb = item / nblk, nb = item % nblk, k0 = 64 * kb, n0 = 32 * nb;
#pragma unroll 8
    for (int i = 0; i < 32; ++i) { const int kk = 2 * i + (lane >> 5); float v = W[(size_t)(k0 + kk) * N + n0 + (lane & 31)]; if (gk) v *= gk[k0 + kk]; scr[kk * 33 + (lane & 31)] = v; }
    asm volatile("s_waitcnt lgkmcnt(0)" ::: "memory");
    const int c = lane & 7;
#pragma unroll
    for (int j = 0; j < 4; ++j) { const int n = (lane >> 3) + 8 * j; const LAS float* s = scr + (8 * c) * 33 + n;
        u32x4 o; o.x = cvt_pk_bf16(s[0 * 33], s[1 * 33]); o.y = cvt_pk_bf16(s[2 * 33], s[3 * 33]); o.z = cvt_pk_bf16(s[4 * 33], s[5 * 33]); o.w = cvt_pk_bf16(s[6 * 33], s[7 * 33]);
        const int f = n0 + n; const int drow = (MAP == 0) ? f : (256 * (f >> 7) + (f & 127) + (MAP == 2 ? 128 : 0));
        *(u32x4*)(WT + (size_t)drow * K + k0 + 8 * c) = o; }
    asm volatile("s_waitcnt lgkmcnt(0)" ::: "memory");
}
__device__ __forceinline__ void rms_row_to_bf16(const float* xrow, const float* g, bf16_t* orow, int lane) {
    const f32x4* xr = (const f32x4*)xrow + lane; const f32x4* gr = (const f32x4*)g + lane;
    f32x4 v[4]; float s = 0.f;
#pragma unroll
    for (int j = 0; j < 4; ++j) { v[j] = xr[64 * j]; s += (v[j][0] * v[j][0] + v[j][1] * v[j][1]) + (v[j][2] * v[j][2] + v[j][3] * v[j][3]); }
    const float rstd = 1.0f / sqrtf(wave_sum(s) * (1.f / D) + EPS);
    u32x2* o8 = (u32x2*)orow + lane;
#pragma unroll
    for (int j = 0; j < 4; ++j) { const f32x4 gg = gr[64 * j]; u32x2 w; w.x = cvt_pk_bf16(v[j][0] * rstd * gg[0], v[j][1] * rstd * gg[1]); w.y = cvt_pk_bf16(v[j][2] * rstd * gg[2], v[j][3] * rstd * gg[3]); o8[64 * j] = w; }
}

namespace att {
constexpr int NT = S / 64, SLOT = 16384, LDS_K = 0, LDS_V = 3 * SLOT, LDS_OST = 4 * SLOT, LDS_X = 0;
constexpr int LDS_WSF = LDS_MISC, LDS_BIAS = LDS_MISC + 2048, LDS_TOT = LDS_MISC + 3072, LDS_CW = LDS_MISC + 5120;
constexpr int THR = 8;
typedef LAS const char* lds_cptr;
typedef short v4i16_t __attribute__((ext_vector_type(4)));
__device__ __forceinline__ int crow(int r, int hi) { return (r & 3) + 8 * (r >> 2) + 4 * hi; }
__device__ __forceinline__ void glds16(const void* gsrc, unsigned lds_dst) { unsigned keep;
    asm volatile("s_mov_b32 %0, m0\n\ts_mov_b32 m0, %2\n\ts_nop 0\n\tglobal_load_lds_dwordx4 %1, off\n\ts_mov_b32 m0, %0" : "=&s"(keep) : "v"(gsrc), "s"(lds_dst) : "memory"); }
__device__ __forceinline__ s16x4 vtr(lds_cptr p) { return __builtin_bit_cast(s16x4, __builtin_amdgcn_ds_read_tr16_b64_v4i16((LAS v4i16_t*)p)); }
#define ATT_MX3(a, b, c) __builtin_fmaxf(__builtin_fmaxf((a), (b)), (c))
__device__ __forceinline__ float rowmax(const f32x16& p0, const f32x16& p1) {
    float a = ATT_MX3(p0[0], p0[1], p1[0]), b = ATT_MX3(p0[2], p0[3], p1[1]); a = ATT_MX3(a, p1[2], p1[3]);
#pragma unroll
    for (int r = 4; r < 16; r += 4) { a = ATT_MX3(a, p0[r], p0[r + 1]); b = ATT_MX3(b, p0[r + 2], p0[r + 3]); a = ATT_MX3(a, p1[r], p1[r + 1]); b = ATT_MX3(b, p1[r + 2], p1[r + 3]); }
    float m = __builtin_fmaxf(a, b); auto rr = __builtin_amdgcn_permlane32_swap(__float_as_uint(m), __float_as_uint(m), false, false);
    return __builtin_fmaxf(__uint_as_float(rr[0]), __uint_as_float(rr[1]));
}
#define ATT_WAIT_BAR(N) asm volatile("s_waitcnt vmcnt(" #N ") lgkmcnt(0)\n\ts_barrier" ::: "memory")
#define ATT_MFMA(a, b, c) __builtin_amdgcn_mfma_f32_32x32x16_bf16(a, b, c, 0, 0, 0)

template <bool FIRST>
__device__ __forceinline__ void tile_h1(int t, lds_cptr kp, const bf16x8 (&qr)[4], f32x16 (&o)[4], u32x4 (&pw)[4], float& mhat, float& l_reg,
                                        LAS float* wsf, const LAS float* btab, int qrow, int qw0, float c_left, float c_right, int r32, int hi) {
    const int relmin = 64 * t - qw0 - 31, relmax = 64 * t + 63 - qw0;
    const bool band = !(relmax <= -91 || relmin >= 91);
    const float cb = band ? 0.f : (relmin >= 91 ? c_right : c_left);
    f32x16 p0, p1;
    const f32x16 z16 = (f32x16){0.f, 0.f, 0.f, 0.f, 0.f, 0.f, 0.f, 0.f, 0.f, 0.f, 0.f, 0.f, 0.f, 0.f, 0.f, 0.f};
#pragma unroll
    for (int d0 = 0; d0 < 4; ++d0) {
        const bf16x8 k0 = *(const LAS bf16x8*)(kp + d0 * 2048), k1 = *(const LAS bf16x8*)(kp + d0 * 2048 + 512);
        if (d0 == 0) { p0 = ATT_MFMA(k0, qr[0], z16); p1 = ATT_MFMA(k1, qr[0], z16); }
        else { p0 = ATT_MFMA(k0, qr[d0], p0); p1 = ATT_MFMA(k1, qr[d0], p1); }
    }
    if (band) {
        const int relb = 64 * t + 4 * hi - qrow + 128;
#pragma unroll
        for (int r = 0; r < 16; ++r) { const int i0 = relb + (r & 3) + 8 * (r >> 2); const int a0 = i0 < 0 ? 0 : (i0 > 255 ? 255 : i0); const int i1 = i0 + 32; const int a1 = i1 < 0 ? 0 : (i1 > 255 ? 255 : i1);
            p0[r] += btab[a0]; p1[r] += btab[a1]; }
    }
    const float rm = rowmax(p0, p1) + cb;
    if (FIRST) { mhat = rm; }
    else if (__builtin_expect(__any(rm - mhat > (float)THR), 0)) {
        const float dl = __builtin_fmaxf(rm - mhat, 0.f); mhat += dl;
        const float f = __builtin_amdgcn_exp2f(-dl); l_reg *= f;
        if (hi == 0) wsf[r32] = f;
        asm volatile("s_waitcnt lgkmcnt(0)" ::: "memory");
        float fr[16];
#pragma unroll
        for (int r = 0; r < 16; ++r) fr[r] = wsf[crow(r, hi)];
#pragma unroll
        for (int db = 0; db < 4; ++db)
#pragma unroll
            for (int r = 0; r < 16; ++r) o[db][r] *= fr[r];
        asm volatile("s_waitcnt lgkmcnt(0)" ::: "memory");
    }
    const float off = cb - mhat;
    float sacc = 0.f;
#pragma unroll
    for (int r = 0; r < 16; ++r) { p0[r] = __builtin_amdgcn_exp2f(p0[r] + off); p1[r] = __builtin_amdgcn_exp2f(p1[r] + off); sacc += p0[r] + p1[r]; }
    l_reg += sacc;
#pragma unroll
    for (int ks = 0; ks < 4; ++ks) { const f32x16& P = (ks < 2) ? p0 : p1; const int b = 8 * (ks & 1);
        pw[ks] = (u32x4){cvt_pk_bf16(P[b], P[b + 1]), cvt_pk_bf16(P[b + 2], P[b + 3]), cvt_pk_bf16(P[b + 4], P[b + 5]), cvt_pk_bf16(P[b + 6], P[b + 7])}; }
}
__device__ __forceinline__ void tile_h2(lds_cptr vp, f32x16 (&o)[4], const u32x4 (&pw)[4]) {
#pragma unroll
    for (int ks = 0; ks < 4; ++ks)
#pragma unroll
        for (int db = 0; db < 4; ++db) {
            const s16x4 lo = vtr(vp + db * 4096 + ks * 1024), h4 = vtr(vp + db * 4096 + ks * 1024 + 512);
            const bf16x8 vf = (bf16x8){lo[0], lo[1], lo[2], lo[3], h4[0], h4[1], h4[2], h4[3]};
            o[db] = ATT_MFMA(__builtin_bit_cast(bf16x8, pw[ks]), vf, o[db]);
        }
}

__device__ __forceinline__ void attn_unit(int b, int h, int qb, const bf16_t* Q, const bf16_t* KT, const bf16_t* VT, bf16_t* MIXED, LAS unsigned char* lds, float lam, const float* subln_g, const float* rel_bias) {
    const int tid = threadIdx.x, lane = tid & 63, r32 = lane & 31, hi = lane >> 5; const int wid = __builtin_amdgcn_readfirstlane(tid >> 6);
    const int wq = wid & 3, mp = wid >> 2;
    const size_t rowbase = (size_t)b * S; const int q0 = qb * 128, qw0 = q0 + 32 * wq, qrow = qw0 + r32;
    LAS float* btab = (LAS float*)(lds + LDS_BIAS); LAS float* wsf = (LAS float*)(lds + LDS_WSF) + wid * 64;
    if (tid < 256) { const int rel = tid - 128; const int n = rel < 0 ? -rel : rel; int bk; if (n < 8) bk = n; else { bk = 2 + (31 - __clz(n * n)); if (bk > 15) bk = 15; } if (rel > 0) bk += 16;
        btab[tid] = rel_bias[bk * NH + h] * LOG2E; }
    const float c_left = rel_bias[15 * NH + h] * LOG2E, c_right = rel_bias[31 * NH + h] * LOG2E;
    const bf16_t* Qw = Q + (rowbase + qw0) * 512 + h * 128 + mp * 64;
    bf16x8 qr[4];
#pragma unroll
    for (int d0 = 0; d0 < 4; ++d0) qr[d0] = *(const bf16x8*)(Qw + (size_t)r32 * 512 + d0 * 16 + hi * 8);
    const char* k1src = (const char*)KT + ((size_t)((b * 4 + h) * 2) * 64) * 8192 + wid * 1024 + lane * 16;
    const char* k2src = k1src + (size_t)64 * 8192;
    const char* vsrc = (const char*)VT + ((size_t)(b * 4 + h) * 64) * 16384 + wid * 1024 + lane * 16;
    const unsigned lds0 = (unsigned)(uintptr_t)(unsigned char*)lds;
    const unsigned kdst = lds0 + LDS_K + wid * 1024, vdst = lds0 + LDS_V + wid * 1024;
    const lds_cptr kp0 = (lds_cptr)lds + LDS_K + mp * 8192 + hi * 1024 + r32 * 16;
    const lds_cptr vp0 = (lds_cptr)lds + LDS_V + ((lane >> 4) & 1) * 32 + (lane & 3) * 8 + (4 * hi + ((lane & 15) >> 2)) * 64;
#define ATT_DMA_TILE(t, ks_, vs_) do { glds16(k1src + (size_t)(t) * 8192, (unsigned)__builtin_amdgcn_readfirstlane(kdst + (ks_))); glds16(k2src + (size_t)(t) * 8192, (unsigned)__builtin_amdgcn_readfirstlane(kdst + (ks_) + 8192)); \
        glds16(vsrc + (size_t)(t) * 16384, (unsigned)__builtin_amdgcn_readfirstlane(vdst + (vs_))); glds16(vsrc + (size_t)(t) * 16384 + 8192, (unsigned)__builtin_amdgcn_readfirstlane(vdst + (vs_) + 8192)); } while (0)
    ATT_DMA_TILE(0, 0, 0); ATT_DMA_TILE(1, SLOT, SLOT);
    float mhat = 0.f, l_reg = 0.f; f32x16 o[4]; u32x4 pw[4];
#pragma unroll
    for (int db = 0; db < 4; ++db)
#pragma unroll
        for (int r = 0; r < 16; ++r) o[db][r] = 0.f;
    int ksl = 0, ksl2 = 2 * SLOT, vsl = 0, vsl2 = 2 * SLOT, vprev = 0;
#define ATT_ROT() do { ksl = (ksl == 2 * SLOT) ? 0 : ksl + SLOT; ksl2 = (ksl2 == 2 * SLOT) ? 0 : ksl2 + SLOT; vprev = vsl; vsl = (vsl + SLOT) & (4 * SLOT - 1); vsl2 = (vsl2 + SLOT) & (4 * SLOT - 1); } while (0)
#define ATT_H1(FIRST_, t) tile_h1<FIRST_>(t, kp0 + ksl, qr, o, pw, mhat, l_reg, wsf, btab, qrow, qw0, c_left, c_right, r32, hi)
    if (mp == 0) {
        ATT_WAIT_BAR(4); ATT_DMA_TILE(2, ksl2, vsl2); ATT_H1(true, 0); tile_h2(vp0 + vsl, o, pw); ATT_ROT();
        for (int t = 1; t < NT - 2; ++t) { ATT_WAIT_BAR(4); ATT_DMA_TILE(t + 2, ksl2, vsl2); ATT_H1(false, t); tile_h2(vp0 + vsl, o, pw); ATT_ROT(); }
        ATT_WAIT_BAR(4); ATT_H1(false, NT - 2); tile_h2(vp0 + vsl, o, pw); ATT_ROT();
        ATT_WAIT_BAR(0); ATT_H1(false, NT - 1); tile_h2(vp0 + vsl, o, pw);
    } else {
        ATT_WAIT_BAR(4); ATT_DMA_TILE(2, ksl2, vsl2); ATT_H1(true, 0); ATT_ROT();
        for (int t = 1; t < NT - 2; ++t) { ATT_WAIT_BAR(4); ATT_DMA_TILE(t + 2, ksl2, vsl2); tile_h2(vp0 + vprev, o, pw); ATT_H1(false, t); ATT_ROT(); }
        ATT_WAIT_BAR(4); tile_h2(vp0 + vprev, o, pw); ATT_H1(false, NT - 2); ATT_ROT();
        ATT_WAIT_BAR(0); tile_h2(vp0 + vprev, o, pw); ATT_H1(false, NT - 1);
        tile_h2(vp0 + vsl, o, pw);
    }
#undef ATT_H1
    { auto rr = __builtin_amdgcn_permlane32_swap(__float_as_uint(l_reg), __float_as_uint(l_reg), false, false); l_reg = __uint_as_float(rr[0]) + __uint_as_float(rr[1]); }
    const float scale_q = (mp == 0 ? 1.0f : lam) * __builtin_amdgcn_rcpf(l_reg);
    if (hi == 0) wsf[r32] = scale_q;
    asm volatile("s_waitcnt lgkmcnt(0)" ::: "memory");
    float sc[16];
#pragma unroll
    for (int r = 0; r < 16; ++r) sc[r] = wsf[crow(r, hi)];
    asm volatile("s_waitcnt lgkmcnt(0)\n\ts_barrier" ::: "memory");
    LAS float* X = (LAS float*)(lds + LDS_X) + wq * 4096 + lane;
    if (mp == 1) {
#pragma unroll
        for (int db = 0; db < 4; ++db)
#pragma unroll
            for (int r = 0; r < 16; ++r) X[(db * 16 + r) * 64] = o[db][r] * sc[r];
    }
    asm volatile("s_waitcnt lgkmcnt(0)\n\ts_barrier" ::: "memory");
    if (mp == 0) {
        float ss[16];
#pragma unroll
        for (int r = 0; r < 16; ++r) ss[r] = 0.f;
#pragma unroll
        for (int db = 0; db < 4; ++db)
#pragma unroll
            for (int r = 0; r < 16; ++r) { const float d = o[db][r] * sc[r] - X[(db * 16 + r) * 64]; o[db][r] = d; ss[r] += d * d; }
#pragma unroll
        for (int r = 0; r < 16; ++r) {
#pragma unroll
            for (int x = 1; x < 32; x <<= 1) ss[r] += __shfl_xor(ss[r], x);
            ss[r] = __builtin_amdgcn_rsqf(ss[r] * (1.0f / 128.0f) + EPS) * 0.8f;
        }
        LAS bf16_t* stg = (LAS bf16_t*)(lds + LDS_OST) + wq * 4096;
#pragma unroll
        for (int db = 0; db < 4; ++db) { const float g = subln_g[db * 32 + r32];
#pragma unroll
            for (int r = 0; r < 16; ++r) { const unsigned w = cvt_pk_bf16(o[db][r] * ss[r] * g, 0.f); stg[crow(r, hi) * 128 + db * 32 + r32] = (bf16_t)(w & 0xffffu); } }
        asm volatile("s_waitcnt lgkmcnt(0)" ::: "memory");
        bf16_t* Ow = MIXED + (rowbase + qw0) * 1024 + h * 128;
#pragma unroll
        for (int i = 0; i < 8; ++i) { const int row = i * 4 + (lane >> 4), ch = lane & 15; const u32x4 v = *(const LAS u32x4*)(stg + row * 128 + ch * 8); *(u32x4*)(Ow + (size_t)row * 1024 + ch * 8) = v; }
    }
    asm volatile("s_waitcnt vmcnt(0) lgkmcnt(0)\n\ts_barrier" ::: "memory");
#undef ATT_DMA_TILE
#undef ATT_ROT
}
}

namespace lru {
template <int N> __device__ __forceinline__ float dpp_shr(float v, float ident) {
    return __int_as_float(__builtin_amdgcn_update_dpp(__float_as_int(ident), __float_as_int(v), 0x110 + N, 0xF, 0xF, false));
}
#define LRU_MFMA16(a, b, c) __builtin_amdgcn_mfma_f32_16x16x32_bf16(a, b, c, 0, 0, 0)
__device__ __forceinline__ void lru_item(int b, int cg, const bf16_t* XR, const bf16_t* GR, float* HF, bf16_t* MIXED, LAS unsigned char* lds,
                                         const float* conv_w, const float* conv_b, const float* w_rg, const float* b_rg, const float* w_ig, const float* b_ig, const float* lru_lambda) {
    const int tid = threadIdx.x, lane = tid & 63, p = lane & 15, g = lane >> 4; const int wid = __builtin_amdgcn_readfirstlane(tid >> 6);
    const int n = cg >> 2, e16 = cg & 3, c0 = n * 64 + e16 * 16;
    const size_t rowbase = (size_t)b * S;
    LAS float* tot = (LAS float*)(lds + att::LDS_TOT);
    bf16x8 idf;
#pragma unroll
    for (int j = 0; j < 8; ++j) idf[j] = ((8 * g + j) == (16 * (e16 & 1) + p)) ? (short)0x3f80 : (short)0;
    int par = 0;
    LAS float* cwl = (LAS float*)(lds + att::LDS_CW);
    if (tid < 320) { const int j = tid >> 6, c = tid & 63; cwl[tid] = (j < 4) ? conv_w[j * 512 + n * 64 + c] : conv_b[n * 64 + c]; }
    __syncthreads();
    for (int dir = 0; dir < 2; ++dir) {
        bf16x8 wrf[2], wif[2];
#pragma unroll
        for (int ks = 0; ks < 2; ++ks) {
            unsigned wr_[4], wi_[4];
#pragma unroll
            for (int j2 = 0; j2 < 4; ++j2) { const int d = 32 * ks + 8 * g + 2 * j2; const size_t i0 = ((size_t)((dir * 8 + n) * 64 + d)) * 64 + e16 * 16 + p;
                wr_[j2] = cvt_pk_bf16(w_rg[i0], w_rg[i0 + 64]); wi_[j2] = cvt_pk_bf16(w_ig[i0], w_ig[i0 + 64]); }
            wrf[ks] = __builtin_bit_cast(bf16x8, (u32x4){wr_[0], wr_[1], wr_[2], wr_[3]}); wif[ks] = __builtin_bit_cast(bf16x8, (u32x4){wi_[0], wi_[1], wi_[2], wi_[3]});
        }
        float br[4], bi[4], sp8[4], carry[4];
#pragma unroll
        for (int r = 0; r < 4; ++r) { const int c = dir * 512 + c0 + 4 * g + r; br[r] = b_rg[c]; bi[r] = b_ig[c]; const float lm = lru_lambda[c]; sp8[r] = 8.0f * log1pf(expf(-lm)); carry[r] = 0.f; }
        for (int sc = 0; sc < 8; ++sc) {
            const int P0 = sc * 512 + wid * 64;
            f32x4 ar[4], ai[4], ax[4];
            {
                const int Pb = P0 + 4 * p; const int tlo = dir ? (S - 1 - Pb - 5) : (Pb - 2);
                bf16x8 xf[4][2];
#pragma unroll
                for (int ks = 0; ks < 2; ++ks) {
                    const int c8 = n * 64 + 32 * ks + 8 * g, cl8 = 32 * ks + 8 * g;
                    bf16x8 rowv[7];
#pragma unroll
                    for (int k = 0; k < 7; ++k) {
                        const int tt = tlo + k; const bool ok = (tt >= 0) && (tt < S); const int tc = tt < 0 ? 0 : (tt >= S ? S - 1 : tt);
                        const bf16x8 xv = *(const bf16x8*)(XR + (rowbase + tc) * 512 + c8);
                        rowv[k] = ok ? xv : (bf16x8){0, 0, 0, 0, 0, 0, 0, 0};
                    }
                    float wj[4][8], bb[8];
#pragma unroll
                    for (int j = 0; j < 4; ++j) { const f32x4 w0 = *(const LAS f32x4*)(cwl + j * 64 + cl8), w1 = *(const LAS f32x4*)(cwl + j * 64 + cl8 + 4);
#pragma unroll
                        for (int e = 0; e < 4; ++e) { wj[j][e] = w0[e]; wj[j][4 + e] = w1[e]; } }
                    { const f32x4 b0 = *(const LAS f32x4*)(cwl + 256 + cl8), b1 = *(const LAS f32x4*)(cwl + 256 + cl8 + 4);
#pragma unroll
                      for (int e = 0; e < 4; ++e) { bb[e] = b0[e]; bb[4 + e] = b1[e]; } }
#pragma unroll
                    for (int i = 0; i < 4; ++i) {
                        float a8[8];
#pragma unroll
                        for (int e = 0; e < 8; ++e) a8[e] = bb[e];
#pragma unroll
                        for (int j = 0; j < 4; ++j) { const int k = (dir ? 3 - i : i) + j;
#pragma unroll
                            for (int e = 0; e < 8; ++e) a8[e] += wj[j][e] * bf2f((unsigned short)rowv[k][e]); }
                        xf[i][ks] = __builtin_bit_cast(bf16x8, (u32x4){cvt_pk_bf16(a8[0], a8[1]), cvt_pk_bf16(a8[2], a8[3]), cvt_pk_bf16(a8[4], a8[5]), cvt_pk_bf16(a8[6], a8[7])});
                    }
                }
                const f32x4 z = (f32x4){0.f, 0.f, 0.f, 0.f};
#pragma unroll
                for (int i = 0; i < 4; ++i) {
                    ar[i] = LRU_MFMA16(wrf[0], xf[i][0], z); ar[i] = LRU_MFMA16(wrf[1], xf[i][1], ar[i]);
                    ai[i] = LRU_MFMA16(wif[0], xf[i][0], z); ai[i] = LRU_MFMA16(wif[1], xf[i][1], ai[i]);
                    ax[i] = LRU_MFMA16(idf, (e16 & 2) ? xf[i][1] : xf[i][0], z);
                }
            }
            float hh[4][4], cpp[4][4], Al[4], Hl[4];
#pragma unroll
            for (int r = 0; r < 4; ++r) {
                float h = 0.f, cp = 1.f;
#pragma unroll
                for (int i = 0; i < 4; ++i) {
                    const float rg = fast_sigmoid(ar[i][r] + br[r]), ig = fast_sigmoid(ai[i][r] + bi[r]);
                    const float la = -rg * sp8[r]; const float a_ = __builtin_amdgcn_exp2f(la * LOG2E);
                    const float x2 = 2.0f * la;
                    const float om = -x2 * (1.0f + x2 * (0.5f + x2 * ((1.0f / 6.0f) + x2 * ((1.0f / 24.0f) + x2 * ((1.0f / 120.0f) + x2 * (1.0f / 720.0f))))));
                    const float u_ = __builtin_sqrtf(om) * (ig * ax[i][r]);
                    h = a_ * h + u_; cp = a_ * cp; hh[i][r] = h; cpp[i][r] = cp;
                }
                Al[r] = cp; Hl[r] = h;
            }
#define LRU_KS(NN) do { _Pragma("unroll") for (int r = 0; r < 4; ++r) { const float Ap = dpp_shr<NN>(Al[r], 1.0f), Hp = dpp_shr<NN>(Hl[r], 0.0f); Hl[r] = Al[r] * Hp + Hl[r]; Al[r] = Al[r] * Ap; } } while (0)
            LRU_KS(1); LRU_KS(2); LRU_KS(4); LRU_KS(8);
#undef LRU_KS
            float Aex[4], Hex[4];
#pragma unroll
            for (int r = 0; r < 4; ++r) { Aex[r] = dpp_shr<1>(Al[r], 1.0f); Hex[r] = dpp_shr<1>(Hl[r], 0.0f); }
            if (p == 15) {
#pragma unroll
                for (int r = 0; r < 4; ++r) { tot[((par * 8 + wid) * 16 + 4 * g + r) * 2] = Al[r]; tot[((par * 8 + wid) * 16 + 4 * g + r) * 2 + 1] = Hl[r]; }
            }
            asm volatile("s_waitcnt lgkmcnt(0)\n\ts_barrier" ::: "memory");
            float cin[4];
#pragma unroll
            for (int r = 0; r < 4; ++r) cin[r] = 0.f;
#pragma unroll
            for (int w = 0; w < 8; ++w) {
                const f32x4 t0 = *(const LAS f32x4*)(tot + ((par * 8 + w) * 16 + 4 * g) * 2), t1 = *(const LAS f32x4*)(tot + ((par * 8 + w) * 16 + 4 * g) * 2 + 4);
                const float Aw[4] = {t0[0], t0[2], t1[0], t1[2]}, Hw[4] = {t0[1], t0[3], t1[1], t1[3]};
#pragma unroll
                for (int r = 0; r < 4; ++r) { if (w == wid) cin[r] = carry[r]; carry[r] = Aw[r] * carry[r] + Hw[r]; }
            }
            par ^= 1;
            float cl[4];
#pragma unroll
            for (int r = 0; r < 4; ++r) cl[r] = Aex[r] * cin[r] + Hex[r];
#pragma unroll
            for (int i = 0; i < 4; ++i) {
                const int P = P0 + 4 * p + i; const int tok = dir ? (S - 1 - P) : P;
                f32x4 hv;
#pragma unroll
                for (int r = 0; r < 4; ++r) hv[r] = hh[i][r] + cpp[i][r] * cl[r];
                float* hfp = HF + (rowbase + tok) * 512 + c0 + 4 * g;
                if (dir == 0) *(f32x4*)hfp = hv;
                else {
                    const f32x4 hf = *(const f32x4*)hfp; const u32x2 gv = *(const u32x2*)(GR + (rowbase + tok) * 512 + c0 + 4 * g);
                    const float gr4[4] = {__uint_as_float(gv.x << 16), __uint_as_float(gv.x & 0xffff0000u), __uint_as_float(gv.y << 16), __uint_as_float(gv.y & 0xffff0000u)};
                    float y[4];
#pragma unroll
                    for (int r = 0; r < 4; ++r) { const float x = gr4[r]; const float gl = x * fast_sigmoid(1.5957691216057308f * (x + 0.044715f * x * x * x)); y[r] = gl * (hv[r] + hf[r]); }
                    u32x2 w; w.x = cvt_pk_bf16(y[0], y[1]); w.y = cvt_pk_bf16(y[2], y[3]);
                    *(u32x2*)(MIXED + (rowbase + tok) * 1024 + 512 + c0 + 4 * g) = w;
                }
            }
        }
        __syncthreads();
    }
}
}
struct Args { const float* in[22]; float* out; unsigned char* ws; int ph_lo, ph_hi; };
constexpr int N_PHASES = 7;

__global__ void __launch_bounds__(NWAVES * 64, 2) mk_fwd(Args args) {
    extern __shared__ __attribute__((aligned(16))) unsigned char lds_raw[];
    LAS unsigned char* lds = (LAS unsigned char*)lds_raw;
    const int tid = threadIdx.x, lane = tid & 63; const int wave = __builtin_amdgcn_readfirstlane(tid >> 6);
    const int G = gridDim.x, bx = blockIdx.x; const int vcu = (G % 8 == 0) ? (bx % 8) * (G / 8) + bx / 8 : bx;
    unsigned char* ws = args.ws;
    const float* x = args.in[0]; float* out = args.out;
    bf16_t* WIN = (bf16_t*)(ws + WS_WIN); bf16_t* WOUT = (bf16_t*)(ws + WS_WOUT); bf16_t* WGU = (bf16_t*)(ws + WS_WGU); bf16_t* WDN = (bf16_t*)(ws + WS_WDN);
    float* RSS1 = (float*)(ws + WS_RSS1); float* RSS2 = (float*)(ws + WS_RSS2);
    bf16_t* XN = (bf16_t*)(ws + WS_XN); bf16_t* HB = XN;
    bf16_t* Qb = (bf16_t*)(ws + WS_Q); bf16_t* KT = (bf16_t*)(ws + WS_KT); bf16_t* VT = (bf16_t*)(ws + WS_VT); bf16_t* XR = (bf16_t*)(ws + WS_XR); bf16_t* GR = (bf16_t*)(ws + WS_GR);
    float* HF = (float*)(ws + WS_HF); bf16_t* MIXED = (bf16_t*)(ws + WS_MIXED); bf16_t* ACT = (bf16_t*)(ws + WS_ACT);
    const int lo = args.ph_lo, hi = args.ph_hi;
    volatile LAS unsigned* bst = (volatile LAS unsigned*)(lds + LDS_MISC + 8192);
    if (tid == 0) { bst[0] = 0u; bst[1] = 0u; }
    __syncthreads();
    xb::XcdBarrier bar = xb::xcd_barrier_post((unsigned*)ws, bst);
    if (lo > 1000) cooperative_groups::this_grid().sync();
#define IN(k) (lo <= (k) && (k) < hi)
#ifndef REP_PHASE
#define REP_PHASE -1
#endif
#define REPS(k) ((REP_PHASE == (k)) ? 2 : 1)
#define REPSYNC(k, rep) do { if ((rep) + 1 < REPS(k)) xb::xcd_barrier(bar); } while (0)
#define SEAM(k) do { if (IN(k) && IN((k) + 1)) { xb::xcd_barrier(bar); } } while (0)

    if (IN(0)) for (int rep = 0; rep < REPS(0); ++rep) {
        LAS float* scr = (LAS float*)(lds + wave * 16384);
        const int gw = vcu * NWAVES + wave, NGW = G * NWAVES;
        constexpr int I_IN = (D / 64) * (DIN / 32), I_OUT = (D / 64) * (D / 32), I_G = (D / 64) * (DFF / 32), I_DN = (DFF / 64) * (D / 32);
        constexpr int NITEMS = I_IN + I_OUT + 2 * I_G + I_DN;
        for (int it = gw; it < NITEMS; it += NGW) {
            int r = it;
            if (r < I_IN) { p0_transpose_item<0>(args.in[2], D, DIN, WIN, nullptr, scr, r, lane); continue; } r -= I_IN;
            if (r < I_OUT) { p0_transpose_item<0>(args.in[16], D, D, WOUT, nullptr, scr, r, lane); continue; } r -= I_OUT;
            if (r < I_G) { p0_transpose_item<1>(args.in[18], D, DFF, WGU, args.in[17], scr, r, lane); continue; } r -= I_G;
            if (r < I_G) { p0_transpose_item<2>(args.in[19], D, DFF, WGU, args.in[17], scr, r, lane); continue; } r -= I_G;
            p0_transpose_item<0>(args.in[20], DFF, D, WDN, nullptr, scr, r, lane);
        }
        for (int m = gw; m < M; m += NGW) rms_row_to_bf16(x + (size_t)m * D, args.in[1], XN + (size_t)m * D, lane);
        REPSYNC(0, rep);
    }
    SEAM(0);
    if (IN(1)) for (int rep = 0; rep < REPS(1); ++rep) {
        pg8::Gemm g{XN, WIN, M, DIN, D}; pg8::StaticOrder So; So.init(M, DIN, G, bx);
        pg8::EpiInProj E{Qb, KT, VT, XR, GR, QSCALE};
        pg8::gemm_phase<pg8::EpiInProj, pg8::StaticOrder, true, true>(lds, g, So, E);
        REPSYNC(1, rep);
    }
    SEAM(1);
    if (IN(2)) {
        float lam;
        { float s1 = 0.f, s2 = 0.f; for (int i = 0; i < 64; ++i) { s1 += args.in[3][i] * args.in[4][i]; s2 += args.in[5][i] * args.in[6][i]; } lam = expf(s1) - expf(s2) + 0.2f; }
        for (int rep = 0; rep < REPS(20); ++rep)
        for (int rnd = 0; rnd * G + vcu < NB * NH * 32; ++rnd) {
            const int u = rnd * G + vcu; int b_, h_, qb_;
            if (G == 256) { b_ = vcu >> 5; h_ = rnd; qb_ = vcu & 31; } else { qb_ = u & 31; h_ = (u >> 5) & 3; b_ = u >> 7; }
            att::attn_unit(b_, h_, qb_, Qb, KT, VT, MIXED, lds, lam, args.in[7], args.in[8]);
        }
        for (int rep = 0; rep < REPS(21); ++rep)
        for (int it = vcu; it < NB * 32; it += G) {
            const int b_ = it >> 5, cg = it & 31;
            lru::lru_item(b_, cg, XR, GR, HF, MIXED, lds, args.in[9], args.in[10], args.in[11], args.in[12], args.in[13], args.in[14], args.in[15]);
        }
    }
    SEAM(2);
    if (IN(3)) for (int rep = 0; rep < REPS(3); ++rep) {
        pg8::Gemm g{MIXED, WOUT, M, D, D}; pg8::StaticOrder So; So.init(M, D, G, bx);
        pg8::EpiResid<true> E{x, out, HB, RSS1, D};
        pg8::gemm_phase<pg8::EpiResid<true>, pg8::StaticOrder, true, true>(lds, g, So, E);
        REPSYNC(3, rep);
    }
    SEAM(3);
    if (IN(4)) for (int rep = 0; rep < REPS(4); ++rep) {
        pg8::Gemm g{HB, WGU, M, 2 * DFF, D}; pg8::StaticOrder So; So.init(M, 2 * DFF, G, bx);
        pg8::EpiGateUp E{ACT, RSS1, DFF, EPS};
        pg8::gemm_phase<pg8::EpiGateUp, pg8::StaticOrder, true, true>(lds, g, So, E);
        REPSYNC(4, rep);
    }
    SEAM(4);
    if (IN(5)) {
        pg8::Gemm g{ACT, WDN, M, D, DFF}; pg8::StaticOrder So; So.init(M, D, G, bx);
        pg8::EpiResid<false> E{out, out, nullptr, RSS2, D};
        pg8::gemm_phase<pg8::EpiResid<false>, pg8::StaticOrder, true, true>(lds, g, So, E);
    }
    SEAM(5);
    if (IN(6)) {
        const int gw = vcu * NWAVES + wave, NGW = G * NWAVES; const f32x4* gf = (const f32x4*)args.in[21] + lane;
        for (int m = gw; m < M; m += NGW) {
            const f32x4* rp = (const f32x4*)(RSS2 + (size_t)m * 16); const f32x4 s0 = rp[0], s1 = rp[1], s2 = rp[2], s3 = rp[3];
            const float tot = ((s0[0] + s0[1]) + (s0[2] + s0[3])) + ((s1[0] + s1[1]) + (s1[2] + s1[3])) + ((s2[0] + s2[1]) + (s2[2] + s2[3])) + ((s3[0] + s3[1]) + (s3[2] + s3[3]));
            const float rstd = 1.0f / sqrtf(tot * (1.0f / D) + EPS);
            f32x4* orow = (f32x4*)(out + (size_t)m * D) + lane;
#pragma unroll
            for (int j = 0; j < 4; ++j) { const f32x4 v = orow[64 * j], gg = gf[64 * j]; orow[64 * j] = v * rstd * gg; }
        }
    }
#if REP_PHASE == 99
    for (int i = 0; i < 20; ++i) xb::xcd_barrier(bar);
#endif
#undef IN
#undef SEAM
}
}
namespace dbg {
using namespace mk;
__global__ void __launch_bounds__(256) k_unpack_proj(const bf16_t* Qb, const bf16_t* KT, const bf16_t* VT, const bf16_t* XR, const bf16_t* GR, float* q, float* k, float* v, float* xr, float* gr) {
    const size_t idx = (size_t)blockIdx.x * 256 + threadIdx.x;
    const int c = (int)(idx & 511); const int row = (int)(idx >> 9); const int b = row >> 12, tok = row & 4095, t = tok >> 6, rr = tok & 63;
    q[idx] = bf2f(Qb[idx]) * (1.0f / QSCALE);
    { const int h = c >> 7, w = c & 127, s = w >> 6, d = w & 63, chunk = d >> 3, j = d & 7;
      k[idx] = bf2f(KT[((((size_t)(b * 4 + h) * 2 + s) * 64 + t) * 8 + chunk) * 512 + rr * 8 + j]); }
    { const int h = c >> 7, dv = c & 127, db = dv >> 5, cc = dv & 31;
      v[idx] = bf2f(VT[(((size_t)(b * 4 + h) * 64 + t) * 4 + db) * 2048 + rr * 32 + cc]); }
    xr[idx] = bf2f(XR[idx]); gr[idx] = bf2f(GR[idx]);
}
__global__ void __launch_bounds__(256) k_unpack_bf16(const bf16_t* src, float* dst) { const size_t idx = (size_t)blockIdx.x * 256 + threadIdx.x; dst[idx] = bf2f(src[idx]); }
}

#ifndef STAGE
#define STAGE 4
#endif
static void mk_launch_phases(const mk::Args& a0, int lo, int hi, int grid, hipStream_t stream, bool coop) {
    mk::Args a = a0; a.ph_lo = lo; a.ph_hi = hi;
    if (coop) { void* args[] = {&a}; hipError_t e = hipLaunchCooperativeKernel((const void*)mk::mk_fwd, dim3(grid), dim3(mk::NWAVES * 64), args, mk::LDS_BYTES, stream);
        if (e != hipSuccess) fprintf(stderr, "cooperative launch failed: %s (grid %d)\n", hipGetErrorString(e), grid); }
    else { hipLaunchKernelGGL(mk::mk_fwd, dim3(grid), dim3(mk::NWAVES * 64), mk::LDS_BYTES, stream, a); }
}

extern "C" void kernel_launch(void* const* d_in, const int* in_sizes, int n_in, void* d_out, int out_size, void* d_ws, size_t ws_size, hipStream_t stream) {
    static int grid = 0;
    if (grid == 0) {
        int dev = 0, cus = 0, per_cu = 0;
        hipGetDevice(&dev); hipDeviceGetAttribute(&cus, hipDeviceAttributeMultiprocessorCount, dev);
        if (hipFuncSetAttribute((const void*)mk::mk_fwd, hipFuncAttributeMaxDynamicSharedMemorySize, mk::LDS_BYTES) != hipSuccess) { fprintf(stderr, "hipFuncSetAttribute failed\n"); grid = -1; return; }
        if (hipOccupancyMaxActiveBlocksPerMultiprocessor(&per_cu, (const void*)mk::mk_fwd, mk::NWAVES * 64, mk::LDS_BYTES) != hipSuccess || per_cu < 1) { fprintf(stderr, "occupancy query: %d\n", per_cu); per_cu = 1; }
        (void)hipGetLastError();
        grid = cus * 1;
        if (n_in != 22 || ws_size < 512u * mk::MiB) fprintf(stderr, "kernel_launch: unexpected n_in %d / ws_size %zu\n", n_in, ws_size);
    }
    if (grid < 0) return;
    if (hipMemsetAsync(d_ws, 0, 65536, stream) != hipSuccess) { fprintf(stderr, "memset failed\n"); return; }
    mk::Args a{};
    for (int i = 0; i < 22; ++i) a.in[i] = (const float*)d_in[i];
    a.out = (float*)d_out; a.ws = (unsigned char*)d_ws;
    char* ws = (char*)d_ws; const size_t MiB = 1u << 20;
#if STAGE == 4
    mk_launch_phases(a, 0, mk::N_PHASES, grid, stream, true);
#elif STAGE == 3
    for (int p = 0; p < mk::N_PHASES; ++p) mk_launch_phases(a, p, p + 1, grid, stream, false);
#elif STAGE == 1
    for (int p = 0; p < 2; ++p) mk_launch_phases(a, p, p + 1, grid, stream, false);
    float* q = (float*)(ws + 32 * MiB), *k = (float*)(ws + 256 * MiB), *v = (float*)(ws + 320 * MiB), *xr = (float*)(ws + 384 * MiB), *gr = (float*)(ws + 448 * MiB);
    dbg::k_unpack_proj<<<mk::M * 512 / 256, 256, 0, stream>>>((const mk::bf16_t*)(ws + mk::WS_Q), (const mk::bf16_t*)(ws + mk::WS_KT), (const mk::bf16_t*)(ws + mk::WS_VT), (const mk::bf16_t*)(ws + mk::WS_XR), (const mk::bf16_t*)(ws + mk::WS_GR), q, k, v, xr, gr);
    float* mixed = (float*)(ws + 96 * MiB);
    nv::naive_mid(d_in, q, k, v, xr, gr, mixed, stream);
    nv::naive_tail(d_in, mixed, (float*)d_out, (float*)(ws + 0), (float*)(ws + 128 * MiB), stream);
#elif STAGE == 2
    for (int p = 0; p < 3; ++p) mk_launch_phases(a, p, p + 1, grid, stream, false);
    float* mixed = (float*)(ws + 0);
    dbg::k_unpack_bf16<<<mk::M * 1024 / 256, 256, 0, stream>>>((const mk::bf16_t*)(ws + mk::WS_MIXED), mixed);
    nv::naive_tail(d_in, mixed, (float*)d_out, (float*)(ws + 0), (float*)(ws + 128 * MiB), stream);
#endif
}
```

```cpp
#include <hip/hip_runtime.h>
#include <hip/hip_cooperative_groups.h>
#include <cstdio>
#include <cstdint>
#include <cmath>
#define STAGE 4
namespace pg8 {
#define PG8_LAS __attribute__((address_space(3)))
typedef unsigned short bf16_t;
typedef short bf16x8 __attribute__((ext_vector_type(8)));
typedef float f32x4 __attribute__((ext_vector_type(4)));
typedef unsigned u32x4 __attribute__((ext_vector_type(4)));
constexpr int BM = 256, BK = 64, HALF = 128, HTB = HALF * BK * 2  , STAGE_BYTES = 8 * HTB, NXCD = 8, WGM = 8;

__host__ __device__ __forceinline__ int lds_byte(int r, int c) { const int st = (r >> 4) * 2 + (c >> 5), rr = r & 15, cc = c & 31, ob = rr * 64 + cc * 2; return st * 1024 + (ob ^ (((ob >> 9) & 1) << 5)); }
__host__ __device__ __forceinline__ void stage_rc(int b, int& R, int& C) { const int st = b / 1024, sb = b % 1024, swz = sb ^ (((sb >> 9) & 1) << 5); R = (st >> 1) * 16 + swz / 64; C = (st & 1) * 32 + (swz % 64) / 2; }
__host__ __device__ __forceinline__ int perm32(int rho) { const int n = rho >> 4, i = rho & 15; return 8 * (i >> 2) + 4 * n + (i & 3); }

struct Unit { int pm, pn; };
struct Gemm { const bf16_t* A; const bf16_t* Bt; int M, N, K; };

struct StaticOrder {
    int nM, nN, nwg, G, c;
    __host__ __device__ void init(int M, int N, int G_, int c_) { nM = M / BM; nN = N / BM; nwg = nM * nN; G = G_; c = c_; }
    __host__ __device__ bool next(int i, Unit& u) const {
        const long L = (long)i * G + c; if (L >= nwg) return false;
        int wgid = (int)L; { const int q = nwg / NXCD, r = nwg % NXCD, xcd = wgid % NXCD, off = wgid / NXCD; wgid = (xcd < r ? xcd * (q + 1) : r * (q + 1) + (xcd - r) * q) + off; }
        const int nig = WGM * nN, gid = wgid / nig, fm = gid * WGM, gsz = (nM - fm) < WGM ? (nM - fm) : WGM;
        u.pm = fm + ((wgid % nig) % gsz); u.pn = (wgid % nig) / gsz; return true;
    }
    __device__ __forceinline__ void a_ready(const Unit&) const {}
    __device__ __forceinline__ void done(const Unit&) const {}
};

typedef float f32x2_cv __attribute__((ext_vector_type(2))); typedef __bf16 bf16x2_cv __attribute__((ext_vector_type(2)));
__device__ __forceinline__ unsigned cvt_pk_bf16(float lo, float hi) { f32x2_cv v = {lo, hi}; bf16x2_cv b = __builtin_convertvector(v, bf16x2_cv); return __builtin_bit_cast(unsigned, b); }
typedef float f32x2 __attribute__((ext_vector_type(2)));
typedef unsigned u32x2 __attribute__((ext_vector_type(2)));
__device__ __forceinline__ u32x4 pack8(f32x4 v0, f32x4 v1) { u32x4 w; w.x = cvt_pk_bf16(v0[0], v0[1]); w.y = cvt_pk_bf16(v0[2], v0[3]); w.z = cvt_pk_bf16(v1[0], v1[1]); w.w = cvt_pk_bf16(v1[2], v1[3]); return w; }
struct EpiInProj {
    static constexpr bool PERM = true, AFTER_DRAIN = false;
    bf16_t *Q, *KT, *VT, *XR, *GR; float qscale;
    __device__ __forceinline__ void operator()(const f32x4 (&acc)[2][2][4][2], const Unit& u, int wr, int wc, int fr, int fq) const {
        const int sec = u.pn >> 1, half = u.pn & 1;
#pragma unroll
        for (int ai = 0; ai < 2; ++ai)
#pragma unroll
            for (int m = 0; m < 4; ++m) {
                const int row = u.pm * BM + ai * HALF + wr * 64 + m * 16 + fr;
                const int b = row >> 12, tok = row & 4095, t = tok >> 6, rr = tok & 63;
#pragma unroll
                for (int bj = 0; bj < 2; ++bj) {
                    f32x4 v0 = acc[ai][bj][m][0], v1 = acc[ai][bj][m][1];
                    const int cs = half * 256 + bj * HALF + wc * 32 + 8 * fq;
                    if (sec == 0) { v0 = v0 * qscale; v1 = v1 * qscale; *(u32x4*)(Q + (size_t)row * 512 + cs) = pack8(v0, v1); }
                    else if (sec == 1) { const int h = half * 2 + bj, s = wc >> 1, chunk = 4 * (wc & 1) + fq;
                        *(u32x4*)(KT + ((((size_t)(b * 4 + h) * 2 + s) * 64 + t) * 8 + chunk) * 512 + rr * 8) = pack8(v0, v1); }
                    else if (sec == 2) { const int h = half * 2 + bj;
                        *(u32x4*)(VT + (((size_t)(b * 4 + h) * 64 + t) * 4 + wc) * 2048 + rr * 32 + 8 * fq) = pack8(v0, v1); }
                    else if (sec == 3) { *(u32x4*)(XR + (size_t)row * 512 + cs) = pack8(v0, v1); }
                    else { *(u32x4*)(GR + (size_t)row * 512 + cs) = pack8(v0, v1); }
                }
            }
    }
};
template <bool WRITE_HB, bool WRITE_F32 = true> struct EpiResid {
    static constexpr bool PERM = false, AFTER_DRAIN = false;
    const float* base; float* out; bf16_t* hb; float* rss; int ldc;
    __device__ __forceinline__ void operator()(const f32x4 (&acc)[2][2][4][2], const Unit& u, int wr, int wc, int fr, int fq) const {
        const int col0 = u.pn * BM + wc * 32 + 4 * fq;
#pragma unroll
        for (int ai = 0; ai < 2; ++ai)
#pragma unroll
            for (int m = 0; m < 4; ++m) {
                const int row = u.pm * BM + ai * HALF + wr * 64 + m * 16 + fr; const size_t off = (size_t)row * ldc + col0; float ss = 0.f;
#pragma unroll
                for (int bj = 0; bj < 2; ++bj)
#pragma unroll
                    for (int n = 0; n < 2; ++n) {
                        const f32x4 bs = *(const f32x4*)(base + off + bj * HALF + n * 16); const f32x4 o = acc[ai][bj][m][n] + bs;
                        if (WRITE_F32) *(f32x4*)(out + off + bj * HALF + n * 16) = o;
                        if (WRITE_HB) { u32x2 w; w.x = cvt_pk_bf16(o[0], o[1]); w.y = cvt_pk_bf16(o[2], o[3]); *(u32x2*)(hb + off + bj * HALF + n * 16) = w; }
                        ss += (o[0] * o[0] + o[1] * o[1]) + (o[2] * o[2] + o[3] * o[3]);
                    }
                ss += __shfl_xor(ss, 16); ss += __shfl_xor(ss, 32);
                if (fq == 0) rss[(size_t)row * 16 + u.pn * 4 + wc] = ss;
            }
    }
};
struct EpiGateUp {
    static constexpr bool PERM = true, AFTER_DRAIN = false;
    bf16_t* act; const float* rss; int ldo; float eps;
    __device__ __forceinline__ void operator()(const f32x4 (&acc)[2][2][4][2], const Unit& u, int wr, int wc, int fr, int fq) const {
        const int col0 = u.pn * HALF + wc * 32 + 8 * fq;
#pragma unroll
        for (int ai = 0; ai < 2; ++ai)
#pragma unroll
            for (int m = 0; m < 4; ++m) {
                const int row = u.pm * BM + ai * HALF + wr * 64 + m * 16 + fr;
                const f32x4* rp = (const f32x4*)(rss + (size_t)row * 16); const f32x4 s0 = rp[0], s1 = rp[1], s2 = rp[2], s3 = rp[3];
                const float tot = ((s0[0] + s0[1]) + (s0[2] + s0[3])) + ((s1[0] + s1[1]) + (s1[2] + s1[3])) + ((s2[0] + s2[1]) + (s2[2] + s2[3])) + ((s3[0] + s3[1]) + (s3[2] + s3[3]));
                const float rstd = __builtin_amdgcn_rsqf(tot * (1.0f / 1024.0f) + eps);
                f32x4 o[2];
#pragma unroll
                for (int n = 0; n < 2; ++n) {
                    const f32x4 g = acc[ai][0][m][n] * rstd, up = acc[ai][1][m][n] * rstd;
#pragma unroll
                    for (int i = 0; i < 4; ++i) { const float e = __builtin_amdgcn_exp2f(g[i] * -1.4426950408889634f); o[n][i] = g[i] * __builtin_amdgcn_rcpf(1.0f + e) * up[i]; }
                }
                *(u32x4*)(act + (size_t)row * ldo + col0) = pack8(o[0], o[1]);
            }
    }
};

struct EpiDownNorm {
    static constexpr bool PERM = false, AFTER_DRAIN = true;
    const bf16_t* hb; float* out; const float* gain; float* xbuf; unsigned* cnt; int ldc; float eps;
    __device__ __forceinline__ void fused(f32x4 (&acc)[2][2][4][2], const Unit& u, int wr, int wc, int fr, int fq, PG8_LAS unsigned char* lds, int wid, int lane) const {
        PG8_LAS float* P = (PG8_LAS float*)lds;
        PG8_LAS float* Sx = (PG8_LAS float*)(lds + 4096);
        PG8_LAS unsigned* flag = (PG8_LAS unsigned*)(lds + 4096 + 1024);
        const int col0 = u.pn * BM + wc * 32 + 4 * fq;
#pragma unroll
        for (int ai = 0; ai < 2; ++ai)
#pragma unroll
            for (int m = 0; m < 4; ++m) {
                const int r = ai * HALF + wr * 64 + m * 16 + fr; const size_t off = (size_t)(u.pm * BM + r) * ldc + col0; float ss = 0.f;
#pragma unroll
                for (int bj = 0; bj < 2; ++bj)
#pragma unroll
                    for (int n = 0; n < 2; ++n) {
                        const u32x2 hv = *(const u32x2*)(hb + off + bj * HALF + n * 16);
                        const f32x4 h4 = (f32x4){__uint_as_float(hv.x << 16), __uint_as_float(hv.x & 0xffff0000u), __uint_as_float(hv.y << 16), __uint_as_float(hv.y & 0xffff0000u)};
                        const f32x4 o = acc[ai][bj][m][n] + h4; acc[ai][bj][m][n] = o;
                        ss += (o[0] * o[0] + o[1] * o[1]) + (o[2] * o[2] + o[3] * o[3]);
                    }
                ss += __shfl_xor(ss, 16); ss += __shfl_xor(ss, 32);
                if (fq == 0) P[r * 4 + wc] = ss;
            }
        asm volatile("s_waitcnt lgkmcnt(0)" ::: "memory"); __builtin_amdgcn_s_barrier(); asm volatile("" ::: "memory");
        const int row = wid * 32 + (lane & 31);
        if (lane < 32) {
            const float s = (P[row * 4 + 0] + P[row * 4 + 1]) + (P[row * 4 + 2] + P[row * 4 + 3]);
            __hip_atomic_store(xbuf + (size_t)(u.pm * BM + row) * 4 + u.pn, s, __ATOMIC_RELAXED, __HIP_MEMORY_SCOPE_AGENT);
        }
        asm volatile("s_waitcnt vmcnt(0)" ::: "memory");
        if (lane == 0) __hip_atomic_fetch_add(cnt + 64 * u.pm, 1u, __ATOMIC_RELAXED, __HIP_MEMORY_SCOPE_AGENT);
        if (wid == 0) {
            unsigned sp = 0;
            for (;;) {
                if ((unsigned)__builtin_amdgcn_readfirstlane(__hip_atomic_load(cnt + 64 * u.pm, __ATOMIC_RELAXED, __HIP_MEMORY_SCOPE_AGENT)) >= 32u) break;
                if (++sp > (1u << 22)) break;
                __builtin_amdgcn_s_sleep(2);
            }
            __builtin_amdgcn_fence(__ATOMIC_ACQUIRE, "agent");
            if (lane == 0) flag[0] = 0u;
        }
        asm volatile("s_waitcnt vmcnt(0) lgkmcnt(0)" ::: "memory"); __builtin_amdgcn_s_barrier(); asm volatile("" ::: "memory");
        if (lane < 32) {
            const float* slot = xbuf + (size_t)(u.pm * BM + row) * 4;
            const float a = __hip_atomic_load(slot + 0, __ATOMIC_RELAXED, __HIP_MEMORY_SCOPE_AGENT), b = __hip_atomic_load(slot + 1, __ATOMIC_RELAXED, __HIP_MEMORY_SCOPE_AGENT),
                        c = __hip_atomic_load(slot + 2, __ATOMIC_RELAXED, __HIP_MEMORY_SCOPE_AGENT), d = __hip_atomic_load(slot + 3, __ATOMIC_RELAXED, __HIP_MEMORY_SCOPE_AGENT);
            Sx[row] = 1.0f / sqrtf(((a + b) + (c + d)) * (1.0f / 1024.0f) + eps);
        }
        asm volatile("s_waitcnt lgkmcnt(0)" ::: "memory"); __builtin_amdgcn_s_barrier(); asm volatile("" ::: "memory");
        f32x4 gv[2][2];
#pragma unroll
        for (int bj = 0; bj < 2; ++bj)
#pragma unroll
            for (int n = 0; n < 2; ++n) gv[bj][n] = *(const f32x4*)(gain + col0 + bj * HALF + n * 16);
#pragma unroll
        for (int ai = 0; ai < 2; ++ai)
#pragma unroll
            for (int m = 0; m < 4; ++m) {
                const int r = ai * HALF + wr * 64 + m * 16 + fr; const float rs = Sx[r]; const size_t off = (size_t)(u.pm * BM + r) * ldc + col0;
#pragma unroll
                for (int bj = 0; bj < 2; ++bj)
#pragma unroll
                    for (int n = 0; n < 2; ++n) *(f32x4*)(out + off + bj * HALF + n * 16) = acc[ai][bj][m][n] * rs * gv[bj][n];
            }
    }
};
template <class Epi, class Sched, bool ALIGN_EPI = false, bool SP2 = false>
__device__ __forceinline__ void gemm_phase(PG8_LAS unsigned char* lds, const Gemm g, const Sched& S, const Epi& E) {
    const int tid = threadIdx.x, wid = __builtin_amdgcn_readfirstlane(tid >> 6), lane = tid & 63, wr = wid >> 2, wc = wid & 3, fr = lane & 15, fq = lane >> 4;
    const int K = g.K, nt = K / BK;
    unsigned voffA[2], voffB[2];
#pragma unroll
    for (int i = 0; i < 2; ++i) { int R, C; stage_rc(tid * 16 + i * 8192, R, C); const int Rb = Epi::PERM ? ((R & ~31) + perm32(R & 31)) : R;
        voffA[i] = (unsigned)(R * K + C) * 2u; voffB[i] = (unsigned)(Rb * K + C) * 2u; }
    const size_t kstep = (size_t)(BK * 2);
    const size_t hstep = (size_t)HALF * K * 2;
    const size_t tstep = 2 * hstep;
    const unsigned ldsw = (unsigned)wid * 1024u;
    const int aoff = lds_byte(wr * 64 + fr, fq * 8), boff = lds_byte(wc * 32 + fr, fq * 8);
#define PG8_SA(b, h) (((b) * 2 + (h)) * HTB)
#define PG8_SB(b, h) ((4 + (b) * 2 + (h)) * HTB)
#define PG8_STAGE(bufoff, gbase, voff) do { _Pragma("unroll") for (int _i = 0; _i < 2; ++_i) \
        __builtin_amdgcn_global_load_lds((const unsigned*)((const char*)(gbase) + (voff)[_i]), (PG8_LAS unsigned*)(lds + (bufoff) + ldsw + _i * 8192), 16, 0, 0); } while (0)
#define PG8_LDA(dst, b, h) do { _Pragma("unroll") for (int m = 0; m < 4; ++m) _Pragma("unroll") for (int k = 0; k < 2; ++k) dst[m][k] = *(const PG8_LAS bf16x8*)(lds + PG8_SA(b, h) + aoff + m * 2048 + k * 1024); } while (0)
#define PG8_LDB(dst, b, h) do { _Pragma("unroll") for (int n = 0; n < 2; ++n) _Pragma("unroll") for (int k = 0; k < 2; ++k) dst[n][k] = *(const PG8_LAS bf16x8*)(lds + PG8_SB(b, h) + boff + n * 2048 + k * 1024); } while (0)
#define PG8_MMA(ai, bj, At, Bt) do { __builtin_amdgcn_s_setprio(1); _Pragma("unroll") for (int m = 0; m < 4; ++m) _Pragma("unroll") for (int n = 0; n < 2; ++n) _Pragma("unroll") for (int k = 0; k < 2; ++k) \
        acc[ai][bj][m][n] = __builtin_amdgcn_mfma_f32_16x16x32_bf16(Bt[n][k], At[m][k], acc[ai][bj][m][n], 0, 0, 0); __builtin_amdgcn_s_setprio(0); } while (0)
#define PG8_WAIT_V(n) asm volatile("s_waitcnt vmcnt(" #n ")" ::: "memory")
#define PG8_WAIT_L(n) asm volatile("s_waitcnt lgkmcnt(" #n ")" ::: "memory")
#define PG8_BAR __builtin_amdgcn_s_barrier()
#define PG8_SCHED __builtin_amdgcn_sched_barrier(0)
    Unit cur, nxt; int ui = 0;
    if (!S.next(0, cur)) return;
    f32x4 acc[2][2][4][2];
#pragma unroll
    for (int a = 0; a < 2; ++a)
#pragma unroll
        for (int b = 0; b < 2; ++b)
#pragma unroll
            for (int m = 0; m < 4; ++m)
#pragma unroll
                for (int n = 0; n < 2; ++n) acc[a][b][m][n] = (f32x4){0.f, 0.f, 0.f, 0.f};
    bf16x8 At[4][2], B0[2][2], B1[2][2];
    const char* cA = (const char*)g.A + (size_t)cur.pm * tstep; const char* cB = (const char*)g.Bt + (size_t)cur.pn * tstep;
    S.a_ready(cur);
    if constexpr (SP2) {
        PG8_STAGE(PG8_SB(0, 0), cB, voffB); PG8_STAGE(PG8_SB(0, 1), cB + hstep, voffB); PG8_STAGE(PG8_SA(0, 0), cA, voffA); PG8_STAGE(PG8_SA(0, 1), cA + hstep, voffA);
        if (wr == 1) PG8_BAR;
        PG8_WAIT_V(2); PG8_BAR;
        PG8_STAGE(PG8_SB(1, 0), cB + kstep, voffB); PG8_STAGE(PG8_SA(1, 0), cA + kstep, voffA); PG8_STAGE(PG8_SB(1, 1), cB + hstep + kstep, voffB);
        PG8_WAIT_V(6); PG8_BAR;
    } else {
        PG8_STAGE(PG8_SB(0, 0), cB, voffB); PG8_STAGE(PG8_SA(0, 0), cA, voffA); PG8_STAGE(PG8_SB(0, 1), cB + hstep, voffB); PG8_STAGE(PG8_SA(0, 1), cA + hstep, voffA);
        if (wr == 1) PG8_BAR;
        PG8_WAIT_V(4); PG8_BAR;
        PG8_STAGE(PG8_SB(1, 0), cB + kstep, voffB); PG8_STAGE(PG8_SA(1, 0), cA + kstep, voffA); PG8_STAGE(PG8_SB(1, 1), cB + hstep + kstep, voffB);
        PG8_WAIT_V(6); PG8_BAR;
    }
    for (;;) {
        const bool has_next = S.next(ui + 1, nxt);
        const char* nA = has_next ? (const char*)g.A + (size_t)nxt.pm * tstep : cA; const char* nB = has_next ? (const char*)g.Bt + (size_t)nxt.pn * tstep : cB;
        for (int t = 0; t < nt; t += 2) {
            const bool last = (t == nt - 2);
            const char* a1 = cA + (size_t)(t + 1) * kstep;
            const char* a2 = last ? nA : cA + (size_t)(t + 2) * kstep; const char* b2 = last ? nB : cB + (size_t)(t + 2) * kstep;
            const char* a3 = a2 + kstep; const char* b3 = b2 + kstep;
            if (last && has_next) S.a_ready(nxt);
            if constexpr (SP2) {
            PG8_LDB(B0, 0, 0); PG8_LDB(B1, 0, 1); PG8_SCHED; PG8_LDA(At, 0, 0); PG8_STAGE(PG8_SA(1, 1), a1 + hstep, voffA);
            PG8_WAIT_V(8); PG8_WAIT_L(0); PG8_BAR; PG8_MMA(0, 0, At, B0); PG8_MMA(0, 1, At, B1); PG8_BAR; PG8_SCHED;
            PG8_LDA(At, 0, 1); PG8_STAGE(PG8_SB(0, 0), b2, voffB); PG8_STAGE(PG8_SB(0, 1), b2 + hstep, voffB); PG8_STAGE(PG8_SA(0, 0), a2, voffA);
            PG8_WAIT_V(8); PG8_WAIT_L(0); PG8_BAR; PG8_MMA(1, 0, At, B0); PG8_MMA(1, 1, At, B1); PG8_BAR; PG8_SCHED;
            PG8_LDB(B0, 1, 0); PG8_LDB(B1, 1, 1); PG8_SCHED; PG8_LDA(At, 1, 0); PG8_STAGE(PG8_SA(0, 1), a2 + hstep, voffA);
            PG8_WAIT_V(8); PG8_WAIT_L(0); PG8_BAR; PG8_MMA(0, 0, At, B0); PG8_MMA(0, 1, At, B1); PG8_BAR; PG8_SCHED;
            PG8_LDA(At, 1, 1); PG8_STAGE(PG8_SB(1, 0), b3, voffB); PG8_STAGE(PG8_SB(1, 1), b3 + hstep, voffB); PG8_STAGE(PG8_SA(1, 0), a3, voffA);
            PG8_WAIT_V(8); PG8_WAIT_L(0); PG8_BAR; PG8_MMA(1, 0, At, B0); PG8_MMA(1, 1, At, B1); PG8_BAR; PG8_SCHED;
            } else {
            PG8_LDB(B0, 0, 0); PG8_SCHED; PG8_LDA(At, 0, 0); PG8_STAGE(PG8_SA(1, 1), a1 + hstep, voffA);
            PG8_WAIT_L(8); PG8_BAR; PG8_WAIT_L(0); PG8_MMA(0, 0, At, B0); PG8_BAR; PG8_SCHED;
            PG8_LDB(B1, 0, 1); PG8_STAGE(PG8_SB(0, 0), b2, voffB);
            PG8_BAR; PG8_WAIT_L(0); PG8_MMA(0, 1, At, B1); PG8_BAR;
            PG8_LDA(At, 0, 1); PG8_STAGE(PG8_SA(0, 0), a2, voffA);
            PG8_BAR; PG8_WAIT_L(0); PG8_MMA(1, 0, At, B0); PG8_BAR; PG8_SCHED;
            PG8_STAGE(PG8_SB(0, 1), b2 + hstep, voffB);
            PG8_WAIT_V(6); PG8_BAR; PG8_MMA(1, 1, At, B1); PG8_BAR;
            PG8_LDB(B0, 1, 0); PG8_SCHED; PG8_LDA(At, 1, 0); PG8_STAGE(PG8_SA(0, 1), a2 + hstep, voffA);
            PG8_WAIT_L(8); PG8_BAR; PG8_WAIT_L(0); PG8_MMA(0, 0, At, B0); PG8_BAR; PG8_SCHED;
            PG8_LDB(B1, 1, 1); PG8_STAGE(PG8_SB(1, 0), b3, voffB);
            PG8_BAR; PG8_WAIT_L(0); PG8_MMA(0, 1, At, B1); PG8_BAR;
            PG8_LDA(At, 1, 1); PG8_STAGE(PG8_SA(1, 0), a3, voffA);
            PG8_BAR; PG8_WAIT_L(0); PG8_MMA(1, 0, At, B0); PG8_BAR; PG8_SCHED;
            PG8_STAGE(PG8_SB(1, 1), b3 + hstep, voffB);
            PG8_WAIT_V(6); PG8_BAR; PG8_MMA(1, 1, At, B1); PG8_BAR;
            }
        }
        if constexpr (ALIGN_EPI) { if (wr == 0) PG8_BAR; }
        if constexpr (!Epi::AFTER_DRAIN) { E(acc, cur, wr, wc, fr, fq); S.done(cur); }
        if (!has_next) break;
#pragma unroll
        for (int a = 0; a < 2; ++a)
#pragma unroll
            for (int b = 0; b < 2; ++b)
#pragma unroll
                for (int m = 0; m < 4; ++m)
#pragma unroll
                    for (int n = 0; n < 2; ++n) acc[a][b][m][n] = (f32x4){0.f, 0.f, 0.f, 0.f};
        cur = nxt; cA = nA; cB = nB; ++ui;
        if constexpr (ALIGN_EPI) { if (wr == 1) PG8_BAR; }
    }
    PG8_WAIT_V(0);
    if constexpr (!ALIGN_EPI) { if (wr == 0) PG8_BAR; }
    PG8_BAR;
    if constexpr (Epi::AFTER_DRAIN) { E.fused(acc, cur, wr, wc, fr, fq, lds, wid, lane); S.done(cur); }
#undef PG8_SA
#undef PG8_SB
#undef PG8_STAGE
#undef PG8_LDA
#undef PG8_LDB
#undef PG8_MMA
#undef PG8_WAIT_V
#undef PG8_WAIT_L
#undef PG8_BAR
#undef PG8_SCHED
}
}
namespace xb {
#define LAS __attribute__((address_space(3)))
#define XB_TMO      128
#define XB_XCNT(j)  (256  + 64 * (j))
#define XB_XSUB(j)  (1280 + 64 * (j))
#define XB_XGEN(j)  (2304 + 64 * (j))
#define XB_TOP      3328
#define XB_TOPGEN   3392
#define XCD_BAR_WORDS 3456
#define XB_SPIN_CAP (1u << 18)

__device__ __forceinline__ unsigned xb_ld(unsigned* p)              { return __hip_atomic_load(p, __ATOMIC_RELAXED, __HIP_MEMORY_SCOPE_AGENT); }
__device__ __forceinline__ unsigned xb_add(unsigned* p, unsigned v) { return __hip_atomic_fetch_add(p, v, __ATOMIC_RELAXED, __HIP_MEMORY_SCOPE_AGENT); }
__device__ __forceinline__ unsigned xb_xcc_id() { return (unsigned)__builtin_amdgcn_s_getreg((3 << 11) | 20) & 0xFu; }
#define XB_SPIN(cond, bar) do { unsigned _sp = 0; while (cond) { __builtin_amdgcn_s_sleep(1); \
    if ((++_sp & 255u) == 0u) { if (xb_ld(&(bar)[XB_TMO])) break; if (_sp > XB_SPIN_CAP) { atomicAdd(&(bar)[XB_TMO], 1u); break; } } } } while (0)

struct XcdBarrier {
    unsigned* bar; unsigned x;
    volatile LAS unsigned* st;
};

__device__ __forceinline__ XcdBarrier xcd_barrier_post(unsigned* bar, volatile LAS unsigned* st) {
    XcdBarrier b; b.bar = bar; b.x = xb_xcc_id(); b.st = st;
    if (threadIdx.x == 0) (void)xb_add(&bar[XB_XCNT(b.x)], 1u);
    return b;
}
__device__ __forceinline__ void xcd_barrier_complete(unsigned* bar, unsigned x, unsigned& nloc, unsigned& nx) {
    const unsigned G = gridDim.x * gridDim.y * gridDim.z;
    unsigned sum, cnt, mine, sp = 0u;
    for (;;) {
        sum = 0u; cnt = 0u; mine = 0u;
#pragma unroll
        for (unsigned j = 0; j < 16; ++j) { const unsigned c = xb_ld(&bar[XB_XCNT(j)]); sum += c; cnt += (c > 0u) ? 1u : 0u; mine = (j == x) ? c : mine; }
        if (sum == G) break;
        __builtin_amdgcn_s_sleep(1);
        if ((++sp & 255u) == 0u) { if (xb_ld(&bar[XB_TMO])) break; if (sp > XB_SPIN_CAP) { atomicAdd(&bar[XB_TMO], 1u); break; } }
    }
    nloc = mine > 0u ? mine : 1u; nx = cnt > 0u ? cnt : 1u;
}

__device__ __forceinline__ void xcd_barrier(const XcdBarrier& b) {
    asm volatile("s_waitcnt vmcnt(0)" ::: "memory");
    __syncthreads();
    if (threadIdx.x == 0) {
        unsigned* bar = b.bar;
        __builtin_amdgcn_s_waitcnt(0);
        unsigned nloc = b.st[0], nx = b.st[1];
        if (nloc == 0u) { xcd_barrier_complete(bar, b.x, nloc, nx); b.st[0] = nloc; b.st[1] = nx; }
        const unsigned old = xb_add(&bar[XB_XSUB(b.x)], 1u);
        const unsigned gen = old / nloc;
        if (old + 1u == (gen + 1u) * nloc) {
            __builtin_amdgcn_fence(__ATOMIC_RELEASE, "agent");
            asm volatile("s_waitcnt vmcnt(0)" ::: "memory");
            const unsigned og = xb_add(&bar[XB_TOP], 1u);
            const unsigned tg = og / nx;
            if (og + 1u == (tg + 1u) * nx) xb_add(&bar[XB_TOPGEN], 1u);
            else XB_SPIN(xb_ld(&bar[XB_TOPGEN]) == tg, bar);
            __builtin_amdgcn_fence(__ATOMIC_ACQUIRE, "agent");
            xb_add(&bar[XB_XGEN(b.x)], 1u);
            asm volatile("s_waitcnt vmcnt(0)" ::: "memory");
        } else {
            XB_SPIN(xb_ld(&bar[XB_XGEN(b.x)]) == gen, bar);
            __builtin_amdgcn_fence(__ATOMIC_ACQUIRE, "agent");
            asm volatile("s_waitcnt vmcnt(0)" ::: "memory");
        }
    }
    __syncthreads();
}

}
namespace mk {
#define LAS __attribute__((address_space(3)))
typedef unsigned short bf16_t;
typedef short bf16x8 __attribute__((ext_vector_type(8)));
typedef short s16x4 __attribute__((ext_vector_type(4)));
typedef float f32x4 __attribute__((ext_vector_type(4)));
typedef float f32x16 __attribute__((ext_vector_type(16)));
typedef unsigned u32x4 __attribute__((ext_vector_type(4)));
typedef unsigned u32x2 __attribute__((ext_vector_type(2)));
constexpr int NB = 8, S = 4096, D = 1024, M = NB * S, NH = 4, DFF = 2816, DIN = 2560, NWAVES = 8;
constexpr float EPS = 1e-6f, LOG2E = 1.4426950408889634f;
constexpr float QSCALE = 0.125f * LOG2E;
constexpr size_t MiB = 1u << 20;
constexpr size_t WS_WIN = 1 * MiB, WS_WOUT = 6 * MiB, WS_WGU = 8 * MiB, WS_WDN = 19 * MiB, WS_RSS1 = 25 * MiB, WS_RSS2 = 27 * MiB;
constexpr size_t WS_XN = 32 * MiB, WS_Q = 96 * MiB, WS_KT = 128 * MiB, WS_VT = 160 * MiB, WS_XR = 192 * MiB, WS_GR = 224 * MiB, WS_HF = 256 * MiB, WS_MIXED = 320 * MiB, WS_ACT = 96 * MiB, WS_END = 384 * MiB;
static_assert(WS_ACT + (size_t)M * DFF * 2 <= WS_MIXED, "act overlays Q..HF only");
constexpr int RING_BYTES = 131072, LDS_MISC = 131072, LDS_BYTES = 147456;

__device__ __forceinline__ unsigned cvt_pk_bf16(float lo, float hi) { return pg8::cvt_pk_bf16(lo, hi); }
__device__ __forceinline__ float bf2f(unsigned short b) { return __uint_as_float(((unsigned)b) << 16); }
__device__ __forceinline__ float wave_sum(float v) {
#pragma unroll
    for (int o = 1; o < 64; o <<= 1) v += __shfl_xor(v, o);
    return v;
}
__device__ __forceinline__ float fast_sigmoid(float x) { return __builtin_amdgcn_rcpf(1.0f + __builtin_amdgcn_exp2f(-LOG2E * x)); }

template <int MAP  >
__device__ __forceinline__ void p0_transpose_item(const float* W, int K, int N, bf16_t* WT, const float* gk, LAS float* scr, int item, int lane) {
    const int nblk = N / 32, kb = item / nblk, nb = item % nblk, k0 = 64 * kb, n0 = 32 * nb;
#pragma unroll
    for (int i = 0; i < 32; ++i) { const int kk = 2 * i + (lane >> 5); float v = W[(size_t)(k0 + kk) * N + n0 + (lane & 31)]; if (gk) v *= gk[k0 + kk]; scr[kk * 33 + (lane & 31)] = v; }
    asm volatile("s_waitcnt lgkmcnt(0)" ::: "memory");
    const int c = lane & 7;
#pragma unroll
    for (int j = 0; j < 4; ++j) { const int n = (lane >> 3) + 8 * j; const LAS float* s = scr + (8 * c) * 33 + n;
        u32x4 o; o.x = cvt_pk_bf16(s[0 * 33], s[1 * 33]); o.y = cvt_pk_bf16(s[2 * 33], s[3 * 33]); o.z = cvt_pk_bf16(s[4 * 33], s[5 * 33]); o.w = cvt_pk_bf16(s[6 * 33], s[7 * 33]);
        const int f = n0 + n; const int drow = (MAP == 0) ? f : (256 * (f >> 7) + (f & 127) + (MAP == 2 ? 128 : 0));
        *(u32x4*)(WT + (size_t)drow * K + k0 + 8 * c) = o; }
    asm volatile("s_waitcnt lgkmcnt(0)" ::: "memory");
}
template <int NR>
__device__ __forceinline__ void rms_rows_to_bf16(const float* xrow, const float* g, bf16_t* orow, int lane) {
    const f32x4* gr = (const f32x4*)g + lane;
    f32x4 v[NR][4]; float s[NR];
#pragma unroll
    for (int q = 0; q < NR; ++q) { const f32x4* xr = (const f32x4*)(xrow + (size_t)q * D) + lane;
#pragma unroll
        for (int j = 0; j < 4; ++j) v[q][j] = __builtin_nontemporal_load(xr + 64 * j); }
#pragma unroll
    for (int q = 0; q < NR; ++q) { float a = 0.f;
#pragma unroll
        for (int j = 0; j < 4; ++j) a += (v[q][j][0] * v[q][j][0] + v[q][j][1] * v[q][j][1]) + (v[q][j][2] * v[q][j][2] + v[q][j][3] * v[q][j][3]);
        s[q] = a; }
#pragma unroll
    for (int o = 1; o < 64; o <<= 1)
#pragma unroll
        for (int q = 0; q < NR; ++q) s[q] += __shfl_xor(s[q], o);
    f32x4 gg[4];
#pragma unroll
    for (int j = 0; j < 4; ++j) gg[j] = gr[64 * j];
#pragma unroll
    for (int q = 0; q < NR; ++q) { const float rstd = 1.0f / sqrtf(s[q] * (1.f / D) + EPS); u32x2* o8 = (u32x2*)(orow + (size_t)q * D) + lane;
#pragma unroll
        for (int j = 0; j < 4; ++j) { u32x2 w; w.x = cvt_pk_bf16(v[q][j][0] * rstd * gg[j][0], v[q][j][1] * rstd * gg[j][1]); w.y = cvt_pk_bf16(v[q][j][2] * rstd * gg[j][2], v[q][j][3] * rstd * gg[j][3]); o8[64 * j] = w; } }
}

namespace att {
constexpr int NT = S / 64, SLOT = 16384, LDS_K = 0, LDS_V = 3 * SLOT, LDS_OST = 4 * SLOT, LDS_X = 0;
constexpr int LDS_WSF = LDS_MISC, LDS_BIAS = LDS_MISC + 2048, LDS_TOT = LDS_MISC + 3072, LDS_CW = LDS_MISC + 5120;
constexpr int THR = 8;
typedef LAS const char* lds_cptr;
typedef short v4i16_t __attribute__((ext_vector_type(4)));
__device__ __forceinline__ int crow(int r, int hi) { return (r & 3) + 8 * (r >> 2) + 4 * hi; }
__device__ __forceinline__ void glds16(const void* gsrc, unsigned lds_dst) { unsigned keep;
    asm volatile("s_mov_b32 %0, m0\n\ts_mov_b32 m0, %2\n\ts_nop 0\n\tglobal_load_lds_dwordx4 %1, off\n\ts_mov_b32 m0, %0" : "=&s"(keep) : "v"(gsrc), "s"(lds_dst) : "memory"); }
__device__ __forceinline__ s16x4 vtr(lds_cptr p) { return __builtin_bit_cast(s16x4, __builtin_amdgcn_ds_read_tr16_b64_v4i16((LAS v4i16_t*)p)); }
#define ATT_MX3(a, b, c) __builtin_fmaxf(__builtin_fmaxf((a), (b)), (c))
__device__ __forceinline__ float rowmax(const f32x16& p0, const f32x16& p1) {
    float a = ATT_MX3(p0[0], p0[1], p1[0]), b = ATT_MX3(p0[2], p0[3], p1[1]); a = ATT_MX3(a, p1[2], p1[3]);
#pragma unroll
    for (int r = 4; r < 16; r += 4) { a = ATT_MX3(a, p0[r], p0[r + 1]); b = ATT_MX3(b, p0[r + 2], p0[r + 3]); a = ATT_MX3(a, p1[r], p1[r + 1]); b = ATT_MX3(b, p1[r + 2], p1[r + 3]); }
    float m = __builtin_fmaxf(a, b); auto rr = __builtin_amdgcn_permlane32_swap(__float_as_uint(m), __float_as_uint(m), false, false);
    return __builtin_fmaxf(__uint_as_float(rr[0]), __uint_as_float(rr[1]));
}
#define ATT_WAIT_BAR(N) asm volatile("s_waitcnt vmcnt(" #N ") lgkmcnt(0)\n\ts_barrier" ::: "memory")
#define ATT_MFMA(a, b, c) __builtin_amdgcn_mfma_f32_32x32x16_bf16(a, b, c, 0, 0, 0)

template <bool FIRST>
__device__ __forceinline__ void tile_h1(int t, lds_cptr kp, const bf16x8 (&qr)[4], f32x16 (&o)[4], u32x4 (&pw)[4], float& mhat, float& l_reg,
                                        LAS float* wsf, const LAS float* btab, int qrow, int qw0, float c_left, float c_right, int r32, int hi) {
    const int relmin = 64 * t - qw0 - 31, relmax = 64 * t + 63 - qw0;
    const bool band = !(relmax <= -91 || relmin >= 91);
    const float cb = band ? 0.f : (relmin >= 91 ? c_right : c_left);
    f32x16 p0, p1;
    const f32x16 z16 = (f32x16){0.f, 0.f, 0.f, 0.f, 0.f, 0.f, 0.f, 0.f, 0.f, 0.f, 0.f, 0.f, 0.f, 0.f, 0.f, 0.f};
#pragma unroll
    for (int d0 = 0; d0 < 4; ++d0) {
        const bf16x8 k0 = *(const LAS bf16x8*)(kp + d0 * 2048), k1 = *(const LAS bf16x8*)(kp + d0 * 2048 + 512);
        if (d0 == 0) { p0 = ATT_MFMA(k0, qr[0], z16); p1 = ATT_MFMA(k1, qr[0], z16); }
        else { p0 = ATT_MFMA(k0, qr[d0], p0); p1 = ATT_MFMA(k1, qr[d0], p1); }
    }
    if (band) {
        const int relb = 64 * t + 4 * hi - qrow + 128;
#pragma unroll
        for (int r = 0; r < 16; ++r) { const int i0 = relb + (r & 3) + 8 * (r >> 2); const int a0 = i0 < 0 ? 0 : (i0 > 255 ? 255 : i0); const int i1 = i0 + 32; const int a1 = i1 < 0 ? 0 : (i1 > 255 ? 255 : i1);
            p0[r] += btab[a0]; p1[r] += btab[a1]; }
    }
    const float rm = rowmax(p0, p1) + cb;
    if (FIRST) { mhat = rm; }
    else if (__builtin_expect(__any(rm - mhat > (float)THR), 0)) {
        const float dl = __builtin_fmaxf(rm - mhat, 0.f); mhat += dl;
        const float f = __builtin_amdgcn_exp2f(-dl); l_reg *= f;
        if (hi == 0) wsf[r32] = f;
        asm volatile("s_waitcnt lgkmcnt(0)" ::: "memory");
        float fr[16];
#pragma unroll
        for (int r = 0; r < 16; ++r) fr[r] = wsf[crow(r, hi)];
#pragma unroll
        for (int db = 0; db < 4; ++db)
#pragma unroll
            for (int r = 0; r < 16; ++r) o[db][r] *= fr[r];
        asm volatile("s_waitcnt lgkmcnt(0)" ::: "memory");
    }
    const float off = cb - mhat;
    float sacc = 0.f;
#pragma unroll
    for (int r = 0; r < 16; ++r) { p0[r] = __builtin_amdgcn_exp2f(p0[r] + off); p1[r] = __builtin_amdgcn_exp2f(p1[r] + off); sacc += p0[r] + p1[r]; }
    l_reg += sacc;
#pragma unroll
    for (int ks = 0; ks < 4; ++ks) { const f32x16& P = (ks < 2) ? p0 : p1; const int b = 8 * (ks & 1);
        pw[ks] = (u32x4){cvt_pk_bf16(P[b], P[b + 1]), cvt_pk_bf16(P[b + 2], P[b + 3]), cvt_pk_bf16(P[b + 4], P[b + 5]), cvt_pk_bf16(P[b + 6], P[b + 7])}; }
}
__device__ __forceinline__ void tile_h2(lds_cptr vp, f32x16 (&o)[4], const u32x4 (&pw)[4]) {
#pragma unroll
    for (int ks = 0; ks < 4; ++ks)
#pragma unroll
        for (int db = 0; db < 4; ++db) {
            const s16x4 lo = vtr(vp + db * 4096 + ks * 1024), h4 = vtr(vp + db * 4096 + ks * 1024 + 512);
            const bf16x8 vf = (bf16x8){lo[0], lo[1], lo[2], lo[3], h4[0], h4[1], h4[2], h4[3]};
            o[db] = ATT_MFMA(__builtin_bit_cast(bf16x8, pw[ks]), vf, o[db]);
        }
}

__device__ __forceinline__ void attn_unit(int b, int h, int qb, const bf16_t* Q, const bf16_t* KT, const bf16_t* VT, bf16_t* MIXED, LAS unsigned char* lds, float lam, const float* subln_g, const float* rel_bias) {
    const int tid = threadIdx.x, lane = tid & 63, r32 = lane & 31, hi = lane >> 5; const int wid = __builtin_amdgcn_readfirstlane(tid >> 6);
    const int wq = wid & 3, mp = wid >> 2;
    const size_t rowbase = (size_t)b * S; const int q0 = qb * 128, qw0 = q0 + 32 * wq, qrow = qw0 + r32;
    LAS float* btab = (LAS float*)(lds + LDS_BIAS); LAS float* wsf = (LAS float*)(lds + LDS_WSF) + wid * 64;
    if (tid < 256) { const int rel = tid - 128; const int n = rel < 0 ? -rel : rel; int bk; if (n < 8) bk = n; else { bk = 2 + (31 - __clz(n * n)); if (bk > 15) bk = 15; } if (rel > 0) bk += 16;
        btab[tid] = rel_bias[bk * NH + h] * LOG2E; }
    const float c_left = rel_bias[15 * NH + h] * LOG2E, c_right = rel_bias[31 * NH + h] * LOG2E;
    const bf16_t* Qw = Q + (rowbase + qw0) * 512 + h * 128 + mp * 64;
    bf16x8 qr[4];
#pragma unroll
    for (int d0 = 0; d0 < 4; ++d0) qr[d0] = *(const bf16x8*)(Qw + (size_t)r32 * 512 + d0 * 16 + hi * 8);
    const char* k1src = (const char*)KT + ((size_t)((b * 4 + h) * 2) * 64) * 8192 + wid * 1024 + lane * 16;
    const char* k2src = k1src + (size_t)64 * 8192;
    const char* vsrc = (const char*)VT + ((size_t)(b * 4 + h) * 64) * 16384 + wid * 1024 + lane * 16;
    const unsigned lds0 = (unsigned)(uintptr_t)(unsigned char*)lds;
    const unsigned kdst = lds0 + LDS_K + wid * 1024, vdst = lds0 + LDS_V + wid * 1024;
    const lds_cptr kp0 = (lds_cptr)lds + LDS_K + mp * 8192 + hi * 1024 + r32 * 16;
    const lds_cptr vp0 = (lds_cptr)lds + LDS_V + ((lane >> 4) & 1) * 32 + (lane & 3) * 8 + (4 * hi + ((lane & 15) >> 2)) * 64;
#define ATT_DMA_TILE(t, ks_, vs_) do { glds16(k1src + (size_t)(t) * 8192, (unsigned)__builtin_amdgcn_readfirstlane(kdst + (ks_))); glds16(k2src + (size_t)(t) * 8192, (unsigned)__builtin_amdgcn_readfirstlane(kdst + (ks_) + 8192)); \
        glds16(vsrc + (size_t)(t) * 16384, (unsigned)__builtin_amdgcn_readfirstlane(vdst + (vs_))); glds16(vsrc + (size_t)(t) * 16384 + 8192, (unsigned)__builtin_amdgcn_readfirstlane(vdst + (vs_) + 8192)); } while (0)
    ATT_DMA_TILE(0, 0, 0); ATT_DMA_TILE(1, SLOT, SLOT);
    float mhat = 0.f, l_reg = 0.f; f32x16 o[4]; u32x4 pw[4];
#pragma unroll
    for (int db = 0; db < 4; ++db)
#pragma unroll
        for (int r = 0; r < 16; ++r) o[db][r] = 0.f;
    int ksl = 0, ksl2 = 2 * SLOT, vsl = 0, vsl2 = 2 * SLOT, vprev = 0;
#define ATT_ROT() do { ksl = (ksl == 2 * SLOT) ? 0 : ksl + SLOT; ksl2 = (ksl2 == 2 * SLOT) ? 0 : ksl2 + SLOT; vprev = vsl; vsl = (vsl + SLOT) & (4 * SLOT - 1); vsl2 = (vsl2 + SLOT) & (4 * SLOT - 1); } while (0)
#define ATT_H1(FIRST_, t) tile_h1<FIRST_>(t, kp0 + ksl, qr, o, pw, mhat, l_reg, wsf, btab, qrow, qw0, c_left, c_right, r32, hi)
    if (mp == 0) {
        ATT_WAIT_BAR(4); ATT_DMA_TILE(2, ksl2, vsl2); ATT_H1(true, 0); tile_h2(vp0 + vsl, o, pw); ATT_ROT();
        for (int t = 1; t < NT - 2; ++t) { ATT_WAIT_BAR(4); ATT_DMA_TILE(t + 2, ksl2, vsl2); ATT_H1(false, t); tile_h2(vp0 + vsl, o, pw); ATT_ROT(); }
        ATT_WAIT_BAR(4); ATT_H1(false, NT - 2); tile_h2(vp0 + vsl, o, pw); ATT_ROT();
        ATT_WAIT_BAR(0); ATT_H1(false, NT - 1); tile_h2(vp0 + vsl, o, pw);
    } else {
        ATT_WAIT_BAR(4); ATT_DMA_TILE(2, ksl2, vsl2); ATT_H1(true, 0); ATT_ROT();
        for (int t = 1; t < NT - 2; ++t) { ATT_WAIT_BAR(4); ATT_DMA_TILE(t + 2, ksl2, vsl2); tile_h2(vp0 + vprev, o, pw); ATT_H1(false, t); ATT_ROT(); }
        ATT_WAIT_BAR(4); tile_h2(vp0 + vprev, o, pw); ATT_H1(false, NT - 2); ATT_ROT();
        ATT_WAIT_BAR(0); tile_h2(vp0 + vprev, o, pw); ATT_H1(false, NT - 1);
        tile_h2(vp0 + vsl, o, pw);
    }
#undef ATT_H1
    { auto rr = __builtin_amdgcn_permlane32_swap(__float_as_uint(l_reg), __float_as_uint(l_reg), false, false); l_reg = __uint_as_float(rr[0]) + __uint_as_float(rr[1]); }
    const float scale_q = (mp == 0 ? 1.0f : lam) * __builtin_amdgcn_rcpf(l_reg);
    if (hi == 0) wsf[r32] = scale_q;
    asm volatile("s_waitcnt lgkmcnt(0)" ::: "memory");
    float sc[16];
#pragma unroll
    for (int r = 0; r < 16; ++r) sc[r] = wsf[crow(r, hi)];
    asm volatile("s_waitcnt lgkmcnt(0)\n\ts_barrier" ::: "memory");
    LAS float* X = (LAS float*)(lds + LDS_X) + wq * 4096 + lane;
    if (mp == 1) {
#pragma unroll
        for (int db = 0; db < 4; ++db)
#pragma unroll
            for (int r = 0; r < 16; ++r) X[(db * 16 + r) * 64] = o[db][r] * sc[r];
    }
    asm volatile("s_waitcnt lgkmcnt(0)\n\ts_barrier" ::: "memory");
    if (mp == 0) {
        float ss[16];
#pragma unroll
        for (int r = 0; r < 16; ++r) ss[r] = 0.f;
#pragma unroll
        for (int db = 0; db < 4; ++db)
#pragma unroll
            for (int r = 0; r < 16; ++r) { const float d = o[db][r] * sc[r] - X[(db * 16 + r) * 64]; o[db][r] = d; ss[r] += d * d; }
#pragma unroll
        for (int r = 0; r < 16; ++r) {
#pragma unroll
            for (int x = 1; x < 32; x <<= 1) ss[r] += __shfl_xor(ss[r], x);
            ss[r] = __builtin_amdgcn_rsqf(ss[r] * (1.0f / 128.0f) + EPS) * 0.8f;
        }
        LAS bf16_t* stg = (LAS bf16_t*)(lds + LDS_OST) + wq * 4096;
#pragma unroll
        for (int db = 0; db < 4; ++db) { const float g = subln_g[db * 32 + r32];
#pragma unroll
            for (int r = 0; r < 16; ++r) { const unsigned w = cvt_pk_bf16(o[db][r] * ss[r] * g, 0.f); stg[crow(r, hi) * 128 + db * 32 + r32] = (bf16_t)(w & 0xffffu); } }
        asm volatile("s_waitcnt lgkmcnt(0)" ::: "memory");
        bf16_t* Ow = MIXED + (rowbase + qw0) * 1024 + h * 128;
#pragma unroll
        for (int i = 0; i < 8; ++i) { const int row = i * 4 + (lane >> 4), ch = lane & 15; const u32x4 v = *(const LAS u32x4*)(stg + row * 128 + ch * 8); *(u32x4*)(Ow + (size_t)row * 1024 + ch * 8) = v; }
    }
    asm volatile("s_waitcnt vmcnt(0) lgkmcnt(0)\n\ts_barrier" ::: "memory");
#undef ATT_DMA_TILE
#undef ATT_ROT
}
}

namespace lru {
template <int N> __device__ __forceinline__ float dpp_shr(float v, float ident) {
    return __int_as_float(__builtin_amdgcn_update_dpp(__float_as_int(ident), __float_as_int(v), 0x110 + N, 0xF, 0xF, false));
}
#define LRU_MFMA16(a, b, c) __builtin_amdgcn_mfma_f32_16x16x32_bf16(a, b, c, 0, 0, 0)
__device__ __forceinline__ void lru_rows(bf16x8 (&rowv)[2][7], __amdgpu_buffer_rsrc_t xsrd, int dir, int Pb, int ch0) {
#pragma unroll
    for (int k = 0; k < 7; ++k) {
        const int tt = dir ? (S - Pb - k) : (Pb - 2 + k);
#pragma unroll
        for (int ks = 0; ks < 2; ++ks) rowv[ks][k] = __builtin_bit_cast(bf16x8, __builtin_amdgcn_raw_buffer_load_b128(xsrd, (tt * 512 + ch0 + 32 * ks) * 2, 0, 0));
    }
}
__device__ __forceinline__ void lru_item(int b, int cg, const bf16_t* XR, const bf16_t* GR, float* HF, bf16_t* MIXED, LAS unsigned char* lds,
                                         const float* conv_w, const float* conv_b, const float* w_rg, const float* b_rg, const float* w_ig, const float* b_ig, const float* lru_lambda) {
    const int tid = threadIdx.x, lane = tid & 63, p = lane & 15, g = lane >> 4; const int wid = __builtin_amdgcn_readfirstlane(tid >> 6);
    const int n = cg >> 2, e16 = cg & 3, c0 = n * 64 + e16 * 16;
    const size_t rowbase = (size_t)b * S;
    const __amdgpu_buffer_rsrc_t XRb = __builtin_amdgcn_make_buffer_rsrc((void*)(XR + rowbase * 512), (short)0, S * 512 * 2, 0x00020000); const int ch0 = n * 64 + 8 * g;
    LAS float* tot = (LAS float*)(lds + att::LDS_TOT);
    bf16x8 idf;
#pragma unroll
    for (int j = 0; j < 8; ++j) idf[j] = ((8 * g + j) == (16 * (e16 & 1) + p)) ? (short)0x3f80 : (short)0;
    int par = 0;
    LAS float* cwl = (LAS float*)(lds + att::LDS_CW);
    if (tid < 320) { const int j = tid >> 6, c = tid & 63; cwl[tid] = (j < 4) ? conv_w[j * 512 + n * 64 + c] : conv_b[n * 64 + c]; }
    __syncthreads();
    for (int dir = 0; dir < 2; ++dir) {
        bf16x8 wrf[2], wif[2];
#pragma unroll
        for (int ks = 0; ks < 2; ++ks) {
            unsigned wr_[4], wi_[4];
#pragma unroll
            for (int j2 = 0; j2 < 4; ++j2) { const int d = 32 * ks + 8 * g + 2 * j2; const size_t i0 = ((size_t)((dir * 8 + n) * 64 + d)) * 64 + e16 * 16 + p;
                wr_[j2] = cvt_pk_bf16(w_rg[i0], w_rg[i0 + 64]); wi_[j2] = cvt_pk_bf16(w_ig[i0], w_ig[i0 + 64]); }
            wrf[ks] = __builtin_bit_cast(bf16x8, (u32x4){wr_[0], wr_[1], wr_[2], wr_[3]}); wif[ks] = __builtin_bit_cast(bf16x8, (u32x4){wi_[0], wi_[1], wi_[2], wi_[3]});
        }
        float br[4], bi[4], sp8[4], carry[4];
#pragma unroll
        for (int r = 0; r < 4; ++r) { const int c = dir * 512 + c0 + 4 * g + r; br[r] = b_rg[c] * -LOG2E; bi[r] = b_ig[c] * -LOG2E; const float lm = lru_lambda[c]; sp8[r] = 8.0f * LOG2E * log1pf(expf(-lm)); carry[r] = 0.f; }
        LAS u32x4* lst = (LAS u32x4*)lds + tid;
        lst[0 * 512] = __builtin_bit_cast(u32x4, wrf[0]); lst[1 * 512] = __builtin_bit_cast(u32x4, wrf[1]); lst[2 * 512] = __builtin_bit_cast(u32x4, wif[0]); lst[3 * 512] = __builtin_bit_cast(u32x4, wif[1]);
        lst[4 * 512] = __builtin_bit_cast(u32x4, (f32x4){br[0], br[1], br[2], br[3]}); lst[5 * 512] = __builtin_bit_cast(u32x4, (f32x4){bi[0], bi[1], bi[2], bi[3]}); lst[6 * 512] = __builtin_bit_cast(u32x4, (f32x4){sp8[0], sp8[1], sp8[2], sp8[3]}); lst[7 * 512] = __builtin_bit_cast(u32x4, idf);
        for (int sc = 0; sc < 8; ++sc) {
            const int P0 = sc * 512 + wid * 64, Pb = P0 + 4 * p;
            f32x4 ar[4], ai[4], ax[4];
            {
                bf16x8 rowv[2][7];
                lru_rows(rowv, XRb, dir, Pb, ch0);
                int zoff = 0; asm volatile("" : "+v"(zoff));
                const LAS float* cwi = cwl + zoff;
                const LAS u32x4* lsi = (const LAS u32x4*)lds + tid + zoff;
                const bf16x8 wrf0 = __builtin_bit_cast(bf16x8, lsi[0 * 512]), wrf1 = __builtin_bit_cast(bf16x8, lsi[1 * 512]), wif0 = __builtin_bit_cast(bf16x8, lsi[2 * 512]), wif1 = __builtin_bit_cast(bf16x8, lsi[3 * 512]), idf_ = __builtin_bit_cast(bf16x8, lsi[7 * 512]);
                u32x4 xfu[4][2];
#pragma unroll
                for (int ks = 0; ks < 2; ++ks) {
#pragma unroll
                    for (int eh = 0; eh < 2; ++eh) {
                        const int cl4 = 32 * ks + 8 * g + 4 * eh;
                        f32x4 wj[4];
#pragma unroll
                        for (int j = 0; j < 4; ++j) wj[j] = *(const LAS f32x4*)(cwi + (dir ? 3 - j : j) * 64 + cl4);
                        const f32x4 bb = *(const LAS f32x4*)(cwi + 256 + cl4);
                        f32x4 xr[7];
#pragma unroll
                        for (int k = 0; k < 7; ++k) { const u32x4 rw = __builtin_bit_cast(u32x4, rowv[ks][k]); const unsigned d0 = rw[2 * eh], d1 = rw[2 * eh + 1];
                            xr[k] = (f32x4){__uint_as_float(d0 << 16), __uint_as_float(d0 & 0xffff0000u), __uint_as_float(d1 << 16), __uint_as_float(d1 & 0xffff0000u)}; }
#pragma unroll
                        for (int i = 0; i < 4; ++i) {
                            f32x4 a4 = bb;
#pragma unroll
                            for (int j = 0; j < 4; ++j) a4 += wj[j] * xr[i + j];
                            xfu[i][ks][2 * eh] = cvt_pk_bf16(a4[0], a4[1]); xfu[i][ks][2 * eh + 1] = cvt_pk_bf16(a4[2], a4[3]);
                        }
                        __builtin_amdgcn_sched_barrier(0);
                    }
                }
                bf16x8 xf[4][2];
#pragma unroll
                for (int i = 0; i < 4; ++i) { xf[i][0] = __builtin_bit_cast(bf16x8, xfu[i][0]); xf[i][1] = __builtin_bit_cast(bf16x8, xfu[i][1]); }
                const f32x4 z = (f32x4){0.f, 0.f, 0.f, 0.f};
#pragma unroll
                for (int i = 0; i < 4; ++i) {
                    ar[i] = LRU_MFMA16(wrf0, xf[i][0], z); ar[i] = LRU_MFMA16(wrf1, xf[i][1], ar[i]);
                    ai[i] = LRU_MFMA16(wif0, xf[i][0], z); ai[i] = LRU_MFMA16(wif1, xf[i][1], ai[i]);
                    ax[i] = LRU_MFMA16(idf_, (e16 & 2) ? xf[i][1] : xf[i][0], z);
                }
            }
            float hh[4][4], cpp[4][4], Al[4], Hl[4];
            int zoff2 = 0; asm volatile("" : "+v"(zoff2));
            const LAS f32x4* lsg = (const LAS f32x4*)lds + tid + zoff2;
            const f32x4 brv = lsg[4 * 512], biv = lsg[5 * 512], spv = lsg[6 * 512];
#pragma unroll
            for (int r = 0; r < 4; ++r) {
                float h = 0.f, cp = 1.f;
#pragma unroll
                for (int i = 0; i < 4; ++i) {
                    const float rg = __builtin_amdgcn_rcpf(1.0f + __builtin_amdgcn_exp2f(ar[i][r] * -LOG2E + brv[r])), ig = __builtin_amdgcn_rcpf(1.0f + __builtin_amdgcn_exp2f(ai[i][r] * -LOG2E + biv[r]));
                    const float a_ = __builtin_amdgcn_exp2f(-rg * spv[r]);
                    const float om = __builtin_fmaf(-a_, a_, 1.0f);
                    const float u_ = __builtin_amdgcn_sqrtf(om) * (ig * ax[i][r]);
                    h = a_ * h + u_; cp = a_ * cp; hh[i][r] = h; cpp[i][r] = cp;
                }
                Al[r] = cp; Hl[r] = h;
            }
#define LRU_KS(NN) do { _Pragma("unroll") for (int r = 0; r < 4; ++r) { const float Ap = dpp_shr<NN>(Al[r], 1.0f), Hp = dpp_shr<NN>(Hl[r], 0.0f); Hl[r] = Al[r] * Hp + Hl[r]; Al[r] = Al[r] * Ap; } } while (0)
            LRU_KS(1); LRU_KS(2); LRU_KS(4); LRU_KS(8);
#undef LRU_KS
            float Aex[4], Hex[4];
#pragma unroll
            for (int r = 0; r < 4; ++r) { Aex[r] = dpp_shr<1>(Al[r], 1.0f); Hex[r] = dpp_shr<1>(Hl[r], 0.0f); }
            if (p == 15) {
#pragma unroll
                for (int r = 0; r < 4; ++r) { tot[((par * 8 + wid) * 16 + 4 * g + r) * 2] = Al[r]; tot[((par * 8 + wid) * 16 + 4 * g + r) * 2 + 1] = Hl[r]; }
            }
            asm volatile("s_waitcnt lgkmcnt(0)\n\ts_barrier" ::: "memory");
            float cin[4];
#pragma unroll
            for (int r = 0; r < 4; ++r) cin[r] = 0.f;
#pragma unroll
            for (int w = 0; w < 8; ++w) {
                const f32x4 t0 = *(const LAS f32x4*)(tot + ((par * 8 + w) * 16 + 4 * g) * 2), t1 = *(const LAS f32x4*)(tot + ((par * 8 + w) * 16 + 4 * g) * 2 + 4);
                const float Aw[4] = {t0[0], t0[2], t1[0], t1[2]}, Hw[4] = {t0[1], t0[3], t1[1], t1[3]};
#pragma unroll
                for (int r = 0; r < 4; ++r) { if (w == wid) cin[r] = carry[r]; carry[r] = Aw[r] * carry[r] + Hw[r]; }
            }
            par ^= 1;
            f32x4 hfv[4]; u32x2 gv[4];
            if (dir) {
#pragma unroll
                for (int i = 0; i < 4; ++i) { const int tok = S - 1 - (Pb + i); hfv[i] = *(const f32x4*)(HF + (rowbase + tok) * 512 + c0 + 4 * g); gv[i] = *(const u32x2*)(GR + (rowbase + tok) * 512 + c0 + 4 * g); }
            }
            float cl[4];
#pragma unroll
            for (int r = 0; r < 4; ++r) cl[r] = Aex[r] * cin[r] + Hex[r];
#pragma unroll
            for (int i = 0; i < 4; ++i) {
                const int P = Pb + i; const int tok = dir ? (S - 1 - P) : P;
                f32x4 hv;
#pragma unroll
                for (int r = 0; r < 4; ++r) hv[r] = hh[i][r] + cpp[i][r] * cl[r];
                if (dir == 0) *(f32x4*)(HF + (rowbase + tok) * 512 + c0 + 4 * g) = hv;
                else {
                    const float gr4[4] = {__uint_as_float(gv[i].x << 16), __uint_as_float(gv[i].x & 0xffff0000u), __uint_as_float(gv[i].y << 16), __uint_as_float(gv[i].y & 0xffff0000u)};
                    float y[4];
#pragma unroll
                    for (int r = 0; r < 4; ++r) { const float x = gr4[r]; const float gl = x * fast_sigmoid(1.5957691216057308f * (x + 0.044715f * x * x * x)); y[r] = gl * (hv[r] + hfv[i][r]); }
                    u32x2 w; w.x = cvt_pk_bf16(y[0], y[1]); w.y = cvt_pk_bf16(y[2], y[3]);
                    *(u32x2*)(MIXED + (rowbase + tok) * 1024 + 512 + c0 + 4 * g) = w;
                }
            }
        }
        __syncthreads();
    }
}
}
struct Args { const float* in[22]; float* out; unsigned char* ws; int ph_lo, ph_hi; };
constexpr int N_PHASES = 6;

__global__ void __launch_bounds__(NWAVES * 64, 2) mk_fwd(Args args) {
    extern __shared__ __attribute__((aligned(16))) unsigned char lds_raw[];
    LAS unsigned char* lds = (LAS unsigned char*)lds_raw;
    const int tid = threadIdx.x, lane = tid & 63; const int wave = __builtin_amdgcn_readfirstlane(tid >> 6);
    const int G = gridDim.x, bx = blockIdx.x; const int vcu = (G % 8 == 0) ? (bx % 8) * (G / 8) + bx / 8 : bx;
    unsigned char* ws = args.ws;
    const float* x = args.in[0]; float* out = args.out;
    bf16_t* WIN = (bf16_t*)(ws + WS_WIN); bf16_t* WOUT = (bf16_t*)(ws + WS_WOUT); bf16_t* WGU = (bf16_t*)(ws + WS_WGU); bf16_t* WDN = (bf16_t*)(ws + WS_WDN);
    float* RSS1 = (float*)(ws + WS_RSS1); float* RSS2 = (float*)(ws + WS_RSS2);
    bf16_t* XN = (bf16_t*)(ws + WS_XN); bf16_t* HB = XN;
    bf16_t* Qb = (bf16_t*)(ws + WS_Q); bf16_t* KT = (bf16_t*)(ws + WS_KT); bf16_t* VT = (bf16_t*)(ws + WS_VT); bf16_t* XR = (bf16_t*)(ws + WS_XR); bf16_t* GR = (bf16_t*)(ws + WS_GR);
    float* HF = (float*)(ws + WS_HF); bf16_t* MIXED = (bf16_t*)(ws + WS_MIXED); bf16_t* ACT = (bf16_t*)(ws + WS_ACT);
    const int lo = args.ph_lo, hi = args.ph_hi;
    volatile LAS unsigned* bst = (volatile LAS unsigned*)(lds + LDS_MISC + 8192);
    if (tid == 0) { bst[0] = 0u; bst[1] = 0u; }
    __syncthreads();
    xb::XcdBarrier bar = xb::xcd_barrier_post((unsigned*)ws, bst);
    if (lo > 1000) cooperative_groups::this_grid().sync();
#define IN(k) (lo <= (k) && (k) < hi)
#ifndef REP_PHASE
#define REP_PHASE -1
#endif
#define REPS(k) ((REP_PHASE == (k)) ? 2 : 1)
#define REPSYNC(k, rep) do { if ((rep) + 1 < REPS(k)) xb::xcd_barrier(bar); } while (0)
#define SEAM(k) do { if (IN(k) && IN((k) + 1)) { xb::xcd_barrier(bar); } } while (0)

    if (IN(0)) for (int rep = 0; rep < REPS(0); ++rep) {
        LAS float* scr = (LAS float*)(lds + wave * 16384);
        const int gw = vcu * NWAVES + wave, NGW = G * NWAVES;
        constexpr int I_IN = (D / 64) * (DIN / 32), I_OUT = (D / 64) * (D / 32), I_G = (D / 64) * (DFF / 32), I_DN = (DFF / 64) * (D / 32);
        constexpr int NITEMS = I_IN + I_OUT + 2 * I_G + I_DN;
        for (int it = gw; it < NITEMS; it += NGW) {
            int r = it;
            if (r < I_IN) { p0_transpose_item<0>(args.in[2], D, DIN, WIN, nullptr, scr, r, lane); continue; } r -= I_IN;
            if (r < I_OUT) { p0_transpose_item<0>(args.in[16], D, D, WOUT, nullptr, scr, r, lane); continue; } r -= I_OUT;
            if (r < I_G) { p0_transpose_item<1>(args.in[18], D, DFF, WGU, args.in[17], scr, r, lane); continue; } r -= I_G;
            if (r < I_G) { p0_transpose_item<2>(args.in[19], D, DFF, WGU, args.in[17], scr, r, lane); continue; } r -= I_G;
            p0_transpose_item<0>(args.in[20], DFF, D, WDN, nullptr, scr, r, lane);
        }
        for (int m = gw * 4; m < M; m += NGW * 4) rms_rows_to_bf16<4>(x + (size_t)m * D, args.in[1], XN + (size_t)m * D, lane);
        REPSYNC(0, rep);
    }
    SEAM(0);
    if (IN(1)) for (int rep = 0; rep < REPS(1); ++rep) {
        pg8::Gemm g{XN, WIN, M, DIN, D}; pg8::StaticOrder So; So.init(M, DIN, G, bx);
        pg8::EpiInProj E{Qb, KT, VT, XR, GR, QSCALE};
        pg8::gemm_phase<pg8::EpiInProj, pg8::StaticOrder, true, true>(lds, g, So, E);
        REPSYNC(1, rep);
    }
    SEAM(1);
    if (IN(2)) {
        float lam;
        { float s1 = 0.f, s2 = 0.f; for (int i = 0; i < 64; ++i) { s1 += args.in[3][i] * args.in[4][i]; s2 += args.in[5][i] * args.in[6][i]; } lam = expf(s1) - expf(s2) + 0.2f; }
        for (int rep = 0; rep < REPS(20); ++rep)
        for (int rnd = 0; rnd * G + vcu < NB * NH * 32; ++rnd) {
            const int u = rnd * G + vcu; int b_, h_, qb_;
            if (G == 256) { b_ = vcu >> 5; h_ = rnd; qb_ = vcu & 31; } else { qb_ = u & 31; h_ = (u >> 5) & 3; b_ = u >> 7; }
            att::attn_unit(b_, h_, qb_, Qb, KT, VT, MIXED, lds, lam, args.in[7], args.in[8]);
        }
        for (int rep = 0; rep < REPS(21); ++rep)
        for (int it = vcu; it < NB * 32; it += G) {
            const int b_ = it >> 5, cg = it & 31;
            lru::lru_item(b_, cg, XR, GR, HF, MIXED, lds, args.in[9], args.in[10], args.in[11], args.in[12], args.in[13], args.in[14], args.in[15]);
        }
    }
    SEAM(2);
    if (IN(3)) for (int rep = 0; rep < REPS(3); ++rep) {
        pg8::Gemm g{MIXED, WOUT, M, D, D}; pg8::StaticOrder So; So.init(M, D, G, bx);
        pg8::EpiResid<true, false> E{x, out, HB, RSS1, D};
        pg8::gemm_phase<pg8::EpiResid<true, false>, pg8::StaticOrder, true, true>(lds, g, So, E);
        REPSYNC(3, rep);
    }
    SEAM(3);
    if (IN(4)) for (int rep = 0; rep < REPS(4); ++rep) {
        pg8::Gemm g{HB, WGU, M, 2 * DFF, D}; pg8::StaticOrder So; So.init(M, 2 * DFF, G, bx);
        pg8::EpiGateUp E{ACT, RSS1, DFF, EPS};
        pg8::gemm_phase<pg8::EpiGateUp, pg8::StaticOrder, true, true>(lds, g, So, E);
        REPSYNC(4, rep);
    }
    SEAM(4);
    if (IN(5)) {
        if (G == 256) {
#pragma unroll 1
            for (int half = 0; half < 2; ++half) {
                const size_t r0 = (size_t)half * (M / 2);
                pg8::Gemm g{ACT + r0 * DFF, WDN, M / 2, D, DFF}; pg8::StaticOrder So; So.init(M / 2, D, G, bx);
                pg8::EpiDownNorm E{HB + r0 * D, out + r0 * D, args.in[21], RSS2 + r0 * 4, (unsigned*)ws + 4096 + 64 * 64 * half, D, EPS};
                pg8::gemm_phase<pg8::EpiDownNorm, pg8::StaticOrder, false, true>(lds, g, So, E);
                __syncthreads();
            }
        }
    }
#if REP_PHASE == 99
    for (int i = 0; i < 20; ++i) xb::xcd_barrier(bar);
#endif
#undef IN
#undef SEAM
}
}
namespace dbg {
using namespace mk;
__global__ void __launch_bounds__(256) k_unpack_proj(const bf16_t* Qb, const bf16_t* KT, const bf16_t* VT, const bf16_t* XR, const bf16_t* GR, float* q, float* k, float* v, float* xr, float* gr) {
    const size_t idx = (size_t)blockIdx.x * 256 + threadIdx.x;
    const int c = (int)(idx & 511); const int row = (int)(idx >> 9); const int b = row >> 12, tok = row & 4095, t = tok >> 6, rr = tok & 63;
    q[idx] = bf2f(Qb[idx]) * (1.0f / QSCALE);
    { const int h = c >> 7, w = c & 127, s = w >> 6, d = w & 63, chunk = d >> 3, j = d & 7;
      k[idx] = bf2f(KT[((((size_t)(b * 4 + h) * 2 + s) * 64 + t) * 8 + chunk) * 512 + rr * 8 + j]); }
    { const int h = c >> 7, dv = c & 127, db = dv >> 5, cc = dv & 31;
      v[idx] = bf2f(VT[(((size_t)(b * 4 + h) * 64 + t) * 4 + db) * 2048 + rr * 32 + cc]); }
    xr[idx] = bf2f(XR[idx]); gr[idx] = bf2f(GR[idx]);
}
__global__ void __launch_bounds__(256) k_unpack_bf16(const bf16_t* src, float* dst) { const size_t idx = (size_t)blockIdx.x * 256 + threadIdx.x; dst[idx] = bf2f(src[idx]); }
}

#ifndef STAGE
#define STAGE 4
#endif
static void mk_launch_phases(const mk::Args& a0, int lo, int hi, int grid, hipStream_t stream, bool coop) {
    mk::Args a = a0; a.ph_lo = lo; a.ph_hi = hi;
    if (coop) { void* args[] = {&a}; hipError_t e = hipLaunchCooperativeKernel((const void*)mk::mk_fwd, dim3(grid), dim3(mk::NWAVES * 64), args, mk::LDS_BYTES, stream);
        if (e != hipSuccess) fprintf(stderr, "cooperative launch failed: %s (grid %d)\n", hipGetErrorString(e), grid); }
    else { hipLaunchKernelGGL(mk::mk_fwd, dim3(grid), dim3(mk::NWAVES * 64), mk::LDS_BYTES, stream, a); }
}

extern "C" void kernel_launch(void* const* d_in, const int* in_sizes, int n_in, void* d_out, int out_size, void* d_ws, size_t ws_size, hipStream_t stream) {
    static int grid = 0;
    if (grid == 0) {
        int dev = 0, cus = 0, per_cu = 0;
        hipGetDevice(&dev); hipDeviceGetAttribute(&cus, hipDeviceAttributeMultiprocessorCount, dev);
        if (hipFuncSetAttribute((const void*)mk::mk_fwd, hipFuncAttributeMaxDynamicSharedMemorySize, mk::LDS_BYTES) != hipSuccess) { fprintf(stderr, "hipFuncSetAttribute failed\n"); grid = -1; return; }
        if (hipOccupancyMaxActiveBlocksPerMultiprocessor(&per_cu, (const void*)mk::mk_fwd, mk::NWAVES * 64, mk::LDS_BYTES) != hipSuccess || per_cu < 1) { fprintf(stderr, "occupancy query: %d\n", per_cu); per_cu = 1; }
        (void)hipGetLastError();
        grid = cus * 1;
        if (n_in != 22 || ws_size < 512u * mk::MiB) fprintf(stderr, "kernel_launch: unexpected n_in %d / ws_size %zu\n", n_in, ws_size);
    }
    if (grid < 0) return;
    if (hipMemsetAsync(d_ws, 0, 65536, stream) != hipSuccess) { fprintf(stderr, "memset failed\n"); return; }
    mk::Args a{};
    for (int i = 0; i < 22; ++i) a.in[i] = (const float*)d_in[i];
    a.out = (float*)d_out; a.ws = (unsigned char*)d_ws;
    char* ws = (char*)d_ws; const size_t MiB = 1u << 20;
#if STAGE == 4
    mk_launch_phases(a, 0, mk::N_PHASES, grid, stream, true);
#elif STAGE == 3
    for (int p = 0; p < mk::N_PHASES; ++p) mk_launch_phases(a, p, p + 1, grid, stream, false);
#elif STAGE == 1
    for (int p = 0; p < 2; ++p) mk_launch_phases(a, p, p + 1, grid, stream, false);
    float* q = (float*)(ws + 32 * MiB), *k = (float*)(ws + 256 * MiB), *v = (float*)(ws + 320 * MiB), *xr = (float*)(ws + 384 * MiB), *gr = (float*)(ws + 448 * MiB);
    dbg::k_unpack_proj<<<mk::M * 512 / 256, 256, 0, stream>>>((const mk::bf16_t*)(ws + mk::WS_Q), (const mk::bf16_t*)(ws + mk::WS_KT), (const mk::bf16_t*)(ws + mk::WS_VT), (const mk::bf16_t*)(ws + mk::WS_XR), (const mk::bf16_t*)(ws + mk::WS_GR), q, k, v, xr, gr);
    float* mixed = (float*)(ws + 96 * MiB);
    nv::naive_mid(d_in, q, k, v, xr, gr, mixed, stream);
    nv::naive_tail(d_in, mixed, (float*)d_out, (float*)(ws + 0), (float*)(ws + 128 * MiB), stream);
#elif STAGE == 2
    for (int p = 0; p < 3; ++p) mk_launch_phases(a, p, p + 1, grid, stream, false);
    float* mixed = (float*)(ws + 0);
    dbg::k_unpack_bf16<<<mk::M * 1024 / 256, 256, 0, stream>>>((const mk::bf16_t*)(ws + mk::WS_MIXED), mixed);
    nv::naive_tail(d_in, mixed, (float*)d_out, (float*)(ws + 0), (float*)(ws + 128 * MiB), stream);
#endif
}
```

```cpp
#include <hip/hip_runtime.h>
#include <hip/hip_cooperative_groups.h>
#include <cstdio>
#include <cstdint>
#include <cmath>
#define STAGE 4
namespace pg8 {
#define PG8_LAS __attribute__((address_space(3)))
typedef unsigned short bf16_t;
typedef short bf16x8 __attribute__((ext_vector_type(8)));
typedef float f32x4 __attribute__((ext_vector_type(4)));
typedef unsigned u32x4 __attribute__((ext_vector_type(4)));
constexpr int BM = 256, BK = 64, HALF = 128, HTB = HALF * BK * 2  , STAGE_BYTES = 8 * HTB, NXCD = 8, WGM = 8;

__host__ __device__ __forceinline__ int lds_byte(int r, int c) { const int st = (r >> 4) * 2 + (c >> 5), rr = r & 15, cc = c & 31, ob = rr * 64 + cc * 2; return st * 1024 + (ob ^ (((ob >> 9) & 1) << 5)); }
__host__ __device__ __forceinline__ void stage_rc(int b, int& R, int& C) { const int st = b / 1024, sb = b % 1024, swz = sb ^ (((sb >> 9) & 1) << 5); R = (st >> 1) * 16 + swz / 64; C = (st & 1) * 32 + (swz % 64) / 2; }
__host__ __device__ __forceinline__ int perm32(int rho) { const int n = rho >> 4, i = rho & 15; return 8 * (i >> 2) + 4 * n + (i & 3); }

struct Unit { int pm, pn; };
struct Gemm { const bf16_t* A; const bf16_t* Bt; int M, N, K; };

struct StaticOrder {
    int nM, nN, nwg, G, c;
    __host__ __device__ void init(int M, int N, int G_, int c_) { nM = M / BM; nN = N / BM; nwg = nM * nN; G = G_; c = c_; }
    __host__ __device__ bool next(int i, Unit& u) const {
        const long L = (long)i * G + c; if (L >= nwg) return false;
        int wgid = (int)L; { const int q = nwg / NXCD, r = nwg % NXCD, xcd = wgid % NXCD, off = wgid / NXCD; wgid = (xcd < r ? xcd * (q + 1) : r * (q + 1) + (xcd - r) * q) + off; }
        const int nig = WGM * nN, gid = wgid / nig, fm = gid * WGM, gsz = (nM - fm) < WGM ? (nM - fm) : WGM;
        u.pm = fm + ((wgid % nig) % gsz); u.pn = (wgid % nig) / gsz; return true;
    }
    __device__ __forceinline__ void a_ready(const Unit&) const {}
    __device__ __forceinline__ void done(const Unit&) const {}
};

typedef float f32x2_cv __attribute__((ext_vector_type(2))); typedef __bf16 bf16x2_cv __attribute__((ext_vector_type(2)));
__device__ __forceinline__ unsigned cvt_pk_bf16(float lo, float hi) { f32x2_cv v = {lo, hi}; bf16x2_cv b = __builtin_convertvector(v, bf16x2_cv); return __builtin_bit_cast(unsigned, b); }
typedef float f32x2 __attribute__((ext_vector_type(2)));
typedef unsigned u32x2 __attribute__((ext_vector_type(2)));
__device__ __forceinline__ u32x4 pack8(f32x4 v0, f32x4 v1) { u32x4 w; w.x = cvt_pk_bf16(v0[0], v0[1]); w.y = cvt_pk_bf16(v0[2], v0[3]); w.z = cvt_pk_bf16(v1[0], v1[1]); w.w = cvt_pk_bf16(v1[2], v1[3]); return w; }
struct EpiInProj {
    static constexpr bool PERM = true, AFTER_DRAIN = false;
    bf16_t *Q, *KT, *VT, *XR, *GR; float qscale;
    __device__ __forceinline__ void operator()(const f32x4 (&acc)[2][2][4][2], const Unit& u, int wr, int wc, int fr, int fq) const {
        const int sec = u.pn >> 1, half = u.pn & 1;
#pragma unroll
        for (int ai = 0; ai < 2; ++ai)
#pragma unroll
            for (int m = 0; m < 4; ++m) {
                const int row = u.pm * BM + ai * HALF + wr * 64 + m * 16 + fr;
                const int b = row >> 12, tok = row & 4095, t = tok >> 6, rr = tok & 63;
#pragma unroll
                for (int bj = 0; bj < 2; ++bj) {
                    f32x4 v0 = acc[ai][bj][m][0], v1 = acc[ai][bj][m][1];
                    const int cs = half * 256 + bj * HALF + wc * 32 + 8 * fq;
                    if (sec == 0) { v0 = v0 * qscale; v1 = v1 * qscale; *(u32x4*)(Q + (size_t)row * 512 + cs) = pack8(v0, v1); }
                    else if (sec == 1) { const int h = half * 2 + bj, s = wc >> 1, chunk = 4 * (wc & 1) + fq;
                        *(u32x4*)(KT + ((((size_t)(b * 4 + h) * 2 + s) * 64 + t) * 8 + chunk) * 512 + rr * 8) = pack8(v0, v1); }
                    else if (sec == 2) { const int h = half * 2 + bj;
                        *(u32x4*)(VT + (((size_t)(b * 4 + h) * 64 + t) * 4 + wc) * 2048 + rr * 32 + 8 * fq) = pack8(v0, v1); }
                    else if (sec == 3) { *(u32x4*)(XR + (size_t)row * 512 + cs) = pack8(v0, v1); }
                    else { *(u32x4*)(GR + (size_t)row * 512 + cs) = pack8(v0, v1); }
                }
            }
    }
};
template <bool WRITE_HB, bool WRITE_F32 = true> struct EpiResid {
    static constexpr bool PERM = false, AFTER_DRAIN = false;
    const float* base; float* out; bf16_t* hb; float* rss; int ldc;
    __device__ __forceinline__ void operator()(const f32x4 (&acc)[2][2][4][2], const Unit& u, int wr, int wc, int fr, int fq) const {
        const int col0 = u.pn * BM + wc * 32 + 4 * fq;
#pragma unroll
        for (int ai = 0; ai < 2; ++ai)
#pragma unroll
            for (int m = 0; m < 4; ++m) {
                const int row = u.pm * BM + ai * HALF + wr * 64 + m * 16 + fr; const size_t off = (size_t)row * ldc + col0; float ss = 0.f;
#pragma unroll
                for (int bj = 0; bj < 2; ++bj)
#pragma unroll
                    for (int n = 0; n < 2; ++n) {
                        const f32x4 bs = *(const f32x4*)(base + off + bj * HALF + n * 16); const f32x4 o = acc[ai][bj][m][n] + bs;
                        if (WRITE_F32) *(f32x4*)(out + off + bj * HALF + n * 16) = o;
                        if (WRITE_HB) { u32x2 w; w.x = cvt_pk_bf16(o[0], o[1]); w.y = cvt_pk_bf16(o[2], o[3]); *(u32x2*)(hb + off + bj * HALF + n * 16) = w; }
                        ss += (o[0] * o[0] + o[1] * o[1]) + (o[2] * o[2] + o[3] * o[3]);
                    }
                ss += __shfl_xor(ss, 16); ss += __shfl_xor(ss, 32);
                if (fq == 0) rss[(size_t)row * 16 + u.pn * 4 + wc] = ss;
            }
    }
};
struct EpiGateUp {
    static constexpr bool PERM = true, AFTER_DRAIN = false;
    bf16_t* act; const float* rss; int ldo; float eps;
    __device__ __forceinline__ void operator()(const f32x4 (&acc)[2][2][4][2], const Unit& u, int wr, int wc, int fr, int fq) const {
        const int col0 = u.pn * HALF + wc * 32 + 8 * fq;
#pragma unroll
        for (int ai = 0; ai < 2; ++ai)
#pragma unroll
            for (int m = 0; m < 4; ++m) {
                const int row = u.pm * BM + ai * HALF + wr * 64 + m * 16 + fr;
                const f32x4* rp = (const f32x4*)(rss + (size_t)row * 16); const f32x4 s0 = rp[0], s1 = rp[1], s2 = rp[2], s3 = rp[3];
                const float tot = ((s0[0] + s0[1]) + (s0[2] + s0[3])) + ((s1[0] + s1[1]) + (s1[2] + s1[3])) + ((s2[0] + s2[1]) + (s2[2] + s2[3])) + ((s3[0] + s3[1]) + (s3[2] + s3[3]));
                const float rstd = __builtin_amdgcn_rsqf(tot * (1.0f / 1024.0f) + eps);
                f32x4 o[2];
#pragma unroll
                for (int n = 0; n < 2; ++n) {
                    const f32x4 g = acc[ai][0][m][n] * rstd, up = acc[ai][1][m][n] * rstd;
#pragma unroll
                    for (int i = 0; i < 4; ++i) { const float e = __builtin_amdgcn_exp2f(g[i] * -1.4426950408889634f); o[n][i] = g[i] * __builtin_amdgcn_rcpf(1.0f + e) * up[i]; }
                }
                *(u32x4*)(act + (size_t)row * ldo + col0) = pack8(o[0], o[1]);
            }
    }
};

struct EpiDownNorm {
    static constexpr bool PERM = false, AFTER_DRAIN = true;
    const bf16_t* hb; float* out; const float* gain; float* xbuf; unsigned* cnt; int ldc; float eps;
    __device__ __forceinline__ void fused(f32x4 (&acc)[2][2][4][2], const Unit& u, int wr, int wc, int fr, int fq, PG8_LAS unsigned char* lds, int wid, int lane) const {
        PG8_LAS float* P = (PG8_LAS float*)lds;
        PG8_LAS float* Sx = (PG8_LAS float*)(lds + 4096);
        PG8_LAS unsigned* flag = (PG8_LAS unsigned*)(lds + 4096 + 1024);
        const int col0 = u.pn * BM + wc * 32 + 4 * fq;
#pragma unroll
        for (int ai = 0; ai < 2; ++ai)
#pragma unroll
            for (int m = 0; m < 4; ++m) {
                const int r = ai * HALF + wr * 64 + m * 16 + fr; const size_t off = (size_t)(u.pm * BM + r) * ldc + col0; float ss = 0.f;
#pragma unroll
                for (int bj = 0; bj < 2; ++bj)
#pragma unroll
                    for (int n = 0; n < 2; ++n) {
                        const u32x2 hv = *(const u32x2*)(hb + off + bj * HALF + n * 16);
                        const f32x4 h4 = (f32x4){__uint_as_float(hv.x << 16), __uint_as_float(hv.x & 0xffff0000u), __uint_as_float(hv.y << 16), __uint_as_float(hv.y & 0xffff0000u)};
                        const f32x4 o = acc[ai][bj][m][n] + h4; acc[ai][bj][m][n] = o;
                        ss += (o[0] * o[0] + o[1] * o[1]) + (o[2] * o[2] + o[3] * o[3]);
                    }
                ss += __shfl_xor(ss, 16); ss += __shfl_xor(ss, 32);
                if (fq == 0) P[r * 4 + wc] = ss;
            }
        asm volatile("s_waitcnt lgkmcnt(0)" ::: "memory"); __builtin_amdgcn_s_barrier(); asm volatile("" ::: "memory");
        const int row = wid * 32 + (lane & 31);
        if (lane < 32) {
            const float s = (P[row * 4 + 0] + P[row * 4 + 1]) + (P[row * 4 + 2] + P[row * 4 + 3]);
            __hip_atomic_store(xbuf + (size_t)(u.pm * BM + row) * 4 + u.pn, s, __ATOMIC_RELAXED, __HIP_MEMORY_SCOPE_AGENT);
        }
        asm volatile("s_waitcnt vmcnt(0)" ::: "memory");
        if (lane == 0) __hip_atomic_fetch_add(cnt + 64 * u.pm, 1u, __ATOMIC_RELAXED, __HIP_MEMORY_SCOPE_AGENT);
        if (wid == 0) {
            unsigned sp = 0;
            for (;;) {
                if ((unsigned)__builtin_amdgcn_readfirstlane(__hip_atomic_load(cnt + 64 * u.pm, __ATOMIC_RELAXED, __HIP_MEMORY_SCOPE_AGENT)) >= 32u) break;
                if (++sp > (1u << 22)) break;
                __builtin_amdgcn_s_sleep(2);
            }
            __builtin_amdgcn_fence(__ATOMIC_ACQUIRE, "agent");
            if (lane == 0) flag[0] = 0u;
        }
        asm volatile("s_waitcnt vmcnt(0) lgkmcnt(0)" ::: "memory"); __builtin_amdgcn_s_barrier(); asm volatile("" ::: "memory");
        if (lane < 32) {
            const float* slot = xbuf + (size_t)(u.pm * BM + row) * 4;
            const float a = __hip_atomic_load(slot + 0, __ATOMIC_RELAXED, __HIP_MEMORY_SCOPE_AGENT), b = __hip_atomic_load(slot + 1, __ATOMIC_RELAXED, __HIP_MEMORY_SCOPE_AGENT),
                        c = __hip_atomic_load(slot + 2, __ATOMIC_RELAXED, __HIP_MEMORY_SCOPE_AGENT), d = __hip_atomic_load(slot + 3, __ATOMIC_RELAXED, __HIP_MEMORY_SCOPE_AGENT);
            Sx[row] = 1.0f / sqrtf(((a + b) + (c + d)) * (1.0f / 1024.0f) + eps);
        }
        asm volatile("s_waitcnt lgkmcnt(0)" ::: "memory"); __builtin_amdgcn_s_barrier(); asm volatile("" ::: "memory");
        f32x4 gv[2][2];
#pragma unroll
        for (int bj = 0; bj < 2; ++bj)
#pragma unroll
            for (int n = 0; n < 2; ++n) gv[bj][n] = *(const f32x4*)(gain + col0 + bj * HALF + n * 16);
#pragma unroll
        for (int ai = 0; ai < 2; ++ai)
#pragma unroll
            for (int m = 0; m < 4; ++m) {
                const int r = ai * HALF + wr * 64 + m * 16 + fr; const float rs = Sx[r]; const size_t off = (size_t)(u.pm * BM + r) * ldc + col0;
#pragma unroll
                for (int bj = 0; bj < 2; ++bj)
#pragma unroll
                    for (int n = 0; n < 2; ++n) *(f32x4*)(out + off + bj * HALF + n * 16) = acc[ai][bj][m][n] * rs * gv[bj][n];
            }
    }
};
template <class Epi, class Sched, bool ALIGN_EPI = false, bool SP2 = false>
__device__ __forceinline__ void gemm_phase(PG8_LAS unsigned char* lds, const Gemm g, const Sched& S, const Epi& E) {
    const int tid = threadIdx.x, wid = __builtin_amdgcn_readfirstlane(tid >> 6), lane = tid & 63, wr = wid >> 2, wc = wid & 3, fr = lane & 15, fq = lane >> 4;
    const int K = g.K, nt = K / BK;
    unsigned voffA[2], voffB[2];
#pragma unroll
    for (int i = 0; i < 2; ++i) { int R, C; stage_rc(tid * 16 + i * 8192, R, C); const int Rb = Epi::PERM ? ((R & ~31) + perm32(R & 31)) : R;
        voffA[i] = (unsigned)(R * K + C) * 2u; voffB[i] = (unsigned)(Rb * K + C) * 2u; }
    const size_t kstep = (size_t)(BK * 2);
    const size_t hstep = (size_t)HALF * K * 2;
    const size_t tstep = 2 * hstep;
    const unsigned ldsw = (unsigned)wid * 1024u;
    const int aoff = lds_byte(wr * 64 + fr, fq * 8), boff = lds_byte(wc * 32 + fr, fq * 8);
#define PG8_SA(b, h) (((b) * 2 + (h)) * HTB)
#define PG8_SB(b, h) ((4 + (b) * 2 + (h)) * HTB)
#define PG8_STAGE(bufoff, gbase, voff) do { _Pragma("unroll") for (int _i = 0; _i < 2; ++_i) \
        __builtin_amdgcn_global_load_lds((const unsigned*)((const char*)(gbase) + (voff)[_i]), (PG8_LAS unsigned*)(lds + (bufoff) + ldsw + _i * 8192), 16, 0, 0); } while (0)
#define PG8_LDA(dst, b, h) do { _Pragma("unroll") for (int m = 0; m < 4; ++m) _Pragma("unroll") for (int k = 0; k < 2; ++k) dst[m][k] = *(const PG8_LAS bf16x8*)(lds + PG8_SA(b, h) + aoff + m * 2048 + k * 1024); } while (0)
#define PG8_LDB(dst, b, h) do { _Pragma("unroll") for (int n = 0; n < 2; ++n) _Pragma("unroll") for (int k = 0; k < 2; ++k) dst[n][k] = *(const PG8_LAS bf16x8*)(lds + PG8_SB(b, h) + boff + n * 2048 + k * 1024); } while (0)
#define PG8_MMA(ai, bj, At, Bt) do { __builtin_amdgcn_s_setprio(1); _Pragma("unroll") for (int m = 0; m < 4; ++m) _Pragma("unroll") for (int n = 0; n < 2; ++n) _Pragma("unroll") for (int k = 0; k < 2; ++k) \
        acc[ai][bj][m][n] = __builtin_amdgcn_mfma_f32_16x16x32_bf16(Bt[n][k], At[m][k], acc[ai][bj][m][n], 0, 0, 0); __builtin_amdgcn_s_setprio(0); } while (0)
#define PG8_WAIT_V(n) asm volatile("s_waitcnt vmcnt(" #n ")" ::: "memory")
#define PG8_WAIT_L(n) asm volatile("s_waitcnt lgkmcnt(" #n ")" ::: "memory")
#define PG8_BAR __builtin_amdgcn_s_barrier()
#define PG8_SCHED __builtin_amdgcn_sched_barrier(0)
    Unit cur, nxt; int ui = 0;
    if (!S.next(0, cur)) return;
    f32x4 acc[2][2][4][2];
#pragma unroll
    for (int a = 0; a < 2; ++a)
#pragma unroll
        for (int b = 0; b < 2; ++b)
#pragma unroll
            for (int m = 0; m < 4; ++m)
#pragma unroll
                for (int n = 0; n < 2; ++n) acc[a][b][m][n] = (f32x4){0.f, 0.f, 0.f, 0.f};
    bf16x8 At[4][2], B0[2][2], B1[2][2];
    const char* cA = (const char*)g.A + (size_t)cur.pm * tstep; const char* cB = (const char*)g.Bt + (size_t)cur.pn * tstep;
    S.a_ready(cur);
    if constexpr (SP2) {
        PG8_STAGE(PG8_SB(0, 0), cB, voffB); PG8_STAGE(PG8_SB(0, 1), cB + hstep, voffB); PG8_STAGE(PG8_SA(0, 0), cA, voffA); PG8_STAGE(PG8_SA(0, 1), cA + hstep, voffA);
        if (wr == 1) PG8_BAR;
        PG8_WAIT_V(2); PG8_BAR;
        PG8_STAGE(PG8_SB(1, 0), cB + kstep, voffB); PG8_STAGE(PG8_SA(1, 0), cA + kstep, voffA); PG8_STAGE(PG8_SB(1, 1), cB + hstep + kstep, voffB);
        PG8_WAIT_V(6); PG8_BAR;
    } else {
        PG8_STAGE(PG8_SB(0, 0), cB, voffB); PG8_STAGE(PG8_SA(0, 0), cA, voffA); PG8_STAGE(PG8_SB(0, 1), cB + hstep, voffB); PG8_STAGE(PG8_SA(0, 1), cA + hstep, voffA);
        if (wr == 1) PG8_BAR;
        PG8_WAIT_V(4); PG8_BAR;
        PG8_STAGE(PG8_SB(1, 0), cB + kstep, voffB); PG8_STAGE(PG8_SA(1, 0), cA + kstep, voffA); PG8_STAGE(PG8_SB(1, 1), cB + hstep + kstep, voffB);
        PG8_WAIT_V(6); PG8_BAR;
    }
    for (;;) {
        const bool has_next = S.next(ui + 1, nxt);
        const char* nA = has_next ? (const char*)g.A + (size_t)nxt.pm * tstep : cA; const char* nB = has_next ? (const char*)g.Bt + (size_t)nxt.pn * tstep : cB;
        for (int t = 0; t < nt; t += 2) {
            const bool last = (t == nt - 2);
            const char* a1 = cA + (size_t)(t + 1) * kstep;
            const char* a2 = last ? nA : cA + (size_t)(t + 2) * kstep; const char* b2 = last ? nB : cB + (size_t)(t + 2) * kstep;
            const char* a3 = a2 + kstep; const char* b3 = b2 + kstep;
            if (last && has_next) S.a_ready(nxt);
            if constexpr (SP2) {
            PG8_LDB(B0, 0, 0); PG8_LDB(B1, 0, 1); PG8_SCHED; PG8_LDA(At, 0, 0); PG8_STAGE(PG8_SA(1, 1), a1 + hstep, voffA);
            PG8_WAIT_V(8); PG8_WAIT_L(0); PG8_BAR; PG8_MMA(0, 0, At, B0); PG8_MMA(0, 1, At, B1); PG8_BAR; PG8_SCHED;
            PG8_LDA(At, 0, 1); PG8_STAGE(PG8_SB(0, 0), b2, voffB); PG8_STAGE(PG8_SB(0, 1), b2 + hstep, voffB); PG8_STAGE(PG8_SA(0, 0), a2, voffA);
            PG8_WAIT_V(8); PG8_WAIT_L(0); PG8_BAR; PG8_MMA(1, 0, At, B0); PG8_MMA(1, 1, At, B1); PG8_BAR; PG8_SCHED;
            PG8_LDB(B0, 1, 0); PG8_LDB(B1, 1, 1); PG8_SCHED; PG8_LDA(At, 1, 0); PG8_STAGE(PG8_SA(0, 1), a2 + hstep, voffA);
            PG8_WAIT_V(8); PG8_WAIT_L(0); PG8_BAR; PG8_MMA(0, 0, At, B0); PG8_MMA(0, 1, At, B1); PG8_BAR; PG8_SCHED;
            PG8_LDA(At, 1, 1); PG8_STAGE(PG8_SB(1, 0), b3, voffB); PG8_STAGE(PG8_SB(1, 1), b3 + hstep, voffB); PG8_STAGE(PG8_SA(1, 0), a3, voffA);
            PG8_WAIT_V(8); PG8_WAIT_L(0); PG8_BAR; PG8_MMA(1, 0, At, B0); PG8_MMA(1, 1, At, B1); PG8_BAR; PG8_SCHED;
            } else {
            PG8_LDB(B0, 0, 0); PG8_SCHED; PG8_LDA(At, 0, 0); PG8_STAGE(PG8_SA(1, 1), a1 + hstep, voffA);
            PG8_WAIT_L(8); PG8_BAR; PG8_WAIT_L(0); PG8_MMA(0, 0, At, B0); PG8_BAR; PG8_SCHED;
            PG8_LDB(B1, 0, 1); PG8_STAGE(PG8_SB(0, 0), b2, voffB);
            PG8_BAR; PG8_WAIT_L(0); PG8_MMA(0, 1, At, B1); PG8_BAR;
            PG8_LDA(At, 0, 1); PG8_STAGE(PG8_SA(0, 0), a2, voffA);
            PG8_BAR; PG8_WAIT_L(0); PG8_MMA(1, 0, At, B0); PG8_BAR; PG8_SCHED;
            PG8_STAGE(PG8_SB(0, 1), b2 + hstep, voffB);
            PG8_WAIT_V(6); PG8_BAR; PG8_MMA(1, 1, At, B1); PG8_BAR;
            PG8_LDB(B0, 1, 0); PG8_SCHED; PG8_LDA(At, 1, 0); PG8_STAGE(PG8_SA(0, 1), a2 + hstep, voffA);
            PG8_WAIT_L(8); PG8_BAR; PG8_WAIT_L(0); PG8_MMA(0, 0, At, B0); PG8_BAR; PG8_SCHED;
            PG8_LDB(B1, 1, 1); PG8_STAGE(PG8_SB(1, 0), b3, voffB);
            PG8_BAR; PG8_WAIT_L(0); PG8_MMA(0, 1, At, B1); PG8_BAR;
            PG8_LDA(At, 1, 1); PG8_STAGE(PG8_SA(1, 0), a3, voffA);
            PG8_BAR; PG8_WAIT_L(0); PG8_MMA(1, 0, At, B0); PG8_BAR; PG8_SCHED;
            PG8_STAGE(PG8_SB(1, 1), b3 + hstep, voffB);
            PG8_WAIT_V(6); PG8_BAR; PG8_MMA(1, 1, At, B1); PG8_BAR;
            }
        }
        if constexpr (ALIGN_EPI) { if (wr == 0) PG8_BAR; }
        if constexpr (!Epi::AFTER_DRAIN) { E(acc, cur, wr, wc, fr, fq); S.done(cur); }
        if (!has_next) break;
#pragma unroll
        for (int a = 0; a < 2; ++a)
#pragma unroll
            for (int b = 0; b < 2; ++b)
#pragma unroll
                for (int m = 0; m < 4; ++m)
#pragma unroll
                    for (int n = 0; n < 2; ++n) acc[a][b][m][n] = (f32x4){0.f, 0.f, 0.f, 0.f};
        cur = nxt; cA = nA; cB = nB; ++ui;
        if constexpr (ALIGN_EPI) { if (wr == 1) PG8_BAR; }
    }
    PG8_WAIT_V(0);
    if constexpr (!ALIGN_EPI) { if (wr == 0) PG8_BAR; }
    PG8_BAR;
    if constexpr (Epi::AFTER_DRAIN) { E.fused(acc, cur, wr, wc, fr, fq, lds, wid, lane); S.done(cur); }
#undef PG8_SA
#undef PG8_SB
#undef PG8_STAGE
#undef PG8_LDA
#undef PG8_LDB
#undef PG8_MMA
#undef PG8_WAIT_V
#undef PG8_WAIT_L
#undef PG8_BAR
#undef PG8_SCHED
}
}
namespace xb {
#define LAS __attribute__((address_space(3)))
#define XB_TMO      128
#define XB_XCNT(j)  (256  + 64 * (j))
#define XB_XSUB(j)  (1280 + 64 * (j))
#define XB_XGEN(j)  (2304 + 64 * (j))
#define XB_TOP      3328
#define XB_TOPGEN   3392
#define XCD_BAR_WORDS 3456
#define XB_SPIN_CAP (1u << 18)

__device__ __forceinline__ unsigned xb_ld(unsigned* p)              { return __hip_atomic_load(p, __ATOMIC_RELAXED, __HIP_MEMORY_SCOPE_AGENT); }
__device__ __forceinline__ unsigned xb_add(unsigned* p, unsigned v) { return __hip_atomic_fetch_add(p, v, __ATOMIC_RELAXED, __HIP_MEMORY_SCOPE_AGENT); }
__device__ __forceinline__ unsigned xb_xcc_id() { return (unsigned)__builtin_amdgcn_s_getreg((3 << 11) | 20) & 0xFu; }
#define XB_SPIN(cond, bar) do { unsigned _sp = 0; while (cond) { __builtin_amdgcn_s_sleep(1); \
    if ((++_sp & 255u) == 0u) { if (xb_ld(&(bar)[XB_TMO])) break; if (_sp > XB_SPIN_CAP) { atomicAdd(&(bar)[XB_TMO], 1u); break; } } } } while (0)

struct XcdBarrier {
    unsigned* bar; unsigned x;
    volatile LAS unsigned* st;
};

__device__ __forceinline__ XcdBarrier xcd_barrier_post(unsigned* bar, volatile LAS unsigned* st) {
    XcdBarrier b; b.bar = bar; b.x = xb_xcc_id(); b.st = st;
    if (threadIdx.x == 0) (void)xb_add(&bar[XB_XCNT(b.x)], 1u);
    return b;
}
__device__ __forceinline__ void xcd_barrier_complete(unsigned* bar, unsigned x, unsigned& nloc, unsigned& nx) {
    const unsigned G = gridDim.x * gridDim.y * gridDim.z;
    unsigned sum, cnt, mine, sp = 0u;
    for (;;) {
        sum = 0u; cnt = 0u; mine = 0u;
#pragma unroll
        for (unsigned j = 0; j < 16; ++j) { const unsigned c = xb_ld(&bar[XB_XCNT(j)]); sum += c; cnt += (c > 0u) ? 1u : 0u; mine = (j == x) ? c : mine; }
        if (sum == G) break;
        __builtin_amdgcn_s_sleep(1);
        if ((++sp & 255u) == 0u) { if (xb_ld(&bar[XB_TMO])) break; if (sp > XB_SPIN_CAP) { atomicAdd(&bar[XB_TMO], 1u); break; } }
    }
    nloc = mine > 0u ? mine : 1u; nx = cnt > 0u ? cnt : 1u;
}

__device__ __forceinline__ void xcd_barrier(const XcdBarrier& b) {
    asm volatile("s_waitcnt vmcnt(0)" ::: "memory");
    __syncthreads();
    if (threadIdx.x == 0) {
        unsigned* bar = b.bar;
        __builtin_amdgcn_s_waitcnt(0);
        unsigned nloc = b.st[0], nx = b.st[1];
        if (nloc == 0u) { xcd_barrier_complete(bar, b.x, nloc, nx); b.st[0] = nloc; b.st[1] = nx; }
        const unsigned old = xb_add(&bar[XB_XSUB(b.x)], 1u);
        const unsigned gen = old / nloc;
        if (old + 1u == (gen + 1u) * nloc) {
            __builtin_amdgcn_fence(__ATOMIC_RELEASE, "agent");
            asm volatile("s_waitcnt vmcnt(0)" ::: "memory");
            const unsigned og = xb_add(&bar[XB_TOP], 1u);
            const unsigned tg = og / nx;
            if (og + 1u == (tg + 1u) * nx) xb_add(&bar[XB_TOPGEN], 1u);
            else XB_SPIN(xb_ld(&bar[XB_TOPGEN]) == tg, bar);
            __builtin_amdgcn_fence(__ATOMIC_ACQUIRE, "agent");
            xb_add(&bar[XB_XGEN(b.x)], 1u);
            asm volatile("s_waitcnt vmcnt(0)" ::: "memory");
        } else {
            XB_SPIN(xb_ld(&bar[XB_XGEN(b.x)]) == gen, bar);
            __builtin_amdgcn_fence(__ATOMIC_ACQUIRE, "agent");
            asm volatile("s_waitcnt vmcnt(0)" ::: "memory");
        }
    }
    __syncthreads();
}

}
namespace mk {
#define LAS __attribute__((address_space(3)))
typedef unsigned short bf16_t;
typedef short bf16x8 __attribute__((ext_vector_type(8)));
typedef short s16x4 __attribute__((ext_vector_type(4)));
typedef float f32x4 __attribute__((ext_vector_type(4)));
typedef float f32x16 __attribute__((ext_vector_type(16)));
typedef unsigned u32x4 __attribute__((ext_vector_type(4)));
typedef unsigned u32x2 __attribute__((ext_vector_type(2)));
constexpr int NB = 8, S = 4096, D = 1024, M = NB * S, NH = 4, DFF = 2816, DIN = 2560, NWAVES = 8;
constexpr float EPS = 1e-6f, LOG2E = 1.4426950408889634f;
constexpr float QSCALE = 0.125f * LOG2E;
constexpr size_t MiB = 1u << 20;
constexpr size_t WS_WIN = 1 * MiB, WS_WOUT = 6 * MiB, WS_WGU = 8 * MiB, WS_WDN = 19 * MiB, WS_RSS1 = 25 * MiB, WS_RSS2 = 27 * MiB;
constexpr size_t WS_XN = 32 * MiB, WS_Q = 96 * MiB, WS_KT = 128 * MiB, WS_VT = 160 * MiB, WS_XR = 192 * MiB, WS_GR = 224 * MiB, WS_HF = 256 * MiB, WS_MIXED = 320 * MiB, WS_ACT = 96 * MiB, WS_END = 384 * MiB;
static_assert(WS_ACT + (size_t)M * DFF * 2 <= WS_MIXED, "act overlays Q..HF only");
constexpr int RING_BYTES = 131072, LDS_MISC = 131072, LDS_BYTES = 147456;

__device__ __forceinline__ unsigned cvt_pk_bf16(float lo, float hi) { return pg8::cvt_pk_bf16(lo, hi); }
__device__ __forceinline__ float bf2f(unsigned short b) { return __uint_as_float(((unsigned)b) << 16); }
__device__ __forceinline__ float wave_sum(float v) {
#pragma unroll
    for (int o = 1; o < 64; o <<= 1) v += __shfl_xor(v, o);
    return v;
}
__device__ __forceinline__ float fast_sigmoid(float x) { return __builtin_amdgcn_rcpf(1.0f + __builtin_amdgcn_exp2f(-LOG2E * x)); }

template <int MAP  >
__device__ __forceinline__ void p0_transpose_item(const float* W, int K, int N, bf16_t* WT, const float* gk, LAS float* scr, int item, int lane) {
    const int nblk = N / 32, kb = item / nblk, nb = item % nblk, k0 = 64 * kb, n0 = 32 * nb;
#pragma unroll
    for (int i = 0; i < 32; ++i) { const int kk = 2 * i + (lane >> 5); float v = W[(size_t)(k0 + kk) * N + n0 + (lane & 31)]; if (gk) v *= gk[k0 + kk]; scr[kk * 33 + (lane & 31)] = v; }
    asm volatile("s_waitcnt lgkmcnt(0)" ::: "memory");
    const int c = lane & 7;
#pragma unroll
    for (int j = 0; j < 4; ++j) { const int n = (lane >> 3) + 8 * j; const LAS float* s = scr + (8 * c) * 33 + n;
        u32x4 o; o.x = cvt_pk_bf16(s[0 * 33], s[1 * 33]); o.y = cvt_pk_bf16(s[2 * 33], s[3 * 33]); o.z = cvt_pk_bf16(s[4 * 33], s[5 * 33]); o.w = cvt_pk_bf16(s[6 * 33], s[7 * 33]);
        const int f = n0 + n; const int drow = (MAP == 0) ? f : (256 * (f >> 7) + (f & 127) + (MAP == 2 ? 128 : 0));
        *(u32x4*)(WT + (size_t)drow * K + k0 + 8 * c) = o; }
    asm volatile("s_waitcnt lgkmcnt(0)" ::: "memory");
}
template <int NR>
__device__ __forceinline__ void rms_rows_to_bf16(const float* xrow, const float* g, bf16_t* orow, int lane) {
    const f32x4* gr = (const f32x4*)g + lane;
    f32x4 v[NR][4]; float s[NR];
#pragma unroll
    for (int q = 0; q < NR; ++q) { const f32x4* xr = (const f32x4*)(xrow + (size_t)q * D) + lane;
#pragma unroll
        for (int j = 0; j < 4; ++j) v[q][j] = __builtin_nontemporal_load(xr + 64 * j); }
#pragma unroll
    for (int q = 0; q < NR; ++q) { float a = 0.f;
#pragma unroll
        for (int j = 0; j < 4; ++j) a += (v[q][j][0] * v[q][j][0] + v[q][j][1] * v[q][j][1]) + (v[q][j][2] * v[q][j][2] + v[q][j][3] * v[q][j][3]);
        s[q] = a; }
#pragma unroll
    for (int o = 1; o < 64; o <<= 1)
#pragma unroll
        for (int q = 0; q < NR; ++q) s[q] += __shfl_xor(s[q], o);
    f32x4 gg[4];
#pragma unroll
    for (int j = 0; j < 4; ++j) gg[j] = gr[64 * j];
#pragma unroll
    for (int q = 0; q < NR; ++q) { const float rstd = 1.0f / sqrtf(s[q] * (1.f / D) + EPS); u32x2* o8 = (u32x2*)(orow + (size_t)q * D) + lane;
#pragma unroll
        for (int j = 0; j < 4; ++j) { u32x2 w; w.x = cvt_pk_bf16(v[q][j][0] * rstd * gg[j][0], v[q][j][1] * rstd * gg[j][1]); w.y = cvt_pk_bf16(v[q][j][2] * rstd * gg[j][2], v[q][j][3] * rstd * gg[j][3]); o8[64 * j] = w; } }
}

namespace att {
constexpr int NT = S / 64, SLOT = 16384, LDS_K = 0, LDS_V = 3 * SLOT, LDS_OST = 4 * SLOT, LDS_X = 0;
constexpr int LDS_WSF = LDS_MISC, LDS_BIAS = LDS_MISC + 2048, LDS_TOT = LDS_MISC + 3072, LDS_CW = LDS_MISC + 5120;
constexpr int THR = 8;
typedef LAS const char* lds_cptr;
typedef short v4i16_t __attribute__((ext_vector_type(4)));
__device__ __forceinline__ int crow(int r, int hi) { return (r & 3) + 8 * (r >> 2) + 4 * hi; }
__device__ __forceinline__ void glds16(const void* gsrc, unsigned lds_dst) { unsigned keep;
    asm volatile("s_mov_b32 %0, m0\n\ts_mov_b32 m0, %2\n\ts_nop 0\n\tglobal_load_lds_dwordx4 %1, off\n\ts_mov_b32 m0, %0" : "=&s"(keep) : "v"(gsrc), "s"(lds_dst) : "memory"); }
__device__ __forceinline__ s16x4 vtr(lds_cptr p) { return __builtin_bit_cast(s16x4, __builtin_amdgcn_ds_read_tr16_b64_v4i16((LAS v4i16_t*)p)); }
#define ATT_MX3(a, b, c) __builtin_fmaxf(__builtin_fmaxf((a), (b)), (c))
__device__ __forceinline__ float rowmax(const f32x16& p0, const f32x16& p1) {
    float a = ATT_MX3(p0[0], p0[1], p1[0]), b = ATT_MX3(p0[2], p0[3], p1[1]); a = ATT_MX3(a, p1[2], p1[3]);
#pragma unroll
    for (int r = 4; r < 16; r += 4) { a = ATT_MX3(a, p0[r], p0[r + 1]); b = ATT_MX3(b, p0[r + 2], p0[r + 3]); a = ATT_MX3(a, p1[r], p1[r + 1]); b = ATT_MX3(b, p1[r + 2], p1[r + 3]); }
    float m = __builtin_fmaxf(a, b); auto rr = __builtin_amdgcn_permlane32_swap(__float_as_uint(m), __float_as_uint(m), false, false);
    return __builtin_fmaxf(__uint_as_float(rr[0]), __uint_as_float(rr[1]));
}
#define ATT_WAIT_BAR(N) asm volatile("s_waitcnt vmcnt(" #N ") lgkmcnt(0)\n\ts_barrier" ::: "memory")
#define ATT_MFMA(a, b, c) __builtin_amdgcn_mfma_f32_32x32x16_bf16(a, b, c, 0, 0, 0)

template <bool FIRST>
__device__ __forceinline__ void tile_h1(int t, lds_cptr kp, const bf16x8 (&qr)[4], f32x16 (&o)[4], u32x4 (&pw)[4], float& mhat, float& l_reg,
                                        LAS float* wsf, const LAS float* btab, int qrow, int qw0, float c_left, float c_right, int r32, int hi) {
    const int relmin = 64 * t - qw0 - 31, relmax = 64 * t + 63 - qw0;
    const bool band = !(relmax <= -91 || relmin >= 91);
    const float cb = band ? 0.f : (relmin >= 91 ? c_right : c_left);
    f32x16 p0, p1;
    const f32x16 z16 = (f32x16){0.f, 0.f, 0.f, 0.f, 0.f, 0.f, 0.f, 0.f, 0.f, 0.f, 0.f, 0.f, 0.f, 0.f, 0.f, 0.f};
#pragma unroll
    for (int d0 = 0; d0 < 4; ++d0) {
        const bf16x8 k0 = *(const LAS bf16x8*)(kp + d0 * 2048), k1 = *(const LAS bf16x8*)(kp + d0 * 2048 + 512);
        if (d0 == 0) { p0 = ATT_MFMA(k0, qr[0], z16); p1 = ATT_MFMA(k1, qr[0], z16); }
        else { p0 = ATT_MFMA(k0, qr[d0], p0); p1 = ATT_MFMA(k1, qr[d0], p1); }
    }
    if (band) {
        const int relb = 64 * t + 4 * hi - qrow + 128;
#pragma unroll
        for (int r = 0; r < 16; ++r) { const int i0 = relb + (r & 3) + 8 * (r >> 2); const int a0 = i0 < 0 ? 0 : (i0 > 255 ? 255 : i0); const int i1 = i0 + 32; const int a1 = i1 < 0 ? 0 : (i1 > 255 ? 255 : i1);
            p0[r] += btab[a0]; p1[r] += btab[a1]; }
    }
    const float rm = rowmax(p0, p1) + cb;
    if (FIRST) { mhat = rm; }
    else if (__builtin_expect(__any(rm - mhat > (float)THR), 0)) {
        const float dl = __builtin_fmaxf(rm - mhat, 0.f); mhat += dl;
        const float f = __builtin_amdgcn_exp2f(-dl); l_reg *= f;
        if (hi == 0) wsf[r32] = f;
        asm volatile("s_waitcnt lgkmcnt(0)" ::: "memory");
        float fr[16];
#pragma unroll
        for (int r = 0; r < 16; ++r) fr[r] = wsf[crow(r, hi)];
#pragma unroll
        for (int db = 0; db < 4; ++db)
#pragma unroll
            for (int r = 0; r < 16; ++r) o[db][r] *= fr[r];
        asm volatile("s_waitcnt lgkmcnt(0)" ::: "memory");
    }
    const float off = cb - mhat;
    float sacc = 0.f;
#pragma unroll
    for (int r = 0; r < 16; ++r) { p0[r] = __builtin_amdgcn_exp2f(p0[r] + off); p1[r] = __builtin_amdgcn_exp2f(p1[r] + off); sacc += p0[r] + p1[r]; }
    l_reg += sacc;
#pragma unroll
    for (int ks = 0; ks < 4; ++ks) { const f32x16& P = (ks < 2) ? p0 : p1; const int b = 8 * (ks & 1);
        pw[ks] = (u32x4){cvt_pk_bf16(P[b], P[b + 1]), cvt_pk_bf16(P[b + 2], P[b + 3]), cvt_pk_bf16(P[b + 4], P[b + 5]), cvt_pk_bf16(P[b + 6], P[b + 7])}; }
}
__device__ __forceinline__ void tile_h2(lds_cptr vp, f32x16 (&o)[4], const u32x4 (&pw)[4]) {
#pragma unroll
    for (int ks = 0; ks < 4; ++ks)
#pragma unroll
        for (int db = 0; db < 4; ++db) {
            const s16x4 lo = vtr(vp + db * 4096 + ks * 1024), h4 = vtr(vp + db * 4096 + ks * 1024 + 512);
            const bf16x8 vf = (bf16x8){lo[0], lo[1], lo[2], lo[3], h4[0], h4[1], h4[2], h4[3]};
            o[db] = ATT_MFMA(__builtin_bit_cast(bf16x8, pw[ks]), vf, o[db]);
        }
}

struct VFrag { s16x4 lo, hi; };
template <int I> __device__ __forceinline__ VFrag vload(lds_cptr vp) {
    constexpr int off_ = (I & 3) * 4096 + (I >> 2) * 1024; VFrag f; f.lo = vtr(vp + off_); f.hi = vtr(vp + off_ + 512); return f;
}
__device__ __forceinline__ void attn_unit(int b, int h, int qb, const bf16_t* Q, const bf16_t* KT, const bf16_t* VT, bf16_t* MIXED, LAS unsigned char* lds, float lam, const float* subln_g, const float* rel_bias) {
    const int tid = threadIdx.x, lane = tid & 63, r32 = lane & 31, hi = lane >> 5; const int wid = __builtin_amdgcn_readfirstlane(tid >> 6);
    const int wq = wid & 3, mp = wid >> 2;
    const size_t rowbase = (size_t)b * S; const int q0 = qb * 128, qw0 = q0 + 32 * wq, qrow = qw0 + r32;
    LAS float* btab = (LAS float*)(lds + LDS_BIAS); LAS float* wsf = (LAS float*)(lds + LDS_WSF) + wid * 64;
    if (tid < 256) { const int rel = tid - 128; const int n = rel < 0 ? -rel : rel; int bk; if (n < 8) bk = n; else { bk = 2 + (31 - __clz(n * n)); if (bk > 15) bk = 15; } if (rel > 0) bk += 16;
        btab[tid] = rel_bias[bk * NH + h] * LOG2E; }
    const float c_left = rel_bias[15 * NH + h] * LOG2E, c_right = rel_bias[31 * NH + h] * LOG2E;
    const bf16_t* Qw = Q + (rowbase + qw0) * 512 + h * 128 + mp * 64;
    bf16x8 qr[4];
#pragma unroll
    for (int d0 = 0; d0 < 4; ++d0) qr[d0] = *(const bf16x8*)(Qw + (size_t)r32 * 512 + d0 * 16 + hi * 8);
    const char* k1src = (const char*)KT + ((size_t)((b * 4 + h) * 2) * 64) * 8192 + wid * 1024 + lane * 16;
    const char* k2src = k1src + (size_t)64 * 8192;
    const char* vsrc = (const char*)VT + ((size_t)(b * 4 + h) * 64) * 16384 + wid * 1024 + lane * 16;
    const unsigned lds0 = (unsigned)(uintptr_t)(unsigned char*)lds;
    const unsigned kdst = lds0 + LDS_K + wid * 1024, vdst = lds0 + LDS_V + wid * 1024;
    const lds_cptr kp0 = (lds_cptr)lds + LDS_K + mp * 8192 + hi * 1024 + r32 * 16;
    const lds_cptr vp0 = (lds_cptr)lds + LDS_V + ((lane >> 4) & 1) * 32 + (lane & 3) * 8 + (4 * hi + ((lane & 15) >> 2)) * 64;
#define ATT_DMA_TILE(t, ks_, vs_) do { glds16(k1src + (size_t)(t) * 8192, (unsigned)__builtin_amdgcn_readfirstlane(kdst + (ks_))); glds16(k2src + (size_t)(t) * 8192, (unsigned)__builtin_amdgcn_readfirstlane(kdst + (ks_) + 8192)); \
        glds16(vsrc + (size_t)(t) * 16384, (unsigned)__builtin_amdgcn_readfirstlane(vdst + (vs_))); glds16(vsrc + (size_t)(t) * 16384 + 8192, (unsigned)__builtin_amdgcn_readfirstlane(vdst + (vs_) + 8192)); } while (0)
    ATT_DMA_TILE(0, 0, 0); ATT_DMA_TILE(1, SLOT, SLOT);
    float mhat = 0.f, l_reg = 0.f; f32x16 o[4]; u32x4 pw[4];
#pragma unroll
    for (int db = 0; db < 4; ++db)
#pragma unroll
        for (int r = 0; r < 16; ++r) o[db][r] = 0.f;
    int ksl = 0, ksl2 = 2 * SLOT, vsl = 0, vsl2 = 2 * SLOT, vprev = 0;
#define ATT_ROT() do { ksl = (ksl == 2 * SLOT) ? 0 : ksl + SLOT; ksl2 = (ksl2 == 2 * SLOT) ? 0 : ksl2 + SLOT; vprev = vsl; vsl = (vsl + SLOT) & (4 * SLOT - 1); vsl2 = (vsl2 + SLOT) & (4 * SLOT - 1); } while (0)
#define ATT_SB() __builtin_amdgcn_sched_barrier(0)
#define ATT_PIN(x) asm volatile("" : "+v"(x))
#define ATT_F(T0, T1, e) (((e) < 16) ? T0[(e) & 15] : T1[(e) & 15])
#define ATT_KRD(f) (*(const LAS bf16x8*)(kp_ + ((f) >> 1) * 2048 + ((f) & 1) * 512))
    const f32x16 z16 = (f32x16){0.f, 0.f, 0.f, 0.f, 0.f, 0.f, 0.f, 0.f, 0.f, 0.f, 0.f, 0.f, 0.f, 0.f, 0.f, 0.f};
#define ATT_GA(C0, C1, P0, P1, f) do { \
        if (((f) & 1) == 0) C0 = ATT_MFMA(kq[(f) % 3], qr[(f) >> 1], ((f) < 2) ? z16 : C0); else C1 = ATT_MFMA(kq[(f) % 3], qr[(f) >> 1], ((f) < 2) ? z16 : C1); \
        if ((f) + 3 < 8) kq[(f) % 3] = ATT_KRD((f) + 3); \
        sacc += ATT_F(P0, P1, 4 * (f)); sacc += ATT_F(P0, P1, 4 * (f) + 1); sacc += ATT_F(P0, P1, 4 * (f) + 2); sacc += ATT_F(P0, P1, 4 * (f) + 3); ATT_PIN(sacc); \
        pw[(f) >> 1][2 * ((f) & 1)] = cvt_pk_bf16(ATT_F(P0, P1, 4 * (f)), ATT_F(P0, P1, 4 * (f) + 1)); pw[(f) >> 1][2 * ((f) & 1) + 1] = cvt_pk_bf16(ATT_F(P0, P1, 4 * (f) + 2), ATT_F(P0, P1, 4 * (f) + 3)); ATT_PIN(pw[(f) >> 1]); \
        ATT_SB(); } while (0)
#define ATT_VRD(I) vload<(I) & 15>(vp_)
#define ATT_GBF(I, FILL) do { \
        { const VFrag& vv = vq[(I) % 3]; const bf16x8 vf = (bf16x8){vv.lo[0], vv.lo[1], vv.lo[2], vv.lo[3], vv.hi[0], vv.hi[1], vv.hi[2], vv.hi[3]}; \
          o[(I) & 3] = ATT_MFMA(__builtin_bit_cast(bf16x8, pw[(I) >> 2]), vf, o[(I) & 3]); } \
        if ((I) + 3 < 16) vq[(I) % 3] = ATT_VRD((I) + 3); \
        FILL; ATT_SB(); } while (0)
#define ATT_EX(C0, C1, e) do { if ((e) < 16) { C0[(e) & 15] = __builtin_amdgcn_exp2f(C0[(e) & 15] + off); } else { C1[(e) & 15] = __builtin_amdgcn_exp2f(C1[(e) & 15] + off); } } while (0)
#define ATT_EX3(C0, C1, e) do { ATT_EX(C0, C1, e); ATT_EX(C0, C1, (e) + 1); ATT_EX(C0, C1, (e) + 2); ATT_PIN(C0); ATT_PIN(C1); } while (0)
#define ATT_EX2(C0, C1, e) do { ATT_EX(C0, C1, e); ATT_EX(C0, C1, (e) + 1); ATT_PIN(C0); ATT_PIN(C1); } while (0)
#define ATT_MX3(a, b, c) __builtin_fmaxf(__builtin_fmaxf((a), (b)), (c))
#define ATT_BIAS(C0, C1, t) \
        const int relmin_ = 64 * (t) - qw0 - 31, relmax_ = 64 * (t) + 63 - qw0; const bool band_ = !(relmax_ <= -91 || relmin_ >= 91); const float cb_ = band_ ? 0.f : (relmin_ >= 91 ? c_right : c_left); \
        if (band_) { const int relb_ = 64 * (t) + 4 * hi - qrow + 128; \
            _Pragma("unroll") for (int r = 0; r < 16; ++r) { const int i0 = relb_ + (r & 3) + 8 * (r >> 2); const int a0 = i0 < 0 ? 0 : (i0 > 255 ? 255 : i0); const int i1 = i0 + 32; const int a1 = i1 < 0 ? 0 : (i1 > 255 ? 255 : i1); \
                C0[r] += btab[a0]; C1[r] += btab[a1]; } }
#define ATT_MAXP(C0, C1, g) do { if ((g) == 0) { ma_ = ATT_MX3(C0[0], C0[1], C1[0]); mb_ = ATT_MX3(C0[2], C0[3], C1[1]); ma_ = ATT_MX3(ma_, C1[2], C1[3]); } \
        else { ma_ = ATT_MX3(ma_, C0[4 * (g)], C0[4 * (g) + 1]); mb_ = ATT_MX3(mb_, C0[4 * (g) + 2], C0[4 * (g) + 3]); ma_ = ATT_MX3(ma_, C1[4 * (g)], C1[4 * (g) + 1]); mb_ = ATT_MX3(mb_, C1[4 * (g) + 2], C1[4 * (g) + 3]); } \
        ATT_PIN(ma_); ATT_PIN(mb_); } while (0)
#define ATT_DECIDE2(FIRST_) do { float rm_ = __builtin_fmaxf(ma_, mb_); { auto rr = __builtin_amdgcn_permlane32_swap(__float_as_uint(rm_), __float_as_uint(rm_), false, false); rm_ = __builtin_fmaxf(__uint_as_float(rr[0]), __uint_as_float(rr[1])); } \
        rm_ += cb_; resc = false; \
        if (FIRST_) { mhat = rm_; } \
        else if (__builtin_expect(__any(rm_ - mhat > (float)THR), 0)) { const float dl_ = __builtin_fmaxf(rm_ - mhat, 0.f); mhat += dl_; const float f_ = __builtin_amdgcn_exp2f(-dl_); l_reg *= f_; if (hi == 0) wsf[r32] = f_; resc = true; } \
        off = cb_ - mhat; ATT_SB(); } while (0)
#define ATT_RESC() do { if (resc) { asm volatile("s_waitcnt lgkmcnt(0)" ::: "memory"); float fr_[16]; \
        _Pragma("unroll") for (int r = 0; r < 16; ++r) fr_[r] = wsf[crow(r, hi)]; \
        _Pragma("unroll") for (int db = 0; db < 4; ++db) _Pragma("unroll") for (int r = 0; r < 16; ++r) o[db][r] *= fr_[r]; \
        asm volatile("s_waitcnt lgkmcnt(0)" ::: "memory"); } } while (0)
#define ATT_STEP(C0, C1, P0, P1, t) do { \
        const lds_cptr kp_ = kp0 + ksl; const lds_cptr vp_ = vp0 + vprev; float sacc = 0.f, ma_, mb_; \
        kq[0] = ATT_KRD(0); kq[1] = ATT_KRD(1); kq[2] = ATT_KRD(2); ATT_SB(); \
        ATT_GA(C0, C1, P0, P1, 0); ATT_GA(C0, C1, P0, P1, 1); ATT_GA(C0, C1, P0, P1, 2); ATT_GA(C0, C1, P0, P1, 3); \
        vq[0] = ATT_VRD(0); vq[1] = ATT_VRD(1); vq[2] = ATT_VRD(2); ATT_SB(); \
        ATT_GA(C0, C1, P0, P1, 4); ATT_GA(C0, C1, P0, P1, 5); ATT_GA(C0, C1, P0, P1, 6); ATT_GA(C0, C1, P0, P1, 7); \
        l_reg += sacc; \
        ATT_BIAS(C0, C1, t) ATT_SB(); \
        ATT_GBF(0, ATT_MAXP(C0, C1, 0)); ATT_GBF(1, ATT_MAXP(C0, C1, 1)); ATT_GBF(2, ATT_MAXP(C0, C1, 2)); ATT_GBF(3, ATT_MAXP(C0, C1, 3)); \
        ATT_DECIDE2(false); \
        ATT_GBF(4, ATT_EX3(C0, C1, 0)); ATT_GBF(5, ATT_EX3(C0, C1, 3)); ATT_GBF(6, ATT_EX3(C0, C1, 6)); ATT_GBF(7, ATT_EX3(C0, C1, 9)); \
        ATT_GBF(8, ATT_EX3(C0, C1, 12)); ATT_GBF(9, ATT_EX3(C0, C1, 15)); ATT_GBF(10, ATT_EX3(C0, C1, 18)); ATT_GBF(11, ATT_EX3(C0, C1, 21)); \
        ATT_GBF(12, ATT_EX2(C0, C1, 24)); ATT_GBF(13, ATT_EX2(C0, C1, 26)); ATT_GBF(14, ATT_EX2(C0, C1, 28)); ATT_GBF(15, ATT_EX2(C0, C1, 30)); \
        ATT_RESC(); ATT_ROT(); } while (0)
    f32x16 sa0, sa1, sb0, sb1; bf16x8 kq[3]; VFrag vq[3]; float off = 0.f; bool resc = false;
    ATT_WAIT_BAR(4); ATT_DMA_TILE(2, ksl2, vsl2);
    { const lds_cptr kp_ = kp0 + ksl;
#pragma unroll
      for (int d0 = 0; d0 < 4; ++d0) { const bf16x8 k0 = ATT_KRD(2 * d0), k1 = ATT_KRD(2 * d0 + 1);
          if (d0 == 0) { sa0 = ATT_MFMA(k0, qr[0], z16); sa1 = ATT_MFMA(k1, qr[0], z16); } else { sa0 = ATT_MFMA(k0, qr[d0], sa0); sa1 = ATT_MFMA(k1, qr[d0], sa1); } }
      float ma_, mb_; ATT_BIAS(sa0, sa1, 0) ATT_MAXP(sa0, sa1, 0); ATT_MAXP(sa0, sa1, 1); ATT_MAXP(sa0, sa1, 2); ATT_MAXP(sa0, sa1, 3); ATT_DECIDE2(true);
#pragma unroll
      for (int r = 0; r < 16; ++r) { sa0[r] = __builtin_amdgcn_exp2f(sa0[r] + off); sa1[r] = __builtin_amdgcn_exp2f(sa1[r] + off); }
      ATT_ROT(); }
    for (int t = 1; t < NT - 3; t += 2) {
        ATT_WAIT_BAR(4); ATT_DMA_TILE(t + 2, ksl2, vsl2); ATT_STEP(sb0, sb1, sa0, sa1, t);
        ATT_WAIT_BAR(4); ATT_DMA_TILE(t + 3, ksl2, vsl2); ATT_STEP(sa0, sa1, sb0, sb1, t + 1);
    }
    ATT_WAIT_BAR(4); ATT_DMA_TILE(NT - 1, ksl2, vsl2); ATT_STEP(sb0, sb1, sa0, sa1, NT - 3);
    ATT_WAIT_BAR(4); ATT_STEP(sa0, sa1, sb0, sb1, NT - 2);
    ATT_WAIT_BAR(0); ATT_STEP(sb0, sb1, sa0, sa1, NT - 1);
    { float sacc = 0.f;
#pragma unroll
      for (int r = 0; r < 16; ++r) sacc += sb0[r] + sb1[r];
      l_reg += sacc;
#pragma unroll
      for (int g = 0; g < 16; ++g) pw[g >> 2][g & 3] = cvt_pk_bf16(ATT_F(sb0, sb1, 2 * g), ATT_F(sb0, sb1, 2 * g + 1));
      const lds_cptr vp_ = vp0 + vprev;
#pragma unroll
      for (int ks = 0; ks < 4; ++ks)
#pragma unroll
          for (int db = 0; db < 4; ++db) { const s16x4 lo = vtr(vp_ + db * 4096 + ks * 1024), h4 = vtr(vp_ + db * 4096 + ks * 1024 + 512);
              const bf16x8 vf = (bf16x8){lo[0], lo[1], lo[2], lo[3], h4[0], h4[1], h4[2], h4[3]}; o[db] = ATT_MFMA(__builtin_bit_cast(bf16x8, pw[ks]), vf, o[db]); } }
#undef ATT_STEP
#undef ATT_RESC
#undef ATT_DECIDE2
#undef ATT_MAXP
#undef ATT_BIAS
#undef ATT_EX2
#undef ATT_EX3
#undef ATT_EX
#undef ATT_GBF
#undef ATT_GA
#undef ATT_VRD
#undef ATT_KRD
#undef ATT_F
#undef ATT_PIN
#undef ATT_SB
    { auto rr = __builtin_amdgcn_permlane32_swap(__float_as_uint(l_reg), __float_as_uint(l_reg), false, false); l_reg = __uint_as_float(rr[0]) + __uint_as_float(rr[1]); }
    const float scale_q = (mp == 0 ? 1.0f : lam) * __builtin_amdgcn_rcpf(l_reg);
    if (hi == 0) wsf[r32] = scale_q;
    asm volatile("s_waitcnt lgkmcnt(0)" ::: "memory");
    float sc[16];
#pragma unroll
    for (int r = 0; r < 16; ++r) sc[r] = wsf[crow(r, hi)];
    asm volatile("s_waitcnt lgkmcnt(0)\n\ts_barrier" ::: "memory");
    LAS float* X = (LAS float*)(lds + LDS_X) + wq * 4096 + lane;
    if (mp == 1) {
#pragma unroll
        for (int db = 0; db < 4; ++db)
#pragma unroll
            for (int r = 0; r < 16; ++r) X[(db * 16 + r) * 64] = o[db][r] * sc[r];
    }
    asm volatile("s_waitcnt lgkmcnt(0)\n\ts_barrier" ::: "memory");
    if (mp == 0) {
        float ss[16];
#pragma unroll
        for (int r = 0; r < 16; ++r) ss[r] = 0.f;
#pragma unroll
        for (int db = 0; db < 4; ++db)
#pragma unroll
            for (int r = 0; r < 16; ++r) { const float d = o[db][r] * sc[r] - X[(db * 16 + r) * 64]; o[db][r] = d; ss[r] += d * d; }
#pragma unroll
        for (int r = 0; r < 16; ++r) {
#pragma unroll
            for (int x = 1; x < 32; x <<= 1) ss[r] += __shfl_xor(ss[r], x);
            ss[r] = __builtin_amdgcn_rsqf(ss[r] * (1.0f / 128.0f) + EPS) * 0.8f;
        }
        LAS bf16_t* stg = (LAS bf16_t*)(lds + LDS_OST) + wq * 4096;
#pragma unroll
        for (int db = 0; db < 4; ++db) { const float g = subln_g[db * 32 + r32];
#pragma unroll
            for (int r = 0; r < 16; ++r) { const unsigned w = cvt_pk_bf16(o[db][r] * ss[r] * g, 0.f); stg[crow(r, hi) * 128 + db * 32 + r32] = (bf16_t)(w & 0xffffu); } }
        asm volatile("s_waitcnt lgkmcnt(0)" ::: "memory");
        bf16_t* Ow = MIXED + (rowbase + qw0) * 1024 + h * 128;
#pragma unroll
        for (int i = 0; i < 8; ++i) { const int row = i * 4 + (lane >> 4), ch = lane & 15; const u32x4 v = *(const LAS u32x4*)(stg + row * 128 + ch * 8); *(u32x4*)(Ow + (size_t)row * 1024 + ch * 8) = v; }
    }
    asm volatile("s_waitcnt vmcnt(0) lgkmcnt(0)\n\ts_barrier" ::: "memory");
#undef ATT_DMA_TILE
#undef ATT_ROT
}
}

namespace lru {
template <int N> __device__ __forceinline__ float dpp_shr(float v, float ident) {
    return __int_as_float(__builtin_amdgcn_update_dpp(__float_as_int(ident), __float_as_int(v), 0x110 + N, 0xF, 0xF, false));
}
#define LRU_MFMA16(a, b, c) __builtin_amdgcn_mfma_f32_16x16x32_bf16(a, b, c, 0, 0, 0)
__device__ __forceinline__ void lru_rows(bf16x8 (&rowv)[2][7], __amdgpu_buffer_rsrc_t xsrd, int dir, int Pb, int ch0) {
#pragma unroll
    for (int k = 0; k < 7; ++k) {
        const int tt = dir ? (S - Pb - k) : (Pb - 2 + k);
#pragma unroll
        for (int ks = 0; ks < 2; ++ks) rowv[ks][k] = __builtin_bit_cast(bf16x8, __builtin_amdgcn_raw_buffer_load_b128(xsrd, (tt * 512 + ch0 + 32 * ks) * 2, 0, 0));
    }
}
__device__ __forceinline__ void lru_item(int b, int cg, const bf16_t* XR, const bf16_t* GR, float* HF, bf16_t* MIXED, LAS unsigned char* lds,
                                         const float* conv_w, const float* conv_b, const float* w_rg, const float* b_rg, const float* w_ig, const float* b_ig, const float* lru_lambda) {
    const int tid = threadIdx.x, lane = tid & 63, p = lane & 15, g = lane >> 4; const int wid = __builtin_amdgcn_readfirstlane(tid >> 6);
    const int n = cg >> 2, e16 = cg & 3, c0 = n * 64 + e16 * 16;
    const size_t rowbase = (size_t)b * S;
    const __amdgpu_buffer_rsrc_t XRb = __builtin_amdgcn_make_buffer_rsrc((void*)(XR + rowbase * 512), (short)0, S * 512 * 2, 0x00020000); const int ch0 = n * 64 + 8 * g;
    LAS float* tot = (LAS float*)(lds + att::LDS_TOT);
    bf16x8 idf;
#pragma unroll
    for (int j = 0; j < 8; ++j) idf[j] = ((8 * g + j) == (16 * (e16 & 1) + p)) ? (short)0x3f80 : (short)0;
    int par = 0;
    LAS float* cwl = (LAS float*)(lds + att::LDS_CW);
    if (tid < 320) { const int j = tid >> 6, c = tid & 63; cwl[tid] = (j < 4) ? conv_w[j * 512 + n * 64 + c] : conv_b[n * 64 + c]; }
    __syncthreads();
    for (int dir = 0; dir < 2; ++dir) {
        bf16x8 wrf[2], wif[2];
#pragma unroll
        for (int ks = 0; ks < 2; ++ks) {
            unsigned wr_[4], wi_[4];
#pragma unroll
            for (int j2 = 0; j2 < 4; ++j2) { const int d = 32 * ks + 8 * g + 2 * j2; const size_t i0 = ((size_t)((dir * 8 + n) * 64 + d)) * 64 + e16 * 16 + p;
                wr_[j2] = cvt_pk_bf16(w_rg[i0], w_rg[i0 + 64]); wi_[j2] = cvt_pk_bf16(w_ig[i0], w_ig[i0 + 64]); }
            wrf[ks] = __builtin_bit_cast(bf16x8, (u32x4){wr_[0], wr_[1], wr_[2], wr_[3]}); wif[ks] = __builtin_bit_cast(bf16x8, (u32x4){wi_[0], wi_[1], wi_[2], wi_[3]});
        }
        float br[4], bi[4], sp8[4], carry[4];
#pragma unroll
        for (int r = 0; r < 4; ++r) { const int c = dir * 512 + c0 + 4 * g + r; br[r] = b_rg[c] * -LOG2E; bi[r] = b_ig[c] * -LOG2E; const float lm = lru_lambda[c]; sp8[r] = 8.0f * LOG2E * log1pf(expf(-lm)); carry[r] = 0.f; }
        LAS u32x4* lst = (LAS u32x4*)lds + tid;
        lst[0 * 512] = __builtin_bit_cast(u32x4, wrf[0]); lst[1 * 512] = __builtin_bit_cast(u32x4, wrf[1]); lst[2 * 512] = __builtin_bit_cast(u32x4, wif[0]); lst[3 * 512] = __builtin_bit_cast(u32x4, wif[1]);
        lst[4 * 512] = __builtin_bit_cast(u32x4, (f32x4){br[0], br[1], br[2], br[3]}); lst[5 * 512] = __builtin_bit_cast(u32x4, (f32x4){bi[0], bi[1], bi[2], bi[3]}); lst[6 * 512] = __builtin_bit_cast(u32x4, (f32x4){sp8[0], sp8[1], sp8[2], sp8[3]}); lst[7 * 512] = __builtin_bit_cast(u32x4, idf);
        for (int sc = 0; sc < 8; ++sc) {
            const int P0 = sc * 512 + wid * 64, Pb = P0 + 4 * p;
            f32x4 ar[4], ai[4], ax[4];
            {
                bf16x8 rowv[2][7];
                lru_rows(rowv, XRb, dir, Pb, ch0);
                int zoff = 0; asm volatile("" : "+v"(zoff));
                const LAS float* cwi = cwl + zoff;
                const LAS u32x4* lsi = (const LAS u32x4*)lds + tid + zoff;
                const bf16x8 wrf0 = __builtin_bit_cast(bf16x8, lsi[0 * 512]), wrf1 = __builtin_bit_cast(bf16x8, lsi[1 * 512]), wif0 = __builtin_bit_cast(bf16x8, lsi[2 * 512]), wif1 = __builtin_bit_cast(bf16x8, lsi[3 * 512]), idf_ = __builtin_bit_cast(bf16x8, lsi[7 * 512]);
                u32x4 xfu[4][2];
#pragma unroll
                for (int ks = 0; ks < 2; ++ks) {
#pragma unroll
                    for (int eh = 0; eh < 2; ++eh) {
                        const int cl4 = 32 * ks + 8 * g + 4 * eh;
                        f32x4 wj[4];
#pragma unroll
                        for (int j = 0; j < 4; ++j) wj[j] = *(const LAS f32x4*)(cwi + (dir ? 3 - j : j) * 64 + cl4);
                        const f32x4 bb = *(const LAS f32x4*)(cwi + 256 + cl4);
                        f32x4 xr[7];
#pragma unroll
                        for (int k = 0; k < 7; ++k) { const u32x4 rw = __builtin_bit_cast(u32x4, rowv[ks][k]); const unsigned d0 = rw[2 * eh], d1 = rw[2 * eh + 1];
                            xr[k] = (f32x4){__uint_as_float(d0 << 16), __uint_as_float(d0 & 0xffff0000u), __uint_as_float(d1 << 16), __uint_as_float(d1 & 0xffff0000u)}; }
#pragma unroll
                        for (int i = 0; i < 4; ++i) {
                            f32x4 a4 = bb;
#pragma unroll
                            for (int j = 0; j < 4; ++j) a4 += wj[j] * xr[i + j];
                            xfu[i][ks][2 * eh] = cvt_pk_bf16(a4[0], a4[1]); xfu[i][ks][2 * eh + 1] = cvt_pk_bf16(a4[2], a4[3]);
                        }
                        __builtin_amdgcn_sched_barrier(0);
                    }
                }
                bf16x8 xf[4][2];
#pragma unroll
                for (int i = 0; i < 4; ++i) { xf[i][0] = __builtin_bit_cast(bf16x8, xfu[i][0]); xf[i][1] = __builtin_bit_cast(bf16x8, xfu[i][1]); }
                const f32x4 z = (f32x4){0.f, 0.f, 0.f, 0.f};
#pragma unroll
                for (int i = 0; i < 4; ++i) {
                    ar[i] = LRU_MFMA16(wrf0, xf[i][0], z); ar[i] = LRU_MFMA16(wrf1, xf[i][1], ar[i]);
                    ai[i] = LRU_MFMA16(wif0, xf[i][0], z); ai[i] = LRU_MFMA16(wif1, xf[i][1], ai[i]);
                    ax[i] = LRU_MFMA16(idf_, (e16 & 2) ? xf[i][1] : xf[i][0], z);
                }
            }
            float hh[4][4], cpp[4][4], Al[4], Hl[4];
            int zoff2 = 0; asm volatile("" : "+v"(zoff2));
            const LAS f32x4* lsg = (const LAS f32x4*)lds + tid + zoff2;
            const f32x4 brv = lsg[4 * 512], biv = lsg[5 * 512], spv = lsg[6 * 512];
#pragma unroll
            for (int r = 0; r < 4; ++r) {
                float h = 0.f, cp = 1.f;
#pragma unroll
                for (int i = 0; i < 4; ++i) {
                    const float rg = __builtin_amdgcn_rcpf(1.0f + __builtin_amdgcn_exp2f(ar[i][r] * -LOG2E + brv[r])), ig = __builtin_amdgcn_rcpf(1.0f + __builtin_amdgcn_exp2f(ai[i][r] * -LOG2E + biv[r]));
                    const float a_ = __builtin_amdgcn_exp2f(-rg * spv[r]);
                    const float om = __builtin_fmaf(-a_, a_, 1.0f);
                    const float u_ = __builtin_amdgcn_sqrtf(om) * (ig * ax[i][r]);
                    h = a_ * h + u_; cp = a_ * cp; hh[i][r] = h; cpp[i][r] = cp;
                }
                Al[r] = cp; Hl[r] = h;
            }
#define LRU_KS(NN) do { _Pragma("unroll") for (int r = 0; r < 4; ++r) { const float Ap = dpp_shr<NN>(Al[r], 1.0f), Hp = dpp_shr<NN>(Hl[r], 0.0f); Hl[r] = Al[r] * Hp + Hl[r]; Al[r] = Al[r] * Ap; } } while (0)
            LRU_KS(1); LRU_KS(2); LRU_KS(4); LRU_KS(8);
#undef LRU_KS
            float Aex[4], Hex[4];
#pragma unroll
            for (int r = 0; r < 4; ++r) { Aex[r] = dpp_shr<1>(Al[r], 1.0f); Hex[r] = dpp_shr<1>(Hl[r], 0.0f); }
            if (p == 15) {
#pragma unroll
                for (int r = 0; r < 4; ++r) { tot[((par * 8 + wid) * 16 + 4 * g + r) * 2] = Al[r]; tot[((par * 8 + wid) * 16 + 4 * g + r) * 2 + 1] = Hl[r]; }
            }
            asm volatile("s_waitcnt lgkmcnt(0)\n\ts_barrier" ::: "memory");
            float cin[4];
#pragma unroll
            for (int r = 0; r < 4; ++r) cin[r] = 0.f;
#pragma unroll
            for (int w = 0; w < 8; ++w) {
                const f32x4 t0 = *(const LAS f32x4*)(tot + ((par * 8 + w) * 16 + 4 * g) * 2), t1 = *(const LAS f32x4*)(tot + ((par * 8 + w) * 16 + 4 * g) * 2 + 4);
                const float Aw[4] = {t0[0], t0[2], t1[0], t1[2]}, Hw[4] = {t0[1], t0[3], t1[1], t1[3]};
#pragma unroll
                for (int r = 0; r < 4; ++r) { if (w == wid) cin[r] = carry[r]; carry[r] = Aw[r] * carry[r] + Hw[r]; }
            }
            par ^= 1;
            f32x4 hfv[4]; u32x2 gv[4];
            if (dir) {
#pragma unroll
                for (int i = 0; i < 4; ++i) { const int tok = S - 1 - (Pb + i); hfv[i] = *(const f32x4*)(HF + (rowbase + tok) * 512 + c0 + 4 * g); gv[i] = *(const u32x2*)(GR + (rowbase + tok) * 512 + c0 + 4 * g); }
            }
            float cl[4];
#pragma unroll
            for (int r = 0; r < 4; ++r) cl[r] = Aex[r] * cin[r] + Hex[r];
#pragma unroll
            for (int i = 0; i < 4; ++i) {
                const int P = Pb + i; const int tok = dir ? (S - 1 - P) : P;
                f32x4 hv;
#pragma unroll
                for (int r = 0; r < 4; ++r) hv[r] = hh[i][r] + cpp[i][r] * cl[r];
                if (dir == 0) *(f32x4*)(HF + (rowbase + tok) * 512 + c0 + 4 * g) = hv;
                else {
                    const float gr4[4] = {__uint_as_float(gv[i].x << 16), __uint_as_float(gv[i].x & 0xffff0000u), __uint_as_float(gv[i].y << 16), __uint_as_float(gv[i].y & 0xffff0000u)};
                    float y[4];
#pragma unroll
                    for (int r = 0; r < 4; ++r) { const float x = gr4[r]; const float gl = x * fast_sigmoid(1.5957691216057308f * (x + 0.044715f * x * x * x)); y[r] = gl * (hv[r] + hfv[i][r]); }
                    u32x2 w; w.x = cvt_pk_bf16(y[0], y[1]); w.y = cvt_pk_bf16(y[2], y[3]);
                    *(u32x2*)(MIXED + (rowbase + tok) * 1024 + 512 + c0 + 4 * g) = w;
                }
            }
        }
        __syncthreads();
    }
}
}
struct Args { const float* in[22]; float* out; unsigned char* ws; int ph_lo, ph_hi; };
constexpr int N_PHASES = 6;

__global__ void __launch_bounds__(NWAVES * 64, 2) mk_fwd(Args args) {
    extern __shared__ __attribute__((aligned(16))) unsigned char lds_raw[];
    LAS unsigned char* lds = (LAS unsigned char*)lds_raw;
    const int tid = threadIdx.x, lane = tid & 63; const int wave = __builtin_amdgcn_readfirstlane(tid >> 6);
    const int G = gridDim.x, bx = blockIdx.x; const int vcu = (G % 8 == 0) ? (bx % 8) * (G / 8) + bx / 8 : bx;
    unsigned char* ws = args.ws;
    const float* x = args.in[0]; float* out = args.out;
    bf16_t* WIN = (bf16_t*)(ws + WS_WIN); bf16_t* WOUT = (bf16_t*)(ws + WS_WOUT); bf16_t* WGU = (bf16_t*)(ws + WS_WGU); bf16_t* WDN = (bf16_t*)(ws + WS_WDN);
    float* RSS1 = (float*)(ws + WS_RSS1); float* RSS2 = (float*)(ws + WS_RSS2);
    bf16_t* XN = (bf16_t*)(ws + WS_XN); bf16_t* HB = XN;
    bf16_t* Qb = (bf16_t*)(ws + WS_Q); bf16_t* KT = (bf16_t*)(ws + WS_KT); bf16_t* VT = (bf16_t*)(ws + WS_VT); bf16_t* XR = (bf16_t*)(ws + WS_XR); bf16_t* GR = (bf16_t*)(ws + WS_GR);
    float* HF = (float*)(ws + WS_HF); bf16_t* MIXED = (bf16_t*)(ws + WS_MIXED); bf16_t* ACT = (bf16_t*)(ws + WS_ACT);
    const int lo = args.ph_lo, hi = args.ph_hi;
    volatile LAS unsigned* bst = (volatile LAS unsigned*)(lds + LDS_MISC + 8192);
    if (tid == 0) { bst[0] = 0u; bst[1] = 0u; }
    __syncthreads();
    xb::XcdBarrier bar = xb::xcd_barrier_post((unsigned*)ws, bst);
    if (lo > 1000) cooperative_groups::this_grid().sync();
#define IN(k) (lo <= (k) && (k) < hi)
#ifndef REP_PHASE
#define REP_PHASE -1
#endif
#define REPS(k) ((REP_PHASE == (k)) ? 2 : 1)
#define REPSYNC(k, rep) do { if ((rep) + 1 < REPS(k)) xb::xcd_barrier(bar); } while (0)
#define SEAM(k) do { if (IN(k) && IN((k) + 1)) { xb::xcd_barrier(bar); } } while (0)

    if (IN(0)) for (int rep = 0; rep < REPS(0); ++rep) {
        LAS float* scr = (LAS float*)(lds + wave * 16384);
        const int gw = vcu * NWAVES + wave, NGW = G * NWAVES;
        constexpr int I_IN = (D / 64) * (DIN / 32), I_OUT = (D / 64) * (D / 32), I_G = (D / 64) * (DFF / 32), I_DN = (DFF / 64) * (D / 32);
        constexpr int NITEMS = I_IN + I_OUT + 2 * I_G + I_DN;
        for (int it = gw; it < NITEMS; it += NGW) {
            int r = it;
            if (r < I_IN) { p0_transpose_item<0>(args.in[2], D, DIN, WIN, nullptr, scr, r, lane); continue; } r -= I_IN;
            if (r < I_OUT) { p0_transpose_item<0>(args.in[16], D, D, WOUT, nullptr, scr, r, lane); continue; } r -= I_OUT;
            if (r < I_G) { p0_transpose_item<1>(args.in[18], D, DFF, WGU, args.in[17], scr, r, lane); continue; } r -= I_G;
            if (r < I_G) { p0_transpose_item<2>(args.in[19], D, DFF, WGU, args.in[17], scr, r, lane); continue; } r -= I_G;
            p0_transpose_item<0>(args.in[20], DFF, D, WDN, nullptr, scr, r, lane);
        }
        for (int m = gw * 4; m < M; m += NGW * 4) rms_rows_to_bf16<4>(x + (size_t)m * D, args.in[1], XN + (size_t)m * D, lane);
        REPSYNC(0, rep);
    }
    SEAM(0);
    if (IN(1)) for (int rep = 0; rep < REPS(1); ++rep) {
        pg8::Gemm g{XN, WIN, M, DIN, D}; pg8::StaticOrder So; So.init(M, DIN, G, bx);
        pg8::EpiInProj E{Qb, KT, VT, XR, GR, QSCALE};
        pg8::gemm_phase<pg8::EpiInProj, pg8::StaticOrder, true, true>(lds, g, So, E);
        REPSYNC(1, rep);
    }
    SEAM(1);
    if (IN(2)) {
        float lam;
        { float s1 = 0.f, s2 = 0.f; for (int i = 0; i < 64; ++i) { s1 += args.in[3][i] * args.in[4][i]; s2 += args.in[5][i] * args.in[6][i]; } lam = expf(s1) - expf(s2) + 0.2f; }
        for (int rep = 0; rep < REPS(20); ++rep)
        for (int rnd = 0; rnd * G + vcu < NB * NH * 32; ++rnd) {
            const int u = rnd * G + vcu; int b_, h_, qb_;
            if (G == 256) { b_ = vcu >> 5; h_ = rnd; qb_ = vcu & 31; } else { qb_ = u & 31; h_ = (u >> 5) & 3; b_ = u >> 7; }
            att::attn_unit(b_, h_, qb_, Qb, KT, VT, MIXED, lds, lam, args.in[7], args.in[8]);
        }
        for (int rep = 0; rep < REPS(21); ++rep)
        for (int it = vcu; it < NB * 32; it += G) {
            const int b_ = it >> 5, cg = it & 31;
            lru::lru_item(b_, cg, XR, GR, HF, MIXED, lds, args.in[9], args.in[10], args.in[11], args.in[12], args.in[13], args.in[14], args.in[15]);
        }
    }
    SEAM(2);
    if (IN(3)) for (int rep = 0; rep < REPS(3); ++rep) {
        pg8::Gemm g{MIXED, WOUT, M, D, D}; pg8::StaticOrder So; So.init(M, D, G, bx);
        pg8::EpiResid<true, false> E{x, out, HB, RSS1, D};
        pg8::gemm_phase<pg8::EpiResid<true, false>, pg8::StaticOrder, true, true>(lds, g, So, E);
        REPSYNC(3, rep);
    }
    SEAM(3);
    if (IN(4)) for (int rep = 0; rep < REPS(4); ++rep) {
        pg8::Gemm g{HB, WGU, M, 2 * DFF, D}; pg8::StaticOrder So; So.init(M, 2 * DFF, G, bx);
        pg8::EpiGateUp E{ACT, RSS1, DFF, EPS};
        pg8::gemm_phase<pg8::EpiGateUp, pg8::StaticOrder, true, true>(lds, g, So, E);
        REPSYNC(4, rep);
    }
    SEAM(4);
    if (IN(5)) for (int rep = 0; rep < REPS(5); ++rep) {
        if (G == 256) {
#pragma unroll 1
            for (int half = 0; half < 2; ++half) {
                const size_t r0 = (size_t)half * (M / 2);
                pg8::Gemm g{ACT + r0 * DFF, WDN, M / 2, D, DFF}; pg8::StaticOrder So; So.init(M / 2, D, G, bx);
                pg8::EpiDownNorm E{HB + r0 * D, out + r0 * D, args.in[21], RSS2 + r0 * 4, (unsigned*)ws + 4096 + 64 * 64 * half, D, EPS};
                pg8::gemm_phase<pg8::EpiDownNorm, pg8::StaticOrder, false, true>(lds, g, So, E);
                __syncthreads();
            }
        }
        REPSYNC(5, rep);
    }
#if REP_PHASE == 99
    for (int i = 0; i < 20; ++i) xb::xcd_barrier(bar);
#endif
#undef IN
#undef SEAM
}
}
namespace dbg {
using namespace mk;
__global__ void __launch_bounds__(256) k_unpack_proj(const bf16_t* Qb, const bf16_t* KT, const bf16_t* VT, const bf16_t* XR, const bf16_t* GR, float* q, float* k, float* v, float* xr, float* gr) {
    const size_t idx = (size_t)blockIdx.x * 256 + threadIdx.x;
    const int c = (int)(idx & 511); const int row = (int)(idx >> 9); const int b = row >> 12, tok = row & 4095, t = tok >> 6, rr = tok & 63;
    q[idx] = bf2f(Qb[idx]) * (1.0f / QSCALE);
    { const int h = c >> 7, w = c & 127, s = w >> 6, d = w & 63, chunk = d >> 3, j = d & 7;
      k[idx] = bf2f(KT[((((size_t)(b * 4 + h) * 2 + s) * 64 + t) * 8 + chunk) * 512 + rr * 8 + j]); }
    { const int h = c >> 7, dv = c & 127, db = dv >> 5, cc = dv & 31;
      v[idx] = bf2f(VT[(((size_t)(b * 4 + h) * 64 + t) * 4 + db) * 2048 + rr * 32 + cc]); }
    xr[idx] = bf2f(XR[idx]); gr[idx] = bf2f(GR[idx]);
}
__global__ void __launch_bounds__(256) k_unpack_bf16(const bf16_t* src, float* dst) { const size_t idx = (size_t)blockIdx.x * 256 + threadIdx.x; dst[idx] = bf2f(src[idx]); }
}

#ifndef STAGE
#define STAGE 4
#endif
static void mk_launch_phases(const mk::Args& a0, int lo, int hi, int grid, hipStream_t stream, bool coop) {
    mk::Args a = a0; a.ph_lo = lo; a.ph_hi = hi;
    if (coop) { void* args[] = {&a}; hipError_t e = hipLaunchCooperativeKernel((const void*)mk::mk_fwd, dim3(grid), dim3(mk::NWAVES * 64), args, mk::LDS_BYTES, stream);
        if (e != hipSuccess) fprintf(stderr, "cooperative launch failed: %s (grid %d)\n", hipGetErrorString(e), grid); }
    else { hipLaunchKernelGGL(mk::mk_fwd, dim3(grid), dim3(mk::NWAVES * 64), mk::LDS_BYTES, stream, a); }
}

extern "C" void kernel_launch(void* const* d_in, const int* in_sizes, int n_in, void* d_out, int out_size, void* d_ws, size_t ws_size, hipStream_t stream) {
    static int grid = 0;
    if (grid == 0) {
        int dev = 0, cus = 0, per_cu = 0;
        hipGetDevice(&dev); hipDeviceGetAttribute(&cus, hipDeviceAttributeMultiprocessorCount, dev);
        if (hipFuncSetAttribute((const void*)mk::mk_fwd, hipFuncAttributeMaxDynamicSharedMemorySize, mk::LDS_BYTES) != hipSuccess) { fprintf(stderr, "hipFuncSetAttribute failed\n"); grid = -1; return; }
        if (hipOccupancyMaxActiveBlocksPerMultiprocessor(&per_cu, (const void*)mk::mk_fwd, mk::NWAVES * 64, mk::LDS_BYTES) != hipSuccess || per_cu < 1) { fprintf(stderr, "occupancy query: %d\n", per_cu); per_cu = 1; }
        (void)hipGetLastError();
        grid = cus * 1;
        if (n_in != 22 || ws_size < 512u * mk::MiB) fprintf(stderr, "kernel_launch: unexpected n_in %d / ws_size %zu\n", n_in, ws_size);
    }
    if (grid < 0) return;
    if (hipMemsetAsync(d_ws, 0, 65536, stream) != hipSuccess) { fprintf(stderr, "memset failed\n"); return; }
    mk::Args a{};
    for (int i = 0; i < 22; ++i) a.in[i] = (const float*)d_in[i];
    a.out = (float*)d_out; a.ws = (unsigned char*)d_ws;
    char* ws = (char*)d_ws; const size_t MiB = 1u << 20;
#if STAGE == 4
    mk_launch_phases(a, 0, mk::N_PHASES, grid, stream, true);
#elif STAGE == 3
    for (int p = 0; p < mk::N_PHASES; ++p) mk_launch_phases(a, p, p + 1, grid, stream, false);
#elif STAGE == 1
    for (int p = 0; p < 2; ++p) mk_launch_phases(a, p, p + 1, grid, stream, false);
    float* q = (float*)(ws + 32 * MiB), *k = (float*)(ws + 256 * MiB), *v = (float*)(ws + 320 * MiB), *xr = (float*)(ws + 384 * MiB), *gr = (float*)(ws + 448 * MiB);
    dbg::k_unpack_proj<<<mk::M * 512 / 256, 256, 0, stream>>>((const mk::bf16_t*)(ws + mk::WS_Q), (const mk::bf16_t*)(ws + mk::WS_KT), (const mk::bf16_t*)(ws + mk::WS_VT), (const mk::bf16_t*)(ws + mk::WS_XR), (const mk::bf16_t*)(ws + mk::WS_GR), q, k, v, xr, gr);
    float* mixed = (float*)(ws + 96 * MiB);
    nv::naive_mid(d_in, q, k, v, xr, gr, mixed, stream);
    nv::naive_tail(d_in, mixed, (float*)d_out, (float*)(ws + 0), (float*)(ws + 128 * MiB), stream);
#elif STAGE == 2
    for (int p = 0; p < 3; ++p) mk_launch_phases(a, p, p + 1, grid, stream, false);
    float* mixed = (float*)(ws + 0);
    dbg::k_unpack_bf16<<<mk::M * 1024 / 256, 256, 0, stream>>>((const mk::bf16_t*)(ws + mk::WS_MIXED), mixed);
    nv::naive_tail(d_in, mixed, (float*)d_out, (float*)(ws + 0), (float*)(ws + 128 * MiB), stream);
#endif
}
```

```cpp
#include <hip/hip_runtime.h>
#include <hip/hip_cooperative_groups.h>
#include <cstdio>
#include <cstdint>
#include <cmath>
#define STAGE 4
namespace pg8 {
#define PG8_LAS __attribute__((address_space(3)))
typedef unsigned short bf16_t;
typedef short bf16x8 __attribute__((ext_vector_type(8)));
typedef float f32x4 __attribute__((ext_vector_type(4)));
typedef unsigned u32x4 __attribute__((ext_vector_type(4)));
constexpr int BM = 256, BK = 64, HALF = 128, HTB = HALF * BK * 2  , STAGE_BYTES = 8 * HTB, NXCD = 8, WGM = 8;

__host__ __device__ __forceinline__ int lds_byte(int r, int c) { const int st = (r >> 4) * 2 + (c >> 5), rr = r & 15, cc = c & 31, ob = rr * 64 + cc * 2; return st * 1024 + (ob ^ (((ob >> 9) & 1) << 5)); }
__host__ __device__ __forceinline__ void stage_rc(int b, int& R, int& C) { const int st = b / 1024, sb = b % 1024, swz = sb ^ (((sb >> 9) & 1) << 5); R = (st >> 1) * 16 + swz / 64; C = (st & 1) * 32 + (swz % 64) / 2; }
__host__ __device__ __forceinline__ int perm32(int rho) { const int n = rho >> 4, i = rho & 15; return 8 * (i >> 2) + 4 * n + (i & 3); }

struct Unit { int pm, pn; };
struct Gemm { const bf16_t* A; const bf16_t* Bt; int M, N, K; };

struct StaticOrder {
    int nM, nN, nwg, G, c;
    __host__ __device__ void init(int M, int N, int G_, int c_) { nM = M / BM; nN = N / BM; nwg = nM * nN; G = G_; c = c_; }
    __host__ __device__ bool next(int i, Unit& u) const {
        const long L = (long)i * G + c; if (L >= nwg) return false;
        int wgid = (int)L; { const int q = nwg / NXCD, r = nwg % NXCD, xcd = wgid % NXCD, off = wgid / NXCD; wgid = (xcd < r ? xcd * (q + 1) : r * (q + 1) + (xcd - r) * q) + off; }
        const int nig = WGM * nN, gid = wgid / nig, fm = gid * WGM, gsz = (nM - fm) < WGM ? (nM - fm) : WGM;
        u.pm = fm + ((wgid % nig) % gsz); u.pn = (wgid % nig) / gsz; return true;
    }
    __device__ __forceinline__ void a_ready(const Unit&) const {}
    __device__ __forceinline__ void done(const Unit&) const {}
};

typedef float f32x2_cv __attribute__((ext_vector_type(2))); typedef __bf16 bf16x2_cv __attribute__((ext_vector_type(2)));
__device__ __forceinline__ unsigned cvt_pk_bf16(float lo, float hi) { f32x2_cv v = {lo, hi}; bf16x2_cv b = __builtin_convertvector(v, bf16x2_cv); return __builtin_bit_cast(unsigned, b); }
typedef float f32x2 __attribute__((ext_vector_type(2)));
typedef unsigned u32x2 __attribute__((ext_vector_type(2)));
__device__ __forceinline__ u32x4 pack8(f32x4 v0, f32x4 v1) { u32x4 w; w.x = cvt_pk_bf16(v0[0], v0[1]); w.y = cvt_pk_bf16(v0[2], v0[3]); w.z = cvt_pk_bf16(v1[0], v1[1]); w.w = cvt_pk_bf16(v1[2], v1[3]); return w; }
struct EpiInProj {
    static constexpr bool PERM = true, AFTER_DRAIN = false;
    bf16_t *Q, *KT, *VT, *XR, *GR; float qscale;
    __device__ __forceinline__ void operator()(const f32x4 (&acc)[2][2][4][2], const Unit& u, int wr, int wc, int fr, int fq) const {
        const int sec = u.pn >> 1, half = u.pn & 1;
#pragma unroll
        for (int ai = 0; ai < 2; ++ai)
#pragma unroll
            for (int m = 0; m < 4; ++m) {
                const int row = u.pm * BM + ai * HALF + wr * 64 + m * 16 + fr;
                const int b = row >> 12, tok = row & 4095, t = tok >> 6, rr = tok & 63;
#pragma unroll
                for (int bj = 0; bj < 2; ++bj) {
                    f32x4 v0 = acc[ai][bj][m][0], v1 = acc[ai][bj][m][1];
                    const int cs = half * 256 + bj * HALF + wc * 32 + 8 * fq;
                    if (sec == 0) { v0 = v0 * qscale; v1 = v1 * qscale; *(u32x4*)(Q + (size_t)row * 512 + cs) = pack8(v0, v1); }
                    else if (sec == 1) { const int h = half * 2 + bj, s = wc >> 1, chunk = 4 * (wc & 1) + fq;
                        *(u32x4*)(KT + ((((size_t)(b * 4 + h) * 2 + s) * 64 + t) * 8 + chunk) * 512 + rr * 8) = pack8(v0, v1); }
                    else if (sec == 2) { const int h = half * 2 + bj;
                        *(u32x4*)(VT + (((size_t)(b * 4 + h) * 64 + t) * 4 + wc) * 2048 + rr * 32 + 8 * fq) = pack8(v0, v1); }
                    else if (sec == 3) { *(u32x4*)(XR + (size_t)row * 512 + cs) = pack8(v0, v1); }
                    else { *(u32x4*)(GR + (size_t)row * 512 + cs) = pack8(v0, v1); }
                }
            }
    }
};
template <bool WRITE_HB, bool WRITE_F32 = true> struct EpiResid {
    static constexpr bool PERM = false, AFTER_DRAIN = false;
    const float* base; float* out; bf16_t* hb; float* rss; int ldc;
    __device__ __forceinline__ void operator()(const f32x4 (&acc)[2][2][4][2], const Unit& u, int wr, int wc, int fr, int fq) const {
        const int col0 = u.pn * BM + wc * 32 + 4 * fq;
#pragma unroll
        for (int ai = 0; ai < 2; ++ai)
#pragma unroll
            for (int m = 0; m < 4; ++m) {
                const int row = u.pm * BM + ai * HALF + wr * 64 + m * 16 + fr; const size_t off = (size_t)row * ldc + col0; float ss = 0.f;
#pragma unroll
                for (int bj = 0; bj < 2; ++bj)
#pragma unroll
                    for (int n = 0; n < 2; ++n) {
                        const f32x4 bs = *(const f32x4*)(base + off + bj * HALF + n * 16); const f32x4 o = acc[ai][bj][m][n] + bs;
                        if (WRITE_F32) *(f32x4*)(out + off + bj * HALF + n * 16) = o;
                        if (WRITE_HB) { u32x2 w; w.x = cvt_pk_bf16(o[0], o[1]); w.y = cvt_pk_bf16(o[2], o[3]); *(u32x2*)(hb + off + bj * HALF + n * 16) = w; }
                        ss += (o[0] * o[0] + o[1] * o[1]) + (o[2] * o[2] + o[3] * o[3]);
                    }
                ss += __shfl_xor(ss, 16); ss += __shfl_xor(ss, 32);
                if (fq == 0) rss[(size_t)row * 16 + u.pn * 4 + wc] = ss;
            }
    }
};
struct EpiGateUp {
    static constexpr bool PERM = true, AFTER_DRAIN = false;
    bf16_t* act; const float* rss; int ldo; float eps;
    __device__ __forceinline__ void operator()(const f32x4 (&acc)[2][2][4][2], const Unit& u, int wr, int wc, int fr, int fq) const {
        const int col0 = u.pn * HALF + wc * 32 + 8 * fq;
#pragma unroll
        for (int ai = 0; ai < 2; ++ai)
#pragma unroll
            for (int m = 0; m < 4; ++m) {
                const int row = u.pm * BM + ai * HALF + wr * 64 + m * 16 + fr;
                const f32x4* rp = (const f32x4*)(rss + (size_t)row * 16); const f32x4 s0 = rp[0], s1 = rp[1], s2 = rp[2], s3 = rp[3];
                const float tot = ((s0[0] + s0[1]) + (s0[2] + s0[3])) + ((s1[0] + s1[1]) + (s1[2] + s1[3])) + ((s2[0] + s2[1]) + (s2[2] + s2[3])) + ((s3[0] + s3[1]) + (s3[2] + s3[3]));
                const float rstd = __builtin_amdgcn_rsqf(tot * (1.0f / 1024.0f) + eps);
                f32x4 o[2];
#pragma unroll
                for (int n = 0; n < 2; ++n) {
                    const f32x4 g = acc[ai][0][m][n] * rstd, up = acc[ai][1][m][n] * rstd;
#pragma unroll
                    for (int i = 0; i < 4; ++i) { const float e = __builtin_amdgcn_exp2f(g[i] * -1.4426950408889634f); o[n][i] = g[i] * __builtin_amdgcn_rcpf(1.0f + e) * up[i]; }
                }
                *(u32x4*)(act + (size_t)row * ldo + col0) = pack8(o[0], o[1]);
            }
    }
};

struct EpiDownNorm {
    static constexpr bool PERM = false, AFTER_DRAIN = true;
    const bf16_t* hb; float* out; const float* gain; float* xbuf; unsigned* cnt; int ldc; float eps;
    __device__ __forceinline__ void fused(f32x4 (&acc)[2][2][4][2], const Unit& u, int wr, int wc, int fr, int fq, PG8_LAS unsigned char* lds, int wid, int lane) const {
        PG8_LAS float* P = (PG8_LAS float*)lds;
        PG8_LAS float* Sx = (PG8_LAS float*)(lds + 4096);
        PG8_LAS unsigned* flag = (PG8_LAS unsigned*)(lds + 4096 + 1024);
        const int col0 = u.pn * BM + wc * 32 + 4 * fq;
#pragma unroll
        for (int ai = 0; ai < 2; ++ai)
#pragma unroll
            for (int m = 0; m < 4; ++m) {
                const int r = ai * HALF + wr * 64 + m * 16 + fr; const size_t off = (size_t)(u.pm * BM + r) * ldc + col0; float ss = 0.f;
#pragma unroll
                for (int bj = 0; bj < 2; ++bj)
#pragma unroll
                    for (int n = 0; n < 2; ++n) {
                        const u32x2 hv = *(const u32x2*)(hb + off + bj * HALF + n * 16);
                        const f32x4 h4 = (f32x4){__uint_as_float(hv.x << 16), __uint_as_float(hv.x & 0xffff0000u), __uint_as_float(hv.y << 16), __uint_as_float(hv.y & 0xffff0000u)};
                        const f32x4 o = acc[ai][bj][m][n] + h4; acc[ai][bj][m][n] = o;
                        ss += (o[0] * o[0] + o[1] * o[1]) + (o[2] * o[2] + o[3] * o[3]);
                    }
                ss += __shfl_xor(ss, 16); ss += __shfl_xor(ss, 32);
                if (fq == 0) P[r * 4 + wc] = ss;
            }
        asm volatile("s_waitcnt lgkmcnt(0)" ::: "memory"); __builtin_amdgcn_s_barrier(); asm volatile("" ::: "memory");
        const int row = wid * 32 + (lane & 31);
        if (lane < 32) {
            const float s = (P[row * 4 + 0] + P[row * 4 + 1]) + (P[row * 4 + 2] + P[row * 4 + 3]);
            __hip_atomic_store(xbuf + (size_t)(u.pm * BM + row) * 4 + u.pn, s, __ATOMIC_RELAXED, __HIP_MEMORY_SCOPE_AGENT);
        }
        asm volatile("s_waitcnt vmcnt(0)" ::: "memory");
        if (lane == 0) __hip_atomic_fetch_add(cnt + 64 * u.pm, 1u, __ATOMIC_RELAXED, __HIP_MEMORY_SCOPE_AGENT);
        if (wid == 0) {
            unsigned sp = 0;
            for (;;) {
                if ((unsigned)__builtin_amdgcn_readfirstlane(__hip_atomic_load(cnt + 64 * u.pm, __ATOMIC_RELAXED, __HIP_MEMORY_SCOPE_AGENT)) >= 32u) break;
                if (++sp > (1u << 22)) break;
                __builtin_amdgcn_s_sleep(2);
            }
            __builtin_amdgcn_fence(__ATOMIC_ACQUIRE, "agent");
            if (lane == 0) flag[0] = 0u;
        }
        asm volatile("s_waitcnt vmcnt(0) lgkmcnt(0)" ::: "memory"); __builtin_amdgcn_s_barrier(); asm volatile("" ::: "memory");
        if (lane < 32) {
            const float* slot = xbuf + (size_t)(u.pm * BM + row) * 4;
            const float a = __hip_atomic_load(slot + 0, __ATOMIC_RELAXED, __HIP_MEMORY_SCOPE_AGENT), b = __hip_atomic_load(slot + 1, __ATOMIC_RELAXED, __HIP_MEMORY_SCOPE_AGENT),
                        c = __hip_atomic_load(slot + 2, __ATOMIC_RELAXED, __HIP_MEMORY_SCOPE_AGENT), d = __hip_atomic_load(slot + 3, __ATOMIC_RELAXED, __HIP_MEMORY_SCOPE_AGENT);
            Sx[row] = 1.0f / sqrtf(((a + b) + (c + d)) * (1.0f / 1024.0f) + eps);
        }
        asm volatile("s_waitcnt lgkmcnt(0)" ::: "memory"); __builtin_amdgcn_s_barrier(); asm volatile("" ::: "memory");
        f32x4 gv[2][2];
#pragma unroll
        for (int bj = 0; bj < 2; ++bj)
#pragma unroll
            for (int n = 0; n < 2; ++n) gv[bj][n] = *(const f32x4*)(gain + col0 + bj * HALF + n * 16);
#pragma unroll
        for (int ai = 0; ai < 2; ++ai)
#pragma unroll
            for (int m = 0; m < 4; ++m) {
                const int r = ai * HALF + wr * 64 + m * 16 + fr; const float rs = Sx[r]; const size_t off = (size_t)(u.pm * BM + r) * ldc + col0;
#pragma unroll
                for (int bj = 0; bj < 2; ++bj)
#pragma unroll
                    for (int n = 0; n < 2; ++n) *(f32x4*)(out + off + bj * HALF + n * 16) = acc[ai][bj][m][n] * rs * gv[bj][n];
            }
    }
};
template <class Epi, class Sched, bool ALIGN_EPI = false, bool SP2 = false>
__device__ __forceinline__ void gemm_phase(PG8_LAS unsigned char* lds, const Gemm g, const Sched& S, const Epi& E) {
    const int tid = threadIdx.x, wid = __builtin_amdgcn_readfirstlane(tid >> 6), lane = tid & 63, wr = wid >> 2, wc = wid & 3, fr = lane & 15, fq = lane >> 4;
    const int K = g.K, nt = K / BK;
    unsigned voffA[2], voffB[2];
#pragma unroll
    for (int i = 0; i < 2; ++i) { int R, C; stage_rc(tid * 16 + i * 8192, R, C); const int Rb = Epi::PERM ? ((R & ~31) + perm32(R & 31)) : R;
        voffA[i] = (unsigned)(R * K + C) * 2u; voffB[i] = (unsigned)(Rb * K + C) * 2u; }
    const size_t kstep = (size_t)(BK * 2);
    const size_t hstep = (size_t)HALF * K * 2;
    const size_t tstep = 2 * hstep;
    const unsigned ldsw = (unsigned)wid * 1024u;
    const int aoff = lds_byte(wr * 64 + fr, fq * 8), boff = lds_byte(wc * 32 + fr, fq * 8);
#define PG8_SA(b, h) (((b) * 2 + (h)) * HTB)
#define PG8_SB(b, h) ((4 + (b) * 2 + (h)) * HTB)
#define PG8_STAGE(bufoff, gbase, voff) do { _Pragma("unroll") for (int _i = 0; _i < 2; ++_i) \
        __builtin_amdgcn_global_load_lds((const unsigned*)((const char*)(gbase) + (voff)[_i]), (PG8_LAS unsigned*)(lds + (bufoff) + ldsw + _i * 8192), 16, 0, 0); } while (0)
#define PG8_LDA(dst, b, h) do { _Pragma("unroll") for (int m = 0; m < 4; ++m) _Pragma("unroll") for (int k = 0; k < 2; ++k) dst[m][k] = *(const PG8_LAS bf16x8*)(lds + PG8_SA(b, h) + aoff + m * 2048 + k * 1024); } while (0)
#define PG8_LDB(dst, b, h) do { _Pragma("unroll") for (int n = 0; n < 2; ++n) _Pragma("unroll") for (int k = 0; k < 2; ++k) dst[n][k] = *(const PG8_LAS bf16x8*)(lds + PG8_SB(b, h) + boff + n * 2048 + k * 1024); } while (0)
#define PG8_MMA(ai, bj, At, Bt) do { __builtin_amdgcn_s_setprio(1); _Pragma("unroll") for (int m = 0; m < 4; ++m) _Pragma("unroll") for (int n = 0; n < 2; ++n) _Pragma("unroll") for (int k = 0; k < 2; ++k) \
        acc[ai][bj][m][n] = __builtin_amdgcn_mfma_f32_16x16x32_bf16(Bt[n][k], At[m][k], acc[ai][bj][m][n], 0, 0, 0); __builtin_amdgcn_s_setprio(0); } while (0)
#define PG8_WAIT_V(n) asm volatile("s_waitcnt vmcnt(" #n ")" ::: "memory")
#define PG8_WAIT_L(n) asm volatile("s_waitcnt lgkmcnt(" #n ")" ::: "memory")
#define PG8_BAR __builtin_amdgcn_s_barrier()
#define PG8_SCHED __builtin_amdgcn_sched_barrier(0)
    Unit cur, nxt; int ui = 0;
    if (!S.next(0, cur)) return;
    f32x4 acc[2][2][4][2];
#pragma unroll
    for (int a = 0; a < 2; ++a)
#pragma unroll
        for (int b = 0; b < 2; ++b)
#pragma unroll
            for (int m = 0; m < 4; ++m)
#pragma unroll
                for (int n = 0; n < 2; ++n) acc[a][b][m][n] = (f32x4){0.f, 0.f, 0.f, 0.f};
    bf16x8 At[4][2], B0[2][2], B1[2][2];
    const char* cA = (const char*)g.A + (size_t)cur.pm * tstep; const char* cB = (const char*)g.Bt + (size_t)cur.pn * tstep;
    S.a_ready(cur);
    if constexpr (SP2) {
        PG8_STAGE(PG8_SB(0, 0), cB, voffB); PG8_STAGE(PG8_SB(0, 1), cB + hstep, voffB); PG8_STAGE(PG8_SA(0, 0), cA, voffA); PG8_STAGE(PG8_SA(0, 1), cA + hstep, voffA);
        if (wr == 1) PG8_BAR;
        PG8_WAIT_V(2); PG8_BAR;
        PG8_STAGE(PG8_SB(1, 0), cB + kstep, voffB); PG8_STAGE(PG8_SA(1, 0), cA + kstep, voffA); PG8_STAGE(PG8_SB(1, 1), cB + hstep + kstep, voffB);
        PG8_WAIT_V(6); PG8_BAR;
    } else {
        PG8_STAGE(PG8_SB(0, 0), cB, voffB); PG8_STAGE(PG8_SA(0, 0), cA, voffA); PG8_STAGE(PG8_SB(0, 1), cB + hstep, voffB); PG8_STAGE(PG8_SA(0, 1), cA + hstep, voffA);
        if (wr == 1) PG8_BAR;
        PG8_WAIT_V(4); PG8_BAR;
        PG8_STAGE(PG8_SB(1, 0), cB + kstep, voffB); PG8_STAGE(PG8_SA(1, 0), cA + kstep, voffA); PG8_STAGE(PG8_SB(1, 1), cB + hstep + kstep, voffB);
        PG8_WAIT_V(6); PG8_BAR;
    }
    for (;;) {
        const bool has_next = S.next(ui + 1, nxt);
        const char* nA = has_next ? (const char*)g.A + (size_t)nxt.pm * tstep : cA; const char* nB = has_next ? (const char*)g.Bt + (size_t)nxt.pn * tstep : cB;
        for (int t = 0; t < nt; t += 2) {
            const bool last = (t == nt - 2);
            const char* a1 = cA + (size_t)(t + 1) * kstep;
            const char* a2 = last ? nA : cA + (size_t)(t + 2) * kstep; const char* b2 = last ? nB : cB + (size_t)(t + 2) * kstep;
            const char* a3 = a2 + kstep; const char* b3 = b2 + kstep;
            if (last && has_next) S.a_ready(nxt);
            if constexpr (SP2) {
            PG8_LDB(B0, 0, 0); PG8_LDB(B1, 0, 1); PG8_SCHED; PG8_LDA(At, 0, 0); PG8_STAGE(PG8_SA(1, 1), a1 + hstep, voffA);
            PG8_WAIT_V(8); PG8_WAIT_L(0); PG8_BAR; PG8_MMA(0, 0, At, B0); PG8_MMA(0, 1, At, B1); PG8_BAR; PG8_SCHED;
            PG8_LDA(At, 0, 1); PG8_STAGE(PG8_SB(0, 0), b2, voffB); PG8_STAGE(PG8_SB(0, 1), b2 + hstep, voffB); PG8_STAGE(PG8_SA(0, 0), a2, voffA);
            PG8_WAIT_V(8); PG8_WAIT_L(0); PG8_BAR; PG8_MMA(1, 0, At, B0); PG8_MMA(1, 1, At, B1); PG8_BAR; PG8_SCHED;
            PG8_LDB(B0, 1, 0); PG8_LDB(B1, 1, 1); PG8_SCHED; PG8_LDA(At, 1, 0); PG8_STAGE(PG8_SA(0, 1), a2 + hstep, voffA);
            PG8_WAIT_V(8); PG8_WAIT_L(0); PG8_BAR; PG8_MMA(0, 0, At, B0); PG8_MMA(0, 1, At, B1); PG8_BAR; PG8_SCHED;
            PG8_LDA(At, 1, 1); PG8_STAGE(PG8_SB(1, 0), b3, voffB); PG8_STAGE(PG8_SB(1, 1), b3 + hstep, voffB); PG8_STAGE(PG8_SA(1, 0), a3, voffA);
            PG8_WAIT_V(8); PG8_WAIT_L(0); PG8_BAR; PG8_MMA(1, 0, At, B0); PG8_MMA(1, 1, At, B1); PG8_BAR; PG8_SCHED;
            } else {
            PG8_LDB(B0, 0, 0); PG8_SCHED; PG8_LDA(At, 0, 0); PG8_STAGE(PG8_SA(1, 1), a1 + hstep, voffA);
            PG8_WAIT_L(8); PG8_BAR; PG8_WAIT_L(0); PG8_MMA(0, 0, At, B0); PG8_BAR; PG8_SCHED;
            PG8_LDB(B1, 0, 1); PG8_STAGE(PG8_SB(0, 0), b2, voffB);
            PG8_BAR; PG8_WAIT_L(0); PG8_MMA(0, 1, At, B1); PG8_BAR;
            PG8_LDA(At, 0, 1); PG8_STAGE(PG8_SA(0, 0), a2, voffA);
            PG8_BAR; PG8_WAIT_L(0); PG8_MMA(1, 0, At, B0); PG8_BAR; PG8_SCHED;
            PG8_STAGE(PG8_SB(0, 1), b2 + hstep, voffB);
            PG8_WAIT_V(6); PG8_BAR; PG8_MMA(1, 1, At, B1); PG8_BAR;
            PG8_LDB(B0, 1, 0); PG8_SCHED; PG8_LDA(At, 1, 0); PG8_STAGE(PG8_SA(0, 1), a2 + hstep, voffA);
            PG8_WAIT_L(8); PG8_BAR; PG8_WAIT_L(0); PG8_MMA(0, 0, At, B0); PG8_BAR; PG8_SCHED;
            PG8_LDB(B1, 1, 1); PG8_STAGE(PG8_SB(1, 0), b3, voffB);
            PG8_BAR; PG8_WAIT_L(0); PG8_MMA(0, 1, At, B1); PG8_BAR;
            PG8_LDA(At, 1, 1); PG8_STAGE(PG8_SA(1, 0), a3, voffA);
            PG8_BAR; PG8_WAIT_L(0); PG8_MMA(1, 0, At, B0); PG8_BAR; PG8_SCHED;
            PG8_STAGE(PG8_SB(1, 1), b3 + hstep, voffB);
            PG8_WAIT_V(6); PG8_BAR; PG8_MMA(1, 1, At, B1); PG8_BAR;
            }
        }
        if constexpr (ALIGN_EPI) { if (wr == 0) PG8_BAR; }
        if constexpr (!Epi::AFTER_DRAIN) { E(acc, cur, wr, wc, fr, fq); S.done(cur); }
        if (!has_next) break;
#pragma unroll
        for (int a = 0; a < 2; ++a)
#pragma unroll
            for (int b = 0; b < 2; ++b)
#pragma unroll
                for (int m = 0; m < 4; ++m)
#pragma unroll
                    for (int n = 0; n < 2; ++n) acc[a][b][m][n] = (f32x4){0.f, 0.f, 0.f, 0.f};
        cur = nxt; cA = nA; cB = nB; ++ui;
        if constexpr (ALIGN_EPI) { if (wr == 1) PG8_BAR; }
    }
    PG8_WAIT_V(0);
    if constexpr (!ALIGN_EPI) { if (wr == 0) PG8_BAR; }
    PG8_BAR;
    if constexpr (Epi::AFTER_DRAIN) { E.fused(acc, cur, wr, wc, fr, fq, lds, wid, lane); S.done(cur); }
#undef PG8_SA
#undef PG8_SB
#undef PG8_STAGE
#undef PG8_LDA
#undef PG8_LDB
#undef PG8_MMA
#undef PG8_WAIT_V
#undef PG8_WAIT_L
#undef PG8_BAR
#undef PG8_SCHED
}
}
namespace xb {
#define LAS __attribute__((address_space(3)))
#define XB_TMO      128
#define XB_XCNT(j)  (256  + 64 * (j))
#define XB_XSUB(j)  (1280 + 64 * (j))
#define XB_XGEN(j)  (2304 + 64 * (j))
#define XB_TOP      3328
#define XB_TOPGEN   3392
#define XCD_BAR_WORDS 3456
#define XB_SPIN_CAP (1u << 18)

__device__ __forceinline__ unsigned xb_ld(unsigned* p)              { return __hip_atomic_load(p, __ATOMIC_RELAXED, __HIP_MEMORY_SCOPE_AGENT); }
__device__ __forceinline__ unsigned xb_add(unsigned* p, unsigned v) { return __hip_atomic_fetch_add(p, v, __ATOMIC_RELAXED, __HIP_MEMORY_SCOPE_AGENT); }
__device__ __forceinline__ unsigned xb_xcc_id() { return (unsigned)__builtin_amdgcn_s_getreg((3 << 11) | 20) & 0xFu; }
#define XB_SPIN(cond, bar) do { unsigned _sp = 0; while (cond) { __builtin_amdgcn_s_sleep(1); \
    if ((++_sp & 255u) == 0u) { if (xb_ld(&(bar)[XB_TMO])) break; if (_sp > XB_SPIN_CAP) { atomicAdd(&(bar)[XB_TMO], 1u); break; } } } } while (0)

struct XcdBarrier {
    unsigned* bar; unsigned x;
    volatile LAS unsigned* st;
};

__device__ __forceinline__ XcdBarrier xcd_barrier_post(unsigned* bar, volatile LAS unsigned* st) {
    XcdBarrier b; b.bar = bar; b.x = xb_xcc_id(); b.st = st;
    if (threadIdx.x == 0) st[2] = xb_add(&bar[XB_XCNT(b.x)], 1u);
    return b;
}
__device__ __forceinline__ void xcd_barrier_complete(unsigned* bar, unsigned x, unsigned& nloc, unsigned& nx) {
    const unsigned G = gridDim.x * gridDim.y * gridDim.z;
    unsigned sum, cnt, mine, sp = 0u;
    for (;;) {
        sum = 0u; cnt = 0u; mine = 0u;
#pragma unroll
        for (unsigned j = 0; j < 16; ++j) { const unsigned c = xb_ld(&bar[XB_XCNT(j)]); sum += c; cnt += (c > 0u) ? 1u : 0u; mine = (j == x) ? c : mine; }
        if (sum == G) break;
        __builtin_amdgcn_s_sleep(1);
        if ((++sp & 255u) == 0u) { if (xb_ld(&bar[XB_TMO])) break; if (sp > XB_SPIN_CAP) { atomicAdd(&bar[XB_TMO], 1u); break; } }
    }
    nloc = mine > 0u ? mine : 1u; nx = cnt > 0u ? cnt : 1u;
}

__device__ __forceinline__ void xcd_barrier(const XcdBarrier& b) {
    asm volatile("s_waitcnt vmcnt(0)" ::: "memory");
    __syncthreads();
    if (threadIdx.x == 0) {
        unsigned* bar = b.bar;
        __builtin_amdgcn_s_waitcnt(0);
        unsigned nloc = b.st[0], nx = b.st[1];
        if (nloc == 0u) { xcd_barrier_complete(bar, b.x, nloc, nx); b.st[0] = nloc; b.st[1] = nx; }
        const unsigned old = xb_add(&bar[XB_XSUB(b.x)], 1u);
        const unsigned gen = old / nloc;
        if (old + 1u == (gen + 1u) * nloc) {
            __builtin_amdgcn_fence(__ATOMIC_RELEASE, "agent");
            asm volatile("s_waitcnt vmcnt(0)" ::: "memory");
            const unsigned og = xb_add(&bar[XB_TOP], 1u);
            const unsigned tg = og / nx;
            if (og + 1u == (tg + 1u) * nx) xb_add(&bar[XB_TOPGEN], 1u);
            else XB_SPIN(xb_ld(&bar[XB_TOPGEN]) == tg, bar);
            __builtin_amdgcn_fence(__ATOMIC_ACQUIRE, "agent");
            xb_add(&bar[XB_XGEN(b.x)], 1u);
            asm volatile("s_waitcnt vmcnt(0)" ::: "memory");
        } else {
            XB_SPIN(xb_ld(&bar[XB_XGEN(b.x)]) == gen, bar);
            __builtin_amdgcn_fence(__ATOMIC_ACQUIRE, "agent");
            asm volatile("s_waitcnt vmcnt(0)" ::: "memory");
        }
    }
    __syncthreads();
}

}
namespace mk {
#define LAS __attribute__((address_space(3)))
typedef unsigned short bf16_t;
typedef short bf16x8 __attribute__((ext_vector_type(8)));
typedef short s16x4 __attribute__((ext_vector_type(4)));
typedef float f32x4 __attribute__((ext_vector_type(4)));
typedef float f32x16 __attribute__((ext_vector_type(16)));
typedef unsigned u32x4 __attribute__((ext_vector_type(4)));
typedef unsigned u32x2 __attribute__((ext_vector_type(2)));
constexpr int NB = 8, S = 4096, D = 1024, M = NB * S, NH = 4, DFF = 2816, DIN = 2560, NWAVES = 8;
constexpr float EPS = 1e-6f, LOG2E = 1.4426950408889634f;
constexpr float QSCALE = 0.125f * LOG2E;
constexpr size_t MiB = 1u << 20;
constexpr size_t WS_WIN = 1 * MiB, WS_WOUT = 6 * MiB, WS_WGU = 8 * MiB, WS_WDN = 19 * MiB, WS_RSS1 = 25 * MiB, WS_RSS2 = 27 * MiB;
constexpr size_t WS_XN = 32 * MiB, WS_Q = 96 * MiB, WS_KT = 128 * MiB, WS_VT = 160 * MiB, WS_XR = 192 * MiB, WS_GR = 224 * MiB, WS_HF = 256 * MiB, WS_MIXED = 320 * MiB, WS_ACT = 96 * MiB, WS_END = 384 * MiB;
static_assert(WS_ACT + (size_t)M * DFF * 2 <= WS_MIXED, "act overlays Q..HF only");
constexpr int RING_BYTES = 131072, LDS_MISC = 131072, LDS_BYTES = 147456;

__device__ __forceinline__ unsigned cvt_pk_bf16(float lo, float hi) { return pg8::cvt_pk_bf16(lo, hi); }
__device__ __forceinline__ float bf2f(unsigned short b) { return __uint_as_float(((unsigned)b) << 16); }
__device__ __forceinline__ float wave_sum(float v) {
#pragma unroll
    for (int o = 1; o < 64; o <<= 1) v += __shfl_xor(v, o);
    return v;
}
__device__ __forceinline__ float fast_sigmoid(float x) { return __builtin_amdgcn_rcpf(1.0f + __builtin_amdgcn_exp2f(-LOG2E * x)); }

template <int MAP  >
__device__ __forceinline__ void p0_transpose_item(const float* W, int K, int N, bf16_t* WT, const float* gk, LAS float* scr, int item, int lane) {
    const int nblk = N / 32, kb = item / nblk, nb = item % nblk, k0 = 64 * kb, n0 = 32 * nb;
#pragma unroll
    for (int i = 0; i < 32; ++i) { const int kk = 2 * i + (lane >> 5); float v = W[(size_t)(k0 + kk) * N + n0 + (lane & 31)]; if (gk) v *= gk[k0 + kk]; scr[kk * 33 + (lane & 31)] = v; }
    asm volatile("s_waitcnt lgkmcnt(0)" ::: "memory");
    const int c = lane & 7;
#pragma unroll
    for (int j = 0; j < 4; ++j) { const int n = (lane >> 3) + 8 * j; const LAS float* s = scr + (8 * c) * 33 + n;
        u32x4 o; o.x = cvt_pk_bf16(s[0 * 33], s[1 * 33]); o.y = cvt_pk_bf16(s[2 * 33], s[3 * 33]); o.z = cvt_pk_bf16(s[4 * 33], s[5 * 33]); o.w = cvt_pk_bf16(s[6 * 33], s[7 * 33]);
        const int f = n0 + n; const int drow = (MAP == 0) ? f : (256 * (f >> 7) + (f & 127) + (MAP == 2 ? 128 : 0));
        *(u32x4*)(WT + (size_t)drow * K + k0 + 8 * c) = o; }
    asm volatile("s_waitcnt lgkmcnt(0)" ::: "memory");
}
template <int NR>
__device__ __forceinline__ void rms_rows_to_bf16(const float* xrow, const float* g, bf16_t* orow, int lane) {
    const f32x4* gr = (const f32x4*)g + lane;
    f32x4 v[NR][4]; float s[NR];
#pragma unroll
    for (int q = 0; q < NR; ++q) { const f32x4* xr = (const f32x4*)(xrow + (size_t)q * D) + lane;
#pragma unroll
        for (int j = 0; j < 4; ++j) v[q][j] = __builtin_nontemporal_load(xr + 64 * j); }
#pragma unroll
    for (int q = 0; q < NR; ++q) { float a = 0.f;
#pragma unroll
        for (int j = 0; j < 4; ++j) a += (v[q][j][0] * v[q][j][0] + v[q][j][1] * v[q][j][1]) + (v[q][j][2] * v[q][j][2] + v[q][j][3] * v[q][j][3]);
        s[q] = a; }
#pragma unroll
    for (int o = 1; o < 64; o <<= 1)
#pragma unroll
        for (int q = 0; q < NR; ++q) s[q] += __shfl_xor(s[q], o);
    f32x4 gg[4];
#pragma unroll
    for (int j = 0; j < 4; ++j) gg[j] = gr[64 * j];
#pragma unroll
    for (int q = 0; q < NR; ++q) { const float rstd = 1.0f / sqrtf(s[q] * (1.f / D) + EPS); u32x2* o8 = (u32x2*)(orow + (size_t)q * D) + lane;
#pragma unroll
        for (int j = 0; j < 4; ++j) { u32x2 w; w.x = cvt_pk_bf16(v[q][j][0] * rstd * gg[j][0], v[q][j][1] * rstd * gg[j][1]); w.y = cvt_pk_bf16(v[q][j][2] * rstd * gg[j][2], v[q][j][3] * rstd * gg[j][3]); o8[64 * j] = w; } }
}

namespace att {
constexpr int NT = S / 64, SLOT = 16384, LDS_K = 0, LDS_V = 3 * SLOT, LDS_OST = 4 * SLOT, LDS_X = 0;
constexpr int LDS_WSF = LDS_MISC, LDS_BIAS = LDS_MISC + 2048, LDS_TOT = LDS_MISC + 3072, LDS_CW = LDS_MISC + 5120, LDS_BIAS2 = LDS_MISC + 8704;
constexpr int THR = 8;
typedef LAS const char* lds_cptr;
typedef short v4i16_t __attribute__((ext_vector_type(4)));
__device__ __forceinline__ int crow(int r, int hi) { return (r & 3) + 8 * (r >> 2) + 4 * hi; }
__device__ __forceinline__ void glds16(const void* gsrc, unsigned lds_dst) { unsigned keep;
    asm volatile("s_mov_b32 %0, m0\n\ts_mov_b32 m0, %2\n\ts_nop 0\n\tglobal_load_lds_dwordx4 %1, off\n\ts_mov_b32 m0, %0" : "=&s"(keep) : "v"(gsrc), "s"(lds_dst) : "memory"); }
__device__ __forceinline__ s16x4 vtr(lds_cptr p) { return __builtin_bit_cast(s16x4, __builtin_amdgcn_ds_read_tr16_b64_v4i16((LAS v4i16_t*)p)); }
#define ATT_MX3(a, b, c) __builtin_fmaxf(__builtin_fmaxf((a), (b)), (c))
__device__ __forceinline__ float rowmax(const f32x16& p0, const f32x16& p1) {
    float a = ATT_MX3(p0[0], p0[1], p1[0]), b = ATT_MX3(p0[2], p0[3], p1[1]); a = ATT_MX3(a, p1[2], p1[3]);
#pragma unroll
    for (int r = 4; r < 16; r += 4) { a = ATT_MX3(a, p0[r], p0[r + 1]); b = ATT_MX3(b, p0[r + 2], p0[r + 3]); a = ATT_MX3(a, p1[r], p1[r + 1]); b = ATT_MX3(b, p1[r + 2], p1[r + 3]); }
    float m = __builtin_fmaxf(a, b); auto rr = __builtin_amdgcn_permlane32_swap(__float_as_uint(m), __float_as_uint(m), false, false);
    return __builtin_fmaxf(__uint_as_float(rr[0]), __uint_as_float(rr[1]));
}
#define ATT_WAIT_BAR(N) asm volatile("s_waitcnt vmcnt(" #N ") lgkmcnt(0)\n\ts_barrier" ::: "memory")
#define ATT_MFMA(a, b, c) __builtin_amdgcn_mfma_f32_32x32x16_bf16(a, b, c, 0, 0, 0)

template <bool FIRST>
__device__ __forceinline__ void tile_h1(int t, lds_cptr kp, const bf16x8 (&qr)[4], f32x16 (&o)[4], u32x4 (&pw)[4], float& mhat, float& l_reg,
                                        LAS float* wsf, const LAS float* btab, int qrow, int qw0, float c_left, float c_right, int r32, int hi) {
    const int relmin = 64 * t - qw0 - 31, relmax = 64 * t + 63 - qw0;
    const bool band = !(relmax <= -91 || relmin >= 91);
    const float cb = band ? 0.f : (relmin >= 91 ? c_right : c_left);
    f32x16 p0, p1;
    const f32x16 z16 = (f32x16){0.f, 0.f, 0.f, 0.f, 0.f, 0.f, 0.f, 0.f, 0.f, 0.f, 0.f, 0.f, 0.f, 0.f, 0.f, 0.f};
#pragma unroll
    for (int d0 = 0; d0 < 4; ++d0) {
        const bf16x8 k0 = *(const LAS bf16x8*)(kp + d0 * 2048), k1 = *(const LAS bf16x8*)(kp + d0 * 2048 + 512);
        if (d0 == 0) { p0 = ATT_MFMA(k0, qr[0], z16); p1 = ATT_MFMA(k1, qr[0], z16); }
        else { p0 = ATT_MFMA(k0, qr[d0], p0); p1 = ATT_MFMA(k1, qr[d0], p1); }
    }
    if (band) {
        const int relb = 64 * t + 4 * hi - qrow + 128;
#pragma unroll
        for (int r = 0; r < 16; ++r) { const int i0 = relb + (r & 3) + 8 * (r >> 2); const int a0 = i0 < 0 ? 0 : (i0 > 255 ? 255 : i0); const int i1 = i0 + 32; const int a1 = i1 < 0 ? 0 : (i1 > 255 ? 255 : i1);
            p0[r] += btab[a0]; p1[r] += btab[a1]; }
    }
    const float rm = rowmax(p0, p1) + cb;
    if (FIRST) { mhat = rm; }
    else if (__builtin_expect(__any(rm - mhat > (float)THR), 0)) {
        const float dl = __builtin_fmaxf(rm - mhat, 0.f); mhat += dl;
        const float f = __builtin_amdgcn_exp2f(-dl); l_reg *= f;
        if (hi == 0) wsf[r32] = f;
        asm volatile("s_waitcnt lgkmcnt(0)" ::: "memory");
        float fr[16];
#pragma unroll
        for (int r = 0; r < 16; ++r) fr[r] = wsf[crow(r, hi)];
#pragma unroll
        for (int db = 0; db < 4; ++db)
#pragma unroll
            for (int r = 0; r < 16; ++r) o[db][r] *= fr[r];
        asm volatile("s_waitcnt lgkmcnt(0)" ::: "memory");
    }
    const float off = cb - mhat;
    float sacc = 0.f;
#pragma unroll
    for (int r = 0; r < 16; ++r) { p0[r] = __builtin_amdgcn_exp2f(p0[r] + off); p1[r] = __builtin_amdgcn_exp2f(p1[r] + off); sacc += p0[r] + p1[r]; }
    l_reg += sacc;
#pragma unroll
    for (int ks = 0; ks < 4; ++ks) { const f32x16& P = (ks < 2) ? p0 : p1; const int b = 8 * (ks & 1);
        pw[ks] = (u32x4){cvt_pk_bf16(P[b], P[b + 1]), cvt_pk_bf16(P[b + 2], P[b + 3]), cvt_pk_bf16(P[b + 4], P[b + 5]), cvt_pk_bf16(P[b + 6], P[b + 7])}; }
}
__device__ __forceinline__ void tile_h2(lds_cptr vp, f32x16 (&o)[4], const u32x4 (&pw)[4]) {
#pragma unroll
    for (int ks = 0; ks < 4; ++ks)
#pragma unroll
        for (int db = 0; db < 4; ++db) {
            const s16x4 lo = vtr(vp + db * 4096 + ks * 1024), h4 = vtr(vp + db * 4096 + ks * 1024 + 512);
            const bf16x8 vf = (bf16x8){lo[0], lo[1], lo[2], lo[3], h4[0], h4[1], h4[2], h4[3]};
            o[db] = ATT_MFMA(__builtin_bit_cast(bf16x8, pw[ks]), vf, o[db]);
        }
}

struct VFrag { s16x4 lo, hi; };
template <int I> __device__ __forceinline__ VFrag vload(lds_cptr vp) {
    constexpr int off_ = (I & 3) * 4096 + (I >> 2) * 1024; VFrag f; f.lo = vtr(vp + off_); f.hi = vtr(vp + off_ + 512); return f;
}
__device__ __forceinline__ void attn_unit(int b, int h, int qb, const bf16_t* Q, const bf16_t* KT, const bf16_t* VT, bf16_t* MIXED, LAS unsigned char* lds, float lam, const float* subln_g, const float* rel_bias) {
    const int tid = threadIdx.x, lane = tid & 63, r32 = lane & 31, hi = lane >> 5; const int wid = __builtin_amdgcn_readfirstlane(tid >> 6);
    const int wq = wid & 3, mp = wid >> 2;
    const size_t rowbase = (size_t)b * S; const int q0 = qb * 128, qw0 = q0 + 32 * wq, qrow = qw0 + r32;
    LAS float* btab = (LAS float*)(lds + LDS_BIAS2); LAS float* wsf = (LAS float*)(lds + LDS_WSF) + wid * 64;
    { const int rel = tid - 256; const int n = rel < 0 ? -rel : rel; int bk; if (n < 8) bk = n; else { bk = 2 + (31 - __clz(n * n)); if (bk > 15) bk = 15; } if (rel > 0) bk += 16;
        btab[tid] = rel_bias[bk * NH + h] * LOG2E; }
    const float c_left = rel_bias[15 * NH + h] * LOG2E, c_right = rel_bias[31 * NH + h] * LOG2E;
    const bf16_t* Qw = Q + (rowbase + qw0) * 512 + h * 128 + mp * 64;
    bf16x8 qr[4];
#pragma unroll
    for (int d0 = 0; d0 < 4; ++d0) qr[d0] = *(const bf16x8*)(Qw + (size_t)r32 * 512 + d0 * 16 + hi * 8);
    const char* k1src = (const char*)KT + ((size_t)((b * 4 + h) * 2) * 64) * 8192 + wid * 1024 + lane * 16;
    const char* k2src = k1src + (size_t)64 * 8192;
    const char* vsrc = (const char*)VT + ((size_t)(b * 4 + h) * 64) * 16384 + wid * 1024 + lane * 16;
    const unsigned lds0 = (unsigned)(uintptr_t)(unsigned char*)lds;
    const unsigned kdst = lds0 + LDS_K + wid * 1024, vdst = lds0 + LDS_V + wid * 1024;
    const lds_cptr kp0 = (lds_cptr)lds + LDS_K + mp * 8192 + hi * 1024 + r32 * 16;
    const lds_cptr vp0 = (lds_cptr)lds + LDS_V + ((lane >> 4) & 1) * 32 + (lane & 3) * 8 + (4 * hi + ((lane & 15) >> 2)) * 64;
#define ATT_DMA_TILE(t, ks_, vs_) do { glds16(k1src + (size_t)(t) * 8192, (unsigned)__builtin_amdgcn_readfirstlane(kdst + (ks_))); glds16(k2src + (size_t)(t) * 8192, (unsigned)__builtin_amdgcn_readfirstlane(kdst + (ks_) + 8192)); \
        glds16(vsrc + (size_t)(t) * 16384, (unsigned)__builtin_amdgcn_readfirstlane(vdst + (vs_))); glds16(vsrc + (size_t)(t) * 16384 + 8192, (unsigned)__builtin_amdgcn_readfirstlane(vdst + (vs_) + 8192)); } while (0)
    ATT_DMA_TILE(0, 0, 0); ATT_DMA_TILE(1, SLOT, SLOT);
    float mhat = 0.f, l_reg = 0.f; f32x16 o[4]; u32x4 pw[4];
#pragma unroll
    for (int db = 0; db < 4; ++db)
#pragma unroll
        for (int r = 0; r < 16; ++r) o[db][r] = 0.f;
    int ksl = 0, ksl2 = 2 * SLOT, vsl = 0, vsl2 = 2 * SLOT, vprev = 0;
#define ATT_ROT() do { ksl = (ksl == 2 * SLOT) ? 0 : ksl + SLOT; ksl2 = (ksl2 == 2 * SLOT) ? 0 : ksl2 + SLOT; vprev = vsl; vsl = (vsl + SLOT) & (4 * SLOT - 1); vsl2 = (vsl2 + SLOT) & (4 * SLOT - 1); } while (0)
#define ATT_SB() __builtin_amdgcn_sched_barrier(0)
#define ATT_PIN(x) asm volatile("" : "+v"(x))
#define ATT_F(T0, T1, e) (((e) < 16) ? T0[(e) & 15] : T1[(e) & 15])
#define ATT_KRD(f) (*(const LAS bf16x8*)(kp_ + ((f) >> 1) * 2048 + ((f) & 1) * 512))
    const f32x16 z16 = (f32x16){0.f, 0.f, 0.f, 0.f, 0.f, 0.f, 0.f, 0.f, 0.f, 0.f, 0.f, 0.f, 0.f, 0.f, 0.f, 0.f};
#define ATT_GA(C0, C1, P0, P1, f) do { \
        if (((f) & 1) == 0) C0 = ATT_MFMA(kq[(f) % 3], qr[(f) >> 1], ((f) < 2) ? z16 : C0); else C1 = ATT_MFMA(kq[(f) % 3], qr[(f) >> 1], ((f) < 2) ? z16 : C1); \
        if ((f) + 3 < 8) kq[(f) % 3] = ATT_KRD((f) + 3); \
        sacc += ATT_F(P0, P1, 4 * (f)); sacc += ATT_F(P0, P1, 4 * (f) + 1); sacc += ATT_F(P0, P1, 4 * (f) + 2); sacc += ATT_F(P0, P1, 4 * (f) + 3); ATT_PIN(sacc); \
        pw[(f) >> 1][2 * ((f) & 1)] = cvt_pk_bf16(ATT_F(P0, P1, 4 * (f)), ATT_F(P0, P1, 4 * (f) + 1)); pw[(f) >> 1][2 * ((f) & 1) + 1] = cvt_pk_bf16(ATT_F(P0, P1, 4 * (f) + 2), ATT_F(P0, P1, 4 * (f) + 3)); ATT_PIN(pw[(f) >> 1]); \
        ATT_SB(); } while (0)
#define ATT_VRD(I) vload<(I) & 15>(vp_)
#define ATT_GBF(I, FILL) do { \
        { const VFrag& vv = vq[(I) % 3]; const bf16x8 vf = (bf16x8){vv.lo[0], vv.lo[1], vv.lo[2], vv.lo[3], vv.hi[0], vv.hi[1], vv.hi[2], vv.hi[3]}; \
          o[(I) & 3] = ATT_MFMA(__builtin_bit_cast(bf16x8, pw[(I) >> 2]), vf, o[(I) & 3]); } \
        if ((I) + 3 < 16) vq[(I) % 3] = ATT_VRD((I) + 3); \
        FILL; ATT_SB(); } while (0)
#define ATT_EX(C0, C1, e) do { if ((e) < 16) { C0[(e) & 15] = __builtin_amdgcn_exp2f(C0[(e) & 15] + off); } else { C1[(e) & 15] = __builtin_amdgcn_exp2f(C1[(e) & 15] + off); } } while (0)
#define ATT_EX3(C0, C1, e) do { ATT_EX(C0, C1, e); ATT_EX(C0, C1, (e) + 1); ATT_EX(C0, C1, (e) + 2); ATT_PIN(C0); ATT_PIN(C1); } while (0)
#define ATT_EX2(C0, C1, e) do { ATT_EX(C0, C1, e); ATT_EX(C0, C1, (e) + 1); ATT_PIN(C0); ATT_PIN(C1); } while (0)
#define ATT_MX3(a, b, c) __builtin_fmaxf(__builtin_fmaxf((a), (b)), (c))
#define ATT_BIAS(C0, C1, t) \
        const int relmin_ = 64 * (t) - qw0 - 31, relmax_ = 64 * (t) + 63 - qw0; const bool band_ = !(relmax_ <= -91 || relmin_ >= 91); const float cb_ = band_ ? 0.f : (relmin_ >= 91 ? c_right : c_left); \
        if (band_) { const LAS float* bp_ = btab + (64 * (t) + 4 * hi - qrow + 256);       \
            _Pragma("unroll") for (int r = 0; r < 16; ++r) { C0[r] += bp_[(r & 3) + 8 * (r >> 2)]; C1[r] += bp_[(r & 3) + 8 * (r >> 2) + 32]; } }
#define ATT_MAXP(C0, C1, g) do { if ((g) == 0) { ma_ = ATT_MX3(C0[0], C0[1], C1[0]); mb_ = ATT_MX3(C0[2], C0[3], C1[1]); ma_ = ATT_MX3(ma_, C1[2], C1[3]); } \
        else { ma_ = ATT_MX3(ma_, C0[4 * (g)], C0[4 * (g) + 1]); mb_ = ATT_MX3(mb_, C0[4 * (g) + 2], C0[4 * (g) + 3]); ma_ = ATT_MX3(ma_, C1[4 * (g)], C1[4 * (g) + 1]); mb_ = ATT_MX3(mb_, C1[4 * (g) + 2], C1[4 * (g) + 3]); } \
        ATT_PIN(ma_); ATT_PIN(mb_); } while (0)
#define ATT_DECIDE2(FIRST_) do { float rm_ = __builtin_fmaxf(ma_, mb_); { auto rr = __builtin_amdgcn_permlane32_swap(__float_as_uint(rm_), __float_as_uint(rm_), false, false); rm_ = __builtin_fmaxf(__uint_as_float(rr[0]), __uint_as_float(rr[1])); } \
        rm_ += cb_; resc = false; \
        if (FIRST_) { mhat = rm_; } \
        else if (__builtin_expect(__any(rm_ - mhat > (float)THR), 0)) { const float dl_ = __builtin_fmaxf(rm_ - mhat, 0.f); mhat += dl_; const float f_ = __builtin_amdgcn_exp2f(-dl_); l_reg *= f_; if (hi == 0) wsf[r32] = f_; resc = true; } \
        off = cb_ - mhat; ATT_SB(); } while (0)
#define ATT_RESC() do { if (resc) { asm volatile("s_waitcnt lgkmcnt(0)" ::: "memory"); float fr_[16]; \
        _Pragma("unroll") for (int r = 0; r < 16; ++r) fr_[r] = wsf[crow(r, hi)]; \
        _Pragma("unroll") for (int db = 0; db < 4; ++db) _Pragma("unroll") for (int r = 0; r < 16; ++r) o[db][r] *= fr_[r]; \
        asm volatile("s_waitcnt lgkmcnt(0)" ::: "memory"); } } while (0)
#define ATT_STEP(C0, C1, P0, P1, t) do { \
        const lds_cptr kp_ = kp0 + ksl; const lds_cptr vp_ = vp0 + vprev; float sacc = 0.f, ma_, mb_; \
        kq[0] = ATT_KRD(0); kq[1] = ATT_KRD(1); kq[2] = ATT_KRD(2); ATT_SB(); \
        ATT_GA(C0, C1, P0, P1, 0); ATT_GA(C0, C1, P0, P1, 1); ATT_GA(C0, C1, P0, P1, 2); ATT_GA(C0, C1, P0, P1, 3); \
        vq[0] = ATT_VRD(0); vq[1] = ATT_VRD(1); vq[2] = ATT_VRD(2); ATT_SB(); \
        ATT_GA(C0, C1, P0, P1, 4); ATT_GA(C0, C1, P0, P1, 5); ATT_GA(C0, C1, P0, P1, 6); ATT_GA(C0, C1, P0, P1, 7); \
        l_reg += sacc; \
        ATT_BIAS(C0, C1, t) ATT_SB(); \
        ATT_GBF(0, ATT_MAXP(C0, C1, 0)); ATT_GBF(1, ATT_MAXP(C0, C1, 1)); ATT_GBF(2, ATT_MAXP(C0, C1, 2)); ATT_GBF(3, ATT_MAXP(C0, C1, 3)); \
        ATT_DECIDE2(false); \
        ATT_GBF(4, ATT_EX3(C0, C1, 0)); ATT_GBF(5, ATT_EX3(C0, C1, 3)); ATT_GBF(6, ATT_EX3(C0, C1, 6)); ATT_GBF(7, ATT_EX3(C0, C1, 9)); \
        ATT_GBF(8, ATT_EX3(C0, C1, 12)); ATT_GBF(9, ATT_EX3(C0, C1, 15)); ATT_GBF(10, ATT_EX3(C0, C1, 18)); ATT_GBF(11, ATT_EX3(C0, C1, 21)); \
        ATT_GBF(12, ATT_EX2(C0, C1, 24)); ATT_GBF(13, ATT_EX2(C0, C1, 26)); ATT_GBF(14, ATT_EX2(C0, C1, 28)); ATT_GBF(15, ATT_EX2(C0, C1, 30)); \
        ATT_RESC(); ATT_ROT(); } while (0)
    f32x16 sa0, sa1, sb0, sb1; bf16x8 kq[3]; VFrag vq[3]; float off = 0.f; bool resc = false;
    ATT_WAIT_BAR(4); ATT_DMA_TILE(2, ksl2, vsl2);
    { const lds_cptr kp_ = kp0 + ksl;
#pragma unroll
      for (int d0 = 0; d0 < 4; ++d0) { const bf16x8 k0 = ATT_KRD(2 * d0), k1 = ATT_KRD(2 * d0 + 1);
          if (d0 == 0) { sa0 = ATT_MFMA(k0, qr[0], z16); sa1 = ATT_MFMA(k1, qr[0], z16); } else { sa0 = ATT_MFMA(k0, qr[d0], sa0); sa1 = ATT_MFMA(k1, qr[d0], sa1); } }
      float ma_, mb_; ATT_BIAS(sa0, sa1, 0) ATT_MAXP(sa0, sa1, 0); ATT_MAXP(sa0, sa1, 1); ATT_MAXP(sa0, sa1, 2); ATT_MAXP(sa0, sa1, 3); ATT_DECIDE2(true);
#pragma unroll
      for (int r = 0; r < 16; ++r) { sa0[r] = __builtin_amdgcn_exp2f(sa0[r] + off); sa1[r] = __builtin_amdgcn_exp2f(sa1[r] + off); }
      ATT_ROT(); }
    for (int t = 1; t < NT - 3; t += 2) {
        ATT_WAIT_BAR(4); ATT_DMA_TILE(t + 2, ksl2, vsl2); ATT_STEP(sb0, sb1, sa0, sa1, t);
        ATT_WAIT_BAR(4); ATT_DMA_TILE(t + 3, ksl2, vsl2); ATT_STEP(sa0, sa1, sb0, sb1, t + 1);
    }
    ATT_WAIT_BAR(4); ATT_DMA_TILE(NT - 1, ksl2, vsl2); ATT_STEP(sb0, sb1, sa0, sa1, NT - 3);
    ATT_WAIT_BAR(4); ATT_STEP(sa0, sa1, sb0, sb1, NT - 2);
    ATT_WAIT_BAR(0); ATT_STEP(sb0, sb1, sa0, sa1, NT - 1);
    { float sacc = 0.f;
#pragma unroll
      for (int r = 0; r < 16; ++r) sacc += sb0[r] + sb1[r];
      l_reg += sacc;
#pragma unroll
      for (int g = 0; g < 16; ++g) pw[g >> 2][g & 3] = cvt_pk_bf16(ATT_F(sb0, sb1, 2 * g), ATT_F(sb0, sb1, 2 * g + 1));
      const lds_cptr vp_ = vp0 + vprev;
#pragma unroll
      for (int ks = 0; ks < 4; ++ks)
#pragma unroll
          for (int db = 0; db < 4; ++db) { const s16x4 lo = vtr(vp_ + db * 4096 + ks * 1024), h4 = vtr(vp_ + db * 4096 + ks * 1024 + 512);
              const bf16x8 vf = (bf16x8){lo[0], lo[1], lo[2], lo[3], h4[0], h4[1], h4[2], h4[3]}; o[db] = ATT_MFMA(__builtin_bit_cast(bf16x8, pw[ks]), vf, o[db]); } }
#undef ATT_STEP
#undef ATT_RESC
#undef ATT_DECIDE2
#undef ATT_MAXP
#undef ATT_BIAS
#undef ATT_EX2
#undef ATT_EX3
#undef ATT_EX
#undef ATT_GBF
#undef ATT_GA
#undef ATT_VRD
#undef ATT_KRD
#undef ATT_F
#undef ATT_PIN
#undef ATT_SB
    { auto rr = __builtin_amdgcn_permlane32_swap(__float_as_uint(l_reg), __float_as_uint(l_reg), false, false); l_reg = __uint_as_float(rr[0]) + __uint_as_float(rr[1]); }
    const float scale_q = (mp == 0 ? 1.0f : lam) * __builtin_amdgcn_rcpf(l_reg);
    if (hi == 0) wsf[r32] = scale_q;
    asm volatile("s_waitcnt lgkmcnt(0)" ::: "memory");
    float sc[16];
#pragma unroll
    for (int r = 0; r < 16; ++r) sc[r] = wsf[crow(r, hi)];
    asm volatile("s_waitcnt lgkmcnt(0)\n\ts_barrier" ::: "memory");
    LAS float* X = (LAS float*)(lds + LDS_X) + wq * 4096 + lane;
    if (mp == 1) {
#pragma unroll
        for (int db = 0; db < 4; ++db)
#pragma unroll
            for (int r = 0; r < 16; ++r) X[(db * 16 + r) * 64] = o[db][r] * sc[r];
    }
    asm volatile("s_waitcnt lgkmcnt(0)\n\ts_barrier" ::: "memory");
    if (mp == 0) {
        float ss[16];
#pragma unroll
        for (int r = 0; r < 16; ++r) ss[r] = 0.f;
#pragma unroll
        for (int db = 0; db < 4; ++db)
#pragma unroll
            for (int r = 0; r < 16; ++r) { const float d = o[db][r] * sc[r] - X[(db * 16 + r) * 64]; o[db][r] = d; ss[r] += d * d; }
#pragma unroll
        for (int r = 0; r < 16; ++r) {
#pragma unroll
            for (int x = 1; x < 32; x <<= 1) ss[r] += __shfl_xor(ss[r], x);
            ss[r] = __builtin_amdgcn_rsqf(ss[r] * (1.0f / 128.0f) + EPS) * 0.8f;
        }
        LAS bf16_t* stg = (LAS bf16_t*)(lds + LDS_OST) + wq * 4096;
#pragma unroll
        for (int db = 0; db < 4; ++db) { const float g = subln_g[db * 32 + r32];
#pragma unroll
            for (int r = 0; r < 16; ++r) { const unsigned w = cvt_pk_bf16(o[db][r] * ss[r] * g, 0.f); stg[crow(r, hi) * 128 + db * 32 + r32] = (bf16_t)(w & 0xffffu); } }
        asm volatile("s_waitcnt lgkmcnt(0)" ::: "memory");
        bf16_t* Ow = MIXED + (rowbase + qw0) * 1024 + h * 128;
#pragma unroll
        for (int i = 0; i < 8; ++i) { const int row = i * 4 + (lane >> 4), ch = lane & 15; const u32x4 v = *(const LAS u32x4*)(stg + row * 128 + ch * 8); *(u32x4*)(Ow + (size_t)row * 1024 + ch * 8) = v; }
    }
    asm volatile("s_waitcnt vmcnt(0) lgkmcnt(0)\n\ts_barrier" ::: "memory");
#undef ATT_DMA_TILE
#undef ATT_ROT
}
}

namespace lru {
template <int N> __device__ __forceinline__ float dpp_shr(float v, float ident) {
    return __int_as_float(__builtin_amdgcn_update_dpp(__float_as_int(ident), __float_as_int(v), 0x110 + N, 0xF, 0xF, false));
}
#define LRU_MFMA16(a, b, c) __builtin_amdgcn_mfma_f32_16x16x32_bf16(a, b, c, 0, 0, 0)
__device__ __forceinline__ void lru_rows(bf16x8 (&rowv)[2][7], __amdgpu_buffer_rsrc_t xsrd, int dir, int Pb, int ch0) {
#pragma unroll
    for (int k = 0; k < 7; ++k) {
        const int tt = dir ? (S - Pb - k) : (Pb - 2 + k);
#pragma unroll
        for (int ks = 0; ks < 2; ++ks) rowv[ks][k] = __builtin_bit_cast(bf16x8, __builtin_amdgcn_raw_buffer_load_b128(xsrd, (tt * 512 + ch0 + 32 * ks) * 2, 0, 0));
    }
}
__device__ __forceinline__ void lru_item(int b, int cg, const bf16_t* XR, const bf16_t* GR, float* HF, bf16_t* MIXED, LAS unsigned char* lds,
                                         const float* conv_w, const float* conv_b, const float* w_rg, const float* b_rg, const float* w_ig, const float* b_ig, const float* lru_lambda) {
    const int tid = threadIdx.x, lane = tid & 63, p = lane & 15, g = lane >> 4; const int wid = __builtin_amdgcn_readfirstlane(tid >> 6);
    const int n = cg >> 2, e16 = cg & 3, c0 = n * 64 + e16 * 16;
    const size_t rowbase = (size_t)b * S;
    const __amdgpu_buffer_rsrc_t XRb = __builtin_amdgcn_make_buffer_rsrc((void*)(XR + rowbase * 512), (short)0, S * 512 * 2, 0x00020000); const int ch0 = n * 64 + 8 * g;
    LAS float* tot = (LAS float*)(lds + att::LDS_TOT);
    bf16x8 idf;
#pragma unroll
    for (int j = 0; j < 8; ++j) idf[j] = ((8 * g + j) == (16 * (e16 & 1) + p)) ? (short)0x3f80 : (short)0;
    int par = 0;
    LAS float* cwl = (LAS float*)(lds + att::LDS_CW);
    if (tid < 320) { const int j = tid >> 6, c = tid & 63; cwl[tid] = (j < 4) ? conv_w[j * 512 + n * 64 + c] : conv_b[n * 64 + c]; }
    __syncthreads();
    for (int dir = 0; dir < 2; ++dir) {
        bf16x8 wrf[2], wif[2];
#pragma unroll
        for (int ks = 0; ks < 2; ++ks) {
            unsigned wr_[4], wi_[4];
#pragma unroll
            for (int j2 = 0; j2 < 4; ++j2) { const int d = 32 * ks + 8 * g + 2 * j2; const size_t i0 = ((size_t)((dir * 8 + n) * 64 + d)) * 64 + e16 * 16 + p;
                wr_[j2] = cvt_pk_bf16(w_rg[i0], w_rg[i0 + 64]); wi_[j2] = cvt_pk_bf16(w_ig[i0], w_ig[i0 + 64]); }
            wrf[ks] = __builtin_bit_cast(bf16x8, (u32x4){wr_[0], wr_[1], wr_[2], wr_[3]}); wif[ks] = __builtin_bit_cast(bf16x8, (u32x4){wi_[0], wi_[1], wi_[2], wi_[3]});
        }
        float br[4], bi[4], sp8[4], carry[4];
#pragma unroll
        for (int r = 0; r < 4; ++r) { const int c = dir * 512 + c0 + 4 * g + r; br[r] = b_rg[c] * -LOG2E; bi[r] = b_ig[c] * -LOG2E; const float lm = lru_lambda[c]; sp8[r] = 8.0f * LOG2E * ((-lm > 20.0f) ? -lm : log1pf(expf(-lm)));     carry[r] = 0.f; }
        LAS u32x4* lst = (LAS u32x4*)lds + tid;
        lst[0 * 512] = __builtin_bit_cast(u32x4, wrf[0]); lst[1 * 512] = __builtin_bit_cast(u32x4, wrf[1]); lst[2 * 512] = __builtin_bit_cast(u32x4, wif[0]); lst[3 * 512] = __builtin_bit_cast(u32x4, wif[1]);
        lst[4 * 512] = __builtin_bit_cast(u32x4, (f32x4){br[0], br[1], br[2], br[3]}); lst[5 * 512] = __builtin_bit_cast(u32x4, (f32x4){bi[0], bi[1], bi[2], bi[3]}); lst[6 * 512] = __builtin_bit_cast(u32x4, (f32x4){sp8[0], sp8[1], sp8[2], sp8[3]}); lst[7 * 512] = __builtin_bit_cast(u32x4, idf);
        for (int sc = 0; sc < 8; ++sc) {
            const int P0 = sc * 512 + wid * 64, Pb = P0 + 4 * p;
            f32x4 ar[4], ai[4], ax[4];
            {
                bf16x8 rowv[2][7];
                lru_rows(rowv, XRb, dir, Pb, ch0);
                int zoff = 0; asm volatile("" : "+v"(zoff));
                const LAS float* cwi = cwl + zoff;
                const LAS u32x4* lsi = (const LAS u32x4*)lds + tid + zoff;
                const bf16x8 wrf0 = __builtin_bit_cast(bf16x8, lsi[0 * 512]), wrf1 = __builtin_bit_cast(bf16x8, lsi[1 * 512]), wif0 = __builtin_bit_cast(bf16x8, lsi[2 * 512]), wif1 = __builtin_bit_cast(bf16x8, lsi[3 * 512]), idf_ = __builtin_bit_cast(bf16x8, lsi[7 * 512]);
                u32x4 xfu[4][2];
#pragma unroll
                for (int ks = 0; ks < 2; ++ks) {
#pragma unroll
                    for (int eh = 0; eh < 2; ++eh) {
                        const int cl4 = 32 * ks + 8 * g + 4 * eh;
                        f32x4 wj[4];
#pragma unroll
                        for (int j = 0; j < 4; ++j) wj[j] = *(const LAS f32x4*)(cwi + (dir ? 3 - j : j) * 64 + cl4);
                        const f32x4 bb = *(const LAS f32x4*)(cwi + 256 + cl4);
                        f32x4 xr[7];
#pragma unroll
                        for (int k = 0; k < 7; ++k) { const u32x4 rw = __builtin_bit_cast(u32x4, rowv[ks][k]); const unsigned d0 = rw[2 * eh], d1 = rw[2 * eh + 1];
                            xr[k] = (f32x4){__uint_as_float(d0 << 16), __uint_as_float(d0 & 0xffff0000u), __uint_as_float(d1 << 16), __uint_as_float(d1 & 0xffff0000u)}; }
#pragma unroll
                        for (int i = 0; i < 4; ++i) {
                            f32x4 a4 = bb;
#pragma unroll
                            for (int j = 0; j < 4; ++j) a4 += wj[j] * xr[i + j];
                            xfu[i][ks][2 * eh] = cvt_pk_bf16(a4[0], a4[1]); xfu[i][ks][2 * eh + 1] = cvt_pk_bf16(a4[2], a4[3]);
                        }
                        __builtin_amdgcn_sched_barrier(0);
                    }
                }
                bf16x8 xf[4][2];
#pragma unroll
                for (int i = 0; i < 4; ++i) { xf[i][0] = __builtin_bit_cast(bf16x8, xfu[i][0]); xf[i][1] = __builtin_bit_cast(bf16x8, xfu[i][1]); }
                const f32x4 z = (f32x4){0.f, 0.f, 0.f, 0.f};
#pragma unroll
                for (int i = 0; i < 4; ++i) {
                    ar[i] = LRU_MFMA16(wrf0, xf[i][0], z); ar[i] = LRU_MFMA16(wrf1, xf[i][1], ar[i]);
                    ai[i] = LRU_MFMA16(wif0, xf[i][0], z); ai[i] = LRU_MFMA16(wif1, xf[i][1], ai[i]);
                    ax[i] = LRU_MFMA16(idf_, (e16 & 2) ? xf[i][1] : xf[i][0], z);
                }
            }
            float hh[4][4], cpp[4][4], Al[4], Hl[4];
            int zoff2 = 0; asm volatile("" : "+v"(zoff2));
            const LAS f32x4* lsg = (const LAS f32x4*)lds + tid + zoff2;
            const f32x4 brv = lsg[4 * 512], biv = lsg[5 * 512], spv = lsg[6 * 512];
#pragma unroll
            for (int r = 0; r < 4; ++r) {
                float h = 0.f, cp = 1.f;
#pragma unroll
                for (int i = 0; i < 4; ++i) {
                    const float rg = __builtin_amdgcn_rcpf(1.0f + __builtin_amdgcn_exp2f(ar[i][r] * -LOG2E + brv[r])), ig = __builtin_amdgcn_rcpf(1.0f + __builtin_amdgcn_exp2f(ai[i][r] * -LOG2E + biv[r]));
                    const float a_ = __builtin_amdgcn_exp2f(-rg * spv[r]);
                    const float om = __builtin_fmaf(-a_, a_, 1.0f);
                    const float u_ = __builtin_amdgcn_sqrtf(om) * (ig * ax[i][r]);
                    h = a_ * h + u_; cp = a_ * cp; hh[i][r] = h; cpp[i][r] = cp;
                }
                Al[r] = cp; Hl[r] = h;
            }
#define LRU_KS(NN) do { _Pragma("unroll") for (int r = 0; r < 4; ++r) { const float Ap = dpp_shr<NN>(Al[r], 1.0f), Hp = dpp_shr<NN>(Hl[r], 0.0f); Hl[r] = Al[r] * Hp + Hl[r]; Al[r] = Al[r] * Ap; } } while (0)
            LRU_KS(1); LRU_KS(2); LRU_KS(4); LRU_KS(8);
#undef LRU_KS
            float Aex[4], Hex[4];
#pragma unroll
            for (int r = 0; r < 4; ++r) { Aex[r] = dpp_shr<1>(Al[r], 1.0f); Hex[r] = dpp_shr<1>(Hl[r], 0.0f); }
            if (p == 15) {
#pragma unroll
                for (int r = 0; r < 4; ++r) { tot[((par * 8 + wid) * 16 + 4 * g + r) * 2] = Al[r]; tot[((par * 8 + wid) * 16 + 4 * g + r) * 2 + 1] = Hl[r]; }
            }
            asm volatile("s_waitcnt lgkmcnt(0)\n\ts_barrier" ::: "memory");
            float cin[4];
#pragma unroll
            for (int r = 0; r < 4; ++r) cin[r] = 0.f;
#pragma unroll
            for (int w = 0; w < 8; ++w) {
                const f32x4 t0 = *(const LAS f32x4*)(tot + ((par * 8 + w) * 16 + 4 * g) * 2), t1 = *(const LAS f32x4*)(tot + ((par * 8 + w) * 16 + 4 * g) * 2 + 4);
                const float Aw[4] = {t0[0], t0[2], t1[0], t1[2]}, Hw[4] = {t0[1], t0[3], t1[1], t1[3]};
#pragma unroll
                for (int r = 0; r < 4; ++r) { if (w == wid) cin[r] = carry[r]; carry[r] = Aw[r] * carry[r] + Hw[r]; }
            }
            par ^= 1;
            f32x4 hfv[4]; u32x2 gv[4];
            if (dir) {
#pragma unroll
                for (int i = 0; i < 4; ++i) { const int tok = S - 1 - (Pb + i); hfv[i] = *(const f32x4*)(HF + (rowbase + tok) * 512 + c0 + 4 * g); gv[i] = *(const u32x2*)(GR + (rowbase + tok) * 512 + c0 + 4 * g); }
            }
            float cl[4];
#pragma unroll
            for (int r = 0; r < 4; ++r) cl[r] = Aex[r] * cin[r] + Hex[r];
#pragma unroll
            for (int i = 0; i < 4; ++i) {
                const int P = Pb + i; const int tok = dir ? (S - 1 - P) : P;
                f32x4 hv;
#pragma unroll
                for (int r = 0; r < 4; ++r) hv[r] = hh[i][r] + cpp[i][r] * cl[r];
                if (dir == 0) *(f32x4*)(HF + (rowbase + tok) * 512 + c0 + 4 * g) = hv;
                else {
                    const float gr4[4] = {__uint_as_float(gv[i].x << 16), __uint_as_float(gv[i].x & 0xffff0000u), __uint_as_float(gv[i].y << 16), __uint_as_float(gv[i].y & 0xffff0000u)};
                    float y[4];
#pragma unroll
                    for (int r = 0; r < 4; ++r) { const float x = gr4[r]; const float gl = x * fast_sigmoid(1.5957691216057308f * (x + 0.044715f * x * x * x)); y[r] = gl * (hv[r] + hfv[i][r]); }
                    u32x2 w; w.x = cvt_pk_bf16(y[0], y[1]); w.y = cvt_pk_bf16(y[2], y[3]);
                    *(u32x2*)(MIXED + (rowbase + tok) * 1024 + 512 + c0 + 4 * g) = w;
                }
            }
        }
        __syncthreads();
    }
}
}
struct Args { const float* in[22]; float* out; unsigned char* ws; int ph_lo, ph_hi; };
constexpr int N_PHASES = 6;

__global__ void __launch_bounds__(NWAVES * 64, 2) mk_fwd(Args args) {
    extern __shared__ __attribute__((aligned(16))) unsigned char lds_raw[];
    LAS unsigned char* lds = (LAS unsigned char*)lds_raw;
    const int tid = threadIdx.x, lane = tid & 63; const int wave = __builtin_amdgcn_readfirstlane(tid >> 6);
    const int G = gridDim.x, bx = blockIdx.x; const int vcu = (G % 8 == 0) ? (bx % 8) * (G / 8) + bx / 8 : bx;
    unsigned char* ws = args.ws;
    const float* x = args.in[0]; float* out = args.out;
    bf16_t* WIN = (bf16_t*)(ws + WS_WIN); bf16_t* WOUT = (bf16_t*)(ws + WS_WOUT); bf16_t* WGU = (bf16_t*)(ws + WS_WGU); bf16_t* WDN = (bf16_t*)(ws + WS_WDN);
    float* RSS1 = (float*)(ws + WS_RSS1); float* RSS2 = (float*)(ws + WS_RSS2);
    bf16_t* XN = (bf16_t*)(ws + WS_XN); bf16_t* HB = XN;
    bf16_t* Qb = (bf16_t*)(ws + WS_Q); bf16_t* KT = (bf16_t*)(ws + WS_KT); bf16_t* VT = (bf16_t*)(ws + WS_VT); bf16_t* XR = (bf16_t*)(ws + WS_XR); bf16_t* GR = (bf16_t*)(ws + WS_GR);
    float* HF = (float*)(ws + WS_HF); bf16_t* MIXED = (bf16_t*)(ws + WS_MIXED); bf16_t* ACT = (bf16_t*)(ws + WS_ACT);
    const int lo = args.ph_lo, hi = args.ph_hi;
    volatile LAS unsigned* bst = (volatile LAS unsigned*)(lds + LDS_MISC + 8192);
    if (tid == 0) { bst[0] = 0u; bst[1] = 0u; bst[2] = 0u; }
    __syncthreads();
    xb::XcdBarrier bar = xb::xcd_barrier_post((unsigned*)ws, bst);
    if (lo > 1000) cooperative_groups::this_grid().sync();
#define IN(k) (lo <= (k) && (k) < hi)
#ifndef REP_PHASE
#define REP_PHASE -1
#endif
#define REPS(k) ((REP_PHASE == (k)) ? 2 : 1)
#define REPSYNC(k, rep) do { if ((rep) + 1 < REPS(k)) xb::xcd_barrier(bar); } while (0)
#define SEAM(k) do { if (IN(k) && IN((k) + 1)) { xb::xcd_barrier(bar); } } while (0)

    if (IN(0)) for (int rep = 0; rep < REPS(0); ++rep) {
        LAS float* scr = (LAS float*)(lds + wave * 16384);
        const int gw = vcu * NWAVES + wave, NGW = G * NWAVES;
        constexpr int I_IN = (D / 64) * (DIN / 32), I_OUT = (D / 64) * (D / 32), I_G = (D / 64) * (DFF / 32), I_DN = (DFF / 64) * (D / 32);
        constexpr int NITEMS = I_IN + I_OUT + 2 * I_G + I_DN;
        for (int it = gw; it < NITEMS; it += NGW) {
            int r = it;
            if (r < I_IN) { p0_transpose_item<0>(args.in[2], D, DIN, WIN, nullptr, scr, r, lane); continue; } r -= I_IN;
            if (r < I_OUT) { p0_transpose_item<0>(args.in[16], D, D, WOUT, nullptr, scr, r, lane); continue; } r -= I_OUT;
            if (r < I_G) { p0_transpose_item<1>(args.in[18], D, DFF, WGU, args.in[17], scr, r, lane); continue; } r -= I_G;
            if (r < I_G) { p0_transpose_item<2>(args.in[19], D, DFF, WGU, args.in[17], scr, r, lane); continue; } r -= I_G;
            p0_transpose_item<0>(args.in[20], DFF, D, WDN, nullptr, scr, r, lane);
        }
        for (int m = gw * 4; m < M; m += NGW * 4) rms_rows_to_bf16<4>(x + (size_t)m * D, args.in[1], XN + (size_t)m * D, lane);
        REPSYNC(0, rep);
    }
    SEAM(0);
    if (IN(1)) for (int rep = 0; rep < REPS(1); ++rep) {
        pg8::Gemm g{XN, WIN, M, DIN, D}; pg8::StaticOrder So; So.init(M, DIN, G, bx);
        pg8::EpiInProj E{Qb, KT, VT, XR, GR, QSCALE};
        pg8::gemm_phase<pg8::EpiInProj, pg8::StaticOrder, true, true>(lds, g, So, E);
        REPSYNC(1, rep);
    }
    SEAM(1);
    if (IN(2)) {
        float lam;
        { float s1 = 0.f, s2 = 0.f; for (int i = 0; i < 64; ++i) { s1 += args.in[3][i] * args.in[4][i]; s2 += args.in[5][i] * args.in[6][i]; } lam = expf(s1) - expf(s2) + 0.2f; }
        for (int rep = 0; rep < REPS(20); ++rep)
        for (int rnd = 0; rnd * G + vcu < NB * NH * 32; ++rnd) {
            const int u = rnd * G + vcu; int b_, h_, qb_;
            if (G == 256) { b_ = vcu >> 5; h_ = rnd; qb_ = vcu & 31; } else { qb_ = u & 31; h_ = (u >> 5) & 3; b_ = u >> 7; }
            att::attn_unit(b_, h_, qb_, Qb, KT, VT, MIXED, lds, lam, args.in[7], args.in[8]);
        }
        for (int rep = 0; rep < REPS(21); ++rep)
        for (int it = vcu; it < NB * 32; it += G) {
            const int b_ = it >> 5, cg = it & 31;
            lru::lru_item(b_, cg, XR, GR, HF, MIXED, lds, args.in[9], args.in[10], args.in[11], args.in[12], args.in[13], args.in[14], args.in[15]);
        }
    }
    SEAM(2);
    if (IN(3)) for (int rep = 0; rep < REPS(3); ++rep) {
        pg8::Gemm g{MIXED, WOUT, M, D, D}; pg8::StaticOrder So; So.init(M, D, G, bx);
        pg8::EpiResid<true, false> E{x, out, HB, RSS1, D};
        pg8::gemm_phase<pg8::EpiResid<true, false>, pg8::StaticOrder, true, true>(lds, g, So, E);
        REPSYNC(3, rep);
    }
    SEAM(3);
    if (IN(4)) for (int rep = 0; rep < REPS(4); ++rep) {
        pg8::Gemm g{HB, WGU, M, 2 * DFF, D}; pg8::StaticOrder So; So.init(M, 2 * DFF, G, bx);
        pg8::EpiGateUp E{ACT, RSS1, DFF, EPS};
        pg8::gemm_phase<pg8::EpiGateUp, pg8::StaticOrder, true, true>(lds, g, So, E);
        REPSYNC(4, rep);
    }
    SEAM(4);
    if (IN(5)) for (int rep = 0; rep < REPS(5); ++rep) {
        if (G == 256) {
#pragma unroll 1
            for (int half = 0; half < 2; ++half) {
                const size_t r0 = (size_t)half * (M / 2);
                pg8::Gemm g{ACT + r0 * DFF, WDN, M / 2, D, DFF}; pg8::StaticOrder So; So.init(M / 2, D, G, bx);
                pg8::EpiDownNorm E{HB + r0 * D, out + r0 * D, args.in[21], RSS2 + r0 * 4, (unsigned*)ws + 4096 + 64 * 64 * half, D, EPS};
                pg8::gemm_phase<pg8::EpiDownNorm, pg8::StaticOrder, false, true>(lds, g, So, E);
                __syncthreads();
            }
        }
        REPSYNC(5, rep);
    }
#if REP_PHASE == 99
    for (int i = 0; i < 20; ++i) xb::xcd_barrier(bar);
#endif
#undef IN
#undef SEAM
}
}
namespace dbg {
using namespace mk;
__global__ void __launch_bounds__(256) k_unpack_proj(const bf16_t* Qb, const bf16_t* KT, const bf16_t* VT, const bf16_t* XR, const bf16_t* GR, float* q, float* k, float* v, float* xr, float* gr) {
    const size_t idx = (size_t)blockIdx.x * 256 + threadIdx.x;
    const int c = (int)(idx & 511); const int row = (int)(idx >> 9); const int b = row >> 12, tok = row & 4095, t = tok >> 6, rr = tok & 63;
    q[idx] = bf2f(Qb[idx]) * (1.0f / QSCALE);
    { const int h = c >> 7, w = c & 127, s = w >> 6, d = w & 63, chunk = d >> 3, j = d & 7;
      k[idx] = bf2f(KT[((((size_t)(b * 4 + h) * 2 + s) * 64 + t) * 8 + chunk) * 512 + rr * 8 + j]); }
    { const int h = c >> 7, dv = c & 127, db = dv >> 5, cc = dv & 31;
      v[idx] = bf2f(VT[(((size_t)(b * 4 + h) * 64 + t) * 4 + db) * 2048 + rr * 32 + cc]); }
    xr[idx] = bf2f(XR[idx]); gr[idx] = bf2f(GR[idx]);
}
__global__ void __launch_bounds__(256) k_unpack_bf16(const bf16_t* src, float* dst) { const size_t idx = (size_t)blockIdx.x * 256 + threadIdx.x; dst[idx] = bf2f(src[idx]); }
}

#ifndef STAGE
#define STAGE 4
#endif
static void mk_launch_phases(const mk::Args& a0, int lo, int hi, int grid, hipStream_t stream, bool coop) {
    mk::Args a = a0; a.ph_lo = lo; a.ph_hi = hi;
    if (coop) { void* args[] = {&a}; hipError_t e = hipLaunchCooperativeKernel((const void*)mk::mk_fwd, dim3(grid), dim3(mk::NWAVES * 64), args, mk::LDS_BYTES, stream);
        if (e != hipSuccess) fprintf(stderr, "cooperative launch failed: %s (grid %d)\n", hipGetErrorString(e), grid); }
    else { hipLaunchKernelGGL(mk::mk_fwd, dim3(grid), dim3(mk::NWAVES * 64), mk::LDS_BYTES, stream, a); }
}

extern "C" void kernel_launch(void* const* d_in, const int* in_sizes, int n_in, void* d_out, int out_size, void* d_ws, size_t ws_size, hipStream_t stream) {
    static int grid = 0;
    if (grid == 0) {
        int dev = 0, cus = 0, per_cu = 0;
        hipGetDevice(&dev); hipDeviceGetAttribute(&cus, hipDeviceAttributeMultiprocessorCount, dev);
        if (hipFuncSetAttribute((const void*)mk::mk_fwd, hipFuncAttributeMaxDynamicSharedMemorySize, mk::LDS_BYTES) != hipSuccess) { fprintf(stderr, "hipFuncSetAttribute failed\n"); grid = -1; return; }
        if (hipOccupancyMaxActiveBlocksPerMultiprocessor(&per_cu, (const void*)mk::mk_fwd, mk::NWAVES * 64, mk::LDS_BYTES) != hipSuccess || per_cu < 1) { fprintf(stderr, "occupancy query: %d\n", per_cu); per_cu = 1; }
        (void)hipGetLastError();
        grid = cus * 1;
        if (n_in != 22 || ws_size < 512u * mk::MiB) fprintf(stderr, "kernel_launch: unexpected n_in %d / ws_size %zu\n", n_in, ws_size);
    }
    if (grid < 0) return;
    if (hipMemsetAsync(d_ws, 0, 65536, stream) != hipSuccess) { fprintf(stderr, "memset failed\n"); return; }
    mk::Args a{};
    for (int i = 0; i < 22; ++i) a.in[i] = (const float*)d_in[i];
    a.out = (float*)d_out; a.ws = (unsigned char*)d_ws;
    char* ws = (char*)d_ws; const size_t MiB = 1u << 20;
#if STAGE == 4
    mk_launch_phases(a, 0, mk::N_PHASES, grid, stream, true);
#elif STAGE == 3
    for (int p = 0; p < mk::N_PHASES; ++p) mk_launch_phases(a, p, p + 1, grid, stream, false);
#elif STAGE == 1
    for (int p = 0; p < 2; ++p) mk_launch_phases(a, p, p + 1, grid, stream, false);
    float* q = (float*)(ws + 32 * MiB), *k = (float*)(ws + 256 * MiB), *v = (float*)(ws + 320 * MiB), *xr = (float*)(ws + 384 * MiB), *gr = (float*)(ws + 448 * MiB);
    dbg::k_unpack_proj<<<mk::M * 512 / 256, 256, 0, stream>>>((const mk::bf16_t*)(ws + mk::WS_Q), (const mk::bf16_t*)(ws + mk::WS_KT), (const mk::bf16_t*)(ws + mk::WS_VT), (const mk::bf16_t*)(ws + mk::WS_XR), (const mk::bf16_t*)(ws + mk::WS_GR), q, k, v, xr, gr);
    float* mixed = (float*)(ws + 96 * MiB);
    nv::naive_mid(d_in, q, k, v, xr, gr, mixed, stream);
    nv::naive_tail(d_in, mixed, (float*)d_out, (float*)(ws + 0), (float*)(ws + 128 * MiB), stream);
#elif STAGE == 2
    for (int p = 0; p < 3; ++p) mk_launch_phases(a, p, p + 1, grid, stream, false);
    float* mixed = (float*)(ws + 0);
    dbg::k_unpack_bf16<<<mk::M * 1024 / 256, 256, 0, stream>>>((const mk::bf16_t*)(ws + mk::WS_MIXED), mixed);
    nv::naive_tail(d_in, mixed, (float*)d_out, (float*)(ws + 0), (float*)(ws + 128 * MiB), stream);
#endif
}
```

```cpp
#include <hip/hip_runtime.h>
#include <hip/hip_cooperative_groups.h>
#include <cstdio>
#include <cstdint>
#include <cmath>
#define STAGE 4
namespace pg8 {
#define PG8_LAS __attribute__((address_space(3)))
typedef unsigned short bf16_t;
typedef short bf16x8 __attribute__((ext_vector_type(8)));
typedef float f32x4 __attribute__((ext_vector_type(4)));
typedef unsigned u32x4 __attribute__((ext_vector_type(4)));
constexpr int BM = 256, BK = 64, HALF = 128, HTB = HALF * BK * 2  , STAGE_BYTES = 8 * HTB, NXCD = 8, WGM = 8;

__host__ __device__ __forceinline__ int lds_byte(int r, int c) { const int st = (r >> 4) * 2 + (c >> 5), rr = r & 15, cc = c & 31, ob = rr * 64 + cc * 2; return st * 1024 + (ob ^ (((ob >> 9) & 1) << 5)); }
__host__ __device__ __forceinline__ void stage_rc(int b, int& R, int& C) { const int st = b / 1024, sb = b % 1024, swz = sb ^ (((sb >> 9) & 1) << 5); R = (st >> 1) * 16 + swz / 64; C = (st & 1) * 32 + (swz % 64) / 2; }
__host__ __device__ __forceinline__ int perm32(int rho) { const int n = rho >> 4, i = rho & 15; return 8 * (i >> 2) + 4 * n + (i & 3); }

struct Unit { int pm, pn; };
struct Gemm { const bf16_t* A; const bf16_t* Bt; int M, N, K; };

struct StaticOrder {
    int nM, nN, nwg, G, c;
    __host__ __device__ void init(int M, int N, int G_, int c_) { nM = M / BM; nN = N / BM; nwg = nM * nN; G = G_; c = c_; }
    __host__ __device__ bool next(int i, Unit& u) const {
        const long L = (long)i * G + c; if (L >= nwg) return false;
        int wgid = (int)L; { const int q = nwg / NXCD, r = nwg % NXCD, xcd = wgid % NXCD, off = wgid / NXCD; wgid = (xcd < r ? xcd * (q + 1) : r * (q + 1) + (xcd - r) * q) + off; }
        const int nig = WGM * nN, gid = wgid / nig, fm = gid * WGM, gsz = (nM - fm) < WGM ? (nM - fm) : WGM;
        u.pm = fm + ((wgid % nig) % gsz); u.pn = (wgid % nig) / gsz; return true;
    }
    __device__ __forceinline__ void a_ready(const Unit&) const {}
    __device__ __forceinline__ void done(const Unit&) const {}
};

typedef float f32x2_cv __attribute__((ext_vector_type(2))); typedef __bf16 bf16x2_cv __attribute__((ext_vector_type(2)));
__device__ __forceinline__ unsigned cvt_pk_bf16(float lo, float hi) { f32x2_cv v = {lo, hi}; bf16x2_cv b = __builtin_convertvector(v, bf16x2_cv); return __builtin_bit_cast(unsigned, b); }
typedef float f32x2 __attribute__((ext_vector_type(2)));
typedef unsigned u32x2 __attribute__((ext_vector_type(2)));
__device__ __forceinline__ u32x4 pack8(f32x4 v0, f32x4 v1) { u32x4 w; w.x = cvt_pk_bf16(v0[0], v0[1]); w.y = cvt_pk_bf16(v0[2], v0[3]); w.z = cvt_pk_bf16(v1[0], v1[1]); w.w = cvt_pk_bf16(v1[2], v1[3]); return w; }
struct EpiInProj {
    static constexpr bool PERM = true, AFTER_DRAIN = false;
    bf16_t *Q, *KT, *VT, *XR, *GR; float qscale;
    __device__ __forceinline__ void operator()(const f32x4 (&acc)[2][2][4][2], const Unit& u, int wr, int wc, int fr, int fq) const {
        const int sec = u.pn >> 1, half = u.pn & 1;
#pragma unroll
        for (int ai = 0; ai < 2; ++ai)
#pragma unroll
            for (int m = 0; m < 4; ++m) {
                const int row = u.pm * BM + ai * HALF + wr * 64 + m * 16 + fr;
                const int b = row >> 12, tok = row & 4095, t = tok >> 6, rr = tok & 63;
#pragma unroll
                for (int bj = 0; bj < 2; ++bj) {
                    f32x4 v0 = acc[ai][bj][m][0], v1 = acc[ai][bj][m][1];
                    const int cs = half * 256 + bj * HALF + wc * 32 + 8 * fq;
                    if (sec == 0) { v0 = v0 * qscale; v1 = v1 * qscale; *(u32x4*)(Q + (size_t)row * 512 + cs) = pack8(v0, v1); }
                    else if (sec == 1) { const int h = half * 2 + bj, s = wc >> 1, chunk = 4 * (wc & 1) + fq;
                        *(u32x4*)(KT + ((((size_t)(b * 4 + h) * 2 + s) * 64 + t) * 8 + chunk) * 512 + rr * 8) = pack8(v0, v1); }
                    else if (sec == 2) { const int h = half * 2 + bj;
                        *(u32x4*)(VT + (((size_t)(b * 4 + h) * 64 + t) * 4 + wc) * 2048 + rr * 32 + 8 * fq) = pack8(v0, v1); }
                    else if (sec == 3) { *(u32x4*)(XR + (size_t)row * 512 + cs) = pack8(v0, v1); }
                    else { *(u32x4*)(GR + (size_t)row * 512 + cs) = pack8(v0, v1); }
                }
            }
    }
};
template <bool WRITE_HB, bool WRITE_F32 = true> struct EpiResid {
    static constexpr bool PERM = false, AFTER_DRAIN = false;
    const float* base; float* out; bf16_t* hb; float* rss; int ldc;
    __device__ __forceinline__ void operator()(const f32x4 (&acc)[2][2][4][2], const Unit& u, int wr, int wc, int fr, int fq) const {
        const int col0 = u.pn * BM + wc * 32 + 4 * fq;
#pragma unroll
        for (int ai = 0; ai < 2; ++ai)
#pragma unroll
            for (int m = 0; m < 4; ++m) {
                const int row = u.pm * BM + ai * HALF + wr * 64 + m * 16 + fr; const size_t off = (size_t)row * ldc + col0; float ss = 0.f;
#pragma unroll
                for (int bj = 0; bj < 2; ++bj)
#pragma unroll
                    for (int n = 0; n < 2; ++n) {
                        const f32x4 bs = *(const f32x4*)(base + off + bj * HALF + n * 16); const f32x4 o = acc[ai][bj][m][n] + bs;
                        if (WRITE_F32) *(f32x4*)(out + off + bj * HALF + n * 16) = o;
                        if (WRITE_HB) { u32x2 w; w.x = cvt_pk_bf16(o[0], o[1]); w.y = cvt_pk_bf16(o[2], o[3]); *(u32x2*)(hb + off + bj * HALF + n * 16) = w; }
                        ss += (o[0] * o[0] + o[1] * o[1]) + (o[2] * o[2] + o[3] * o[3]);
                    }
                ss += __shfl_xor(ss, 16); ss += __shfl_xor(ss, 32);
                if (fq == 0) rss[(size_t)row * 16 + u.pn * 4 + wc] = ss;
            }
    }
};
struct EpiGateUp {
    static constexpr bool PERM = true, AFTER_DRAIN = false;
    bf16_t* act; const float* rss; int ldo; float eps;
    __device__ __forceinline__ void operator()(const f32x4 (&acc)[2][2][4][2], const Unit& u, int wr, int wc, int fr, int fq) const {
        const int col0 = u.pn * HALF + wc * 32 + 8 * fq;
#pragma unroll
        for (int ai = 0; ai < 2; ++ai)
#pragma unroll
            for (int m = 0; m < 4; ++m) {
                const int row = u.pm * BM + ai * HALF + wr * 64 + m * 16 + fr;
                const f32x4* rp = (const f32x4*)(rss + (size_t)row * 16); const f32x4 s0 = rp[0], s1 = rp[1], s2 = rp[2], s3 = rp[3];
                const float tot = ((s0[0] + s0[1]) + (s0[2] + s0[3])) + ((s1[0] + s1[1]) + (s1[2] + s1[3])) + ((s2[0] + s2[1]) + (s2[2] + s2[3])) + ((s3[0] + s3[1]) + (s3[2] + s3[3]));
                const float rstd = __builtin_amdgcn_rsqf(tot * (1.0f / 1024.0f) + eps);
                f32x4 o[2];
#pragma unroll
                for (int n = 0; n < 2; ++n) {
                    const f32x4 g = acc[ai][0][m][n] * rstd, up = acc[ai][1][m][n] * rstd;
#pragma unroll
                    for (int i = 0; i < 4; ++i) { const float e = __builtin_amdgcn_exp2f(g[i] * -1.4426950408889634f); o[n][i] = g[i] * __builtin_amdgcn_rcpf(1.0f + e) * up[i]; }
                }
                *(u32x4*)(act + (size_t)row * ldo + col0) = pack8(o[0], o[1]);
            }
    }
};

struct EpiDownNorm {
    static constexpr bool PERM = false, AFTER_DRAIN = true;
    const bf16_t* hb; float* out; const float* gain; float* xbuf; unsigned* cnt; int ldc; float eps;
    __device__ __forceinline__ void fused(f32x4 (&acc)[2][2][4][2], const Unit& u, int wr, int wc, int fr, int fq, PG8_LAS unsigned char* lds, int wid, int lane) const {
        PG8_LAS float* P = (PG8_LAS float*)lds;
        PG8_LAS float* Sx = (PG8_LAS float*)(lds + 4096);
        PG8_LAS unsigned* flag = (PG8_LAS unsigned*)(lds + 4096 + 1024);
        const int col0 = u.pn * BM + wc * 32 + 4 * fq;
#pragma unroll
        for (int ai = 0; ai < 2; ++ai)
#pragma unroll
            for (int m = 0; m < 4; ++m) {
                const int r = ai * HALF + wr * 64 + m * 16 + fr; const size_t off = (size_t)(u.pm * BM + r) * ldc + col0; float ss = 0.f;
#pragma unroll
                for (int bj = 0; bj < 2; ++bj)
#pragma unroll
                    for (int n = 0; n < 2; ++n) {
                        const u32x2 hv = *(const u32x2*)(hb + off + bj * HALF + n * 16);
                        const f32x4 h4 = (f32x4){__uint_as_float(hv.x << 16), __uint_as_float(hv.x & 0xffff0000u), __uint_as_float(hv.y << 16), __uint_as_float(hv.y & 0xffff0000u)};
                        const f32x4 o = acc[ai][bj][m][n] + h4; acc[ai][bj][m][n] = o;
                        ss += (o[0] * o[0] + o[1] * o[1]) + (o[2] * o[2] + o[3] * o[3]);
                    }
                ss += __shfl_xor(ss, 16); ss += __shfl_xor(ss, 32);
                if (fq == 0) P[r * 4 + wc] = ss;
            }
        asm volatile("s_waitcnt lgkmcnt(0)" ::: "memory"); __builtin_amdgcn_s_barrier(); asm volatile("" ::: "memory");
        const int row = wid * 32 + (lane & 31);
        if (lane < 32) {
            const float s = (P[row * 4 + 0] + P[row * 4 + 1]) + (P[row * 4 + 2] + P[row * 4 + 3]);
            __hip_atomic_store(xbuf + (size_t)(u.pm * BM + row) * 4 + u.pn, s, __ATOMIC_RELAXED, __HIP_MEMORY_SCOPE_AGENT);
        }
        asm volatile("s_waitcnt vmcnt(0)" ::: "memory");
        if (lane == 0) __hip_atomic_fetch_add(cnt + 64 * u.pm, 1u, __ATOMIC_RELAXED, __HIP_MEMORY_SCOPE_AGENT);
        if (wid == 0) {
            unsigned sp = 0;
            for (;;) {
                if ((unsigned)__builtin_amdgcn_readfirstlane(__hip_atomic_load(cnt + 64 * u.pm, __ATOMIC_RELAXED, __HIP_MEMORY_SCOPE_AGENT)) >= 32u) break;
                if (++sp > (1u << 22)) break;
                __builtin_amdgcn_s_sleep(2);
            }
            __builtin_amdgcn_fence(__ATOMIC_ACQUIRE, "agent");
            if (lane == 0) flag[0] = 0u;
        }
        asm volatile("s_waitcnt vmcnt(0) lgkmcnt(0)" ::: "memory"); __builtin_amdgcn_s_barrier(); asm volatile("" ::: "memory");
        if (lane < 32) {
            const float* slot = xbuf + (size_t)(u.pm * BM + row) * 4;
            const float a = __hip_atomic_load(slot + 0, __ATOMIC_RELAXED, __HIP_MEMORY_SCOPE_AGENT), b = __hip_atomic_load(slot + 1, __ATOMIC_RELAXED, __HIP_MEMORY_SCOPE_AGENT),
                        c = __hip_atomic_load(slot + 2, __ATOMIC_RELAXED, __HIP_MEMORY_SCOPE_AGENT), d = __hip_atomic_load(slot + 3, __ATOMIC_RELAXED, __HIP_MEMORY_SCOPE_AGENT);
            Sx[row] = 1.0f / sqrtf(((a + b) + (c + d)) * (1.0f / 1024.0f) + eps);
        }
        asm volatile("s_waitcnt lgkmcnt(0)" ::: "memory"); __builtin_amdgcn_s_barrier(); asm volatile("" ::: "memory");
        f32x4 gv[2][2];
#pragma unroll
        for (int bj = 0; bj < 2; ++bj)
#pragma unroll
            for (int n = 0; n < 2; ++n) gv[bj][n] = *(const f32x4*)(gain + col0 + bj * HALF + n * 16);
#pragma unroll
        for (int ai = 0; ai < 2; ++ai)
#pragma unroll
            for (int m = 0; m < 4; ++m) {
                const int r = ai * HALF + wr * 64 + m * 16 + fr; const float rs = Sx[r]; const size_t off = (size_t)(u.pm * BM + r) * ldc + col0;
#pragma unroll
                for (int bj = 0; bj < 2; ++bj)
#pragma unroll
                    for (int n = 0; n < 2; ++n) *(f32x4*)(out + off + bj * HALF + n * 16) = acc[ai][bj][m][n] * rs * gv[bj][n];
            }
    }
};
template <class Epi, class Sched, bool ALIGN_EPI = false, bool SP2 = false>
__device__ __forceinline__ void gemm_phase(PG8_LAS unsigned char* lds, const Gemm g, const Sched& S, const Epi& E) {
    const int tid = threadIdx.x, wid = __builtin_amdgcn_readfirstlane(tid >> 6), lane = tid & 63, wr = wid >> 2, wc = wid & 3, fr = lane & 15, fq = lane >> 4;
    const int K = g.K, nt = K / BK;
    unsigned voffA[2], voffB[2];
#pragma unroll
    for (int i = 0; i < 2; ++i) { int R, C; stage_rc(tid * 16 + i * 8192, R, C); const int Rb = Epi::PERM ? ((R & ~31) + perm32(R & 31)) : R;
        voffA[i] = (unsigned)(R * K + C) * 2u; voffB[i] = (unsigned)(Rb * K + C) * 2u; }
    const size_t kstep = (size_t)(BK * 2);
    const size_t hstep = (size_t)HALF * K * 2;
    const size_t tstep = 2 * hstep;
    const unsigned ldsw = (unsigned)wid * 1024u;
    const int aoff = lds_byte(wr * 64 + fr, fq * 8), boff = lds_byte(wc * 32 + fr, fq * 8);
#define PG8_SA(b, h) (((b) * 2 + (h)) * HTB)
#define PG8_SB(b, h) ((4 + (b) * 2 + (h)) * HTB)
#define PG8_STAGE(bufoff, gbase, voff) do { _Pragma("unroll") for (int _i = 0; _i < 2; ++_i) \
        __builtin_amdgcn_global_load_lds((const unsigned*)((const char*)(gbase) + (voff)[_i]), (PG8_LAS unsigned*)(lds + (bufoff) + ldsw + _i * 8192), 16, 0, 0); } while (0)
#define PG8_LDA(dst, b, h) do { _Pragma("unroll") for (int m = 0; m < 4; ++m) _Pragma("unroll") for (int k = 0; k < 2; ++k) dst[m][k] = *(const PG8_LAS bf16x8*)(lds + PG8_SA(b, h) + aoff + m * 2048 + k * 1024); } while (0)
#define PG8_LDB(dst, b, h) do { _Pragma("unroll") for (int n = 0; n < 2; ++n) _Pragma("unroll") for (int k = 0; k < 2; ++k) dst[n][k] = *(const PG8_LAS bf16x8*)(lds + PG8_SB(b, h) + boff + n * 2048 + k * 1024); } while (0)
#define PG8_MMA(ai, bj, At, Bt) do { __builtin_amdgcn_s_setprio(1); _Pragma("unroll") for (int m = 0; m < 4; ++m) _Pragma("unroll") for (int n = 0; n < 2; ++n) _Pragma("unroll") for (int k = 0; k < 2; ++k) \
        acc[ai][bj][m][n] = __builtin_amdgcn_mfma_f32_16x16x32_bf16(Bt[n][k], At[m][k], acc[ai][bj][m][n], 0, 0, 0); __builtin_amdgcn_s_setprio(0); } while (0)
#define PG8_WAIT_V(n) asm volatile("s_waitcnt vmcnt(" #n ")" ::: "memory")
#define PG8_WAIT_L(n) asm volatile("s_waitcnt lgkmcnt(" #n ")" ::: "memory")
#define PG8_BAR __builtin_amdgcn_s_barrier()
#define PG8_SCHED __builtin_amdgcn_sched_barrier(0)
    Unit cur, nxt; int ui = 0;
    if (!S.next(0, cur)) return;
    f32x4 acc[2][2][4][2];
#pragma unroll
    for (int a = 0; a < 2; ++a)
#pragma unroll
        for (int b = 0; b < 2; ++b)
#pragma unroll
            for (int m = 0; m < 4; ++m)
#pragma unroll
                for (int n = 0; n < 2; ++n) acc[a][b][m][n] = (f32x4){0.f, 0.f, 0.f, 0.f};
    bf16x8 At[4][2], B0[2][2], B1[2][2];
    const char* cA = (const char*)g.A + (size_t)cur.pm * tstep; const char* cB = (const char*)g.Bt + (size_t)cur.pn * tstep;
    S.a_ready(cur);
    if constexpr (SP2) {
        PG8_STAGE(PG8_SB(0, 0), cB, voffB); PG8_STAGE(PG8_SB(0, 1), cB + hstep, voffB); PG8_STAGE(PG8_SA(0, 0), cA, voffA); PG8_STAGE(PG8_SA(0, 1), cA + hstep, voffA);
        if (wr == 1) PG8_BAR;
        PG8_WAIT_V(2); PG8_BAR;
        PG8_STAGE(PG8_SB(1, 0), cB + kstep, voffB); PG8_STAGE(PG8_SA(1, 0), cA + kstep, voffA); PG8_STAGE(PG8_SB(1, 1), cB + hstep + kstep, voffB);
        PG8_WAIT_V(6); PG8_BAR;
    } else {
        PG8_STAGE(PG8_SB(0, 0), cB, voffB); PG8_STAGE(PG8_SA(0, 0), cA, voffA); PG8_STAGE(PG8_SB(0, 1), cB + hstep, voffB); PG8_STAGE(PG8_SA(0, 1), cA + hstep, voffA);
        if (wr == 1) PG8_BAR;
        PG8_WAIT_V(4); PG8_BAR;
        PG8_STAGE(PG8_SB(1, 0), cB + kstep, voffB); PG8_STAGE(PG8_SA(1, 0), cA + kstep, voffA); PG8_STAGE(PG8_SB(1, 1), cB + hstep + kstep, voffB);
        PG8_WAIT_V(6); PG8_BAR;
    }
    for (;;) {
        const bool has_next = S.next(ui + 1, nxt);
        const char* nA = has_next ? (const char*)g.A + (size_t)nxt.pm * tstep : cA; const char* nB = has_next ? (const char*)g.Bt + (size_t)nxt.pn * tstep : cB;
        for (int t = 0; t < nt; t += 2) {
            const bool last = (t == nt - 2);
            const char* a1 = cA + (size_t)(t + 1) * kstep;
            const char* a2 = last ? nA : cA + (size_t)(t + 2) * kstep; const char* b2 = last ? nB : cB + (size_t)(t + 2) * kstep;
            const char* a3 = a2 + kstep; const char* b3 = b2 + kstep;
            if (last && has_next) S.a_ready(nxt);
            if constexpr (SP2) {
            PG8_LDB(B0, 0, 0); PG8_LDB(B1, 0, 1); PG8_SCHED; PG8_LDA(At, 0, 0); PG8_STAGE(PG8_SA(1, 1), a1 + hstep, voffA);
            PG8_WAIT_V(8); PG8_WAIT_L(0); PG8_BAR; PG8_MMA(0, 0, At, B0); PG8_MMA(0, 1, At, B1); PG8_BAR; PG8_SCHED;
            PG8_LDA(At, 0, 1); PG8_STAGE(PG8_SB(0, 0), b2, voffB); PG8_STAGE(PG8_SB(0, 1), b2 + hstep, voffB); PG8_STAGE(PG8_SA(0, 0), a2, voffA);
            PG8_WAIT_V(8); PG8_WAIT_L(0); PG8_BAR; PG8_MMA(1, 0, At, B0); PG8_MMA(1, 1, At, B1); PG8_BAR; PG8_SCHED;
            PG8_LDB(B0, 1, 0); PG8_LDB(B1, 1, 1); PG8_SCHED; PG8_LDA(At, 1, 0); PG8_STAGE(PG8_SA(0, 1), a2 + hstep, voffA);
            PG8_WAIT_V(8); PG8_WAIT_L(0); PG8_BAR; PG8_MMA(0, 0, At, B0); PG8_MMA(0, 1, At, B1); PG8_BAR; PG8_SCHED;
            PG8_LDA(At, 1, 1); PG8_STAGE(PG8_SB(1, 0), b3, voffB); PG8_STAGE(PG8_SB(1, 1), b3 + hstep, voffB); PG8_STAGE(PG8_SA(1, 0), a3, voffA);
            PG8_WAIT_V(8); PG8_WAIT_L(0); PG8_BAR; PG8_MMA(1, 0, At, B0); PG8_MMA(1, 1, At, B1); PG8_BAR; PG8_SCHED;
            } else {
            PG8_LDB(B0, 0, 0); PG8_SCHED; PG8_LDA(At, 0, 0); PG8_STAGE(PG8_SA(1, 1), a1 + hstep, voffA);
            PG8_WAIT_L(8); PG8_BAR; PG8_WAIT_L(0); PG8_MMA(0, 0, At, B0); PG8_BAR; PG8_SCHED;
            PG8_LDB(B1, 0, 1); PG8_STAGE(PG8_SB(0, 0), b2, voffB);
            PG8_BAR; PG8_WAIT_L(0); PG8_MMA(0, 1, At, B1); PG8_BAR;
            PG8_LDA(At, 0, 1); PG8_STAGE(PG8_SA(0, 0), a2, voffA);
            PG8_BAR; PG8_WAIT_L(0); PG8_MMA(1, 0, At, B0); PG8_BAR; PG8_SCHED;
            PG8_STAGE(PG8_SB(0, 1), b2 + hstep, voffB);
            PG8_WAIT_V(6); PG8_BAR; PG8_MMA(1, 1, At, B1); PG8_BAR;
            PG8_LDB(B0, 1, 0); PG8_SCHED; PG8_LDA(At, 1, 0); PG8_STAGE(PG8_SA(0, 1), a2 + hstep, voffA);
            PG8_WAIT_L(8); PG8_BAR; PG8_WAIT_L(0); PG8_MMA(0, 0, At, B0); PG8_BAR; PG8_SCHED;
            PG8_LDB(B1, 1, 1); PG8_STAGE(PG8_SB(1, 0), b3, voffB);
            PG8_BAR; PG8_WAIT_L(0); PG8_MMA(0, 1, At, B1); PG8_BAR;
            PG8_LDA(At, 1, 1); PG8_STAGE(PG8_SA(1, 0), a3, voffA);
            PG8_BAR; PG8_WAIT_L(0); PG8_MMA(1, 0, At, B0); PG8_BAR; PG8_SCHED;
            PG8_STAGE(PG8_SB(1, 1), b3 + hstep, voffB);
            PG8_WAIT_V(6); PG8_BAR; PG8_MMA(1, 1, At, B1); PG8_BAR;
            }
        }
        if constexpr (ALIGN_EPI) { if (wr == 0) PG8_BAR; }
        if constexpr (!Epi::AFTER_DRAIN) { E(acc, cur, wr, wc, fr, fq); S.done(cur); }
        if (!has_next) break;
#pragma unroll
        for (int a = 0; a < 2; ++a)
#pragma unroll
            for (int b = 0; b < 2; ++b)
#pragma unroll
                for (int m = 0; m < 4; ++m)
#pragma unroll
                    for (int n = 0; n < 2; ++n) acc[a][b][m][n] = (f32x4){0.f, 0.f, 0.f, 0.f};
        cur = nxt; cA = nA; cB = nB; ++ui;
        if constexpr (ALIGN_EPI) { if (wr == 1) PG8_BAR; }
    }
    PG8_WAIT_V(0);
    if constexpr (!ALIGN_EPI) { if (wr == 0) PG8_BAR; }
    PG8_BAR;
    if constexpr (Epi::AFTER_DRAIN) { E.fused(acc, cur, wr, wc, fr, fq, lds, wid, lane); S.done(cur); }
#undef PG8_SA
#undef PG8_SB
#undef PG8_STAGE
#undef PG8_LDA
#undef PG8_LDB
#undef PG8_MMA
#undef PG8_WAIT_V
#undef PG8_WAIT_L
#undef PG8_BAR
#undef PG8_SCHED
}
}
namespace xb {
#define LAS __attribute__((address_space(3)))
#define XB_TMO      128
#define XB_XCNT(j)  (256  + 64 * (j))
#define XB_XSUB(j)  (1280 + 64 * (j))
#define XB_XGEN(j)  (2304 + 64 * (j))
#define XB_TOP      3328
#define XB_TOPGEN   3392
#define XCD_BAR_WORDS 3456
#define XB_SPIN_CAP (1u << 18)

__device__ __forceinline__ unsigned xb_ld(unsigned* p)              { return __hip_atomic_load(p, __ATOMIC_RELAXED, __HIP_MEMORY_SCOPE_AGENT); }
__device__ __forceinline__ unsigned xb_add(unsigned* p, unsigned v) { return __hip_atomic_fetch_add(p, v, __ATOMIC_RELAXED, __HIP_MEMORY_SCOPE_AGENT); }
__device__ __forceinline__ unsigned xb_xcc_id() { return (unsigned)__builtin_amdgcn_s_getreg((3 << 11) | 20) & 0xFu; }
#define XB_SPIN(cond, bar) do { unsigned _sp = 0; while (cond) { __builtin_amdgcn_s_sleep(1); \
    if ((++_sp & 255u) == 0u) { if (xb_ld(&(bar)[XB_TMO])) break; if (_sp > XB_SPIN_CAP) { atomicAdd(&(bar)[XB_TMO], 1u); break; } } } } while (0)

struct XcdBarrier {
    unsigned* bar; unsigned x;
    volatile LAS unsigned* st;
};

__device__ __forceinline__ XcdBarrier xcd_barrier_post(unsigned* bar, volatile LAS unsigned* st) {
    XcdBarrier b; b.bar = bar; b.x = xb_xcc_id(); b.st = st;
    if (threadIdx.x == 0) st[2] = xb_add(&bar[XB_XCNT(b.x)], 1u);
    return b;
}
__device__ __forceinline__ void xcd_barrier_complete(unsigned* bar, unsigned x, unsigned& nloc, unsigned& nx) {
    const unsigned G = gridDim.x * gridDim.y * gridDim.z;
    unsigned sum, cnt, mine, sp = 0u;
    for (;;) {
        sum = 0u; cnt = 0u; mine = 0u;
#pragma unroll
        for (unsigned j = 0; j < 16; ++j) { const unsigned c = xb_ld(&bar[XB_XCNT(j)]); sum += c; cnt += (c > 0u) ? 1u : 0u; mine = (j == x) ? c : mine; }
        if (sum == G) break;
        __builtin_amdgcn_s_sleep(1);
        if ((++sp & 255u) == 0u) { if (xb_ld(&bar[XB_TMO])) break; if (sp > XB_SPIN_CAP) { atomicAdd(&bar[XB_TMO], 1u); break; } }
    }
    nloc = mine > 0u ? mine : 1u; nx = cnt > 0u ? cnt : 1u;
}

__device__ __forceinline__ void xcd_barrier(const XcdBarrier& b) {
    asm volatile("s_waitcnt vmcnt(0)" ::: "memory");
    __syncthreads();
    if (threadIdx.x == 0) {
        unsigned* bar = b.bar;
        __builtin_amdgcn_s_waitcnt(0);
        unsigned nloc = b.st[0], nx = b.st[1];
        if (nloc == 0u) { xcd_barrier_complete(bar, b.x, nloc, nx); b.st[0] = nloc; b.st[1] = nx; }
        const unsigned old = xb_add(&bar[XB_XSUB(b.x)], 1u);
        const unsigned gen = old / nloc;
        if (old + 1u == (gen + 1u) * nloc) {
            __builtin_amdgcn_fence(__ATOMIC_RELEASE, "agent");
            asm volatile("s_waitcnt vmcnt(0)" ::: "memory");
            const unsigned og = xb_add(&bar[XB_TOP], 1u);
            const unsigned tg = og / nx;
            if (og + 1u == (tg + 1u) * nx) xb_add(&bar[XB_TOPGEN], 1u);
            else XB_SPIN(xb_ld(&bar[XB_TOPGEN]) == tg, bar);
            __builtin_amdgcn_fence(__ATOMIC_ACQUIRE, "agent");
            xb_add(&bar[XB_XGEN(b.x)], 1u);
            asm volatile("s_waitcnt vmcnt(0)" ::: "memory");
        } else {
            XB_SPIN(xb_ld(&bar[XB_XGEN(b.x)]) == gen, bar);
            __builtin_amdgcn_fence(__ATOMIC_ACQUIRE, "agent");
            asm volatile("s_waitcnt vmcnt(0)" ::: "memory");
        }
    }
    __syncthreads();
}

}
namespace mk {
#define LAS __attribute__((address_space(3)))
typedef unsigned short bf16_t;
typedef short bf16x8 __attribute__((ext_vector_type(8)));
typedef short s16x4 __attribute__((ext_vector_type(4)));
typedef float f32x4 __attribute__((ext_vector_type(4)));
typedef float f32x16 __attribute__((ext_vector_type(16)));
typedef unsigned u32x4 __attribute__((ext_vector_type(4)));
typedef unsigned u32x2 __attribute__((ext_vector_type(2)));
constexpr int NB = 8, S = 4096, D = 1024, M = NB * S, NH = 4, DFF = 2816, DIN = 2560, NWAVES = 8;
constexpr float EPS = 1e-6f, LOG2E = 1.4426950408889634f;
constexpr float QSCALE = 0.125f * LOG2E;
constexpr size_t MiB = 1u << 20;
constexpr size_t WS_WIN = 1 * MiB, WS_WOUT = 6 * MiB, WS_WGU = 8 * MiB, WS_WDN = 19 * MiB, WS_RSS1 = 25 * MiB, WS_RSS2 = 27 * MiB;
constexpr size_t WS_XN = 32 * MiB, WS_Q = 96 * MiB, WS_KT = 128 * MiB, WS_VT = 160 * MiB, WS_XR = 192 * MiB, WS_GR = 224 * MiB, WS_HF = 256 * MiB, WS_MIXED = 320 * MiB, WS_ACT = 96 * MiB, WS_XC = 384 * MiB, WS_END = 416 * MiB;
static_assert(WS_ACT + (size_t)M * DFF * 2 <= WS_MIXED, "act overlays Q..HF only");
constexpr int RING_BYTES = 131072, LDS_MISC = 131072, LDS_BYTES = 147456;

__device__ __forceinline__ unsigned cvt_pk_bf16(float lo, float hi) { return pg8::cvt_pk_bf16(lo, hi); }
__device__ __forceinline__ float bf2f(unsigned short b) { return __uint_as_float(((unsigned)b) << 16); }
__device__ __forceinline__ float wave_sum(float v) {
#pragma unroll
    for (int o = 1; o < 64; o <<= 1) v += __shfl_xor(v, o);
    return v;
}
__device__ __forceinline__ float fast_sigmoid(float x) { return __builtin_amdgcn_rcpf(1.0f + __builtin_amdgcn_exp2f(-LOG2E * x)); }

template <int MAP  >
__device__ __forceinline__ void p0_transpose_item(const float* W, int K, int N, bf16_t* WT, const float* gk, LAS float* scr, int item, int lane) {
    const int nblk = N / 32, kb = item / nblk, nb = item % nblk, k0 = 64 * kb, n0 = 32 * nb;
#pragma unroll
    for (int i = 0; i < 32; ++i) { const int kk = 2 * i + (lane >> 5); float v = W[(size_t)(k0 + kk) * N + n0 + (lane & 31)]; if (gk) v *= gk[k0 + kk]; scr[kk * 33 + (lane & 31)] = v; }
    asm volatile("s_waitcnt lgkmcnt(0)" ::: "memory");
    const int c = lane & 7;
#pragma unroll
    for (int j = 0; j < 4; ++j) { const int n = (lane >> 3) + 8 * j; const LAS float* s = scr + (8 * c) * 33 + n;
        u32x4 o; o.x = cvt_pk_bf16(s[0 * 33], s[1 * 33]); o.y = cvt_pk_bf16(s[2 * 33], s[3 * 33]); o.z = cvt_pk_bf16(s[4 * 33], s[5 * 33]); o.w = cvt_pk_bf16(s[6 * 33], s[7 * 33]);
        const int f = n0 + n; const int drow = (MAP == 0) ? f : (256 * (f >> 7) + (f & 127) + (MAP == 2 ? 128 : 0));
        *(u32x4*)(WT + (size_t)drow * K + k0 + 8 * c) = o; }
    asm volatile("s_waitcnt lgkmcnt(0)" ::: "memory");
}
template <int NR>
__device__ __forceinline__ void rms_rows_to_bf16(const float* xrow, const float* g, bf16_t* orow, int lane) {
    const f32x4* gr = (const f32x4*)g + lane;
    f32x4 v[NR][4]; float s[NR];
#pragma unroll
    for (int q = 0; q < NR; ++q) { const f32x4* xr = (const f32x4*)(xrow + (size_t)q * D) + lane;
#pragma unroll
        for (int j = 0; j < 4; ++j) v[q][j] = __builtin_nontemporal_load(xr + 64 * j); }
#pragma unroll
    for (int q = 0; q < NR; ++q) { float a = 0.f;
#pragma unroll
        for (int j = 0; j < 4; ++j) a += (v[q][j][0] * v[q][j][0] + v[q][j][1] * v[q][j][1]) + (v[q][j][2] * v[q][j][2] + v[q][j][3] * v[q][j][3]);
        s[q] = a; }
#pragma unroll
    for (int o = 1; o < 64; o <<= 1)
#pragma unroll
        for (int q = 0; q < NR; ++q) s[q] += __shfl_xor(s[q], o);
    f32x4 gg[4];
#pragma unroll
    for (int j = 0; j < 4; ++j) gg[j] = gr[64 * j];
#pragma unroll
    for (int q = 0; q < NR; ++q) { const float rstd = 1.0f / sqrtf(s[q] * (1.f / D) + EPS); u32x2* o8 = (u32x2*)(orow + (size_t)q * D) + lane;
#pragma unroll
        for (int j = 0; j < 4; ++j) { u32x2 w; w.x = cvt_pk_bf16(v[q][j][0] * rstd * gg[j][0], v[q][j][1] * rstd * gg[j][1]); w.y = cvt_pk_bf16(v[q][j][2] * rstd * gg[j][2], v[q][j][3] * rstd * gg[j][3]); o8[64 * j] = w; } }
}

namespace att {
constexpr int NT = S / 64, SLOT = 16384, LDS_K = 0, LDS_V = 3 * SLOT, LDS_OST = 4 * SLOT, LDS_X = 0;
constexpr int LDS_WSF = LDS_MISC, LDS_BIAS = LDS_MISC + 2048, LDS_TOT = LDS_MISC + 3072, LDS_CW = LDS_MISC + 5120, LDS_BIAS2 = LDS_MISC + 8704;
constexpr int THR = 8;
typedef LAS const char* lds_cptr;
typedef short v4i16_t __attribute__((ext_vector_type(4)));
__device__ __forceinline__ int crow(int r, int hi) { return (r & 3) + 8 * (r >> 2) + 4 * hi; }
__device__ __forceinline__ void glds16(const void* gsrc, unsigned lds_dst) { unsigned keep;
    asm volatile("s_mov_b32 %0, m0\n\ts_mov_b32 m0, %2\n\ts_nop 0\n\tglobal_load_lds_dwordx4 %1, off\n\ts_mov_b32 m0, %0" : "=&s"(keep) : "v"(gsrc), "s"(lds_dst) : "memory"); }
__device__ __forceinline__ s16x4 vtr(lds_cptr p) { return __builtin_bit_cast(s16x4, __builtin_amdgcn_ds_read_tr16_b64_v4i16((LAS v4i16_t*)p)); }
#define ATT_MX3(a, b, c) __builtin_fmaxf(__builtin_fmaxf((a), (b)), (c))
__device__ __forceinline__ float rowmax(const f32x16& p0, const f32x16& p1) {
    float a = ATT_MX3(p0[0], p0[1], p1[0]), b = ATT_MX3(p0[2], p0[3], p1[1]); a = ATT_MX3(a, p1[2], p1[3]);
#pragma unroll
    for (int r = 4; r < 16; r += 4) { a = ATT_MX3(a, p0[r], p0[r + 1]); b = ATT_MX3(b, p0[r + 2], p0[r + 3]); a = ATT_MX3(a, p1[r], p1[r + 1]); b = ATT_MX3(b, p1[r + 2], p1[r + 3]); }
    float m = __builtin_fmaxf(a, b); auto rr = __builtin_amdgcn_permlane32_swap(__float_as_uint(m), __float_as_uint(m), false, false);
    return __builtin_fmaxf(__uint_as_float(rr[0]), __uint_as_float(rr[1]));
}
#define ATT_WAIT_BAR(N) asm volatile("s_waitcnt vmcnt(" #N ") lgkmcnt(0)\n\ts_barrier" ::: "memory")
#define ATT_MFMA(a, b, c) __builtin_amdgcn_mfma_f32_32x32x16_bf16(a, b, c, 0, 0, 0)

template <bool FIRST>
__device__ __forceinline__ void tile_h1(int t, lds_cptr kp, const bf16x8 (&qr)[4], f32x16 (&o)[4], u32x4 (&pw)[4], float& mhat, float& l_reg,
                                        LAS float* wsf, const LAS float* btab, int qrow, int qw0, float c_left, float c_right, int r32, int hi) {
    const int relmin = 64 * t - qw0 - 31, relmax = 64 * t + 63 - qw0;
    const bool band = !(relmax <= -91 || relmin >= 91);
    const float cb = band ? 0.f : (relmin >= 91 ? c_right : c_left);
    f32x16 p0, p1;
    const f32x16 z16 = (f32x16){0.f, 0.f, 0.f, 0.f, 0.f, 0.f, 0.f, 0.f, 0.f, 0.f, 0.f, 0.f, 0.f, 0.f, 0.f, 0.f};
#pragma unroll
    for (int d0 = 0; d0 < 4; ++d0) {
        const bf16x8 k0 = *(const LAS bf16x8*)(kp + d0 * 2048), k1 = *(const LAS bf16x8*)(kp + d0 * 2048 + 512);
        if (d0 == 0) { p0 = ATT_MFMA(k0, qr[0], z16); p1 = ATT_MFMA(k1, qr[0], z16); }
        else { p0 = ATT_MFMA(k0, qr[d0], p0); p1 = ATT_MFMA(k1, qr[d0], p1); }
    }
    if (band) {
        const int relb = 64 * t + 4 * hi - qrow + 128;
#pragma unroll
        for (int r = 0; r < 16; ++r) { const int i0 = relb + (r & 3) + 8 * (r >> 2); const int a0 = i0 < 0 ? 0 : (i0 > 255 ? 255 : i0); const int i1 = i0 + 32; const int a1 = i1 < 0 ? 0 : (i1 > 255 ? 255 : i1);
            p0[r] += btab[a0]; p1[r] += btab[a1]; }
    }
    const float rm = rowmax(p0, p1) + cb;
    if (FIRST) { mhat = rm; }
    else if (__builtin_expect(__any(rm - mhat > (float)THR), 0)) {
        const float dl = __builtin_fmaxf(rm - mhat, 0.f); mhat += dl;
        const float f = __builtin_amdgcn_exp2f(-dl); l_reg *= f;
        if (hi == 0) wsf[r32] = f;
        asm volatile("s_waitcnt lgkmcnt(0)" ::: "memory");
        float fr[16];
#pragma unroll
        for (int r = 0; r < 16; ++r) fr[r] = wsf[crow(r, hi)];
#pragma unroll
        for (int db = 0; db < 4; ++db)
#pragma unroll
            for (int r = 0; r < 16; ++r) o[db][r] *= fr[r];
        asm volatile("s_waitcnt lgkmcnt(0)" ::: "memory");
    }
    const float off = cb - mhat;
    float sacc = 0.f;
#pragma unroll
    for (int r = 0; r < 16; ++r) { p0[r] = __builtin_amdgcn_exp2f(p0[r] + off); p1[r] = __builtin_amdgcn_exp2f(p1[r] + off); sacc += p0[r] + p1[r]; }
    l_reg += sacc;
#pragma unroll
    for (int ks = 0; ks < 4; ++ks) { const f32x16& P = (ks < 2) ? p0 : p1; const int b = 8 * (ks & 1);
        pw[ks] = (u32x4){cvt_pk_bf16(P[b], P[b + 1]), cvt_pk_bf16(P[b + 2], P[b + 3]), cvt_pk_bf16(P[b + 4], P[b + 5]), cvt_pk_bf16(P[b + 6], P[b + 7])}; }
}
__device__ __forceinline__ void tile_h2(lds_cptr vp, f32x16 (&o)[4], const u32x4 (&pw)[4]) {
#pragma unroll
    for (int ks = 0; ks < 4; ++ks)
#pragma unroll
        for (int db = 0; db < 4; ++db) {
            const s16x4 lo = vtr(vp + db * 4096 + ks * 1024), h4 = vtr(vp + db * 4096 + ks * 1024 + 512);
            const bf16x8 vf = (bf16x8){lo[0], lo[1], lo[2], lo[3], h4[0], h4[1], h4[2], h4[3]};
            o[db] = ATT_MFMA(__builtin_bit_cast(bf16x8, pw[ks]), vf, o[db]);
        }
}

struct VFrag { s16x4 lo, hi; };
template <int I> __device__ __forceinline__ VFrag vload(lds_cptr vp) {
    constexpr int off_ = (I & 3) * 4096 + (I >> 2) * 1024; VFrag f; f.lo = vtr(vp + off_); f.hi = vtr(vp + off_ + 512); return f;
}
__device__ __forceinline__ void attn_unit(int b, int h, int qb, const bf16_t* Q, const bf16_t* KT, const bf16_t* VT, bf16_t* MIXED, LAS unsigned char* lds, float lam, const float* subln_g, const float* rel_bias) {
    const int tid = threadIdx.x, lane = tid & 63, r32 = lane & 31, hi = lane >> 5; const int wid = __builtin_amdgcn_readfirstlane(tid >> 6);
    const int wq = wid & 3, mp = wid >> 2;
    const size_t rowbase = (size_t)b * S; const int q0 = qb * 128, qw0 = q0 + 32 * wq, qrow = qw0 + r32;
    LAS float* btab = (LAS float*)(lds + LDS_BIAS2); LAS float* wsf = (LAS float*)(lds + LDS_WSF) + wid * 64;
    { const int rel = tid - 256; const int n = rel < 0 ? -rel : rel; int bk; if (n < 8) bk = n; else { bk = 2 + (31 - __clz(n * n)); if (bk > 15) bk = 15; } if (rel > 0) bk += 16;
        btab[tid] = rel_bias[bk * NH + h] * LOG2E; }
    const float c_left = rel_bias[15 * NH + h] * LOG2E, c_right = rel_bias[31 * NH + h] * LOG2E;
    const bf16_t* Qw = Q + (rowbase + qw0) * 512 + h * 128 + mp * 64;
    bf16x8 qr[4];
#pragma unroll
    for (int d0 = 0; d0 < 4; ++d0) qr[d0] = *(const bf16x8*)(Qw + (size_t)r32 * 512 + d0 * 16 + hi * 8);
    const char* k1src = (const char*)KT + ((size_t)((b * 4 + h) * 2) * 64) * 8192 + wid * 1024 + lane * 16;
    const char* k2src = k1src + (size_t)64 * 8192;
    const char* vsrc = (const char*)VT + ((size_t)(b * 4 + h) * 64) * 16384 + wid * 1024 + lane * 16;
    const unsigned lds0 = (unsigned)(uintptr_t)(unsigned char*)lds;
    const unsigned kdst = lds0 + LDS_K + wid * 1024, vdst = lds0 + LDS_V + wid * 1024;
    const lds_cptr kp0 = (lds_cptr)lds + LDS_K + mp * 8192 + hi * 1024 + r32 * 16;
    const lds_cptr vp0 = (lds_cptr)lds + LDS_V + ((lane >> 4) & 1) * 32 + (lane & 3) * 8 + (4 * hi + ((lane & 15) >> 2)) * 64;
#define ATT_DMA_TILE(t, ks_, vs_) do { glds16(k1src + (size_t)(t) * 8192, (unsigned)__builtin_amdgcn_readfirstlane(kdst + (ks_))); glds16(k2src + (size_t)(t) * 8192, (unsigned)__builtin_amdgcn_readfirstlane(kdst + (ks_) + 8192)); \
        glds16(vsrc + (size_t)(t) * 16384, (unsigned)__builtin_amdgcn_readfirstlane(vdst + (vs_))); glds16(vsrc + (size_t)(t) * 16384 + 8192, (unsigned)__builtin_amdgcn_readfirstlane(vdst + (vs_) + 8192)); } while (0)
    ATT_DMA_TILE(0, 0, 0); ATT_DMA_TILE(1, SLOT, SLOT);
    float mhat = 0.f, l_reg = 0.f; f32x16 o[4]; u32x4 pw[4];
#pragma unroll
    for (int db = 0; db < 4; ++db)
#pragma unroll
        for (int r = 0; r < 16; ++r) o[db][r] = 0.f;
    int ksl = 0, ksl2 = 2 * SLOT, vsl = 0, vsl2 = 2 * SLOT, vprev = 0;
#define ATT_ROT() do { ksl = (ksl == 2 * SLOT) ? 0 : ksl + SLOT; ksl2 = (ksl2 == 2 * SLOT) ? 0 : ksl2 + SLOT; vprev = vsl; vsl = (vsl + SLOT) & (4 * SLOT - 1); vsl2 = (vsl2 + SLOT) & (4 * SLOT - 1); } while (0)
#define ATT_SB() __builtin_amdgcn_sched_barrier(0)
#define ATT_PIN(x) asm volatile("" : "+v"(x))
#define ATT_F(T0, T1, e) (((e) < 16) ? T0[(e) & 15] : T1[(e) & 15])
#define ATT_KRD(f) (*(const LAS bf16x8*)(kp_ + ((f) >> 1) * 2048 + ((f) & 1) * 512))
    const f32x16 z16 = (f32x16){0.f, 0.f, 0.f, 0.f, 0.f, 0.f, 0.f, 0.f, 0.f, 0.f, 0.f, 0.f, 0.f, 0.f, 0.f, 0.f};
#define ATT_GA(C0, C1, P0, P1, f) do { \
        if (((f) & 1) == 0) C0 = ATT_MFMA(kq[(f) % 3], qr[(f) >> 1], ((f) < 2) ? z16 : C0); else C1 = ATT_MFMA(kq[(f) % 3], qr[(f) >> 1], ((f) < 2) ? z16 : C1); \
        if ((f) + 3 < 8) kq[(f) % 3] = ATT_KRD((f) + 3); \
        sacc += ATT_F(P0, P1, 4 * (f)); sacc += ATT_F(P0, P1, 4 * (f) + 1); sacc += ATT_F(P0, P1, 4 * (f) + 2); sacc += ATT_F(P0, P1, 4 * (f) + 3); ATT_PIN(sacc); \
        pw[(f) >> 1][2 * ((f) & 1)] = cvt_pk_bf16(ATT_F(P0, P1, 4 * (f)), ATT_F(P0, P1, 4 * (f) + 1)); pw[(f) >> 1][2 * ((f) & 1) + 1] = cvt_pk_bf16(ATT_F(P0, P1, 4 * (f) + 2), ATT_F(P0, P1, 4 * (f) + 3)); ATT_PIN(pw[(f) >> 1]); \
        ATT_SB(); } while (0)
#define ATT_VRD(I) vload<(I) & 15>(vp_)
#define ATT_GBF(I, FILL) do { \
        { const VFrag& vv = vq[(I) % 3]; const bf16x8 vf = (bf16x8){vv.lo[0], vv.lo[1], vv.lo[2], vv.lo[3], vv.hi[0], vv.hi[1], vv.hi[2], vv.hi[3]}; \
          o[(I) & 3] = ATT_MFMA(__builtin_bit_cast(bf16x8, pw[(I) >> 2]), vf, o[(I) & 3]); } \
        if ((I) + 3 < 16) vq[(I) % 3] = ATT_VRD((I) + 3); \
        FILL; ATT_SB(); } while (0)
#define ATT_EX(C0, C1, e) do { if ((e) < 16) { C0[(e) & 15] = __builtin_amdgcn_exp2f(C0[(e) & 15] + off); } else { C1[(e) & 15] = __builtin_amdgcn_exp2f(C1[(e) & 15] + off); } } while (0)
#define ATT_EX3(C0, C1, e) do { ATT_EX(C0, C1, e); ATT_EX(C0, C1, (e) + 1); ATT_EX(C0, C1, (e) + 2); ATT_PIN(C0); ATT_PIN(C1); } while (0)
#define ATT_EX2(C0, C1, e) do { ATT_EX(C0, C1, e); ATT_EX(C0, C1, (e) + 1); ATT_PIN(C0); ATT_PIN(C1); } while (0)
#define ATT_MX3(a, b, c) __builtin_fmaxf(__builtin_fmaxf((a), (b)), (c))
#define ATT_BIAS(C0, C1, t) \
        const int relmin_ = 64 * (t) - qw0 - 31, relmax_ = 64 * (t) + 63 - qw0; const bool band_ = !(relmax_ <= -91 || relmin_ >= 91); const float cb_ = band_ ? 0.f : (relmin_ >= 91 ? c_right : c_left); \
        if (band_) { const LAS float* bp_ = btab + (64 * (t) + 4 * hi - qrow + 256);       \
            _Pragma("unroll") for (int r = 0; r < 16; ++r) { C0[r] += bp_[(r & 3) + 8 * (r >> 2)]; C1[r] += bp_[(r & 3) + 8 * (r >> 2) + 32]; } }
#define ATT_MAXP(C0, C1, g) do { if ((g) == 0) { ma_ = ATT_MX3(C0[0], C0[1], C1[0]); mb_ = ATT_MX3(C0[2], C0[3], C1[1]); ma_ = ATT_MX3(ma_, C1[2], C1[3]); } \
        else { ma_ = ATT_MX3(ma_, C0[4 * (g)], C0[4 * (g) + 1]); mb_ = ATT_MX3(mb_, C0[4 * (g) + 2], C0[4 * (g) + 3]); ma_ = ATT_MX3(ma_, C1[4 * (g)], C1[4 * (g) + 1]); mb_ = ATT_MX3(mb_, C1[4 * (g) + 2], C1[4 * (g) + 3]); } \
        ATT_PIN(ma_); ATT_PIN(mb_); } while (0)
#define ATT_DECIDE2(FIRST_) do { float rm_ = __builtin_fmaxf(ma_, mb_); { auto rr = __builtin_amdgcn_permlane32_swap(__float_as_uint(rm_), __float_as_uint(rm_), false, false); rm_ = __builtin_fmaxf(__uint_as_float(rr[0]), __uint_as_float(rr[1])); } \
        rm_ += cb_; resc = false; \
        if (FIRST_) { mhat = rm_; } \
        else if (__builtin_expect(__any(rm_ - mhat > (float)THR), 0)) { const float dl_ = __builtin_fmaxf(rm_ - mhat, 0.f); mhat += dl_; const float f_ = __builtin_amdgcn_exp2f(-dl_); l_reg *= f_; if (hi == 0) wsf[r32] = f_; resc = true; } \
        off = cb_ - mhat; ATT_SB(); } while (0)
#define ATT_RESC() do { if (resc) { asm volatile("s_waitcnt lgkmcnt(0)" ::: "memory"); float fr_[16]; \
        _Pragma("unroll") for (int r = 0; r < 16; ++r) fr_[r] = wsf[crow(r, hi)]; \
        _Pragma("unroll") for (int db = 0; db < 4; ++db) _Pragma("unroll") for (int r = 0; r < 16; ++r) o[db][r] *= fr_[r]; \
        asm volatile("s_waitcnt lgkmcnt(0)" ::: "memory"); } } while (0)
#define ATT_STEP(C0, C1, P0, P1, t) do { \
        const lds_cptr kp_ = kp0 + ksl; const lds_cptr vp_ = vp0 + vprev; float sacc = 0.f, ma_, mb_; \
        kq[0] = ATT_KRD(0); kq[1] = ATT_KRD(1); kq[2] = ATT_KRD(2); ATT_SB(); \
        ATT_GA(C0, C1, P0, P1, 0); ATT_GA(C0, C1, P0, P1, 1); ATT_GA(C0, C1, P0, P1, 2); ATT_GA(C0, C1, P0, P1, 3); \
        vq[0] = ATT_VRD(0); vq[1] = ATT_VRD(1); vq[2] = ATT_VRD(2); ATT_SB(); \
        ATT_GA(C0, C1, P0, P1, 4); ATT_GA(C0, C1, P0, P1, 5); ATT_GA(C0, C1, P0, P1, 6); ATT_GA(C0, C1, P0, P1, 7); \
        l_reg += sacc; \
        ATT_BIAS(C0, C1, t) ATT_SB(); \
        ATT_GBF(0, ATT_MAXP(C0, C1, 0)); ATT_GBF(1, ATT_MAXP(C0, C1, 1)); ATT_GBF(2, ATT_MAXP(C0, C1, 2)); ATT_GBF(3, ATT_MAXP(C0, C1, 3)); \
        ATT_DECIDE2(false); \
        ATT_GBF(4, ATT_EX3(C0, C1, 0)); ATT_GBF(5, ATT_EX3(C0, C1, 3)); ATT_GBF(6, ATT_EX3(C0, C1, 6)); ATT_GBF(7, ATT_EX3(C0, C1, 9)); \
        ATT_GBF(8, ATT_EX3(C0, C1, 12)); ATT_GBF(9, ATT_EX3(C0, C1, 15)); ATT_GBF(10, ATT_EX3(C0, C1, 18)); ATT_GBF(11, ATT_EX3(C0, C1, 21)); \
        ATT_GBF(12, ATT_EX2(C0, C1, 24)); ATT_GBF(13, ATT_EX2(C0, C1, 26)); ATT_GBF(14, ATT_EX2(C0, C1, 28)); ATT_GBF(15, ATT_EX2(C0, C1, 30)); \
        ATT_RESC(); ATT_ROT(); } while (0)
    f32x16 sa0, sa1, sb0, sb1; bf16x8 kq[3]; VFrag vq[3]; float off = 0.f; bool resc = false;
    ATT_WAIT_BAR(4); ATT_DMA_TILE(2, ksl2, vsl2);
    { const lds_cptr kp_ = kp0 + ksl;
#pragma unroll
      for (int d0 = 0; d0 < 4; ++d0) { const bf16x8 k0 = ATT_KRD(2 * d0), k1 = ATT_KRD(2 * d0 + 1);
          if (d0 == 0) { sa0 = ATT_MFMA(k0, qr[0], z16); sa1 = ATT_MFMA(k1, qr[0], z16); } else { sa0 = ATT_MFMA(k0, qr[d0], sa0); sa1 = ATT_MFMA(k1, qr[d0], sa1); } }
      float ma_, mb_; ATT_BIAS(sa0, sa1, 0) ATT_MAXP(sa0, sa1, 0); ATT_MAXP(sa0, sa1, 1); ATT_MAXP(sa0, sa1, 2); ATT_MAXP(sa0, sa1, 3); ATT_DECIDE2(true);
#pragma unroll
      for (int r = 0; r < 16; ++r) { sa0[r] = __builtin_amdgcn_exp2f(sa0[r] + off); sa1[r] = __builtin_amdgcn_exp2f(sa1[r] + off); }
      ATT_ROT(); }
    for (int t = 1; t < NT - 3; t += 2) {
        ATT_WAIT_BAR(4); ATT_DMA_TILE(t + 2, ksl2, vsl2); ATT_STEP(sb0, sb1, sa0, sa1, t);
        ATT_WAIT_BAR(4); ATT_DMA_TILE(t + 3, ksl2, vsl2); ATT_STEP(sa0, sa1, sb0, sb1, t + 1);
    }
    ATT_WAIT_BAR(4); ATT_DMA_TILE(NT - 1, ksl2, vsl2); ATT_STEP(sb0, sb1, sa0, sa1, NT - 3);
    ATT_WAIT_BAR(4); ATT_STEP(sa0, sa1, sb0, sb1, NT - 2);
    ATT_WAIT_BAR(0); ATT_STEP(sb0, sb1, sa0, sa1, NT - 1);
    { float sacc = 0.f;
#pragma unroll
      for (int r = 0; r < 16; ++r) sacc += sb0[r] + sb1[r];
      l_reg += sacc;
#pragma unroll
      for (int g = 0; g < 16; ++g) pw[g >> 2][g & 3] = cvt_pk_bf16(ATT_F(sb0, sb1, 2 * g), ATT_F(sb0, sb1, 2 * g + 1));
      const lds_cptr vp_ = vp0 + vprev;
#pragma unroll
      for (int ks = 0; ks < 4; ++ks)
#pragma unroll
          for (int db = 0; db < 4; ++db) { const s16x4 lo = vtr(vp_ + db * 4096 + ks * 1024), h4 = vtr(vp_ + db * 4096 + ks * 1024 + 512);
              const bf16x8 vf = (bf16x8){lo[0], lo[1], lo[2], lo[3], h4[0], h4[1], h4[2], h4[3]}; o[db] = ATT_MFMA(__builtin_bit_cast(bf16x8, pw[ks]), vf, o[db]); } }
#undef ATT_STEP
#undef ATT_RESC
#undef ATT_DECIDE2
#undef ATT_MAXP
#undef ATT_BIAS
#undef ATT_EX2
#undef ATT_EX3
#undef ATT_EX
#undef ATT_GBF
#undef ATT_GA
#undef ATT_VRD
#undef ATT_KRD
#undef ATT_F
#undef ATT_PIN
#undef ATT_SB
    { auto rr = __builtin_amdgcn_permlane32_swap(__float_as_uint(l_reg), __float_as_uint(l_reg), false, false); l_reg = __uint_as_float(rr[0]) + __uint_as_float(rr[1]); }
    const float scale_q = (mp == 0 ? 1.0f : lam) * __builtin_amdgcn_rcpf(l_reg);
    if (hi == 0) wsf[r32] = scale_q;
    asm volatile("s_waitcnt lgkmcnt(0)" ::: "memory");
    float sc[16];
#pragma unroll
    for (int r = 0; r < 16; ++r) sc[r] = wsf[crow(r, hi)];
    asm volatile("s_waitcnt lgkmcnt(0)\n\ts_barrier" ::: "memory");
    LAS float* X = (LAS float*)(lds + LDS_X) + wq * 4096 + lane;
    if (mp == 1) {
#pragma unroll
        for (int db = 0; db < 4; ++db)
#pragma unroll
            for (int r = 0; r < 16; ++r) X[(db * 16 + r) * 64] = o[db][r] * sc[r];
    }
    asm volatile("s_waitcnt lgkmcnt(0)\n\ts_barrier" ::: "memory");
    if (mp == 0) {
        float ss[16];
#pragma unroll
        for (int r = 0; r < 16; ++r) ss[r] = 0.f;
#pragma unroll
        for (int db = 0; db < 4; ++db)
#pragma unroll
            for (int r = 0; r < 16; ++r) { const float d = o[db][r] * sc[r] - X[(db * 16 + r) * 64]; o[db][r] = d; ss[r] += d * d; }
#pragma unroll
        for (int r = 0; r < 16; ++r) {
#pragma unroll
            for (int x = 1; x < 32; x <<= 1) ss[r] += __shfl_xor(ss[r], x);
            ss[r] = __builtin_amdgcn_rsqf(ss[r] * (1.0f / 128.0f) + EPS) * 0.8f;
        }
        LAS bf16_t* stg = (LAS bf16_t*)(lds + LDS_OST) + wq * 4096;
#pragma unroll
        for (int db = 0; db < 4; ++db) { const float g = subln_g[db * 32 + r32];
#pragma unroll
            for (int r = 0; r < 16; ++r) { const unsigned w = cvt_pk_bf16(o[db][r] * ss[r] * g, 0.f); stg[crow(r, hi) * 128 + db * 32 + r32] = (bf16_t)(w & 0xffffu); } }
        asm volatile("s_waitcnt lgkmcnt(0)" ::: "memory");
        bf16_t* Ow = MIXED + (rowbase + qw0) * 1024 + h * 128;
#pragma unroll
        for (int i = 0; i < 8; ++i) { const int row = i * 4 + (lane >> 4), ch = lane & 15; const u32x4 v = *(const LAS u32x4*)(stg + row * 128 + ch * 8); *(u32x4*)(Ow + (size_t)row * 1024 + ch * 8) = v; }
    }
    asm volatile("s_waitcnt vmcnt(0) lgkmcnt(0)\n\ts_barrier" ::: "memory");
#undef ATT_DMA_TILE
#undef ATT_ROT
}
}

namespace lru {
template <int N> __device__ __forceinline__ float dpp_shr(float v, float ident) {
    return __int_as_float(__builtin_amdgcn_update_dpp(__float_as_int(ident), __float_as_int(v), 0x110 + N, 0xF, 0xF, false));
}
#define LRU_MFMA16(a, b, c) __builtin_amdgcn_mfma_f32_16x16x32_bf16(a, b, c, 0, 0, 0)
__device__ __forceinline__ void lru_rows(bf16x8 (&rowv)[2][7], __amdgpu_buffer_rsrc_t xsrd, int dir, int Pb, int ch0) {
#pragma unroll
    for (int k = 0; k < 7; ++k) {
        const int tt = dir ? (S - Pb - k) : (Pb - 2 + k);
#pragma unroll
        for (int ks = 0; ks < 2; ++ks) rowv[ks][k] = __builtin_bit_cast(bf16x8, __builtin_amdgcn_raw_buffer_load_b128(xsrd, (tt * 512 + ch0 + 32 * ks) * 2, 0, 0));
    }
}
__device__ __forceinline__ void lru_item(int b, int cg, const bf16_t* XR, const bf16_t* GR, float* HF, bf16_t* MIXED, bf16_t* XC, unsigned* sib_cnt, LAS unsigned char* lds,
                                         const float* conv_w, const float* conv_b, const float* w_rg, const float* b_rg, const float* w_ig, const float* b_ig, const float* lru_lambda) {
    const int tid = threadIdx.x, lane = tid & 63, p = lane & 15, g = lane >> 4; const int wid = __builtin_amdgcn_readfirstlane(tid >> 6);
    const int n = cg >> 2, e16 = cg & 3, c0 = n * 64 + e16 * 16;
    const size_t rowbase = (size_t)b * S;
    const __amdgpu_buffer_rsrc_t XRb = __builtin_amdgcn_make_buffer_rsrc((void*)(XR + rowbase * 512), (short)0, S * 512 * 2, 0x00020000); const int ch0 = n * 64 + 8 * g;
    LAS float* tot = (LAS float*)(lds + att::LDS_TOT);
    bf16x8 idf;
#pragma unroll
    for (int j = 0; j < 8; ++j) idf[j] = ((8 * g + j) == (16 * (e16 & 1) + p)) ? (short)0x3f80 : (short)0;
    int par = 0;
    LAS float* cwl = (LAS float*)(lds + att::LDS_CW);
    if (tid < 320) { const int j = tid >> 6, c = tid & 63; cwl[tid] = (j < 4) ? conv_w[j * 512 + n * 64 + c] : conv_b[n * 64 + c]; }
    __syncthreads();
    {
        const int g8 = tid & 7, trow = tid >> 3;
        const int c8 = n * 64 + 8 * g8;
        f32x4 w0[4], w1[4];
#pragma unroll
        for (int j = 0; j < 4; ++j) { w0[j] = *(const LAS f32x4*)(cwl + j * 64 + 8 * g8); w1[j] = *(const LAS f32x4*)(cwl + j * 64 + 8 * g8 + 4); }
        const f32x4 bb0 = *(const LAS f32x4*)(cwl + 256 + 8 * g8), bb1 = *(const LAS f32x4*)(cwl + 256 + 8 * g8 + 4);
        for (int st = 0; st < 16; ++st) {
            const int tok = e16 * 1024 + st * 64 + trow;
            f32x4 a0 = bb0, a1 = bb1;
#pragma unroll
            for (int j = 0; j < 4; ++j) {
                const u32x4 rw = __builtin_amdgcn_raw_buffer_load_b128(XRb, ((tok + j - 2) * 512 + c8) * 2, 0, 0);
                a0 += w0[j] * (f32x4){__uint_as_float(rw[0] << 16), __uint_as_float(rw[0] & 0xffff0000u), __uint_as_float(rw[1] << 16), __uint_as_float(rw[1] & 0xffff0000u)};
                a1 += w1[j] * (f32x4){__uint_as_float(rw[2] << 16), __uint_as_float(rw[2] & 0xffff0000u), __uint_as_float(rw[3] << 16), __uint_as_float(rw[3] & 0xffff0000u)};
            }
            *(u32x4*)(XC + (rowbase + tok) * 512 + c8) = (u32x4){cvt_pk_bf16(a0[0], a0[1]), cvt_pk_bf16(a0[2], a0[3]), cvt_pk_bf16(a1[0], a1[1]), cvt_pk_bf16(a1[2], a1[3])};
        }
        asm volatile("s_waitcnt vmcnt(0)" ::: "memory");
        __syncthreads();
        if (tid == 0) {
            __builtin_amdgcn_fence(__ATOMIC_RELEASE, "agent");
            asm volatile("s_waitcnt vmcnt(0)" ::: "memory");
            __hip_atomic_fetch_add(sib_cnt, 1u, __ATOMIC_RELAXED, __HIP_MEMORY_SCOPE_AGENT);
            unsigned sp = 0;
            while (__hip_atomic_load(sib_cnt, __ATOMIC_RELAXED, __HIP_MEMORY_SCOPE_AGENT) < 4u) { __builtin_amdgcn_s_sleep(2); if (++sp > (1u << 22)) break; }
            __builtin_amdgcn_fence(__ATOMIC_ACQUIRE, "agent");
            asm volatile("s_waitcnt vmcnt(0)" ::: "memory");
        }
        __syncthreads();
    }
    for (int dir = 0; dir < 2; ++dir) {
        bf16x8 wrf[2], wif[2];
#pragma unroll
        for (int ks = 0; ks < 2; ++ks) {
            unsigned wr_[4], wi_[4];
#pragma unroll
            for (int j2 = 0; j2 < 4; ++j2) { const int d = 32 * ks + 8 * g + 2 * j2; const size_t i0 = ((size_t)((dir * 8 + n) * 64 + d)) * 64 + e16 * 16 + p;
                wr_[j2] = cvt_pk_bf16(w_rg[i0], w_rg[i0 + 64]); wi_[j2] = cvt_pk_bf16(w_ig[i0], w_ig[i0 + 64]); }
            wrf[ks] = __builtin_bit_cast(bf16x8, (u32x4){wr_[0], wr_[1], wr_[2], wr_[3]}); wif[ks] = __builtin_bit_cast(bf16x8, (u32x4){wi_[0], wi_[1], wi_[2], wi_[3]});
        }
        float br[4], bi[4], sp8[4], carry[4];
#pragma unroll
        for (int r = 0; r < 4; ++r) { const int c = dir * 512 + c0 + 4 * g + r; br[r] = b_rg[c] * -LOG2E; bi[r] = b_ig[c] * -LOG2E; const float lm = lru_lambda[c]; sp8[r] = 8.0f * LOG2E * ((-lm > 20.0f) ? -lm : log1pf(expf(-lm)));     carry[r] = 0.f; }
        LAS u32x4* lst = (LAS u32x4*)lds + tid;
        lst[0 * 512] = __builtin_bit_cast(u32x4, wrf[0]); lst[1 * 512] = __builtin_bit_cast(u32x4, wrf[1]); lst[2 * 512] = __builtin_bit_cast(u32x4, wif[0]); lst[3 * 512] = __builtin_bit_cast(u32x4, wif[1]);
        lst[4 * 512] = __builtin_bit_cast(u32x4, (f32x4){br[0], br[1], br[2], br[3]}); lst[5 * 512] = __builtin_bit_cast(u32x4, (f32x4){bi[0], bi[1], bi[2], bi[3]}); lst[6 * 512] = __builtin_bit_cast(u32x4, (f32x4){sp8[0], sp8[1], sp8[2], sp8[3]}); lst[7 * 512] = __builtin_bit_cast(u32x4, idf);
        bf16x8 xf[4][2];
#define LRU_XLOAD(PB_) do { _Pragma("unroll") for (int i = 0; i < 4; ++i) { const int tok_ = dir ? (S - 1 - ((PB_) + i)) : ((PB_) + i); \
            _Pragma("unroll") for (int ks = 0; ks < 2; ++ks) xf[i][ks] = *(const bf16x8*)(XC + (rowbase + tok_) * 512 + ch0 + 32 * ks); } } while (0)
        LRU_XLOAD(wid * 64 + 4 * p);
        for (int sc = 0; sc < 8; ++sc) {
            const int P0 = sc * 512 + wid * 64, Pb = P0 + 4 * p;
            f32x4 ar[4], ai[4], ax[4];
            {
                int zoff = 0; asm volatile("" : "+v"(zoff));
                const LAS u32x4* lsi = (const LAS u32x4*)lds + tid + zoff;
                const bf16x8 wrf0 = __builtin_bit_cast(bf16x8, lsi[0 * 512]), wrf1 = __builtin_bit_cast(bf16x8, lsi[1 * 512]), wif0 = __builtin_bit_cast(bf16x8, lsi[2 * 512]), wif1 = __builtin_bit_cast(bf16x8, lsi[3 * 512]), idf_ = __builtin_bit_cast(bf16x8, lsi[7 * 512]);
                const f32x4 z = (f32x4){0.f, 0.f, 0.f, 0.f};
#pragma unroll
                for (int i = 0; i < 4; ++i) {
                    ar[i] = LRU_MFMA16(wrf0, xf[i][0], z); ar[i] = LRU_MFMA16(wrf1, xf[i][1], ar[i]);
                    ai[i] = LRU_MFMA16(wif0, xf[i][0], z); ai[i] = LRU_MFMA16(wif1, xf[i][1], ai[i]);
                    ax[i] = LRU_MFMA16(idf_, (e16 & 2) ? xf[i][1] : xf[i][0], z);
                }
                __builtin_amdgcn_sched_barrier(0);
                if (sc < 7) LRU_XLOAD(Pb + 512);
            }
            float hh[4][4], cpp[4][4], Al[4], Hl[4];
            int zoff2 = 0; asm volatile("" : "+v"(zoff2));
            const LAS f32x4* lsg = (const LAS f32x4*)lds + tid + zoff2;
            const f32x4 brv = lsg[4 * 512], biv = lsg[5 * 512], spv = lsg[6 * 512];
#pragma unroll
            for (int r = 0; r < 4; ++r) {
                float h = 0.f, cp = 1.f;
#pragma unroll
                for (int i = 0; i < 4; ++i) {
                    const float rg = __builtin_amdgcn_rcpf(1.0f + __builtin_amdgcn_exp2f(ar[i][r] * -LOG2E + brv[r])), ig = __builtin_amdgcn_rcpf(1.0f + __builtin_amdgcn_exp2f(ai[i][r] * -LOG2E + biv[r]));
                    const float a_ = __builtin_amdgcn_exp2f(-rg * spv[r]);
                    const float om = __builtin_fmaf(-a_, a_, 1.0f);
                    const float u_ = __builtin_amdgcn_sqrtf(om) * (ig * ax[i][r]);
                    h = a_ * h + u_; cp = a_ * cp; hh[i][r] = h; cpp[i][r] = cp;
                }
                Al[r] = cp; Hl[r] = h;
            }
#define LRU_KS(NN) do { _Pragma("unroll") for (int r = 0; r < 4; ++r) { const float Ap = dpp_shr<NN>(Al[r], 1.0f), Hp = dpp_shr<NN>(Hl[r], 0.0f); Hl[r] = Al[r] * Hp + Hl[r]; Al[r] = Al[r] * Ap; } } while (0)
            LRU_KS(1); LRU_KS(2); LRU_KS(4); LRU_KS(8);
#undef LRU_KS
            float Aex[4], Hex[4];
#pragma unroll
            for (int r = 0; r < 4; ++r) { Aex[r] = dpp_shr<1>(Al[r], 1.0f); Hex[r] = dpp_shr<1>(Hl[r], 0.0f); }
            if (p == 15) {
#pragma unroll
                for (int r = 0; r < 4; ++r) { tot[((par * 8 + wid) * 16 + 4 * g + r) * 2] = Al[r]; tot[((par * 8 + wid) * 16 + 4 * g + r) * 2 + 1] = Hl[r]; }
            }
            asm volatile("s_waitcnt lgkmcnt(0)\n\ts_barrier" ::: "memory");
            float cin[4];
#pragma unroll
            for (int r = 0; r < 4; ++r) cin[r] = 0.f;
#pragma unroll
            for (int w = 0; w < 8; ++w) {
                const f32x4 t0 = *(const LAS f32x4*)(tot + ((par * 8 + w) * 16 + 4 * g) * 2), t1 = *(const LAS f32x4*)(tot + ((par * 8 + w) * 16 + 4 * g) * 2 + 4);
                const float Aw[4] = {t0[0], t0[2], t1[0], t1[2]}, Hw[4] = {t0[1], t0[3], t1[1], t1[3]};
#pragma unroll
                for (int r = 0; r < 4; ++r) { if (w == wid) cin[r] = carry[r]; carry[r] = Aw[r] * carry[r] + Hw[r]; }
            }
            par ^= 1;
            f32x4 hfv[4]; u32x2 gv[4];
            if (dir) {
#pragma unroll
                for (int i = 0; i < 4; ++i) { const int tok = S - 1 - (Pb + i); hfv[i] = *(const f32x4*)(HF + (rowbase + tok) * 512 + c0 + 4 * g); gv[i] = *(const u32x2*)(GR + (rowbase + tok) * 512 + c0 + 4 * g); }
            }
            float cl[4];
#pragma unroll
            for (int r = 0; r < 4; ++r) cl[r] = Aex[r] * cin[r] + Hex[r];
#pragma unroll
            for (int i = 0; i < 4; ++i) {
                const int P = Pb + i; const int tok = dir ? (S - 1 - P) : P;
                f32x4 hv;
#pragma unroll
                for (int r = 0; r < 4; ++r) hv[r] = hh[i][r] + cpp[i][r] * cl[r];
                if (dir == 0) *(f32x4*)(HF + (rowbase + tok) * 512 + c0 + 4 * g) = hv;
                else {
                    const float gr4[4] = {__uint_as_float(gv[i].x << 16), __uint_as_float(gv[i].x & 0xffff0000u), __uint_as_float(gv[i].y << 16), __uint_as_float(gv[i].y & 0xffff0000u)};
                    float y[4];
#pragma unroll
                    for (int r = 0; r < 4; ++r) { const float x = gr4[r]; const float gl = x * fast_sigmoid(1.5957691216057308f * (x + 0.044715f * x * x * x)); y[r] = gl * (hv[r] + hfv[i][r]); }
                    u32x2 w; w.x = cvt_pk_bf16(y[0], y[1]); w.y = cvt_pk_bf16(y[2], y[3]);
                    *(u32x2*)(MIXED + (rowbase + tok) * 1024 + 512 + c0 + 4 * g) = w;
                }
            }
        }
        __syncthreads();
    }
}
}
struct Args { const float* in[22]; float* out; unsigned char* ws; int ph_lo, ph_hi; };
constexpr int N_PHASES = 6;

__global__ void __launch_bounds__(NWAVES * 64, 2) mk_fwd(Args args) {
    extern __shared__ __attribute__((aligned(16))) unsigned char lds_raw[];
    LAS unsigned char* lds = (LAS unsigned char*)lds_raw;
    const int tid = threadIdx.x, lane = tid & 63; const int wave = __builtin_amdgcn_readfirstlane(tid >> 6);
    const int G = gridDim.x, bx = blockIdx.x; const int vcu = (G % 8 == 0) ? (bx % 8) * (G / 8) + bx / 8 : bx;
    unsigned char* ws = args.ws;
    const float* x = args.in[0]; float* out = args.out;
    bf16_t* WIN = (bf16_t*)(ws + WS_WIN); bf16_t* WOUT = (bf16_t*)(ws + WS_WOUT); bf16_t* WGU = (bf16_t*)(ws + WS_WGU); bf16_t* WDN = (bf16_t*)(ws + WS_WDN);
    float* RSS1 = (float*)(ws + WS_RSS1); float* RSS2 = (float*)(ws + WS_RSS2);
    bf16_t* XN = (bf16_t*)(ws + WS_XN); bf16_t* HB = XN;
    bf16_t* Qb = (bf16_t*)(ws + WS_Q); bf16_t* KT = (bf16_t*)(ws + WS_KT); bf16_t* VT = (bf16_t*)(ws + WS_VT); bf16_t* XR = (bf16_t*)(ws + WS_XR); bf16_t* GR = (bf16_t*)(ws + WS_GR);
    float* HF = (float*)(ws + WS_HF); bf16_t* MIXED = (bf16_t*)(ws + WS_MIXED); bf16_t* ACT = (bf16_t*)(ws + WS_ACT);
    const int lo = args.ph_lo, hi = args.ph_hi;
    volatile LAS unsigned* bst = (volatile LAS unsigned*)(lds + LDS_MISC + 8192);
    if (tid == 0) { bst[0] = 0u; bst[1] = 0u; bst[2] = 0u; }
    __syncthreads();
    xb::XcdBarrier bar = xb::xcd_barrier_post((unsigned*)ws, bst);
    if (lo > 1000) cooperative_groups::this_grid().sync();
#define IN(k) (lo <= (k) && (k) < hi)
#ifndef REP_PHASE
#define REP_PHASE -1
#endif
#define REPS(k) ((REP_PHASE == (k)) ? 2 : 1)
#define REPSYNC(k, rep) do { if ((rep) + 1 < REPS(k)) xb::xcd_barrier(bar); } while (0)
#define SEAM(k) do { if (IN(k) && IN((k) + 1)) { xb::xcd_barrier(bar); } } while (0)

    if (IN(0)) for (int rep = 0; rep < REPS(0); ++rep) {
        LAS float* scr = (LAS float*)(lds + wave * 16384);
        const int gw = vcu * NWAVES + wave, NGW = G * NWAVES;
        constexpr int I_IN = (D / 64) * (DIN / 32), I_OUT = (D / 64) * (D / 32), I_G = (D / 64) * (DFF / 32), I_DN = (DFF / 64) * (D / 32);
        constexpr int NITEMS = I_IN + I_OUT + 2 * I_G + I_DN;
        for (int it = gw; it < NITEMS; it += NGW) {
            int r = it;
            if (r < I_IN) { p0_transpose_item<0>(args.in[2], D, DIN, WIN, nullptr, scr, r, lane); continue; } r -= I_IN;
            if (r < I_OUT) { p0_transpose_item<0>(args.in[16], D, D, WOUT, nullptr, scr, r, lane); continue; } r -= I_OUT;
            if (r < I_G) { p0_transpose_item<1>(args.in[18], D, DFF, WGU, args.in[17], scr, r, lane); continue; } r -= I_G;
            if (r < I_G) { p0_transpose_item<2>(args.in[19], D, DFF, WGU, args.in[17], scr, r, lane); continue; } r -= I_G;
            p0_transpose_item<0>(args.in[20], DFF, D, WDN, nullptr, scr, r, lane);
        }
        for (int m = gw * 4; m < M; m += NGW * 4) rms_rows_to_bf16<4>(x + (size_t)m * D, args.in[1], XN + (size_t)m * D, lane);
        REPSYNC(0, rep);
    }
    SEAM(0);
    if (IN(1)) for (int rep = 0; rep < REPS(1); ++rep) {
        pg8::Gemm g{XN, WIN, M, DIN, D}; pg8::StaticOrder So; So.init(M, DIN, G, bx);
        pg8::EpiInProj E{Qb, KT, VT, XR, GR, QSCALE};
        pg8::gemm_phase<pg8::EpiInProj, pg8::StaticOrder, true, true>(lds, g, So, E);
        REPSYNC(1, rep);
    }
    SEAM(1);
    if (IN(2)) {
        float lam;
        { float s1 = 0.f, s2 = 0.f; for (int i = 0; i < 64; ++i) { s1 += args.in[3][i] * args.in[4][i]; s2 += args.in[5][i] * args.in[6][i]; } lam = expf(s1) - expf(s2) + 0.2f; }
        for (int rep = 0; rep < REPS(20); ++rep)
        for (int rnd = 0; rnd * G + vcu < NB * NH * 32; ++rnd) {
            const int u = rnd * G + vcu; int b_, h_, qb_;
            if (G == 256) { b_ = vcu >> 5; h_ = rnd; qb_ = vcu & 31; } else { qb_ = u & 31; h_ = (u >> 5) & 3; b_ = u >> 7; }
            att::attn_unit(b_, h_, qb_, Qb, KT, VT, MIXED, lds, lam, args.in[7], args.in[8]);
        }
        for (int rep = 0; rep < REPS(21); ++rep)
        for (int it = vcu; it < NB * 32; it += G) {
            const int b_ = it >> 5, cg = it & 31;
            lru::lru_item(b_, cg, XR, GR, HF, MIXED, (bf16_t*)(ws + WS_XC), (unsigned*)ws + 16384 + 64 * (it >> 2), lds, args.in[9], args.in[10], args.in[11], args.in[12], args.in[13], args.in[14], args.in[15]);
        }
    }
    SEAM(2);
    if (IN(3)) for (int rep = 0; rep < REPS(3); ++rep) {
        pg8::Gemm g{MIXED, WOUT, M, D, D}; pg8::StaticOrder So; So.init(M, D, G, bx);
        pg8::EpiResid<true, false> E{x, out, HB, RSS1, D};
        pg8::gemm_phase<pg8::EpiResid<true, false>, pg8::StaticOrder, true, true>(lds, g, So, E);
        REPSYNC(3, rep);
    }
    SEAM(3);
    if (IN(4)) for (int rep = 0; rep < REPS(4); ++rep) {
        pg8::Gemm g{HB, WGU, M, 2 * DFF, D}; pg8::StaticOrder So; So.init(M, 2 * DFF, G, bx);
        pg8::EpiGateUp E{ACT, RSS1, DFF, EPS};
        pg8::gemm_phase<pg8::EpiGateUp, pg8::StaticOrder, true, true>(lds, g, So, E);
        REPSYNC(4, rep);
    }
    SEAM(4);
    if (IN(5)) for (int rep = 0; rep < REPS(5); ++rep) {
        if (G == 256) {
#pragma unroll 1
            for (int half = 0; half < 2; ++half) {
                const size_t r0 = (size_t)half * (M / 2);
                pg8::Gemm g{ACT + r0 * DFF, WDN, M / 2, D, DFF}; pg8::StaticOrder So; So.init(M / 2, D, G, bx);
                pg8::EpiDownNorm E{HB + r0 * D, out + r0 * D, args.in[21], RSS2 + r0 * 4, (unsigned*)ws + 4096 + 64 * 64 * half, D, EPS};
                pg8::gemm_phase<pg8::EpiDownNorm, pg8::StaticOrder, false, true>(lds, g, So, E);
                __syncthreads();
            }
        }
        REPSYNC(5, rep);
    }
#if REP_PHASE == 99
    for (int i = 0; i < 20; ++i) xb::xcd_barrier(bar);
#endif
#undef IN
#undef SEAM
}
}
namespace dbg {
using namespace mk;
__global__ void __launch_bounds__(256) k_unpack_proj(const bf16_t* Qb, const bf16_t* KT, const bf16_t* VT, const bf16_t* XR, const bf16_t* GR, float* q, float* k, float* v, float* xr, float* gr) {
    const size_t idx = (size_t)blockIdx.x * 256 + threadIdx.x;
    const int c = (int)(idx & 511); const int row = (int)(idx >> 9); const int b = row >> 12, tok = row & 4095, t = tok >> 6, rr = tok & 63;
    q[idx] = bf2f(Qb[idx]) * (1.0f / QSCALE);
    { const int h = c >> 7, w = c & 127, s = w >> 6, d = w & 63, chunk = d >> 3, j = d & 7;
      k[idx] = bf2f(KT[((((size_t)(b * 4 + h) * 2 + s) * 64 + t) * 8 + chunk) * 512 + rr * 8 + j]); }
    { const int h = c >> 7, dv = c & 127, db = dv >> 5, cc = dv & 31;
      v[idx] = bf2f(VT[(((size_t)(b * 4 + h) * 64 + t) * 4 + db) * 2048 + rr * 32 + cc]); }
    xr[idx] = bf2f(XR[idx]); gr[idx] = bf2f(GR[idx]);
}
__global__ void __launch_bounds__(256) k_unpack_bf16(const bf16_t* src, float* dst) { const size_t idx = (size_t)blockIdx.x * 256 + threadIdx.x; dst[idx] = bf2f(src[idx]); }
}

#ifndef STAGE
#define STAGE 4
#endif
static void mk_launch_phases(const mk::Args& a0, int lo, int hi, int grid, hipStream_t stream, bool coop) {
    mk::Args a = a0; a.ph_lo = lo; a.ph_hi = hi;
    if (coop) { void* args[] = {&a}; hipError_t e = hipLaunchCooperativeKernel((const void*)mk::mk_fwd, dim3(grid), dim3(mk::NWAVES * 64), args, mk::LDS_BYTES, stream);
        if (e != hipSuccess) fprintf(stderr, "cooperative launch failed: %s (grid %d)\n", hipGetErrorString(e), grid); }
    else { hipLaunchKernelGGL(mk::mk_fwd, dim3(grid), dim3(mk::NWAVES * 64), mk::LDS_BYTES, stream, a); }
}

extern "C" void kernel_launch(void* const* d_in, const int* in_sizes, int n_in, void* d_out, int out_size, void* d_ws, size_t ws_size, hipStream_t stream) {
    static int grid = 0;
    if (grid == 0) {
        int dev = 0, cus = 0, per_cu = 0;
        hipGetDevice(&dev); hipDeviceGetAttribute(&cus, hipDeviceAttributeMultiprocessorCount, dev);
        if (hipFuncSetAttribute((const void*)mk::mk_fwd, hipFuncAttributeMaxDynamicSharedMemorySize, mk::LDS_BYTES) != hipSuccess) { fprintf(stderr, "hipFuncSetAttribute failed\n"); grid = -1; return; }
        if (hipOccupancyMaxActiveBlocksPerMultiprocessor(&per_cu, (const void*)mk::mk_fwd, mk::NWAVES * 64, mk::LDS_BYTES) != hipSuccess || per_cu < 1) { fprintf(stderr, "occupancy query: %d\n", per_cu); per_cu = 1; }
        (void)hipGetLastError();
        grid = cus * 1;
        if (n_in != 22 || ws_size < 512u * mk::MiB) fprintf(stderr, "kernel_launch: unexpected n_in %d / ws_size %zu\n", n_in, ws_size);
    }
    if (grid < 0) return;
    if (hipMemsetAsync(d_ws, 0, 131072, stream) != hipSuccess) { fprintf(stderr, "memset failed\n"); return; }
    mk::Args a{};
    for (int i = 0; i < 22; ++i) a.in[i] = (const float*)d_in[i];
    a.out = (float*)d_out; a.ws = (unsigned char*)d_ws;
    char* ws = (char*)d_ws; const size_t MiB = 1u << 20;
#if STAGE == 4
    mk_launch_phases(a, 0, mk::N_PHASES, grid, stream, true);
#elif STAGE == 3
    for (int p = 0; p < mk::N_PHASES; ++p) mk_launch_phases(a, p, p + 1, grid, stream, false);
#elif STAGE == 1
    for (int p = 0; p < 2; ++p) mk_launch_phases(a, p, p + 1, grid, stream, false);
    float* q = (float*)(ws + 32 * MiB), *k = (float*)(ws + 256 * MiB), *v = (float*)(ws + 320 * MiB), *xr = (float*)(ws + 384 * MiB), *gr = (float*)(ws + 448 * MiB);
    dbg::k_unpack_proj<<<mk::M * 512 / 256, 256, 0, stream>>>((const mk::bf16_t*)(ws + mk::WS_Q), (const mk::bf16_t*)(ws + mk::WS_KT), (const mk::bf16_t*)(ws + mk::WS_VT), (const mk::bf16_t*)(ws + mk::WS_XR), (const mk::bf16_t*)(ws + mk::WS_GR), q, k, v, xr, gr);
    float* mixed = (float*)(ws + 96 * MiB);
    nv::naive_mid(d_in, q, k, v, xr, gr, mixed, stream);
    nv::naive_tail(d_in, mixed, (float*)d_out, (float*)(ws + 0), (float*)(ws + 128 * MiB), stream);
#elif STAGE == 2
    for (int p = 0; p < 3; ++p) mk_launch_phases(a, p, p + 1, grid, stream, false);
    float* mixed = (float*)(ws + 0);
    dbg::k_unpack_bf16<<<mk::M * 1024 / 256, 256, 0, stream>>>((const mk::bf16_t*)(ws + mk::WS_MIXED), mixed);
    nv::naive_tail(d_in, mixed, (float*)d_out, (float*)(ws + 0), (float*)(ws + 128 * MiB), stream);
#endif
}
```

```cpp
#include <hip/hip_runtime.h>
#include <hip/hip_cooperative_groups.h>
#include <cstdio>
#include <cstdint>
#include <cmath>
#define STAGE 4
namespace pg8 {
#define PG8_LAS __attribute__((address_space(3)))
typedef unsigned short bf16_t;
typedef short bf16x8 __attribute__((ext_vector_type(8)));
typedef float f32x4 __attribute__((ext_vector_type(4)));
typedef unsigned u32x4 __attribute__((ext_vector_type(4)));
constexpr int BM = 256, BK = 64, HALF = 128, HTB = HALF * BK * 2  , STAGE_BYTES = 8 * HTB, NXCD = 8, WGM = 8;

__host__ __device__ __forceinline__ int lds_byte(int r, int c) { const int st = (r >> 4) * 2 + (c >> 5), rr = r & 15, cc = c & 31, ob = rr * 64 + cc * 2; return st * 1024 + (ob ^ (((ob >> 9) & 1) << 5)); }
__host__ __device__ __forceinline__ void stage_rc(int b, int& R, int& C) { const int st = b / 1024, sb = b % 1024, swz = sb ^ (((sb >> 9) & 1) << 5); R = (st >> 1) * 16 + swz / 64; C = (st & 1) * 32 + (swz % 64) / 2; }
__host__ __device__ __forceinline__ int perm32(int rho) { const int n = rho >> 4, i = rho & 15; return 8 * (i >> 2) + 4 * n + (i & 3); }

struct Unit { int pm, pn; };
struct Gemm { const bf16_t* A; const bf16_t* Bt; int M, N, K; };

struct StaticOrder {
    int nM, nN, nwg, G, c, rep;
    __host__ __device__ void init(int M, int N, int G_, int c_) { nM = M / BM; nN = N / BM; nwg = nM * nN; G = G_; c = c_; rep = 1; }
    __host__ __device__ bool next(int i, Unit& u) const {
        const long L = (long)(i / rep) * G + c; if (L >= nwg) return false;
        int wgid = (int)L; { const int q = nwg / NXCD, r = nwg % NXCD, xcd = wgid % NXCD, off = wgid / NXCD; wgid = (xcd < r ? xcd * (q + 1) : r * (q + 1) + (xcd - r) * q) + off; }
        const int nig = WGM * nN, gid = wgid / nig, fm = gid * WGM, gsz = (nM - fm) < WGM ? (nM - fm) : WGM;
        u.pm = fm + ((wgid % nig) % gsz); u.pn = (wgid % nig) / gsz; return true;
    }
    __device__ __forceinline__ void a_ready(const Unit&) const {}
    __device__ __forceinline__ void done(const Unit&) const {}
};

typedef float f32x2_cv __attribute__((ext_vector_type(2))); typedef __bf16 bf16x2_cv __attribute__((ext_vector_type(2)));
__device__ __forceinline__ unsigned cvt_pk_bf16(float lo, float hi) { f32x2_cv v = {lo, hi}; bf16x2_cv b = __builtin_convertvector(v, bf16x2_cv); return __builtin_bit_cast(unsigned, b); }
typedef float f32x2 __attribute__((ext_vector_type(2)));
typedef unsigned u32x2 __attribute__((ext_vector_type(2)));
__device__ __forceinline__ u32x4 pack8(f32x4 v0, f32x4 v1) { u32x4 w; w.x = cvt_pk_bf16(v0[0], v0[1]); w.y = cvt_pk_bf16(v0[2], v0[3]); w.z = cvt_pk_bf16(v1[0], v1[1]); w.w = cvt_pk_bf16(v1[2], v1[3]); return w; }
struct EpiInProj {
    static constexpr bool PERM = true, AFTER_DRAIN = false;
    bf16_t *Q, *KT, *VT, *XR, *GR; float qscale;
    __device__ __forceinline__ void operator()(const f32x4 (&acc)[2][2][4][2], const Unit& u, int wr, int wc, int fr, int fq) const {
        const int sec = u.pn >> 1, half = u.pn & 1;
#pragma unroll
        for (int ai = 0; ai < 2; ++ai)
#pragma unroll
            for (int m = 0; m < 4; ++m) {
                const int row = u.pm * BM + ai * HALF + wr * 64 + m * 16 + fr;
                const int b = row >> 12, tok = row & 4095, t = tok >> 6, rr = tok & 63;
#pragma unroll
                for (int bj = 0; bj < 2; ++bj) {
                    f32x4 v0 = acc[ai][bj][m][0], v1 = acc[ai][bj][m][1];
                    const int cs = half * 256 + bj * HALF + wc * 32 + 8 * fq;
                    if (sec == 0) { v0 = v0 * qscale; v1 = v1 * qscale; *(u32x4*)(Q + (size_t)row * 512 + cs) = pack8(v0, v1); }
                    else if (sec == 1) { const int h = half * 2 + bj, s = wc >> 1, chunk = 4 * (wc & 1) + fq;
                        *(u32x4*)(KT + ((((size_t)(b * 4 + h) * 2 + s) * 64 + t) * 8 + chunk) * 512 + rr * 8) = pack8(v0, v1); }
                    else if (sec == 2) { const int h = half * 2 + bj;
                        *(u32x4*)(VT + (((size_t)(b * 4 + h) * 64 + t) * 4 + wc) * 2048 + rr * 32 + 8 * fq) = pack8(v0, v1); }
                    else if (sec == 3) { *(u32x4*)(XR + (size_t)row * 512 + cs) = pack8(v0, v1); }
                    else { *(u32x4*)(GR + (size_t)row * 512 + cs) = pack8(v0, v1); }
                }
            }
    }
};
template <bool WRITE_HB, bool WRITE_F32 = true> struct EpiResid {
    static constexpr bool PERM = false, AFTER_DRAIN = false;
    const float* base; float* out; bf16_t* hb; float* rss; int ldc;
    __device__ __forceinline__ void operator()(const f32x4 (&acc)[2][2][4][2], const Unit& u, int wr, int wc, int fr, int fq) const {
        const int col0 = u.pn * BM + wc * 32 + 4 * fq;
        f32x4 nx[2][2];
        { const size_t off0 = (size_t)(u.pm * BM + wr * 64 + fr) * ldc + col0;
#pragma unroll
          for (int bj = 0; bj < 2; ++bj)
#pragma unroll
              for (int n = 0; n < 2; ++n) nx[bj][n] = *(const f32x4*)(base + off0 + bj * HALF + n * 16); }
#pragma unroll
        for (int gi = 0; gi < 8; ++gi) {
            const int ai = gi >> 2, m = gi & 3;
            const int row = u.pm * BM + ai * HALF + wr * 64 + m * 16 + fr; const size_t off = (size_t)row * ldc + col0; float ss = 0.f;
            f32x4 cur[2][2];
#pragma unroll
            for (int bj = 0; bj < 2; ++bj)
#pragma unroll
                for (int n = 0; n < 2; ++n) cur[bj][n] = nx[bj][n];
            if (gi < 7) { const int ai2 = (gi + 1) >> 2, m2 = (gi + 1) & 3; const size_t off2 = (size_t)(u.pm * BM + ai2 * HALF + wr * 64 + m2 * 16 + fr) * ldc + col0;
#pragma unroll
                for (int bj = 0; bj < 2; ++bj)
#pragma unroll
                    for (int n = 0; n < 2; ++n) nx[bj][n] = *(const f32x4*)(base + off2 + bj * HALF + n * 16); }
#pragma unroll
            for (int bj = 0; bj < 2; ++bj)
#pragma unroll
                for (int n = 0; n < 2; ++n) {
                    const f32x4 o = acc[ai][bj][m][n] + cur[bj][n];
                    if (WRITE_F32) *(f32x4*)(out + off + bj * HALF + n * 16) = o;
                    if (WRITE_HB) { u32x2 w; w.x = cvt_pk_bf16(o[0], o[1]); w.y = cvt_pk_bf16(o[2], o[3]); *(u32x2*)(hb + off + bj * HALF + n * 16) = w; }
                    ss += (o[0] * o[0] + o[1] * o[1]) + (o[2] * o[2] + o[3] * o[3]);
                }
            ss += __shfl_xor(ss, 16); ss += __shfl_xor(ss, 32);
            if (fq == 0) rss[(size_t)row * 16 + u.pn * 4 + wc] = ss;
        }
    }
};
struct EpiGateUp {
    static constexpr bool PERM = true, AFTER_DRAIN = false;
    bf16_t* act; const float* rstd; int ldo;
    __device__ __forceinline__ void operator()(const f32x4 (&acc)[2][2][4][2], const Unit& u, int wr, int wc, int fr, int fq) const {
        const int col0 = u.pn * HALF + wc * 32 + 8 * fq;
        float rs[2][4];
#pragma unroll
        for (int ai = 0; ai < 2; ++ai)
#pragma unroll
            for (int m = 0; m < 4; ++m) rs[ai][m] = rstd[u.pm * BM + ai * HALF + wr * 64 + m * 16 + fr];
#pragma unroll
        for (int ai = 0; ai < 2; ++ai)
#pragma unroll
            for (int m = 0; m < 4; ++m) {
                const int row = u.pm * BM + ai * HALF + wr * 64 + m * 16 + fr;
                const float r_ = rs[ai][m], c1 = r_ * -1.4426950408889634f, r2 = r_ * r_;
                f32x4 o[2];
#pragma unroll
                for (int n = 0; n < 2; ++n) {
                    const f32x4 g = acc[ai][0][m][n], up = acc[ai][1][m][n];
#pragma unroll
                    for (int i = 0; i < 4; ++i) { const float e = __builtin_amdgcn_exp2f(g[i] * c1); o[n][i] = (g[i] * up[i]) * (r2 * __builtin_amdgcn_rcpf(1.0f + e)); }
                }
                *(u32x4*)(act + (size_t)row * ldo + col0) = pack8(o[0], o[1]);
            }
    }
};

struct EpiDownNorm {
    static constexpr bool PERM = false, AFTER_DRAIN = true;
    const bf16_t* hb; float* out; const float* gain; float* xbuf; unsigned* cnt; int ldc; float eps; const void* cnt_base_probe;
    __device__ __forceinline__ void fused(f32x4 (&acc)[2][2][4][2], const Unit& u, int wr, int wc, int fr, int fq, PG8_LAS unsigned char* lds, int wid, int lane) const {
        PG8_LAS float* P = (PG8_LAS float*)lds;
        PG8_LAS float* Sx = (PG8_LAS float*)(lds + 4096);
        PG8_LAS unsigned* flag = (PG8_LAS unsigned*)(lds + 4096 + 1024);
        const int col0 = u.pn * BM + wc * 32 + 4 * fq;
        u32x2 nx[2][2];
        { const size_t off0 = (size_t)(u.pm * BM + wr * 64 + fr) * ldc + col0;
#pragma unroll
          for (int bj = 0; bj < 2; ++bj)
#pragma unroll
              for (int n = 0; n < 2; ++n) nx[bj][n] = *(const u32x2*)(hb + off0 + bj * HALF + n * 16); }
#pragma unroll
        for (int gi = 0; gi < 8; ++gi) {
            const int ai = gi >> 2, m = gi & 3;
            const int r = ai * HALF + wr * 64 + m * 16 + fr; float ss = 0.f;
            u32x2 cur[2][2];
#pragma unroll
            for (int bj = 0; bj < 2; ++bj)
#pragma unroll
                for (int n = 0; n < 2; ++n) cur[bj][n] = nx[bj][n];
            if (gi < 7) { const int ai2 = (gi + 1) >> 2, m2 = (gi + 1) & 3; const size_t off2 = (size_t)(u.pm * BM + ai2 * HALF + wr * 64 + m2 * 16 + fr) * ldc + col0;
#pragma unroll
                for (int bj = 0; bj < 2; ++bj)
#pragma unroll
                    for (int n = 0; n < 2; ++n) nx[bj][n] = *(const u32x2*)(hb + off2 + bj * HALF + n * 16); }
#pragma unroll
            for (int bj = 0; bj < 2; ++bj)
#pragma unroll
                for (int n = 0; n < 2; ++n) {
                    const u32x2 hv = cur[bj][n];
                    const f32x4 h4 = (f32x4){__uint_as_float(hv.x << 16), __uint_as_float(hv.x & 0xffff0000u), __uint_as_float(hv.y << 16), __uint_as_float(hv.y & 0xffff0000u)};
                    const f32x4 o = acc[ai][bj][m][n] + h4; acc[ai][bj][m][n] = o;
                    ss += (o[0] * o[0] + o[1] * o[1]) + (o[2] * o[2] + o[3] * o[3]);
                }
            ss += __shfl_xor(ss, 16); ss += __shfl_xor(ss, 32);
            if (fq == 0) P[r * 4 + wc] = ss;
        }
        asm volatile("s_waitcnt lgkmcnt(0)" ::: "memory"); __builtin_amdgcn_s_barrier(); asm volatile("" ::: "memory");
        const int row = wid * 32 + (lane & 31);
        if (lane < 32) {
            const float s = (P[row * 4 + 0] + P[row * 4 + 1]) + (P[row * 4 + 2] + P[row * 4 + 3]);
            __hip_atomic_store(xbuf + (size_t)(u.pm * BM + row) * 4 + u.pn, s, __ATOMIC_RELAXED, __HIP_MEMORY_SCOPE_AGENT);
        }
        asm volatile("s_waitcnt vmcnt(0)" ::: "memory");
        if (lane == 0) __hip_atomic_fetch_add(cnt + 64 * u.pm, 1u, __ATOMIC_RELAXED, __HIP_MEMORY_SCOPE_AGENT);
        if (wid == 0) {
            unsigned sp = 0;
            for (;;) {
                if ((unsigned)__builtin_amdgcn_readfirstlane(__hip_atomic_load(cnt + 64 * u.pm, __ATOMIC_RELAXED, __HIP_MEMORY_SCOPE_AGENT)) >= 32u) break;
                if (++sp > (1u << 22)) break;
                __builtin_amdgcn_s_sleep(2);
            }
            __builtin_amdgcn_fence(__ATOMIC_ACQUIRE, "agent");
            if (lane == 0) flag[0] = 0u;
        }
        asm volatile("s_waitcnt vmcnt(0) lgkmcnt(0)" ::: "memory"); __builtin_amdgcn_s_barrier(); asm volatile("" ::: "memory");
        if (lane < 32) {
            const float* slot = xbuf + (size_t)(u.pm * BM + row) * 4;
            const float a = __hip_atomic_load(slot + 0, __ATOMIC_RELAXED, __HIP_MEMORY_SCOPE_AGENT), b = __hip_atomic_load(slot + 1, __ATOMIC_RELAXED, __HIP_MEMORY_SCOPE_AGENT),
                        c = __hip_atomic_load(slot + 2, __ATOMIC_RELAXED, __HIP_MEMORY_SCOPE_AGENT), d = __hip_atomic_load(slot + 3, __ATOMIC_RELAXED, __HIP_MEMORY_SCOPE_AGENT);
            Sx[row] = 1.0f / sqrtf(((a + b) + (c + d)) * (1.0f / 1024.0f) + eps);
        }
        asm volatile("s_waitcnt lgkmcnt(0)" ::: "memory"); __builtin_amdgcn_s_barrier(); asm volatile("" ::: "memory");
        f32x4 gv[2][2];
#pragma unroll
        for (int bj = 0; bj < 2; ++bj)
#pragma unroll
            for (int n = 0; n < 2; ++n) gv[bj][n] = *(const f32x4*)(gain + col0 + bj * HALF + n * 16);
#if defined(REP_PHASE) && (REP_PHASE == 77 || REP_PHASE == 79 || REP_PHASE == 80)
        { const float sc_ = 1.0f + ((const float*)cnt_base_probe)[30000];
#pragma unroll
          for (int bj = 0; bj < 2; ++bj)
#pragma unroll
              for (int n = 0; n < 2; ++n) gv[bj][n] = gv[bj][n] * sc_; }
#endif
#pragma unroll
        for (int ai = 0; ai < 2; ++ai)
#pragma unroll
            for (int m = 0; m < 4; ++m) {
                const int r = ai * HALF + wr * 64 + m * 16 + fr; const float rs = Sx[r]; const size_t off = (size_t)(u.pm * BM + r) * ldc + col0;
#pragma unroll
                for (int bj = 0; bj < 2; ++bj)
#pragma unroll
                    for (int n = 0; n < 2; ++n) *(f32x4*)(out + off + bj * HALF + n * 16) = acc[ai][bj][m][n] * rs * gv[bj][n];
            }
    }
};
struct EpiDownNormStream {
    static constexpr bool PERM = false, AFTER_DRAIN = false;
    const bf16_t* hb; float* out; const float* gain; float* xbuf; unsigned* cnt; int ldc; float eps; const void* cnt_base_probe; PG8_LAS unsigned char* lds_x;
    __device__ __forceinline__ void operator()(const f32x4 (&acc_in)[2][2][4][2], const Unit& u, int wr, int wc, int fr, int fq) const {
        PG8_LAS unsigned char* lds = lds_x; const int lane = threadIdx.x & 63, wid = __builtin_amdgcn_readfirstlane(threadIdx.x >> 6);
        f32x4 acc[2][2][4][2];
#pragma unroll
        for (int a_ = 0; a_ < 2; ++a_)
#pragma unroll
            for (int b_ = 0; b_ < 2; ++b_)
#pragma unroll
                for (int m_ = 0; m_ < 4; ++m_)
#pragma unroll
                    for (int n_ = 0; n_ < 2; ++n_) acc[a_][b_][m_][n_] = acc_in[a_][b_][m_][n_];
        PG8_LAS float* P = (PG8_LAS float*)lds;
        PG8_LAS float* Sx = (PG8_LAS float*)(lds + 4096);
        PG8_LAS unsigned* flag = (PG8_LAS unsigned*)(lds + 4096 + 1024);
        const int col0 = u.pn * BM + wc * 32 + 4 * fq;
        u32x2 nx[2][2];
        { const size_t off0 = (size_t)(u.pm * BM + wr * 64 + fr) * ldc + col0;
#pragma unroll
          for (int bj = 0; bj < 2; ++bj)
#pragma unroll
              for (int n = 0; n < 2; ++n) nx[bj][n] = *(const u32x2*)(hb + off0 + bj * HALF + n * 16); }
#pragma unroll
        for (int gi = 0; gi < 8; ++gi) {
            const int ai = gi >> 2, m = gi & 3;
            const int r = ai * HALF + wr * 64 + m * 16 + fr; float ss = 0.f;
            u32x2 cur[2][2];
#pragma unroll
            for (int bj = 0; bj < 2; ++bj)
#pragma unroll
                for (int n = 0; n < 2; ++n) cur[bj][n] = nx[bj][n];
            if (gi < 7) { const int ai2 = (gi + 1) >> 2, m2 = (gi + 1) & 3; const size_t off2 = (size_t)(u.pm * BM + ai2 * HALF + wr * 64 + m2 * 16 + fr) * ldc + col0;
#pragma unroll
                for (int bj = 0; bj < 2; ++bj)
#pragma unroll
                    for (int n = 0; n < 2; ++n) nx[bj][n] = *(const u32x2*)(hb + off2 + bj * HALF + n * 16); }
#pragma unroll
            for (int bj = 0; bj < 2; ++bj)
#pragma unroll
                for (int n = 0; n < 2; ++n) {
                    const u32x2 hv = cur[bj][n];
                    const f32x4 h4 = (f32x4){__uint_as_float(hv.x << 16), __uint_as_float(hv.x & 0xffff0000u), __uint_as_float(hv.y << 16), __uint_as_float(hv.y & 0xffff0000u)};
                    const f32x4 o = acc[ai][bj][m][n] + h4; acc[ai][bj][m][n] = o;
                    ss += (o[0] * o[0] + o[1] * o[1]) + (o[2] * o[2] + o[3] * o[3]);
                }
            ss += __shfl_xor(ss, 16); ss += __shfl_xor(ss, 32);
            if (fq == 0) P[r * 4 + wc] = ss;
        }
        asm volatile("s_waitcnt lgkmcnt(0)" ::: "memory"); __builtin_amdgcn_s_barrier(); asm volatile("" ::: "memory");
        const int row = wid * 32 + (lane & 31);
        if (lane < 32) {
            const float s = (P[row * 4 + 0] + P[row * 4 + 1]) + (P[row * 4 + 2] + P[row * 4 + 3]);
            __hip_atomic_store(xbuf + (size_t)(u.pm * BM + row) * 4 + u.pn, s, __ATOMIC_RELAXED, __HIP_MEMORY_SCOPE_AGENT);
        }
        asm volatile("s_waitcnt vmcnt(0)" ::: "memory");
        if (lane == 0) __hip_atomic_fetch_add(cnt + 64 * u.pm, 1u, __ATOMIC_RELAXED, __HIP_MEMORY_SCOPE_AGENT);
        if (wid == 0) {
            unsigned sp = 0;
            for (;;) {
                if ((unsigned)__builtin_amdgcn_readfirstlane(__hip_atomic_load(cnt + 64 * u.pm, __ATOMIC_RELAXED, __HIP_MEMORY_SCOPE_AGENT)) >= 32u) break;
                if (++sp > (1u << 22)) break;
                __builtin_amdgcn_s_sleep(2);
            }
            __builtin_amdgcn_fence(__ATOMIC_ACQUIRE, "agent");
            if (lane == 0) flag[0] = 0u;
        }
        asm volatile("s_waitcnt vmcnt(0) lgkmcnt(0)" ::: "memory"); __builtin_amdgcn_s_barrier(); asm volatile("" ::: "memory");
        if (lane < 32) {
            const float* slot = xbuf + (size_t)(u.pm * BM + row) * 4;
            const float a = __hip_atomic_load(slot + 0, __ATOMIC_RELAXED, __HIP_MEMORY_SCOPE_AGENT), b = __hip_atomic_load(slot + 1, __ATOMIC_RELAXED, __HIP_MEMORY_SCOPE_AGENT),
                        c = __hip_atomic_load(slot + 2, __ATOMIC_RELAXED, __HIP_MEMORY_SCOPE_AGENT), d = __hip_atomic_load(slot + 3, __ATOMIC_RELAXED, __HIP_MEMORY_SCOPE_AGENT);
            Sx[row] = 1.0f / sqrtf(((a + b) + (c + d)) * (1.0f / 1024.0f) + eps);
        }
        asm volatile("s_waitcnt lgkmcnt(0)" ::: "memory"); __builtin_amdgcn_s_barrier(); asm volatile("" ::: "memory");
        f32x4 gv[2][2];
#pragma unroll
        for (int bj = 0; bj < 2; ++bj)
#pragma unroll
            for (int n = 0; n < 2; ++n) gv[bj][n] = *(const f32x4*)(gain + col0 + bj * HALF + n * 16);
#if defined(REP_PHASE) && (REP_PHASE == 77 || REP_PHASE == 79 || REP_PHASE == 80)
        { const float sc_ = 1.0f + ((const float*)cnt_base_probe)[30000];
#pragma unroll
          for (int bj = 0; bj < 2; ++bj)
#pragma unroll
              for (int n = 0; n < 2; ++n) gv[bj][n] = gv[bj][n] * sc_; }
#endif
#pragma unroll
        for (int ai = 0; ai < 2; ++ai)
#pragma unroll
            for (int m = 0; m < 4; ++m) {
                const int r = ai * HALF + wr * 64 + m * 16 + fr; const float rs = Sx[r]; const size_t off = (size_t)(u.pm * BM + r) * ldc + col0;
#pragma unroll
                for (int bj = 0; bj < 2; ++bj)
#pragma unroll
                    for (int n = 0; n < 2; ++n) *(f32x4*)(out + off + bj * HALF + n * 16) = acc[ai][bj][m][n] * rs * gv[bj][n];
            }
    }
};
template <class Epi, class Sched, bool ALIGN_EPI = false, bool SP2 = false>
__device__ __forceinline__ void gemm_phase(PG8_LAS unsigned char* lds, const Gemm g, const Sched& S, const Epi& E) {
    const int tid = threadIdx.x, wid = __builtin_amdgcn_readfirstlane(tid >> 6), lane = tid & 63, wr = wid >> 2, wc = wid & 3, fr = lane & 15, fq = lane >> 4;
    const int K = g.K, nt = K / BK;
    unsigned voffA[2], voffB[2];
#pragma unroll
    for (int i = 0; i < 2; ++i) { int R, C; stage_rc(tid * 16 + i * 8192, R, C); const int Rb = Epi::PERM ? ((R & ~31) + perm32(R & 31)) : R;
        voffA[i] = (unsigned)(R * K + C) * 2u; voffB[i] = (unsigned)(Rb * K + C) * 2u; }
    const size_t kstep = (size_t)(BK * 2);
    const size_t hstep = (size_t)HALF * K * 2;
    const size_t tstep = 2 * hstep;
    const unsigned ldsw = (unsigned)wid * 1024u;
    const int aoff = lds_byte(wr * 64 + fr, fq * 8), boff = lds_byte(wc * 32 + fr, fq * 8);
#define PG8_SA(b, h) (((b) * 2 + (h)) * HTB)
#define PG8_SB(b, h) ((4 + (b) * 2 + (h)) * HTB)
#define PG8_STAGE(bufoff, gbase, voff) do { _Pragma("unroll") for (int _i = 0; _i < 2; ++_i) \
        __builtin_amdgcn_global_load_lds((const unsigned*)((const char*)(gbase) + (voff)[_i]), (PG8_LAS unsigned*)(lds + (bufoff) + ldsw + _i * 8192), 16, 0, 0); } while (0)
#define PG8_LDA(dst, b, h) do { _Pragma("unroll") for (int m = 0; m < 4; ++m) _Pragma("unroll") for (int k = 0; k < 2; ++k) dst[m][k] = *(const PG8_LAS bf16x8*)(lds + PG8_SA(b, h) + aoff + m * 2048 + k * 1024); } while (0)
#define PG8_LDB(dst, b, h) do { _Pragma("unroll") for (int n = 0; n < 2; ++n) _Pragma("unroll") for (int k = 0; k < 2; ++k) dst[n][k] = *(const PG8_LAS bf16x8*)(lds + PG8_SB(b, h) + boff + n * 2048 + k * 1024); } while (0)
#define PG8_MMA(ai, bj, At, Bt) do { __builtin_amdgcn_s_setprio(1); _Pragma("unroll") for (int m = 0; m < 4; ++m) _Pragma("unroll") for (int n = 0; n < 2; ++n) _Pragma("unroll") for (int k = 0; k < 2; ++k) \
        acc[ai][bj][m][n] = __builtin_amdgcn_mfma_f32_16x16x32_bf16(Bt[n][k], At[m][k], acc[ai][bj][m][n], 0, 0, 0); __builtin_amdgcn_s_setprio(0); } while (0)
#define PG8_WAIT_V(n) asm volatile("s_waitcnt vmcnt(" #n ")" ::: "memory")
#define PG8_WAIT_L(n) asm volatile("s_waitcnt lgkmcnt(" #n ")" ::: "memory")
#define PG8_BAR __builtin_amdgcn_s_barrier()
#define PG8_SCHED __builtin_amdgcn_sched_barrier(0)
    Unit cur, nxt; int ui = 0;
    if (!S.next(0, cur)) return;
    f32x4 acc[2][2][4][2];
#pragma unroll
    for (int a = 0; a < 2; ++a)
#pragma unroll
        for (int b = 0; b < 2; ++b)
#pragma unroll
            for (int m = 0; m < 4; ++m)
#pragma unroll
                for (int n = 0; n < 2; ++n) acc[a][b][m][n] = (f32x4){0.f, 0.f, 0.f, 0.f};
    bf16x8 At[4][2], B0[2][2], B1[2][2];
    const char* cA = (const char*)g.A + (size_t)cur.pm * tstep; const char* cB = (const char*)g.Bt + (size_t)cur.pn * tstep;
    S.a_ready(cur);
    if constexpr (SP2) {
        PG8_STAGE(PG8_SB(0, 0), cB, voffB); PG8_STAGE(PG8_SB(0, 1), cB + hstep, voffB); PG8_STAGE(PG8_SA(0, 0), cA, voffA); PG8_STAGE(PG8_SA(0, 1), cA + hstep, voffA);
        if (wr == 1) PG8_BAR;
        PG8_WAIT_V(2); PG8_BAR;
        PG8_STAGE(PG8_SB(1, 0), cB + kstep, voffB); PG8_STAGE(PG8_SA(1, 0), cA + kstep, voffA); PG8_STAGE(PG8_SB(1, 1), cB + hstep + kstep, voffB);
        PG8_WAIT_V(6); PG8_BAR;
    } else {
        PG8_STAGE(PG8_SB(0, 0), cB, voffB); PG8_STAGE(PG8_SA(0, 0), cA, voffA); PG8_STAGE(PG8_SB(0, 1), cB + hstep, voffB); PG8_STAGE(PG8_SA(0, 1), cA + hstep, voffA);
        if (wr == 1) PG8_BAR;
        PG8_WAIT_V(4); PG8_BAR;
        PG8_STAGE(PG8_SB(1, 0), cB + kstep, voffB); PG8_STAGE(PG8_SA(1, 0), cA + kstep, voffA); PG8_STAGE(PG8_SB(1, 1), cB + hstep + kstep, voffB);
        PG8_WAIT_V(6); PG8_BAR;
    }
    for (;;) {
        const bool has_next = S.next(ui + 1, nxt);
        const char* nA = has_next ? (const char*)g.A + (size_t)nxt.pm * tstep : cA; const char* nB = has_next ? (const char*)g.Bt + (size_t)nxt.pn * tstep : cB;
        for (int t = 0; t < nt; t += 2) {
            const bool last = (t == nt - 2);
            const char* a1 = cA + (size_t)(t + 1) * kstep;
            const char* a2 = last ? nA : cA + (size_t)(t + 2) * kstep; const char* b2 = last ? nB : cB + (size_t)(t + 2) * kstep;
            const char* a3 = a2 + kstep; const char* b3 = b2 + kstep;
            if (last && has_next) S.a_ready(nxt);
            if constexpr (SP2) {
            PG8_LDB(B0, 0, 0); PG8_LDB(B1, 0, 1); PG8_SCHED; PG8_LDA(At, 0, 0); PG8_STAGE(PG8_SA(1, 1), a1 + hstep, voffA);
            PG8_WAIT_V(8); PG8_WAIT_L(0); PG8_BAR; PG8_MMA(0, 0, At, B0); PG8_MMA(0, 1, At, B1); PG8_BAR; PG8_SCHED;
            PG8_LDA(At, 0, 1); PG8_STAGE(PG8_SB(0, 0), b2, voffB); PG8_STAGE(PG8_SB(0, 1), b2 + hstep, voffB); PG8_STAGE(PG8_SA(0, 0), a2, voffA);
            PG8_WAIT_V(8); PG8_WAIT_L(0); PG8_BAR; PG8_MMA(1, 0, At, B0); PG8_MMA(1, 1, At, B1); PG8_BAR; PG8_SCHED;
            PG8_LDB(B0, 1, 0); PG8_LDB(B1, 1, 1); PG8_SCHED; PG8_LDA(At, 1, 0); PG8_STAGE(PG8_SA(0, 1), a2 + hstep, voffA);
            PG8_WAIT_V(8); PG8_WAIT_L(0); PG8_BAR; PG8_MMA(0, 0, At, B0); PG8_MMA(0, 1, At, B1); PG8_BAR; PG8_SCHED;
            PG8_LDA(At, 1, 1); PG8_STAGE(PG8_SB(1, 0), b3, voffB); PG8_STAGE(PG8_SB(1, 1), b3 + hstep, voffB); PG8_STAGE(PG8_SA(1, 0), a3, voffA);
            PG8_WAIT_V(8); PG8_WAIT_L(0); PG8_BAR; PG8_MMA(1, 0, At, B0); PG8_MMA(1, 1, At, B1); PG8_BAR; PG8_SCHED;
            } else {
            PG8_LDB(B0, 0, 0); PG8_SCHED; PG8_LDA(At, 0, 0); PG8_STAGE(PG8_SA(1, 1), a1 + hstep, voffA);
            PG8_WAIT_L(8); PG8_BAR; PG8_WAIT_L(0); PG8_MMA(0, 0, At, B0); PG8_BAR; PG8_SCHED;
            PG8_LDB(B1, 0, 1); PG8_STAGE(PG8_SB(0, 0), b2, voffB);
            PG8_BAR; PG8_WAIT_L(0); PG8_MMA(0, 1, At, B1); PG8_BAR;
            PG8_LDA(At, 0, 1); PG8_STAGE(PG8_SA(0, 0), a2, voffA);
            PG8_BAR; PG8_WAIT_L(0); PG8_MMA(1, 0, At, B0); PG8_BAR; PG8_SCHED;
            PG8_STAGE(PG8_SB(0, 1), b2 + hstep, voffB);
            PG8_WAIT_V(6); PG8_BAR; PG8_MMA(1, 1, At, B1); PG8_BAR;
            PG8_LDB(B0, 1, 0); PG8_SCHED; PG8_LDA(At, 1, 0); PG8_STAGE(PG8_SA(0, 1), a2 + hstep, voffA);
            PG8_WAIT_L(8); PG8_BAR; PG8_WAIT_L(0); PG8_MMA(0, 0, At, B0); PG8_BAR; PG8_SCHED;
            PG8_LDB(B1, 1, 1); PG8_STAGE(PG8_SB(1, 0), b3, voffB);
            PG8_BAR; PG8_WAIT_L(0); PG8_MMA(0, 1, At, B1); PG8_BAR;
            PG8_LDA(At, 1, 1); PG8_STAGE(PG8_SA(1, 0), a3, voffA);
            PG8_BAR; PG8_WAIT_L(0); PG8_MMA(1, 0, At, B0); PG8_BAR; PG8_SCHED;
            PG8_STAGE(PG8_SB(1, 1), b3 + hstep, voffB);
            PG8_WAIT_V(6); PG8_BAR; PG8_MMA(1, 1, At, B1); PG8_BAR;
            }
        }
        if constexpr (ALIGN_EPI) { if (wr == 0) PG8_BAR; }
        if constexpr (!Epi::AFTER_DRAIN) { E(acc, cur, wr, wc, fr, fq); S.done(cur); }
        if (!has_next) break;
#pragma unroll
        for (int a = 0; a < 2; ++a)
#pragma unroll
            for (int b = 0; b < 2; ++b)
#pragma unroll
                for (int m = 0; m < 4; ++m)
#pragma unroll
                    for (int n = 0; n < 2; ++n) acc[a][b][m][n] = (f32x4){0.f, 0.f, 0.f, 0.f};
        cur = nxt; cA = nA; cB = nB; ++ui;
        if constexpr (ALIGN_EPI) { if (wr == 1) PG8_BAR; }
    }
    PG8_WAIT_V(0);
    if constexpr (!ALIGN_EPI) { if (wr == 0) PG8_BAR; }
    PG8_BAR;
    if constexpr (Epi::AFTER_DRAIN) { E.fused(acc, cur, wr, wc, fr, fq, lds, wid, lane); S.done(cur); }
#undef PG8_SA
#undef PG8_SB
#undef PG8_STAGE
#undef PG8_LDA
#undef PG8_LDB
#undef PG8_MMA
#undef PG8_WAIT_V
#undef PG8_WAIT_L
#undef PG8_BAR
#undef PG8_SCHED
}
}
namespace xb {
#define LAS __attribute__((address_space(3)))
#define XB_TMO      128
#define XB_XCNT(j)  (256  + 64 * (j))
#define XB_XSUB(j)  (1280 + 64 * (j))
#define XB_XGEN(j)  (2304 + 64 * (j))
#define XB_TOP      3328
#define XB_TOPGEN   3392
#define XCD_BAR_WORDS 3456
#define XB_SPIN_CAP (1u << 18)

__device__ __forceinline__ unsigned xb_ld(unsigned* p)              { return __hip_atomic_load(p, __ATOMIC_RELAXED, __HIP_MEMORY_SCOPE_AGENT); }
__device__ __forceinline__ unsigned xb_add(unsigned* p, unsigned v) { return __hip_atomic_fetch_add(p, v, __ATOMIC_RELAXED, __HIP_MEMORY_SCOPE_AGENT); }
__device__ __forceinline__ unsigned xb_xcc_id() { return (unsigned)__builtin_amdgcn_s_getreg((3 << 11) | 20) & 0xFu; }
#define XB_SPIN(cond, bar) do { unsigned _sp = 0; while (cond) { __builtin_amdgcn_s_sleep(1); \
    if ((++_sp & 255u) == 0u) { if (xb_ld(&(bar)[XB_TMO])) break; if (_sp > XB_SPIN_CAP) { atomicAdd(&(bar)[XB_TMO], 1u); break; } } } } while (0)

struct XcdBarrier {
    unsigned* bar; unsigned x;
    volatile LAS unsigned* st;
};

__device__ __forceinline__ XcdBarrier xcd_barrier_post(unsigned* bar, volatile LAS unsigned* st) {
    XcdBarrier b; b.bar = bar; b.x = xb_xcc_id(); b.st = st;
    if (threadIdx.x == 0) st[2] = xb_add(&bar[XB_XCNT(b.x)], 1u);
    return b;
}
__device__ __forceinline__ void xcd_barrier_complete(unsigned* bar, unsigned x, unsigned& nloc, unsigned& nx) {
    const unsigned G = gridDim.x * gridDim.y * gridDim.z;
    unsigned sum, cnt, mine, sp = 0u;
    for (;;) {
        sum = 0u; cnt = 0u; mine = 0u;
#pragma unroll
        for (unsigned j = 0; j < 16; ++j) { const unsigned c = xb_ld(&bar[XB_XCNT(j)]); sum += c; cnt += (c > 0u) ? 1u : 0u; mine = (j == x) ? c : mine; }
        if (sum == G) break;
        __builtin_amdgcn_s_sleep(1);
        if ((++sp & 255u) == 0u) { if (xb_ld(&bar[XB_TMO])) break; if (sp > XB_SPIN_CAP) { atomicAdd(&bar[XB_TMO], 1u); break; } }
    }
    nloc = mine > 0u ? mine : 1u; nx = cnt > 0u ? cnt : 1u;
}

__device__ __forceinline__ void xcd_barrier(const XcdBarrier& b) {
    asm volatile("s_waitcnt vmcnt(0)" ::: "memory");
    __syncthreads();
    if (threadIdx.x == 0) {
        unsigned* bar = b.bar;
        __builtin_amdgcn_s_waitcnt(0);
        unsigned nloc = b.st[0], nx = b.st[1];
        if (nloc == 0u) { xcd_barrier_complete(bar, b.x, nloc, nx); b.st[0] = nloc; b.st[1] = nx; }
        const unsigned old = xb_add(&bar[XB_XSUB(b.x)], 1u);
        const unsigned gen = old / nloc;
        if (old + 1u == (gen + 1u) * nloc) {
            __builtin_amdgcn_fence(__ATOMIC_RELEASE, "agent");
            asm volatile("s_waitcnt vmcnt(0)" ::: "memory");
            const unsigned og = xb_add(&bar[XB_TOP], 1u);
            const unsigned tg = og / nx;
            if (og + 1u == (tg + 1u) * nx) xb_add(&bar[XB_TOPGEN], 1u);
            else XB_SPIN(xb_ld(&bar[XB_TOPGEN]) == tg, bar);
            __builtin_amdgcn_fence(__ATOMIC_ACQUIRE, "agent");
            xb_add(&bar[XB_XGEN(b.x)], 1u);
            asm volatile("s_waitcnt vmcnt(0)" ::: "memory");
        } else {
            XB_SPIN(xb_ld(&bar[XB_XGEN(b.x)]) == gen, bar);
            __builtin_amdgcn_fence(__ATOMIC_ACQUIRE, "agent");
            asm volatile("s_waitcnt vmcnt(0)" ::: "memory");
        }
    }
    __syncthreads();
}

}
namespace mk {
#define LAS __attribute__((address_space(3)))
typedef unsigned short bf16_t;
typedef short bf16x8 __attribute__((ext_vector_type(8)));
typedef short s16x4 __attribute__((ext_vector_type(4)));
typedef float f32x4 __attribute__((ext_vector_type(4)));
typedef float f32x16 __attribute__((ext_vector_type(16)));
typedef unsigned u32x4 __attribute__((ext_vector_type(4)));
typedef unsigned u32x2 __attribute__((ext_vector_type(2)));
constexpr int NB = 8, S = 4096, D = 1024, M = NB * S, NH = 4, DFF = 2816, DIN = 2560, NWAVES = 8;
constexpr float EPS = 1e-6f, LOG2E = 1.4426950408889634f;
constexpr float QSCALE = 0.125f * LOG2E;
constexpr size_t MiB = 1u << 20;
constexpr size_t WS_WIN = 1 * MiB, WS_WOUT = 6 * MiB, WS_WGU = 8 * MiB, WS_WDN = 19 * MiB, WS_RSS1 = 25 * MiB, WS_RSS2 = 27 * MiB, WS_RSTD = 29 * MiB;
constexpr size_t WS_XN = 32 * MiB, WS_Q = 96 * MiB, WS_KT = 128 * MiB, WS_VT = 160 * MiB, WS_XR = 192 * MiB, WS_GR = 224 * MiB, WS_HF = 256 * MiB, WS_MIXED = 320 * MiB, WS_ACT = 96 * MiB, WS_XC = 384 * MiB, WS_END = 416 * MiB;
static_assert(WS_ACT + (size_t)M * DFF * 2 <= WS_MIXED, "act overlays Q..HF only");
constexpr int RING_BYTES = 131072, LDS_MISC = 131072, LDS_BYTES = 147456;

__device__ __forceinline__ unsigned cvt_pk_bf16(float lo, float hi) { return pg8::cvt_pk_bf16(lo, hi); }
__device__ __forceinline__ float bf2f(unsigned short b) { return __uint_as_float(((unsigned)b) << 16); }
__device__ __forceinline__ float wave_sum(float v) {
#pragma unroll
    for (int o = 1; o < 64; o <<= 1) v += __shfl_xor(v, o);
    return v;
}
__device__ __forceinline__ float fast_sigmoid(float x) { return __builtin_amdgcn_rcpf(1.0f + __builtin_amdgcn_exp2f(-LOG2E * x)); }

template <int MAP  >
__device__ __forceinline__ void p0_transpose_item(const float* W, int K, int N, bf16_t* WT, const float* gk, LAS float* scr, int item, int lane) {
    const int nblk = N / 32, kb = item / nblk, nb = item % nblk, k0 = 64 * kb, n0 = 32 * nb;
#pragma unroll
    for (int i = 0; i < 32; ++i) { const int kk = 2 * i + (lane >> 5); float v = W[(size_t)(k0 + kk) * N + n0 + (lane & 31)]; if (gk) v *= gk[k0 + kk]; scr[kk * 33 + (lane & 31)] = v; }
    asm volatile("s_waitcnt lgkmcnt(0)" ::: "memory");
    const int c = lane & 7;
#pragma unroll
    for (int j = 0; j < 4; ++j) { const int n = (lane >> 3) + 8 * j; const LAS float* s = scr + (8 * c) * 33 + n;
        u32x4 o; o.x = cvt_pk_bf16(s[0 * 33], s[1 * 33]); o.y = cvt_pk_bf16(s[2 * 33], s[3 * 33]); o.z = cvt_pk_bf16(s[4 * 33], s[5 * 33]); o.w = cvt_pk_bf16(s[6 * 33], s[7 * 33]);
        const int f = n0 + n; const int drow = (MAP == 0) ? f : (256 * (f >> 7) + (f & 127) + (MAP == 2 ? 128 : 0));
        *(u32x4*)(WT + (size_t)drow * K + k0 + 8 * c) = o; }
    asm volatile("s_waitcnt lgkmcnt(0)" ::: "memory");
}
template <int NR>
__device__ __forceinline__ void rms_rows_to_bf16(const float* xrow, const float* g, bf16_t* orow, int lane) {
    const f32x4* gr = (const f32x4*)g + lane;
    f32x4 v[NR][4]; float s[NR];
#pragma unroll
    for (int q = 0; q < NR; ++q) { const f32x4* xr = (const f32x4*)(xrow + (size_t)q * D) + lane;
#pragma unroll
        for (int j = 0; j < 4; ++j) v[q][j] = __builtin_nontemporal_load(xr + 64 * j); }
#pragma unroll
    for (int q = 0; q < NR; ++q) { float a = 0.f;
#pragma unroll
        for (int j = 0; j < 4; ++j) a += (v[q][j][0] * v[q][j][0] + v[q][j][1] * v[q][j][1]) + (v[q][j][2] * v[q][j][2] + v[q][j][3] * v[q][j][3]);
        s[q] = a; }
#pragma unroll
    for (int o = 1; o < 64; o <<= 1)
#pragma unroll
        for (int q = 0; q < NR; ++q) s[q] += __shfl_xor(s[q], o);
    f32x4 gg[4];
#pragma unroll
    for (int j = 0; j < 4; ++j) gg[j] = gr[64 * j];
#pragma unroll
    for (int q = 0; q < NR; ++q) { const float rstd = 1.0f / sqrtf(s[q] * (1.f / D) + EPS); u32x2* o8 = (u32x2*)(orow + (size_t)q * D) + lane;
#pragma unroll
        for (int j = 0; j < 4; ++j) { u32x2 w; w.x = cvt_pk_bf16(v[q][j][0] * rstd * gg[j][0], v[q][j][1] * rstd * gg[j][1]); w.y = cvt_pk_bf16(v[q][j][2] * rstd * gg[j][2], v[q][j][3] * rstd * gg[j][3]); o8[64 * j] = w; } }
}

namespace att {
constexpr int NT = S / 64, SLOT = 16384, LDS_K = 0, LDS_V = 3 * SLOT, LDS_OST = 4 * SLOT, LDS_X = 0;
constexpr int LDS_WSF = LDS_MISC, LDS_BIAS = LDS_MISC + 2048, LDS_TOT = LDS_MISC + 3072, LDS_CW = LDS_MISC + 5120, LDS_BIAS2 = LDS_MISC + 8704;
constexpr int THR = 8;
typedef LAS const char* lds_cptr;
typedef short v4i16_t __attribute__((ext_vector_type(4)));
__device__ __forceinline__ int crow(int r, int hi) { return (r & 3) + 8 * (r >> 2) + 4 * hi; }
__device__ __forceinline__ void glds16(const void* gsrc, unsigned lds_dst) { unsigned keep;
    asm volatile("s_mov_b32 %0, m0\n\ts_mov_b32 m0, %2\n\ts_nop 0\n\tglobal_load_lds_dwordx4 %1, off\n\ts_mov_b32 m0, %0" : "=&s"(keep) : "v"(gsrc), "s"(lds_dst) : "memory"); }
__device__ __forceinline__ s16x4 vtr(lds_cptr p) { return __builtin_bit_cast(s16x4, __builtin_amdgcn_ds_read_tr16_b64_v4i16((LAS v4i16_t*)p)); }
#define ATT_MX3(a, b, c) __builtin_fmaxf(__builtin_fmaxf((a), (b)), (c))
__device__ __forceinline__ float rowmax(const f32x16& p0, const f32x16& p1) {
    float a = ATT_MX3(p0[0], p0[1], p1[0]), b = ATT_MX3(p0[2], p0[3], p1[1]); a = ATT_MX3(a, p1[2], p1[3]);
#pragma unroll
    for (int r = 4; r < 16; r += 4) { a = ATT_MX3(a, p0[r], p0[r + 1]); b = ATT_MX3(b, p0[r + 2], p0[r + 3]); a = ATT_MX3(a, p1[r], p1[r + 1]); b = ATT_MX3(b, p1[r + 2], p1[r + 3]); }
    float m = __builtin_fmaxf(a, b); auto rr = __builtin_amdgcn_permlane32_swap(__float_as_uint(m), __float_as_uint(m), false, false);
    return __builtin_fmaxf(__uint_as_float(rr[0]), __uint_as_float(rr[1]));
}
#define ATT_WAIT_BAR(N) do { if (ABL == 4) asm volatile("s_waitcnt vmcnt(" #N ") lgkmcnt(0)" ::: "memory"); else asm volatile("s_waitcnt vmcnt(" #N ") lgkmcnt(0)\n\ts_barrier" ::: "memory"); } while (0)
#define ATT_MFMA(a, b, c) __builtin_amdgcn_mfma_f32_32x32x16_bf16(a, b, c, 0, 0, 0)

template <bool FIRST>
__device__ __forceinline__ void tile_h1(int t, lds_cptr kp, const bf16x8 (&qr)[4], f32x16 (&o)[4], u32x4 (&pw)[4], float& mhat, float& l_reg,
                                        LAS float* wsf, const LAS float* btab, int qrow, int qw0, float c_left, float c_right, int r32, int hi) {
    const int relmin = 64 * t - qw0 - 31, relmax = 64 * t + 63 - qw0;
    const bool band = !(relmax <= -91 || relmin >= 91);
    const float cb = band ? 0.f : (relmin >= 91 ? c_right : c_left);
    f32x16 p0, p1;
    const f32x16 z16 = (f32x16){0.f, 0.f, 0.f, 0.f, 0.f, 0.f, 0.f, 0.f, 0.f, 0.f, 0.f, 0.f, 0.f, 0.f, 0.f, 0.f};
#pragma unroll
    for (int d0 = 0; d0 < 4; ++d0) {
        const bf16x8 k0 = *(const LAS bf16x8*)(kp + d0 * 2048), k1 = *(const LAS bf16x8*)(kp + d0 * 2048 + 512);
        if (d0 == 0) { p0 = ATT_MFMA(k0, qr[0], z16); p1 = ATT_MFMA(k1, qr[0], z16); }
        else { p0 = ATT_MFMA(k0, qr[d0], p0); p1 = ATT_MFMA(k1, qr[d0], p1); }
    }
    if (band) {
        const int relb = 64 * t + 4 * hi - qrow + 128;
#pragma unroll
        for (int r = 0; r < 16; ++r) { const int i0 = relb + (r & 3) + 8 * (r >> 2); const int a0 = i0 < 0 ? 0 : (i0 > 255 ? 255 : i0); const int i1 = i0 + 32; const int a1 = i1 < 0 ? 0 : (i1 > 255 ? 255 : i1);
            p0[r] += btab[a0]; p1[r] += btab[a1]; }
    }
    const float rm = rowmax(p0, p1) + cb;
    if (FIRST) { mhat = rm; }
    else if (__builtin_expect(__any(rm - mhat > (float)THR), 0)) {
        const float dl = __builtin_fmaxf(rm - mhat, 0.f); mhat += dl;
        const float f = __builtin_amdgcn_exp2f(-dl); l_reg *= f;
        if (hi == 0) wsf[r32] = f;
        asm volatile("s_waitcnt lgkmcnt(0)" ::: "memory");
        float fr[16];
#pragma unroll
        for (int r = 0; r < 16; ++r) fr[r] = wsf[crow(r, hi)];
#pragma unroll
        for (int db = 0; db < 4; ++db)
#pragma unroll
            for (int r = 0; r < 16; ++r) o[db][r] *= fr[r];
        asm volatile("s_waitcnt lgkmcnt(0)" ::: "memory");
    }
    const float off = cb - mhat;
    float sacc = 0.f;
#pragma unroll
    for (int r = 0; r < 16; ++r) { p0[r] = __builtin_amdgcn_exp2f(p0[r] + off); p1[r] = __builtin_amdgcn_exp2f(p1[r] + off); sacc += p0[r] + p1[r]; }
    l_reg += sacc;
#pragma unroll
    for (int ks = 0; ks < 4; ++ks) { const f32x16& P = (ks < 2) ? p0 : p1; const int b = 8 * (ks & 1);
        pw[ks] = (u32x4){cvt_pk_bf16(P[b], P[b + 1]), cvt_pk_bf16(P[b + 2], P[b + 3]), cvt_pk_bf16(P[b + 4], P[b + 5]), cvt_pk_bf16(P[b + 6], P[b + 7])}; }
}
__device__ __forceinline__ void tile_h2(lds_cptr vp, f32x16 (&o)[4], const u32x4 (&pw)[4]) {
#pragma unroll
    for (int ks = 0; ks < 4; ++ks)
#pragma unroll
        for (int db = 0; db < 4; ++db) {
            const s16x4 lo = vtr(vp + db * 4096 + ks * 1024), h4 = vtr(vp + db * 4096 + ks * 1024 + 512);
            const bf16x8 vf = (bf16x8){lo[0], lo[1], lo[2], lo[3], h4[0], h4[1], h4[2], h4[3]};
            o[db] = ATT_MFMA(__builtin_bit_cast(bf16x8, pw[ks]), vf, o[db]);
        }
}

struct VFrag { s16x4 lo, hi; };
template <int I> __device__ __forceinline__ VFrag vload(lds_cptr vp) {
    constexpr int off_ = (I & 3) * 4096 + (I >> 2) * 1024; VFrag f; f.lo = vtr(vp + off_); f.hi = vtr(vp + off_ + 512); return f;
}
template <int ABL>
__device__ __forceinline__ void attn_unit(int b, int h, int qb, const bf16_t* Q, const bf16_t* KT, const bf16_t* VT, bf16_t* MIXED, LAS unsigned char* lds, float lam, const float* subln_g, const float* rel_bias) {
    const int tid = threadIdx.x, lane = tid & 63, r32 = lane & 31, hi = lane >> 5; const int wid = __builtin_amdgcn_readfirstlane(tid >> 6);
    const int wq = wid & 3, mp = wid >> 2;
    const size_t rowbase = (size_t)b * S; const int q0 = qb * 128, qw0 = q0 + 32 * wq, qrow = qw0 + r32;
    LAS float* btab = (LAS float*)(lds + LDS_BIAS2); LAS float* wsf = (LAS float*)(lds + LDS_WSF) + wid * 64;
    { const int rel = tid - 256; const int n = rel < 0 ? -rel : rel; int bk; if (n < 8) bk = n; else { bk = 2 + (31 - __clz(n * n)); if (bk > 15) bk = 15; } if (rel > 0) bk += 16;
        btab[tid] = rel_bias[bk * NH + h] * LOG2E; }
    const float c_left = rel_bias[15 * NH + h] * LOG2E, c_right = rel_bias[31 * NH + h] * LOG2E;
    const bf16_t* Qw = Q + (rowbase + qw0) * 512 + h * 128 + mp * 64;
    bf16x8 qr[4];
#pragma unroll
    for (int d0 = 0; d0 < 4; ++d0) qr[d0] = *(const bf16x8*)(Qw + (size_t)r32 * 512 + d0 * 16 + hi * 8);
    const char* k1src = (const char*)KT + ((size_t)((b * 4 + h) * 2) * 64) * 8192 + wid * 1024 + lane * 16;
    const char* k2src = k1src + (size_t)64 * 8192;
    const char* vsrc = (const char*)VT + ((size_t)(b * 4 + h) * 64) * 16384 + wid * 1024 + lane * 16;
    const unsigned lds0 = (unsigned)(uintptr_t)(unsigned char*)lds;
    const unsigned kdst = lds0 + LDS_K + wid * 1024, vdst = lds0 + LDS_V + wid * 1024;
    const lds_cptr kp0 = (lds_cptr)lds + LDS_K + mp * 8192 + hi * 1024 + r32 * 16;
    const lds_cptr vp0 = (lds_cptr)lds + LDS_V + ((lane >> 4) & 1) * 32 + (lane & 3) * 8 + (4 * hi + ((lane & 15) >> 2)) * 64;
#define ATT_DMA_TILE(t, ks_, vs_) do { if (ABL == 3) break; glds16(k1src + (size_t)(t) * 8192, (unsigned)__builtin_amdgcn_readfirstlane(kdst + (ks_))); glds16(k2src + (size_t)(t) * 8192, (unsigned)__builtin_amdgcn_readfirstlane(kdst + (ks_) + 8192)); \
        glds16(vsrc + (size_t)(t) * 16384, (unsigned)__builtin_amdgcn_readfirstlane(vdst + (vs_))); glds16(vsrc + (size_t)(t) * 16384 + 8192, (unsigned)__builtin_amdgcn_readfirstlane(vdst + (vs_) + 8192)); } while (0)
    ATT_DMA_TILE(0, 0, 0); ATT_DMA_TILE(1, SLOT, SLOT);
    float mhat = 0.f, l_reg = 0.f; f32x16 o[4]; u32x4 pw[4];
#pragma unroll
    for (int db = 0; db < 4; ++db)
#pragma unroll
        for (int r = 0; r < 16; ++r) o[db][r] = 0.f;
    int ksl = 0, ksl2 = 2 * SLOT, vsl = 0, vsl2 = 2 * SLOT, vprev = 0;
#define ATT_ROT() do { ksl = (ksl == 2 * SLOT) ? 0 : ksl + SLOT; ksl2 = (ksl2 == 2 * SLOT) ? 0 : ksl2 + SLOT; vprev = vsl; vsl = (vsl + SLOT) & (4 * SLOT - 1); vsl2 = (vsl2 + SLOT) & (4 * SLOT - 1); } while (0)
#define ATT_SB() __builtin_amdgcn_sched_barrier(0)
#define ATT_PIN(x) asm volatile("" : "+v"(x))
#define ATT_F(T0, T1, e) (((e) < 16) ? T0[(e) & 15] : T1[(e) & 15])
#define ATT_KRD(f) (*(const LAS bf16x8*)(kp_ + ((f) >> 1) * 2048 + ((f) & 1) * 512))
    const f32x16 z16 = (f32x16){0.f, 0.f, 0.f, 0.f, 0.f, 0.f, 0.f, 0.f, 0.f, 0.f, 0.f, 0.f, 0.f, 0.f, 0.f, 0.f};
#define ATT_GA(C0, C1, P0, P1, f) do { \
        if (((f) & 1) == 0) C0 = ATT_MFMA(kq[(f) % 3], qr[(f) >> 1], ((f) < 2) ? z16 : C0); else C1 = ATT_MFMA(kq[(f) % 3], qr[(f) >> 1], ((f) < 2) ? z16 : C1); \
        if (ABL != 5 && (f) + 3 < 8) kq[(f) % 3] = ATT_KRD((f) + 3); \
        if (ABL != 6) { sacc += ATT_F(P0, P1, 4 * (f)); sacc += ATT_F(P0, P1, 4 * (f) + 1); sacc += ATT_F(P0, P1, 4 * (f) + 2); sacc += ATT_F(P0, P1, 4 * (f) + 3); ATT_PIN(sacc); } \
        if (ABL != 6) pw[(f) >> 1][2 * ((f) & 1)] = cvt_pk_bf16(ATT_F(P0, P1, 4 * (f)), ATT_F(P0, P1, 4 * (f) + 1)); if (ABL != 6) pw[(f) >> 1][2 * ((f) & 1) + 1] = cvt_pk_bf16(ATT_F(P0, P1, 4 * (f) + 2), ATT_F(P0, P1, 4 * (f) + 3)); ATT_PIN(pw[(f) >> 1]); \
        ATT_SB(); } while (0)
#define ATT_VRD(I) vload<(I) & 15>(vp_)
#define ATT_GBF(I, FILL) do { \
        { const VFrag& vv = vq[(I) % 3]; const bf16x8 vf = (bf16x8){vv.lo[0], vv.lo[1], vv.lo[2], vv.lo[3], vv.hi[0], vv.hi[1], vv.hi[2], vv.hi[3]}; \
          if (ABL != 7) o[(I) & 3] = ATT_MFMA(__builtin_bit_cast(bf16x8, pw[(I) >> 2]), vf, o[(I) & 3]); else asm volatile("" :: "v"(vf)); } \
        if (ABL != 1 && (I) + 3 < 16) vq[(I) % 3] = ATT_VRD((I) + 3); \
        FILL; ATT_SB(); } while (0)
#define ATT_EXF(x) ((ABL == 2) ? (x) : __builtin_amdgcn_exp2f(x))
#define ATT_EX(C0, C1, e) do { if ((e) < 16) { C0[(e) & 15] = ATT_EXF(C0[(e) & 15] + off); } else { C1[(e) & 15] = ATT_EXF(C1[(e) & 15] + off); } } while (0)
#define ATT_EX3(C0, C1, e) do { ATT_EX(C0, C1, e); ATT_EX(C0, C1, (e) + 1); ATT_EX(C0, C1, (e) + 2); ATT_PIN(C0); ATT_PIN(C1); } while (0)
#define ATT_EX2(C0, C1, e) do { ATT_EX(C0, C1, e); ATT_EX(C0, C1, (e) + 1); ATT_PIN(C0); ATT_PIN(C1); } while (0)
#define ATT_MX3(a, b, c) __builtin_fmaxf(__builtin_fmaxf((a), (b)), (c))
#define ATT_BIAS(C0, C1, t) \
        const int relmin_ = 64 * (t) - qw0 - 31, relmax_ = 64 * (t) + 63 - qw0; const bool band_ = !(relmax_ <= -91 || relmin_ >= 91); const float cb_ = band_ ? 0.f : (relmin_ >= 91 ? c_right : c_left); \
        if (band_) { const LAS float* bp_ = btab + (64 * (t) + 4 * hi - qrow + 256);       \
            _Pragma("unroll") for (int r = 0; r < 16; ++r) { C0[r] += bp_[(r & 3) + 8 * (r >> 2)]; C1[r] += bp_[(r & 3) + 8 * (r >> 2) + 32]; } }
#define ATT_MAXP(C0, C1, g) do { if ((g) == 0) { ma_ = ATT_MX3(C0[0], C0[1], C1[0]); mb_ = ATT_MX3(C0[2], C0[3], C1[1]); ma_ = ATT_MX3(ma_, C1[2], C1[3]); } \
        else { ma_ = ATT_MX3(ma_, C0[4 * (g)], C0[4 * (g) + 1]); mb_ = ATT_MX3(mb_, C0[4 * (g) + 2], C0[4 * (g) + 3]); ma_ = ATT_MX3(ma_, C1[4 * (g)], C1[4 * (g) + 1]); mb_ = ATT_MX3(mb_, C1[4 * (g) + 2], C1[4 * (g) + 3]); } \
        ATT_PIN(ma_); ATT_PIN(mb_); } while (0)
#define ATT_DECIDE2(FIRST_) do { float rm_ = __builtin_fmaxf(ma_, mb_); { auto rr = __builtin_amdgcn_permlane32_swap(__float_as_uint(rm_), __float_as_uint(rm_), false, false); rm_ = __builtin_fmaxf(__uint_as_float(rr[0]), __uint_as_float(rr[1])); } \
        rm_ += cb_; resc = false; \
        if (FIRST_) { mhat = rm_; } \
        else if (__builtin_expect(__any(rm_ - mhat > (float)THR), 0)) { const float dl_ = __builtin_fmaxf(rm_ - mhat, 0.f); mhat += dl_; const float f_ = __builtin_amdgcn_exp2f(-dl_); l_reg *= f_; if (hi == 0) wsf[r32] = f_; resc = true; } \
        off = cb_ - mhat; ATT_SB(); } while (0)
#define ATT_RESC() do { if (resc) { asm volatile("s_waitcnt lgkmcnt(0)" ::: "memory"); float fr_[16]; \
        _Pragma("unroll") for (int r = 0; r < 16; ++r) fr_[r] = wsf[crow(r, hi)]; \
        _Pragma("unroll") for (int db = 0; db < 4; ++db) _Pragma("unroll") for (int r = 0; r < 16; ++r) o[db][r] *= fr_[r]; \
        asm volatile("s_waitcnt lgkmcnt(0)" ::: "memory"); } } while (0)
#define ATT_STEP(C0, C1, P0, P1, t) do { \
        const lds_cptr kp_ = kp0 + ksl; const lds_cptr vp_ = vp0 + vprev; float sacc = 0.f, ma_, mb_; \
        kq[0] = ATT_KRD(0); kq[1] = ATT_KRD(1); kq[2] = ATT_KRD(2); ATT_SB(); \
        ATT_GA(C0, C1, P0, P1, 0); ATT_GA(C0, C1, P0, P1, 1); ATT_GA(C0, C1, P0, P1, 2); ATT_GA(C0, C1, P0, P1, 3); \
        vq[0] = ATT_VRD(0); vq[1] = ATT_VRD(1); vq[2] = ATT_VRD(2); ATT_SB(); \
        ATT_GA(C0, C1, P0, P1, 4); ATT_GA(C0, C1, P0, P1, 5); ATT_GA(C0, C1, P0, P1, 6); ATT_GA(C0, C1, P0, P1, 7); \
        l_reg += sacc; \
        ATT_BIAS(C0, C1, t) ATT_SB(); \
        ATT_GBF(0, ATT_MAXP(C0, C1, 0)); ATT_GBF(1, ATT_MAXP(C0, C1, 1)); ATT_GBF(2, ATT_MAXP(C0, C1, 2)); ATT_GBF(3, ATT_MAXP(C0, C1, 3)); \
        ATT_DECIDE2(false); \
        ATT_GBF(4, ATT_EX3(C0, C1, 0)); ATT_GBF(5, ATT_EX3(C0, C1, 3)); ATT_GBF(6, ATT_EX3(C0, C1, 6)); ATT_GBF(7, ATT_EX3(C0, C1, 9)); \
        ATT_GBF(8, ATT_EX3(C0, C1, 12)); ATT_GBF(9, ATT_EX3(C0, C1, 15)); ATT_GBF(10, ATT_EX3(C0, C1, 18)); ATT_GBF(11, ATT_EX3(C0, C1, 21)); \
        ATT_GBF(12, ATT_EX2(C0, C1, 24)); ATT_GBF(13, ATT_EX2(C0, C1, 26)); ATT_GBF(14, ATT_EX2(C0, C1, 28)); ATT_GBF(15, ATT_EX2(C0, C1, 30)); \
        ATT_RESC(); ATT_ROT(); } while (0)
    f32x16 sa0, sa1, sb0, sb1; bf16x8 kq[3]; VFrag vq[3]; float off = 0.f; bool resc = false;
    ATT_WAIT_BAR(4); ATT_DMA_TILE(2, ksl2, vsl2);
    { const lds_cptr kp_ = kp0 + ksl;
#pragma unroll
      for (int d0 = 0; d0 < 4; ++d0) { const bf16x8 k0 = ATT_KRD(2 * d0), k1 = ATT_KRD(2 * d0 + 1);
          if (d0 == 0) { sa0 = ATT_MFMA(k0, qr[0], z16); sa1 = ATT_MFMA(k1, qr[0], z16); } else { sa0 = ATT_MFMA(k0, qr[d0], sa0); sa1 = ATT_MFMA(k1, qr[d0], sa1); } }
      float ma_, mb_; ATT_BIAS(sa0, sa1, 0) ATT_MAXP(sa0, sa1, 0); ATT_MAXP(sa0, sa1, 1); ATT_MAXP(sa0, sa1, 2); ATT_MAXP(sa0, sa1, 3); ATT_DECIDE2(true);
#pragma unroll
      for (int r = 0; r < 16; ++r) { sa0[r] = __builtin_amdgcn_exp2f(sa0[r] + off); sa1[r] = __builtin_amdgcn_exp2f(sa1[r] + off); }
      ATT_ROT(); }
    for (int t = 1; t < NT - 3; t += 2) {
        ATT_WAIT_BAR(4); ATT_DMA_TILE(t + 2, ksl2, vsl2); ATT_STEP(sb0, sb1, sa0, sa1, t);
        ATT_WAIT_BAR(4); ATT_DMA_TILE(t + 3, ksl2, vsl2); ATT_STEP(sa0, sa1, sb0, sb1, t + 1);
    }
    ATT_WAIT_BAR(4); ATT_DMA_TILE(NT - 1, ksl2, vsl2); ATT_STEP(sb0, sb1, sa0, sa1, NT - 3);
    ATT_WAIT_BAR(4); ATT_STEP(sa0, sa1, sb0, sb1, NT - 2);
    ATT_WAIT_BAR(0); ATT_STEP(sb0, sb1, sa0, sa1, NT - 1);
    { float sacc = 0.f;
#pragma unroll
      for (int r = 0; r < 16; ++r) sacc += sb0[r] + sb1[r];
      l_reg += sacc;
#pragma unroll
      for (int g = 0; g < 16; ++g) pw[g >> 2][g & 3] = cvt_pk_bf16(ATT_F(sb0, sb1, 2 * g), ATT_F(sb0, sb1, 2 * g + 1));
      const lds_cptr vp_ = vp0 + vprev;
#pragma unroll
      for (int ks = 0; ks < 4; ++ks)
#pragma unroll
          for (int db = 0; db < 4; ++db) { const s16x4 lo = vtr(vp_ + db * 4096 + ks * 1024), h4 = vtr(vp_ + db * 4096 + ks * 1024 + 512);
              const bf16x8 vf = (bf16x8){lo[0], lo[1], lo[2], lo[3], h4[0], h4[1], h4[2], h4[3]}; o[db] = ATT_MFMA(__builtin_bit_cast(bf16x8, pw[ks]), vf, o[db]); } }
#undef ATT_STEP
#undef ATT_RESC
#undef ATT_DECIDE2
#undef ATT_MAXP
#undef ATT_BIAS
#undef ATT_EX2
#undef ATT_EX3
#undef ATT_EX
#undef ATT_EXF
#undef ATT_GBF
#undef ATT_GA
#undef ATT_VRD
#undef ATT_KRD
#undef ATT_F
#undef ATT_PIN
#undef ATT_SB
    { auto rr = __builtin_amdgcn_permlane32_swap(__float_as_uint(l_reg), __float_as_uint(l_reg), false, false); l_reg = __uint_as_float(rr[0]) + __uint_as_float(rr[1]); }
    const float scale_q = (mp == 0 ? 1.0f : lam) * __builtin_amdgcn_rcpf(l_reg);
    if (hi == 0) wsf[r32] = scale_q;
    asm volatile("s_waitcnt lgkmcnt(0)" ::: "memory");
    float sc[16];
#pragma unroll
    for (int r = 0; r < 16; ++r) sc[r] = wsf[crow(r, hi)];
    asm volatile("s_waitcnt lgkmcnt(0)\n\ts_barrier" ::: "memory");
    LAS float* X = (LAS float*)(lds + LDS_X) + wq * 4096 + lane;
    if (mp == 1) {
#pragma unroll
        for (int db = 0; db < 4; ++db)
#pragma unroll
            for (int r = 0; r < 16; ++r) X[(db * 16 + r) * 64] = o[db][r] * sc[r];
    }
    asm volatile("s_waitcnt lgkmcnt(0)\n\ts_barrier" ::: "memory");
    if (mp == 0) {
        float ss[16];
#pragma unroll
        for (int r = 0; r < 16; ++r) ss[r] = 0.f;
#pragma unroll
        for (int db = 0; db < 4; ++db)
#pragma unroll
            for (int r = 0; r < 16; ++r) { const float d = o[db][r] * sc[r] - X[(db * 16 + r) * 64]; o[db][r] = d; ss[r] += d * d; }
#pragma unroll
        for (int r = 0; r < 16; ++r) {
#pragma unroll
            for (int x = 1; x < 32; x <<= 1) ss[r] += __shfl_xor(ss[r], x);
            ss[r] = __builtin_amdgcn_rsqf(ss[r] * (1.0f / 128.0f) + EPS) * 0.8f;
        }
        LAS bf16_t* stg = (LAS bf16_t*)(lds + LDS_OST) + wq * 4096;
#pragma unroll
        for (int db = 0; db < 4; ++db) { const float g = subln_g[db * 32 + r32];
#pragma unroll
            for (int r = 0; r < 16; ++r) { const unsigned w = cvt_pk_bf16(o[db][r] * ss[r] * g, 0.f); stg[crow(r, hi) * 128 + db * 32 + r32] = (bf16_t)(w & 0xffffu); } }
        asm volatile("s_waitcnt lgkmcnt(0)" ::: "memory");
        bf16_t* Ow = MIXED + (rowbase + qw0) * 1024 + h * 128;
#pragma unroll
        for (int i = 0; i < 8; ++i) { const int row = i * 4 + (lane >> 4), ch = lane & 15; const u32x4 v = *(const LAS u32x4*)(stg + row * 128 + ch * 8); *(u32x4*)(Ow + (size_t)row * 1024 + ch * 8) = v; }
    }
    asm volatile("s_waitcnt vmcnt(0) lgkmcnt(0)\n\ts_barrier" ::: "memory");
#undef ATT_DMA_TILE
#undef ATT_ROT
}
}

namespace lru {
template <int N> __device__ __forceinline__ float dpp_shr(float v, float ident) {
    return __int_as_float(__builtin_amdgcn_update_dpp(__float_as_int(ident), __float_as_int(v), 0x110 + N, 0xF, 0xF, false));
}
#define LRU_MFMA16(a, b, c) __builtin_amdgcn_mfma_f32_16x16x32_bf16(a, b, c, 0, 0, 0)
__device__ __forceinline__ void lru_rows(bf16x8 (&rowv)[2][7], __amdgpu_buffer_rsrc_t xsrd, int dir, int Pb, int ch0) {
#pragma unroll
    for (int k = 0; k < 7; ++k) {
        const int tt = dir ? (S - Pb - k) : (Pb - 2 + k);
#pragma unroll
        for (int ks = 0; ks < 2; ++ks) rowv[ks][k] = __builtin_bit_cast(bf16x8, __builtin_amdgcn_raw_buffer_load_b128(xsrd, (tt * 512 + ch0 + 32 * ks) * 2, 0, 0));
    }
}
__device__ __forceinline__ void lru_item(int b, int cg, const bf16_t* XR, const bf16_t* GR, float* HF, bf16_t* MIXED, bf16_t* XC, unsigned* sib_cnt, LAS unsigned char* lds,
                                         const float* conv_w, const float* conv_b, const float* w_rg, const float* b_rg, const float* w_ig, const float* b_ig, const float* lru_lambda) {
    const int tid = threadIdx.x, lane = tid & 63, p = lane & 15, g = lane >> 4; const int wid = __builtin_amdgcn_readfirstlane(tid >> 6);
    const int n = cg >> 2, e16 = cg & 3, c0 = n * 64 + e16 * 16;
    const size_t rowbase = (size_t)b * S;
    const __amdgpu_buffer_rsrc_t XRb = __builtin_amdgcn_make_buffer_rsrc((void*)(XR + rowbase * 512), (short)0, S * 512 * 2, 0x00020000); const int ch0 = n * 64 + 8 * g;
    LAS float* tot = (LAS float*)(lds + att::LDS_TOT);
    bf16x8 idf;
#pragma unroll
    for (int j = 0; j < 8; ++j) idf[j] = ((8 * g + j) == (16 * (e16 & 1) + p)) ? (short)0x3f80 : (short)0;
    int par = 0;
    LAS float* cwl = (LAS float*)(lds + att::LDS_CW);
    if (tid < 320) { const int j = tid >> 6, c = tid & 63; cwl[tid] = (j < 4) ? conv_w[j * 512 + n * 64 + c] : conv_b[n * 64 + c]; }
    __syncthreads();
    {
        const int g8 = tid & 7, trow = tid >> 3;
        const int c8 = n * 64 + 8 * g8;
        f32x4 w0[4], w1[4];
#pragma unroll
        for (int j = 0; j < 4; ++j) { w0[j] = *(const LAS f32x4*)(cwl + j * 64 + 8 * g8); w1[j] = *(const LAS f32x4*)(cwl + j * 64 + 8 * g8 + 4); }
        const f32x4 bb0 = *(const LAS f32x4*)(cwl + 256 + 8 * g8), bb1 = *(const LAS f32x4*)(cwl + 256 + 8 * g8 + 4);
        for (int st = 0; st < 16; ++st) {
            const int tok = e16 * 1024 + st * 64 + trow;
            f32x4 a0 = bb0, a1 = bb1;
#pragma unroll
            for (int j = 0; j < 4; ++j) {
                const u32x4 rw = __builtin_amdgcn_raw_buffer_load_b128(XRb, ((tok + j - 2) * 512 + c8) * 2, 0, 0);
                a0 += w0[j] * (f32x4){__uint_as_float(rw[0] << 16), __uint_as_float(rw[0] & 0xffff0000u), __uint_as_float(rw[1] << 16), __uint_as_float(rw[1] & 0xffff0000u)};
                a1 += w1[j] * (f32x4){__uint_as_float(rw[2] << 16), __uint_as_float(rw[2] & 0xffff0000u), __uint_as_float(rw[3] << 16), __uint_as_float(rw[3] & 0xffff0000u)};
            }
            *(u32x4*)(XC + (rowbase + tok) * 512 + c8) = (u32x4){cvt_pk_bf16(a0[0], a0[1]), cvt_pk_bf16(a0[2], a0[3]), cvt_pk_bf16(a1[0], a1[1]), cvt_pk_bf16(a1[2], a1[3])};
        }
        asm volatile("s_waitcnt vmcnt(0)" ::: "memory");
        __syncthreads();
        if (tid == 0) {
            __builtin_amdgcn_fence(__ATOMIC_RELEASE, "agent");
            asm volatile("s_waitcnt vmcnt(0)" ::: "memory");
            __hip_atomic_fetch_add(sib_cnt, 1u, __ATOMIC_RELAXED, __HIP_MEMORY_SCOPE_AGENT);
            unsigned sp = 0;
            while (__hip_atomic_load(sib_cnt, __ATOMIC_RELAXED, __HIP_MEMORY_SCOPE_AGENT) < 4u) { __builtin_amdgcn_s_sleep(2); if (++sp > (1u << 22)) break; }
            __builtin_amdgcn_fence(__ATOMIC_ACQUIRE, "agent");
            asm volatile("s_waitcnt vmcnt(0)" ::: "memory");
        }
        __syncthreads();
    }
    for (int dir = 0; dir < 2; ++dir) {
        bf16x8 wrf[2], wif[2];
#pragma unroll
        for (int ks = 0; ks < 2; ++ks) {
            unsigned wr_[4], wi_[4];
#pragma unroll
            for (int j2 = 0; j2 < 4; ++j2) { const int d = 32 * ks + 8 * g + 2 * j2; const size_t i0 = ((size_t)((dir * 8 + n) * 64 + d)) * 64 + e16 * 16 + p;
                wr_[j2] = cvt_pk_bf16(w_rg[i0], w_rg[i0 + 64]); wi_[j2] = cvt_pk_bf16(w_ig[i0], w_ig[i0 + 64]); }
            wrf[ks] = __builtin_bit_cast(bf16x8, (u32x4){wr_[0], wr_[1], wr_[2], wr_[3]}); wif[ks] = __builtin_bit_cast(bf16x8, (u32x4){wi_[0], wi_[1], wi_[2], wi_[3]});
        }
        float br[4], bi[4], sp8[4], carry[4];
#pragma unroll
        for (int r = 0; r < 4; ++r) { const int c = dir * 512 + c0 + 4 * g + r; br[r] = b_rg[c] * -LOG2E; bi[r] = b_ig[c] * -LOG2E; const float lm = lru_lambda[c]; sp8[r] = 8.0f * LOG2E * ((-lm > 20.0f) ? -lm : log1pf(expf(-lm)));     carry[r] = 0.f; }
        LAS u32x4* lst = (LAS u32x4*)lds + tid;
        lst[0 * 512] = __builtin_bit_cast(u32x4, wrf[0]); lst[1 * 512] = __builtin_bit_cast(u32x4, wrf[1]); lst[2 * 512] = __builtin_bit_cast(u32x4, wif[0]); lst[3 * 512] = __builtin_bit_cast(u32x4, wif[1]);
        lst[4 * 512] = __builtin_bit_cast(u32x4, (f32x4){br[0], br[1], br[2], br[3]}); lst[5 * 512] = __builtin_bit_cast(u32x4, (f32x4){bi[0], bi[1], bi[2], bi[3]}); lst[6 * 512] = __builtin_bit_cast(u32x4, (f32x4){sp8[0], sp8[1], sp8[2], sp8[3]}); lst[7 * 512] = __builtin_bit_cast(u32x4, idf);
        bf16x8 xf[4][2];
#define LRU_XLOAD(PB_) do { _Pragma("unroll") for (int i = 0; i < 4; ++i) { const int tok_ = dir ? (S - 1 - ((PB_) + i)) : ((PB_) + i); \
            _Pragma("unroll") for (int ks = 0; ks < 2; ++ks) xf[i][ks] = *(const bf16x8*)(XC + (rowbase + tok_) * 512 + ch0 + 32 * ks); } } while (0)
        LRU_XLOAD(wid * 64 + 4 * p);
        for (int sc = 0; sc < 8; ++sc) {
            const int P0 = sc * 512 + wid * 64, Pb = P0 + 4 * p;
            f32x4 ar[4], ai[4], ax[4];
            {
                int zoff = 0; asm volatile("" : "+v"(zoff));
                const LAS u32x4* lsi = (const LAS u32x4*)lds + tid + zoff;
                const bf16x8 wrf0 = __builtin_bit_cast(bf16x8, lsi[0 * 512]), wrf1 = __builtin_bit_cast(bf16x8, lsi[1 * 512]), wif0 = __builtin_bit_cast(bf16x8, lsi[2 * 512]), wif1 = __builtin_bit_cast(bf16x8, lsi[3 * 512]), idf_ = __builtin_bit_cast(bf16x8, lsi[7 * 512]);
                const f32x4 z = (f32x4){0.f, 0.f, 0.f, 0.f};
#pragma unroll
                for (int i = 0; i < 4; ++i) {
                    ar[i] = LRU_MFMA16(wrf0, xf[i][0], z); ar[i] = LRU_MFMA16(wrf1, xf[i][1], ar[i]);
                    ai[i] = LRU_MFMA16(wif0, xf[i][0], z); ai[i] = LRU_MFMA16(wif1, xf[i][1], ai[i]);
                    ax[i] = LRU_MFMA16(idf_, (e16 & 2) ? xf[i][1] : xf[i][0], z);
                }
                __builtin_amdgcn_sched_barrier(0);
                if (sc < 7) LRU_XLOAD(Pb + 512);
            }
            float hh[4][4], cpp[4][4], Al[4], Hl[4];
            int zoff2 = 0; asm volatile("" : "+v"(zoff2));
            const LAS f32x4* lsg = (const LAS f32x4*)lds + tid + zoff2;
            const f32x4 brv = lsg[4 * 512], biv = lsg[5 * 512], spv = lsg[6 * 512];
#pragma unroll
            for (int r = 0; r < 4; ++r) {
                float h = 0.f, cp = 1.f;
#pragma unroll
                for (int i = 0; i < 4; ++i) {
                    const float rg = __builtin_amdgcn_rcpf(1.0f + __builtin_amdgcn_exp2f(ar[i][r] * -LOG2E + brv[r])), ig = __builtin_amdgcn_rcpf(1.0f + __builtin_amdgcn_exp2f(ai[i][r] * -LOG2E + biv[r]));
                    const float a_ = __builtin_amdgcn_exp2f(-rg * spv[r]);
                    const float om = __builtin_fmaf(-a_, a_, 1.0f);
                    const float u_ = __builtin_amdgcn_sqrtf(om) * (ig * ax[i][r]);
                    h = a_ * h + u_; cp = a_ * cp; hh[i][r] = h; cpp[i][r] = cp;
                }
                Al[r] = cp; Hl[r] = h;
            }
#define LRU_KS(NN) do { _Pragma("unroll") for (int r = 0; r < 4; ++r) { const float Ap = dpp_shr<NN>(Al[r], 1.0f), Hp = dpp_shr<NN>(Hl[r], 0.0f); Hl[r] = Al[r] * Hp + Hl[r]; Al[r] = Al[r] * Ap; } } while (0)
            LRU_KS(1); LRU_KS(2); LRU_KS(4); LRU_KS(8);
#undef LRU_KS
            float Aex[4], Hex[4];
#pragma unroll
            for (int r = 0; r < 4; ++r) { Aex[r] = dpp_shr<1>(Al[r], 1.0f); Hex[r] = dpp_shr<1>(Hl[r], 0.0f); }
            if (p == 15) {
#pragma unroll
                for (int r = 0; r < 4; ++r) { tot[((par * 8 + wid) * 16 + 4 * g + r) * 2] = Al[r]; tot[((par * 8 + wid) * 16 + 4 * g + r) * 2 + 1] = Hl[r]; }
            }
            asm volatile("s_waitcnt lgkmcnt(0)\n\ts_barrier" ::: "memory");
            float cin[4];
#pragma unroll
            for (int r = 0; r < 4; ++r) cin[r] = 0.f;
#pragma unroll
            for (int w = 0; w < 8; ++w) {
                const f32x4 t0 = *(const LAS f32x4*)(tot + ((par * 8 + w) * 16 + 4 * g) * 2), t1 = *(const LAS f32x4*)(tot + ((par * 8 + w) * 16 + 4 * g) * 2 + 4);
                const float Aw[4] = {t0[0], t0[2], t1[0], t1[2]}, Hw[4] = {t0[1], t0[3], t1[1], t1[3]};
#pragma unroll
                for (int r = 0; r < 4; ++r) { if (w == wid) cin[r] = carry[r]; carry[r] = Aw[r] * carry[r] + Hw[r]; }
            }
            par ^= 1;
            f32x4 hfv[4]; u32x2 gv[4];
            if (dir) {
#pragma unroll
                for (int i = 0; i < 4; ++i) { const int tok = S - 1 - (Pb + i); hfv[i] = *(const f32x4*)(HF + (rowbase + tok) * 512 + c0 + 4 * g); gv[i] = *(const u32x2*)(GR + (rowbase + tok) * 512 + c0 + 4 * g); }
            }
            float cl[4];
#pragma unroll
            for (int r = 0; r < 4; ++r) cl[r] = Aex[r] * cin[r] + Hex[r];
#pragma unroll
            for (int i = 0; i < 4; ++i) {
                const int P = Pb + i; const int tok = dir ? (S - 1 - P) : P;
                f32x4 hv;
#pragma unroll
                for (int r = 0; r < 4; ++r) hv[r] = hh[i][r] + cpp[i][r] * cl[r];
                if (dir == 0) *(f32x4*)(HF + (rowbase + tok) * 512 + c0 + 4 * g) = hv;
                else {
                    const float gr4[4] = {__uint_as_float(gv[i].x << 16), __uint_as_float(gv[i].x & 0xffff0000u), __uint_as_float(gv[i].y << 16), __uint_as_float(gv[i].y & 0xffff0000u)};
                    float y[4];
#pragma unroll
                    for (int r = 0; r < 4; ++r) { const float x = gr4[r]; const float gl = x * fast_sigmoid(1.5957691216057308f * (x + 0.044715f * x * x * x)); y[r] = gl * (hv[r] + hfv[i][r]); }
                    u32x2 w; w.x = cvt_pk_bf16(y[0], y[1]); w.y = cvt_pk_bf16(y[2], y[3]);
                    *(u32x2*)(MIXED + (rowbase + tok) * 1024 + 512 + c0 + 4 * g) = w;
                }
            }
        }
        __syncthreads();
    }
}
}
struct Args { const float* in[22]; float* out; unsigned char* ws; int ph_lo, ph_hi; };
constexpr int N_PHASES = 6;

__global__ void __launch_bounds__(NWAVES * 64, 2) mk_fwd(Args args) {
    extern __shared__ __attribute__((aligned(16))) unsigned char lds_raw[];
    LAS unsigned char* lds = (LAS unsigned char*)lds_raw;
    const int tid = threadIdx.x, lane = tid & 63; const int wave = __builtin_amdgcn_readfirstlane(tid >> 6);
    const int G = gridDim.x, bx = blockIdx.x; const int vcu = (G % 8 == 0) ? (bx % 8) * (G / 8) + bx / 8 : bx;
    unsigned char* ws = args.ws;
    const float* x = args.in[0]; float* out = args.out;
    bf16_t* WIN = (bf16_t*)(ws + WS_WIN); bf16_t* WOUT = (bf16_t*)(ws + WS_WOUT); bf16_t* WGU = (bf16_t*)(ws + WS_WGU); bf16_t* WDN = (bf16_t*)(ws + WS_WDN);
    float* RSS1 = (float*)(ws + WS_RSS1); float* RSS2 = (float*)(ws + WS_RSS2);
    bf16_t* XN = (bf16_t*)(ws + WS_XN); bf16_t* HB = XN;
    bf16_t* Qb = (bf16_t*)(ws + WS_Q); bf16_t* KT = (bf16_t*)(ws + WS_KT); bf16_t* VT = (bf16_t*)(ws + WS_VT); bf16_t* XR = (bf16_t*)(ws + WS_XR); bf16_t* GR = (bf16_t*)(ws + WS_GR);
    float* HF = (float*)(ws + WS_HF); bf16_t* MIXED = (bf16_t*)(ws + WS_MIXED); bf16_t* ACT = (bf16_t*)(ws + WS_ACT);
    const int lo = args.ph_lo, hi = args.ph_hi;
    volatile LAS unsigned* bst = (volatile LAS unsigned*)(lds + LDS_MISC + 8192);
    if (tid == 0) { bst[0] = 0u; bst[1] = 0u; bst[2] = 0u; }
    __syncthreads();
    xb::XcdBarrier bar = xb::xcd_barrier_post((unsigned*)ws, bst);
    if (lo > 1000) cooperative_groups::this_grid().sync();
#define IN(k) (lo <= (k) && (k) < hi)
#ifndef REP_PHASE
#define REP_PHASE -1
#endif
#define REPS(k) ((REP_PHASE == (k)) ? 2 : 1)
#define REPSYNC(k, rep) do { if ((rep) + 1 < REPS(k)) xb::xcd_barrier(bar); } while (0)
#define SEAM(k) do { if (IN(k) && IN((k) + 1)) { xb::xcd_barrier(bar); } } while (0)

    if (IN(0)) for (int rep = 0; rep < REPS(0); ++rep) {
        LAS float* scr = (LAS float*)(lds + wave * 16384);
        const int gw = vcu * NWAVES + wave, NGW = G * NWAVES;
        constexpr int I_IN = (D / 64) * (DIN / 32), I_OUT = (D / 64) * (D / 32), I_G = (D / 64) * (DFF / 32), I_DN = (DFF / 64) * (D / 32);
        constexpr int NITEMS = I_IN + I_OUT + 2 * I_G + I_DN;
        for (int it = gw; it < NITEMS; it += NGW) {
            int r = it;
            if (r < I_IN) { p0_transpose_item<0>(args.in[2], D, DIN, WIN, nullptr, scr, r, lane); continue; } r -= I_IN;
            if (r < I_OUT) { p0_transpose_item<0>(args.in[16], D, D, WOUT, nullptr, scr, r, lane); continue; } r -= I_OUT;
            if (r < I_G) { p0_transpose_item<1>(args.in[18], D, DFF, WGU, args.in[17], scr, r, lane); continue; } r -= I_G;
            if (r < I_G) { p0_transpose_item<2>(args.in[19], D, DFF, WGU, args.in[17], scr, r, lane); continue; } r -= I_G;
            p0_transpose_item<0>(args.in[20], DFF, D, WDN, nullptr, scr, r, lane);
        }
        for (int m = gw * 4; m < M; m += NGW * 4) rms_rows_to_bf16<4>(x + (size_t)m * D, args.in[1], XN + (size_t)m * D, lane);
        REPSYNC(0, rep);
    }
    SEAM(0);
    if (IN(1)) for (int rep = 0; rep < REPS(1); ++rep) {
        pg8::Gemm g{XN, WIN, M, DIN, D}; pg8::StaticOrder So; So.init(M, DIN, G, bx); So.rep = (REP_PHASE == 10) ? 2 : 1;
        pg8::EpiInProj E{Qb, KT, VT, XR, GR, QSCALE};
        pg8::gemm_phase<pg8::EpiInProj, pg8::StaticOrder, true, true>(lds, g, So, E);
        REPSYNC(1, rep);
    }
    SEAM(1);
    if (IN(2)) {
        float lam;
        { float s1 = 0.f, s2 = 0.f; for (int i = 0; i < 64; ++i) { s1 += args.in[3][i] * args.in[4][i]; s2 += args.in[5][i] * args.in[6][i]; } lam = expf(s1) - expf(s2) + 0.2f; }
#if REP_PHASE == 79
        { const long long pr0 = wall_clock64();
          for (int rnd = 0; rnd * G + vcu < NB * NH * 32; ++rnd) { att::attn_unit<ATT_PROBE>(vcu >> 5, rnd, vcu & 31, Qb, KT, VT, (bf16_t*)(ws + WS_XC), lds, lam, args.in[7], args.in[8]); }
          __syncthreads();
          if (bx == 0 && tid == 0) { const long long dr = wall_clock64() - pr0; ((float*)ws)[30000] = (float)dr * 2.0e-6f; } }
#endif
#if REP_PHASE == 77 || REP_PHASE == 78
        const long long pc0 = clock64(), pr0 = wall_clock64();
#endif
        for (int rep = 0; rep < REPS(20); ++rep)
        for (int rnd = 0; rnd * G + vcu < NB * NH * 32; ++rnd) {
            const int u = rnd * G + vcu; int b_, h_, qb_;
            if (G == 256) { b_ = vcu >> 5; h_ = rnd; qb_ = vcu & 31; } else { qb_ = u & 31; h_ = (u >> 5) & 3; b_ = u >> 7; }
            att::attn_unit<0>(b_, h_, qb_, Qb, KT, VT, MIXED, lds, lam, args.in[7], args.in[8]);
        }
#if REP_PHASE == 80
        { const long long pr0 = wall_clock64();
          lru::lru_item<ATT_PROBE>(vcu >> 5, vcu & 31, XR, GR, (float*)(ws + 448 * MiB), (bf16_t*)(ws + WS_XC), (bf16_t*)(ws + 416 * MiB), (unsigned*)ws + 24576 + 64 * (vcu >> 2), lds, args.in[9], args.in[10], args.in[11], args.in[12], args.in[13], args.in[14], args.in[15]);
          __syncthreads();
          if (bx == 0 && tid == 0) { const long long dr = wall_clock64() - pr0; ((float*)ws)[30000] = (float)dr * 6.0e-6f; } }
#endif
#if REP_PHASE == 77
        if (bx == 0 && tid == 0) { const long long dc = clock64() - pc0, dr = wall_clock64() - pr0; ((float*)ws)[30000] = (float)dc / ((float)dr * 10.0f) * 0.05f; }
#endif
        for (int rep = 0; rep < REPS(21); ++rep)
        for (int it = vcu; it < NB * 32; it += G) {
            const int b_ = it >> 5, cg = it & 31;
            lru::lru_item(b_, cg, XR, GR, HF, MIXED, (bf16_t*)(ws + WS_XC), (unsigned*)ws + 16384 + 64 * (it >> 2), lds, args.in[9], args.in[10], args.in[11], args.in[12], args.in[13], args.in[14], args.in[15]);
        }
    }
#if REP_PHASE == 78
    if (IN(2) && bx == 0 && tid == 0) { const long long dc = clock64() - pc0_, dr = wall_clock64() - pr0_; ((float*)ws)[30000] = (float)dc / ((float)dr * 10.0f) * 0.05f; }
#endif
    SEAM(2);
    if (IN(3)) for (int rep = 0; rep < REPS(3); ++rep) {
        pg8::Gemm g{MIXED, WOUT, M, D, D}; pg8::StaticOrder So; So.init(M, D, G, bx);
        pg8::EpiResid<true, false> E{x, out, HB, RSS1, D};
        pg8::gemm_phase<pg8::EpiResid<true, false>, pg8::StaticOrder, true, true>(lds, g, So, E);
        REPSYNC(3, rep);
    }
    SEAM(3);
    if (IN(4)) for (int rep = 0; rep < REPS(4); ++rep) {
        float* RSTD = (float*)(ws + WS_RSTD);
        for (int r = vcu * 128 + (tid >> 2); r < M; r += G * 128) {
            const f32x4 sv = *(const f32x4*)(RSS1 + (size_t)r * 16 + 4 * (tid & 3)); float s = (sv[0] + sv[1]) + (sv[2] + sv[3]);
            s += __shfl_xor(s, 1); s += __shfl_xor(s, 2);
            if ((tid & 3) == 0) RSTD[r] = __builtin_amdgcn_rsqf(s * (1.0f / D) + EPS);
        }
        xb::xcd_barrier(bar);
        pg8::Gemm g{HB, WGU, M, 2 * DFF, D}; pg8::StaticOrder So; So.init(M, 2 * DFF, G, bx); So.rep = (REP_PHASE == 40) ? 2 : 1;
        pg8::EpiGateUp E{ACT, RSTD, DFF};
        pg8::gemm_phase<pg8::EpiGateUp, pg8::StaticOrder, true, true>(lds, g, So, E);
        REPSYNC(4, rep);
    }
    SEAM(4);
    if (IN(5)) for (int rep = 0; rep < REPS(5); ++rep) {
        if (G == 256) {
#pragma unroll 1
            for (int half = 0; half < 2; ++half) {
                const size_t r0 = (size_t)half * (M / 2);
                pg8::Gemm g{ACT + r0 * DFF, WDN, M / 2, D, DFF}; pg8::StaticOrder So; So.init(M / 2, D, G, bx);
                pg8::EpiDownNorm E{HB + r0 * D, out + r0 * D, args.in[21], RSS2 + r0 * 4, (unsigned*)ws + 4096 + 64 * 64 * half, D, EPS, ws};
                pg8::gemm_phase<pg8::EpiDownNorm, pg8::StaticOrder, false, true>(lds, g, So, E);
                __syncthreads();
            }
        }
        REPSYNC(5, rep);
    }
#if REP_PHASE == 99
    for (int i = 0; i < 20; ++i) xb::xcd_barrier(bar);
#endif
#undef IN
#undef SEAM
}
}
namespace dbg {
using namespace mk;
__global__ void __launch_bounds__(256) k_unpack_proj(const bf16_t* Qb, const bf16_t* KT, const bf16_t* VT, const bf16_t* XR, const bf16_t* GR, float* q, float* k, float* v, float* xr, float* gr) {
    const size_t idx = (size_t)blockIdx.x * 256 + threadIdx.x;
    const int c = (int)(idx & 511); const int row = (int)(idx >> 9); const int b = row >> 12, tok = row & 4095, t = tok >> 6, rr = tok & 63;
    q[idx] = bf2f(Qb[idx]) * (1.0f / QSCALE);
    { const int h = c >> 7, w = c & 127, s = w >> 6, d = w & 63, chunk = d >> 3, j = d & 7;
      k[idx] = bf2f(KT[((((size_t)(b * 4 + h) * 2 + s) * 64 + t) * 8 + chunk) * 512 + rr * 8 + j]); }
    { const int h = c >> 7, dv = c & 127, db = dv >> 5, cc = dv & 31;
      v[idx] = bf2f(VT[(((size_t)(b * 4 + h) * 64 + t) * 4 + db) * 2048 + rr * 32 + cc]); }
    xr[idx] = bf2f(XR[idx]); gr[idx] = bf2f(GR[idx]);
}
__global__ void __launch_bounds__(256) k_unpack_bf16(const bf16_t* src, float* dst) { const size_t idx = (size_t)blockIdx.x * 256 + threadIdx.x; dst[idx] = bf2f(src[idx]); }
}

#ifndef STAGE
#define STAGE 4
#endif
static void mk_launch_phases(const mk::Args& a0, int lo, int hi, int grid, hipStream_t stream, bool coop) {
    mk::Args a = a0; a.ph_lo = lo; a.ph_hi = hi;
    if (coop) { void* args[] = {&a}; hipError_t e = hipLaunchCooperativeKernel((const void*)mk::mk_fwd, dim3(grid), dim3(mk::NWAVES * 64), args, mk::LDS_BYTES, stream);
        if (e != hipSuccess) fprintf(stderr, "cooperative launch failed: %s (grid %d)\n", hipGetErrorString(e), grid); }
    else { hipLaunchKernelGGL(mk::mk_fwd, dim3(grid), dim3(mk::NWAVES * 64), mk::LDS_BYTES, stream, a); }
}

extern "C" void kernel_launch(void* const* d_in, const int* in_sizes, int n_in, void* d_out, int out_size, void* d_ws, size_t ws_size, hipStream_t stream) {
    static int grid = 0;
    if (grid == 0) {
        int dev = 0, cus = 0, per_cu = 0;
        hipGetDevice(&dev); hipDeviceGetAttribute(&cus, hipDeviceAttributeMultiprocessorCount, dev);
        if (hipFuncSetAttribute((const void*)mk::mk_fwd, hipFuncAttributeMaxDynamicSharedMemorySize, mk::LDS_BYTES) != hipSuccess) { fprintf(stderr, "hipFuncSetAttribute failed\n"); grid = -1; return; }
        if (hipOccupancyMaxActiveBlocksPerMultiprocessor(&per_cu, (const void*)mk::mk_fwd, mk::NWAVES * 64, mk::LDS_BYTES) != hipSuccess || per_cu < 1) { fprintf(stderr, "occupancy query: %d\n", per_cu); per_cu = 1; }
        (void)hipGetLastError();
        grid = cus * 1;
        if (n_in != 22 || ws_size < 512u * mk::MiB) fprintf(stderr, "kernel_launch: unexpected n_in %d / ws_size %zu\n", n_in, ws_size);
    }
    if (grid < 0) return;
    if (hipMemsetAsync(d_ws, 0, 131072, stream) != hipSuccess) { fprintf(stderr, "memset failed\n"); return; }
    mk::Args a{};
    for (int i = 0; i < 22; ++i) a.in[i] = (const float*)d_in[i];
    a.out = (float*)d_out; a.ws = (unsigned char*)d_ws;
    char* ws = (char*)d_ws; const size_t MiB = 1u << 20;
#if STAGE == 4
    mk_launch_phases(a, 0, mk::N_PHASES, grid, stream, true);
#elif STAGE == 3
    for (int p = 0; p < mk::N_PHASES; ++p) mk_launch_phases(a, p, p + 1, grid, stream, false);
#elif STAGE == 1
    for (int p = 0; p < 2; ++p) mk_launch_phases(a, p, p + 1, grid, stream, false);
    float* q = (float*)(ws + 32 * MiB), *k = (float*)(ws + 256 * MiB), *v = (float*)(ws + 320 * MiB), *xr = (float*)(ws + 384 * MiB), *gr = (float*)(ws + 448 * MiB);
    dbg::k_unpack_proj<<<mk::M * 512 / 256, 256, 0, stream>>>((const mk::bf16_t*)(ws + mk::WS_Q), (const mk::bf16_t*)(ws + mk::WS_KT), (const mk::bf16_t*)(ws + mk::WS_VT), (const mk::bf16_t*)(ws + mk::WS_XR), (const mk::bf16_t*)(ws + mk::WS_GR), q, k, v, xr, gr);
    float* mixed = (float*)(ws + 96 * MiB);
    nv::naive_mid(d_in, q, k, v, xr, gr, mixed, stream);
    nv::naive_tail(d_in, mixed, (float*)d_out, (float*)(ws + 0), (float*)(ws + 128 * MiB), stream);
#elif STAGE == 2
    for (int p = 0; p < 3; ++p) mk_launch_phases(a, p, p + 1, grid, stream, false);
    float* mixed = (float*)(ws + 0);
    dbg::k_unpack_bf16<<<mk::M * 1024 / 256, 256, 0, stream>>>((const mk::bf16_t*)(ws + mk::WS_MIXED), mixed);
    nv::naive_tail(d_in, mixed, (float*)d_out, (float*)(ws + 0), (float*)(ws + 128 * MiB), stream);
#endif
}
```

```cpp
#include <hip/hip_runtime.h>
#include <hip/hip_cooperative_groups.h>
#include <cstdio>
#include <cstdint>
#include <cmath>
#define STAGE 4
namespace pg8 {
#define PG8_LAS __attribute__((address_space(3)))
typedef unsigned short bf16_t;
typedef short bf16x8 __attribute__((ext_vector_type(8)));
typedef float f32x4 __attribute__((ext_vector_type(4)));
typedef unsigned u32x4 __attribute__((ext_vector_type(4)));
constexpr int BM = 256, BK = 64, HALF = 128, HTB = HALF * BK * 2  , STAGE_BYTES = 8 * HTB, NXCD = 8, WGM = 8;

__host__ __device__ __forceinline__ int lds_byte(int r, int c) { const int st = (r >> 4) * 2 + (c >> 5), rr = r & 15, cc = c & 31, ob = rr * 64 + cc * 2; return st * 1024 + (ob ^ (((ob >> 9) & 1) << 5)); }
__host__ __device__ __forceinline__ void stage_rc(int b, int& R, int& C) { const int st = b / 1024, sb = b % 1024, swz = sb ^ (((sb >> 9) & 1) << 5); R = (st >> 1) * 16 + swz / 64; C = (st & 1) * 32 + (swz % 64) / 2; }
__host__ __device__ __forceinline__ int perm32(int rho) { const int n = rho >> 4, i = rho & 15; return 8 * (i >> 2) + 4 * n + (i & 3); }

struct Unit { int pm, pn; };
struct Gemm { const bf16_t* A; const bf16_t* Bt; int M, N, K; };

struct StaticOrder {
    int nM, nN, nwg, G, c, rep;
    __host__ __device__ void init(int M, int N, int G_, int c_) { nM = M / BM; nN = N / BM; nwg = nM * nN; G = G_; c = c_; rep = 1; }
    __host__ __device__ bool next(int i, Unit& u) const {
        const long L = (long)(i / rep) * G + c; if (L >= nwg) return false;
        int wgid = (int)L; { const int q = nwg / NXCD, r = nwg % NXCD, xcd = wgid % NXCD, off = wgid / NXCD; wgid = (xcd < r ? xcd * (q + 1) : r * (q + 1) + (xcd - r) * q) + off; }
        const int nig = WGM * nN, gid = wgid / nig, fm = gid * WGM, gsz = (nM - fm) < WGM ? (nM - fm) : WGM;
        u.pm = fm + ((wgid % nig) % gsz); u.pn = (wgid % nig) / gsz; return true;
    }
    __device__ __forceinline__ void a_ready(const Unit&) const {}
    __device__ __forceinline__ void done(const Unit&) const {}
};

typedef float f32x2_cv __attribute__((ext_vector_type(2))); typedef __bf16 bf16x2_cv __attribute__((ext_vector_type(2)));
__device__ __forceinline__ unsigned cvt_pk_bf16(float lo, float hi) { f32x2_cv v = {lo, hi}; bf16x2_cv b = __builtin_convertvector(v, bf16x2_cv); return __builtin_bit_cast(unsigned, b); }
typedef float f32x2 __attribute__((ext_vector_type(2)));
typedef unsigned u32x2 __attribute__((ext_vector_type(2)));
__device__ __forceinline__ u32x4 pack8(f32x4 v0, f32x4 v1) { u32x4 w; w.x = cvt_pk_bf16(v0[0], v0[1]); w.y = cvt_pk_bf16(v0[2], v0[3]); w.z = cvt_pk_bf16(v1[0], v1[1]); w.w = cvt_pk_bf16(v1[2], v1[3]); return w; }
struct EpiInProj {
    static constexpr bool PERM = true, AFTER_DRAIN = false;
    bf16_t *Q, *KT, *VT, *XR, *GR; float qscale;
    __device__ __forceinline__ void operator()(const f32x4 (&acc)[2][2][4][2], const Unit& u, int wr, int wc, int fr, int fq) const {
        const int sec = u.pn >> 1, half = u.pn & 1;
#pragma unroll
        for (int ai = 0; ai < 2; ++ai)
#pragma unroll
            for (int m = 0; m < 4; ++m) {
                const int row = u.pm * BM + ai * HALF + wr * 64 + m * 16 + fr;
                const int b = row >> 12, tok = row & 4095, t = tok >> 6, rr = tok & 63;
#pragma unroll
                for (int bj = 0; bj < 2; ++bj) {
                    f32x4 v0 = acc[ai][bj][m][0], v1 = acc[ai][bj][m][1];
                    const int cs = half * 256 + bj * HALF + wc * 32 + 8 * fq;
                    if (sec == 0) { v0 = v0 * qscale; v1 = v1 * qscale; *(u32x4*)(Q + (size_t)row * 512 + cs) = pack8(v0, v1); }
                    else if (sec == 1) { const int h = half * 2 + bj, s = wc >> 1, chunk = 4 * (wc & 1) + fq;
                        *(u32x4*)(KT + ((((size_t)(b * 4 + h) * 2 + s) * 64 + t) * 8 + chunk) * 512 + rr * 8) = pack8(v0, v1); }
                    else if (sec == 2) { const int h = half * 2 + bj;
                        *(u32x4*)(VT + (((size_t)(b * 4 + h) * 64 + t) * 4 + wc) * 2048 + rr * 32 + 8 * fq) = pack8(v0, v1); }
                    else if (sec == 3) { *(u32x4*)(XR + (size_t)row * 512 + cs) = pack8(v0, v1); }
                    else { *(u32x4*)(GR + (size_t)row * 512 + cs) = pack8(v0, v1); }
                }
            }
    }
};
template <bool WRITE_HB, bool WRITE_F32 = true> struct EpiResid {
    static constexpr bool PERM = false, AFTER_DRAIN = false;
    const float* base; float* out; bf16_t* hb; float* rss; int ldc;
    __device__ __forceinline__ void operator()(const f32x4 (&acc)[2][2][4][2], const Unit& u, int wr, int wc, int fr, int fq) const {
        const int col0 = u.pn * BM + wc * 32 + 4 * fq;
        f32x4 nx[2][2];
        { const size_t off0 = (size_t)(u.pm * BM + wr * 64 + fr) * ldc + col0;
#pragma unroll
          for (int bj = 0; bj < 2; ++bj)
#pragma unroll
              for (int n = 0; n < 2; ++n) nx[bj][n] = *(const f32x4*)(base + off0 + bj * HALF + n * 16); }
#pragma unroll
        for (int gi = 0; gi < 8; ++gi) {
            const int ai = gi >> 2, m = gi & 3;
            const int row = u.pm * BM + ai * HALF + wr * 64 + m * 16 + fr; const size_t off = (size_t)row * ldc + col0; float ss = 0.f;
            f32x4 cur[2][2];
#pragma unroll
            for (int bj = 0; bj < 2; ++bj)
#pragma unroll
                for (int n = 0; n < 2; ++n) cur[bj][n] = nx[bj][n];
            if (gi < 7) { const int ai2 = (gi + 1) >> 2, m2 = (gi + 1) & 3; const size_t off2 = (size_t)(u.pm * BM + ai2 * HALF + wr * 64 + m2 * 16 + fr) * ldc + col0;
#pragma unroll
                for (int bj = 0; bj < 2; ++bj)
#pragma unroll
                    for (int n = 0; n < 2; ++n) nx[bj][n] = *(const f32x4*)(base + off2 + bj * HALF + n * 16); }
#pragma unroll
            for (int bj = 0; bj < 2; ++bj)
#pragma unroll
                for (int n = 0; n < 2; ++n) {
                    const f32x4 o = acc[ai][bj][m][n] + cur[bj][n];
                    if (WRITE_F32) *(f32x4*)(out + off + bj * HALF + n * 16) = o;
                    if (WRITE_HB) { u32x2 w; w.x = cvt_pk_bf16(o[0], o[1]); w.y = cvt_pk_bf16(o[2], o[3]); *(u32x2*)(hb + off + bj * HALF + n * 16) = w; }
                    ss += (o[0] * o[0] + o[1] * o[1]) + (o[2] * o[2] + o[3] * o[3]);
                }
            ss += __shfl_xor(ss, 16); ss += __shfl_xor(ss, 32);
            if (fq == 0) rss[(size_t)row * 16 + u.pn * 4 + wc] = ss;
        }
    }
};
struct EpiGateUp {
    static constexpr bool PERM = true, AFTER_DRAIN = false;
    bf16_t* act; const float* rstd; int ldo;
    __device__ __forceinline__ void operator()(const f32x4 (&acc)[2][2][4][2], const Unit& u, int wr, int wc, int fr, int fq) const {
        const int col0 = u.pn * HALF + wc * 32 + 8 * fq;
        float rs[2][4];
#pragma unroll
        for (int ai = 0; ai < 2; ++ai)
#pragma unroll
            for (int m = 0; m < 4; ++m) rs[ai][m] = rstd[u.pm * BM + ai * HALF + wr * 64 + m * 16 + fr];
#pragma unroll
        for (int ai = 0; ai < 2; ++ai)
#pragma unroll
            for (int m = 0; m < 4; ++m) {
                const int row = u.pm * BM + ai * HALF + wr * 64 + m * 16 + fr;
                const float r_ = rs[ai][m], c1 = r_ * -1.4426950408889634f, r2 = r_ * r_;
                f32x4 o[2];
#pragma unroll
                for (int n = 0; n < 2; ++n) {
                    const f32x4 g = acc[ai][0][m][n], up = acc[ai][1][m][n];
#pragma unroll
                    for (int i = 0; i < 4; ++i) { const float e = __builtin_amdgcn_exp2f(g[i] * c1); o[n][i] = (g[i] * up[i]) * (r2 * __builtin_amdgcn_rcpf(1.0f + e)); }
                }
                *(u32x4*)(act + (size_t)row * ldo + col0) = pack8(o[0], o[1]);
            }
    }
};

struct EpiDownNorm {
    static constexpr bool PERM = false, AFTER_DRAIN = true;
    const bf16_t* hb; float* out; const float* gain; float* xbuf; unsigned* cnt; int ldc; float eps; const void* cnt_base_probe;
    __device__ __forceinline__ void fused(f32x4 (&acc)[2][2][4][2], const Unit& u, int wr, int wc, int fr, int fq, PG8_LAS unsigned char* lds, int wid, int lane) const {
        PG8_LAS float* P = (PG8_LAS float*)lds;
        PG8_LAS float* Sx = (PG8_LAS float*)(lds + 4096);
        PG8_LAS unsigned* flag = (PG8_LAS unsigned*)(lds + 4096 + 1024);
        const int col0 = u.pn * BM + wc * 32 + 4 * fq;
        u32x2 nx[2][2];
        { const size_t off0 = (size_t)(u.pm * BM + wr * 64 + fr) * ldc + col0;
#pragma unroll
          for (int bj = 0; bj < 2; ++bj)
#pragma unroll
              for (int n = 0; n < 2; ++n) nx[bj][n] = *(const u32x2*)(hb + off0 + bj * HALF + n * 16); }
#pragma unroll
        for (int gi = 0; gi < 8; ++gi) {
            const int ai = gi >> 2, m = gi & 3;
            const int r = ai * HALF + wr * 64 + m * 16 + fr; float ss = 0.f;
            u32x2 cur[2][2];
#pragma unroll
            for (int bj = 0; bj < 2; ++bj)
#pragma unroll
                for (int n = 0; n < 2; ++n) cur[bj][n] = nx[bj][n];
            if (gi < 7) { const int ai2 = (gi + 1) >> 2, m2 = (gi + 1) & 3; const size_t off2 = (size_t)(u.pm * BM + ai2 * HALF + wr * 64 + m2 * 16 + fr) * ldc + col0;
#pragma unroll
                for (int bj = 0; bj < 2; ++bj)
#pragma unroll
                    for (int n = 0; n < 2; ++n) nx[bj][n] = *(const u32x2*)(hb + off2 + bj * HALF + n * 16); }
#pragma unroll
            for (int bj = 0; bj < 2; ++bj)
#pragma unroll
                for (int n = 0; n < 2; ++n) {
                    const u32x2 hv = cur[bj][n];
                    const f32x4 h4 = (f32x4){__uint_as_float(hv.x << 16), __uint_as_float(hv.x & 0xffff0000u), __uint_as_float(hv.y << 16), __uint_as_float(hv.y & 0xffff0000u)};
                    const f32x4 o = acc[ai][bj][m][n] + h4; acc[ai][bj][m][n] = o;
                    ss += (o[0] * o[0] + o[1] * o[1]) + (o[2] * o[2] + o[3] * o[3]);
                }
            ss += __shfl_xor(ss, 16); ss += __shfl_xor(ss, 32);
            if (fq == 0) P[r * 4 + wc] = ss;
        }
        asm volatile("s_waitcnt lgkmcnt(0)" ::: "memory"); __builtin_amdgcn_s_barrier(); asm volatile("" ::: "memory");
        const int row = wid * 32 + (lane & 31);
        if (lane < 32) {
            const float s = (P[row * 4 + 0] + P[row * 4 + 1]) + (P[row * 4 + 2] + P[row * 4 + 3]);
            __hip_atomic_store(xbuf + (size_t)(u.pm * BM + row) * 4 + u.pn, s, __ATOMIC_RELAXED, __HIP_MEMORY_SCOPE_AGENT);
        }
        asm volatile("s_waitcnt vmcnt(0)" ::: "memory");
        if (lane == 0) __hip_atomic_fetch_add(cnt + 64 * u.pm, 1u, __ATOMIC_RELAXED, __HIP_MEMORY_SCOPE_AGENT);
        if (wid == 0) {
            unsigned sp = 0;
            for (;;) {
                if ((unsigned)__builtin_amdgcn_readfirstlane(__hip_atomic_load(cnt + 64 * u.pm, __ATOMIC_RELAXED, __HIP_MEMORY_SCOPE_AGENT)) >= 32u) break;
                if (++sp > (1u << 22)) break;
                __builtin_amdgcn_s_sleep(2);
            }
            __builtin_amdgcn_fence(__ATOMIC_ACQUIRE, "agent");
            if (lane == 0) flag[0] = 0u;
        }
        asm volatile("s_waitcnt vmcnt(0) lgkmcnt(0)" ::: "memory"); __builtin_amdgcn_s_barrier(); asm volatile("" ::: "memory");
        if (lane < 32) {
            const float* slot = xbuf + (size_t)(u.pm * BM + row) * 4;
            const float a = __hip_atomic_load(slot + 0, __ATOMIC_RELAXED, __HIP_MEMORY_SCOPE_AGENT), b = __hip_atomic_load(slot + 1, __ATOMIC_RELAXED, __HIP_MEMORY_SCOPE_AGENT),
                        c = __hip_atomic_load(slot + 2, __ATOMIC_RELAXED, __HIP_MEMORY_SCOPE_AGENT), d = __hip_atomic_load(slot + 3, __ATOMIC_RELAXED, __HIP_MEMORY_SCOPE_AGENT);
            Sx[row] = 1.0f / sqrtf(((a + b) + (c + d)) * (1.0f / 1024.0f) + eps);
        }
        asm volatile("s_waitcnt lgkmcnt(0)" ::: "memory"); __builtin_amdgcn_s_barrier(); asm volatile("" ::: "memory");
        f32x4 gv[2][2];
#pragma unroll
        for (int bj = 0; bj < 2; ++bj)
#pragma unroll
            for (int n = 0; n < 2; ++n) gv[bj][n] = *(const f32x4*)(gain + col0 + bj * HALF + n * 16);
#if defined(REP_PHASE) && (REP_PHASE == 77 || REP_PHASE == 79 || REP_PHASE == 80)
        { const float sc_ = 1.0f + ((const float*)cnt_base_probe)[30000];
#pragma unroll
          for (int bj = 0; bj < 2; ++bj)
#pragma unroll
              for (int n = 0; n < 2; ++n) gv[bj][n] = gv[bj][n] * sc_; }
#endif
#pragma unroll
        for (int ai = 0; ai < 2; ++ai)
#pragma unroll
            for (int m = 0; m < 4; ++m) {
                const int r = ai * HALF + wr * 64 + m * 16 + fr; const float rs = Sx[r]; const size_t off = (size_t)(u.pm * BM + r) * ldc + col0;
#pragma unroll
                for (int bj = 0; bj < 2; ++bj)
#pragma unroll
                    for (int n = 0; n < 2; ++n) *(f32x4*)(out + off + bj * HALF + n * 16) = acc[ai][bj][m][n] * rs * gv[bj][n];
            }
    }
};
struct EpiDownNormStream {
    static constexpr bool PERM = false, AFTER_DRAIN = false;
    const bf16_t* hb; float* out; const float* gain; float* xbuf; unsigned* cnt; int ldc; float eps; const void* cnt_base_probe; PG8_LAS unsigned char* lds_x;
    __device__ __forceinline__ void operator()(const f32x4 (&acc_in)[2][2][4][2], const Unit& u, int wr, int wc, int fr, int fq) const {
        PG8_LAS unsigned char* lds = lds_x; const int lane = threadIdx.x & 63, wid = __builtin_amdgcn_readfirstlane(threadIdx.x >> 6);
        f32x4 acc[2][2][4][2];
#pragma unroll
        for (int a_ = 0; a_ < 2; ++a_)
#pragma unroll
            for (int b_ = 0; b_ < 2; ++b_)
#pragma unroll
                for (int m_ = 0; m_ < 4; ++m_)
#pragma unroll
                    for (int n_ = 0; n_ < 2; ++n_) acc[a_][b_][m_][n_] = acc_in[a_][b_][m_][n_];
        PG8_LAS float* P = (PG8_LAS float*)lds;
        PG8_LAS float* Sx = (PG8_LAS float*)(lds + 4096);
        PG8_LAS unsigned* flag = (PG8_LAS unsigned*)(lds + 4096 + 1024);
        const int col0 = u.pn * BM + wc * 32 + 4 * fq;
        u32x2 nx[2][2];
        { const size_t off0 = (size_t)(u.pm * BM + wr * 64 + fr) * ldc + col0;
#pragma unroll
          for (int bj = 0; bj < 2; ++bj)
#pragma unroll
              for (int n = 0; n < 2; ++n) nx[bj][n] = *(const u32x2*)(hb + off0 + bj * HALF + n * 16); }
#pragma unroll
        for (int gi = 0; gi < 8; ++gi) {
            const int ai = gi >> 2, m = gi & 3;
            const int r = ai * HALF + wr * 64 + m * 16 + fr; float ss = 0.f;
            u32x2 cur[2][2];
#pragma unroll
            for (int bj = 0; bj < 2; ++bj)
#pragma unroll
                for (int n = 0; n < 2; ++n) cur[bj][n] = nx[bj][n];
            if (gi < 7) { const int ai2 = (gi + 1) >> 2, m2 = (gi + 1) & 3; const size_t off2 = (size_t)(u.pm * BM + ai2 * HALF + wr * 64 + m2 * 16 + fr) * ldc + col0;
#pragma unroll
                for (int bj = 0; bj < 2; ++bj)
#pragma unroll
                    for (int n = 0; n < 2; ++n) nx[bj][n] = *(const u32x2*)(hb + off2 + bj * HALF + n * 16); }
#pragma unroll
            for (int bj = 0; bj < 2; ++bj)
#pragma unroll
                for (int n = 0; n < 2; ++n) {
                    const u32x2 hv = cur[bj][n];
                    const f32x4 h4 = (f32x4){__uint_as_float(hv.x << 16), __uint_as_float(hv.x & 0xffff0000u), __uint_as_float(hv.y << 16), __uint_as_float(hv.y & 0xffff0000u)};
                    const f32x4 o = acc[ai][bj][m][n] + h4; acc[ai][bj][m][n] = o;
                    ss += (o[0] * o[0] + o[1] * o[1]) + (o[2] * o[2] + o[3] * o[3]);
                }
            ss += __shfl_xor(ss, 16); ss += __shfl_xor(ss, 32);
            if (fq == 0) P[r * 4 + wc] = ss;
        }
        asm volatile("s_waitcnt lgkmcnt(0)" ::: "memory"); __builtin_amdgcn_s_barrier(); asm volatile("" ::: "memory");
        const int row = wid * 32 + (lane & 31);
        if (lane < 32) {
            const float s = (P[row * 4 + 0] + P[row * 4 + 1]) + (P[row * 4 + 2] + P[row * 4 + 3]);
            __hip_atomic_store(xbuf + (size_t)(u.pm * BM + row) * 4 + u.pn, s, __ATOMIC_RELAXED, __HIP_MEMORY_SCOPE_AGENT);
        }
        asm volatile("s_waitcnt vmcnt(0)" ::: "memory");
        if (lane == 0) __hip_atomic_fetch_add(cnt + 64 * u.pm, 1u, __ATOMIC_RELAXED, __HIP_MEMORY_SCOPE_AGENT);
        if (wid == 0) {
            unsigned sp = 0;
            for (;;) {
                if ((unsigned)__builtin_amdgcn_readfirstlane(__hip_atomic_load(cnt + 64 * u.pm, __ATOMIC_RELAXED, __HIP_MEMORY_SCOPE_AGENT)) >= 32u) break;
                if (++sp > (1u << 22)) break;
                __builtin_amdgcn_s_sleep(2);
            }
            __builtin_amdgcn_fence(__ATOMIC_ACQUIRE, "agent");
            if (lane == 0) flag[0] = 0u;
        }
        asm volatile("s_waitcnt vmcnt(0) lgkmcnt(0)" ::: "memory"); __builtin_amdgcn_s_barrier(); asm volatile("" ::: "memory");
        if (lane < 32) {
            const float* slot = xbuf + (size_t)(u.pm * BM + row) * 4;
            const float a = __hip_atomic_load(slot + 0, __ATOMIC_RELAXED, __HIP_MEMORY_SCOPE_AGENT), b = __hip_atomic_load(slot + 1, __ATOMIC_RELAXED, __HIP_MEMORY_SCOPE_AGENT),
                        c = __hip_atomic_load(slot + 2, __ATOMIC_RELAXED, __HIP_MEMORY_SCOPE_AGENT), d = __hip_atomic_load(slot + 3, __ATOMIC_RELAXED, __HIP_MEMORY_SCOPE_AGENT);
            Sx[row] = 1.0f / sqrtf(((a + b) + (c + d)) * (1.0f / 1024.0f) + eps);
        }
        asm volatile("s_waitcnt lgkmcnt(0)" ::: "memory"); __builtin_amdgcn_s_barrier(); asm volatile("" ::: "memory");
        f32x4 gv[2][2];
#pragma unroll
        for (int bj = 0; bj < 2; ++bj)
#pragma unroll
            for (int n = 0; n < 2; ++n) gv[bj][n] = *(const f32x4*)(gain + col0 + bj * HALF + n * 16);
#if defined(REP_PHASE) && (REP_PHASE == 77 || REP_PHASE == 79 || REP_PHASE == 80)
        { const float sc_ = 1.0f + ((const float*)cnt_base_probe)[30000];
#pragma unroll
          for (int bj = 0; bj < 2; ++bj)
#pragma unroll
              for (int n = 0; n < 2; ++n) gv[bj][n] = gv[bj][n] * sc_; }
#endif
#pragma unroll
        for (int ai = 0; ai < 2; ++ai)
#pragma unroll
            for (int m = 0; m < 4; ++m) {
                const int r = ai * HALF + wr * 64 + m * 16 + fr; const float rs = Sx[r]; const size_t off = (size_t)(u.pm * BM + r) * ldc + col0;
#pragma unroll
                for (int bj = 0; bj < 2; ++bj)
#pragma unroll
                    for (int n = 0; n < 2; ++n) *(f32x4*)(out + off + bj * HALF + n * 16) = acc[ai][bj][m][n] * rs * gv[bj][n];
            }
    }
};
template <class Epi, class Sched, bool ALIGN_EPI = false, bool SP2 = false>
__device__ __forceinline__ void gemm_phase(PG8_LAS unsigned char* lds, const Gemm g, const Sched& S, const Epi& E) {
    const int tid = threadIdx.x, wid = __builtin_amdgcn_readfirstlane(tid >> 6), lane = tid & 63, wr = wid >> 2, wc = wid & 3, fr = lane & 15, fq = lane >> 4;
    const int K = g.K, nt = K / BK;
    unsigned voffA[2], voffB[2];
#pragma unroll
    for (int i = 0; i < 2; ++i) { int R, C; stage_rc(tid * 16 + i * 8192, R, C); const int Rb = Epi::PERM ? ((R & ~31) + perm32(R & 31)) : R;
        voffA[i] = (unsigned)(R * K + C) * 2u; voffB[i] = (unsigned)(Rb * K + C) * 2u; }
    const size_t kstep = (size_t)(BK * 2);
    const size_t hstep = (size_t)HALF * K * 2;
    const size_t tstep = 2 * hstep;
    const unsigned ldsw = (unsigned)wid * 1024u;
    const int aoff = lds_byte(wr * 64 + fr, fq * 8), boff = lds_byte(wc * 32 + fr, fq * 8);
#define PG8_SA(b, h) (((b) * 2 + (h)) * HTB)
#define PG8_SB(b, h) ((4 + (b) * 2 + (h)) * HTB)
#define PG8_STAGE(bufoff, gbase, voff) do { _Pragma("unroll") for (int _i = 0; _i < 2; ++_i) \
        __builtin_amdgcn_global_load_lds((const unsigned*)((const char*)(gbase) + (voff)[_i]), (PG8_LAS unsigned*)(lds + (bufoff) + ldsw + _i * 8192), 16, 0, 0); } while (0)
#define PG8_LDA(dst, b, h) do { _Pragma("unroll") for (int m = 0; m < 4; ++m) _Pragma("unroll") for (int k = 0; k < 2; ++k) dst[m][k] = *(const PG8_LAS bf16x8*)(lds + PG8_SA(b, h) + aoff + m * 2048 + k * 1024); } while (0)
#define PG8_LDB(dst, b, h) do { _Pragma("unroll") for (int n = 0; n < 2; ++n) _Pragma("unroll") for (int k = 0; k < 2; ++k) dst[n][k] = *(const PG8_LAS bf16x8*)(lds + PG8_SB(b, h) + boff + n * 2048 + k * 1024); } while (0)
#define PG8_MMA(ai, bj, At, Bt) do { __builtin_amdgcn_s_setprio(1); _Pragma("unroll") for (int m = 0; m < 4; ++m) _Pragma("unroll") for (int n = 0; n < 2; ++n) _Pragma("unroll") for (int k = 0; k < 2; ++k) \
        acc[ai][bj][m][n] = __builtin_amdgcn_mfma_f32_16x16x32_bf16(Bt[n][k], At[m][k], acc[ai][bj][m][n], 0, 0, 0); __builtin_amdgcn_s_setprio(0); } while (0)
#define PG8_WAIT_V(n) asm volatile("s_waitcnt vmcnt(" #n ")" ::: "memory")
#define PG8_WAIT_L(n) asm volatile("s_waitcnt lgkmcnt(" #n ")" ::: "memory")
#define PG8_BAR __builtin_amdgcn_s_barrier()
#define PG8_SCHED __builtin_amdgcn_sched_barrier(0)
    Unit cur, nxt; int ui = 0;
    if (!S.next(0, cur)) return;
    f32x4 acc[2][2][4][2];
#pragma unroll
    for (int a = 0; a < 2; ++a)
#pragma unroll
        for (int b = 0; b < 2; ++b)
#pragma unroll
            for (int m = 0; m < 4; ++m)
#pragma unroll
                for (int n = 0; n < 2; ++n) acc[a][b][m][n] = (f32x4){0.f, 0.f, 0.f, 0.f};
    bf16x8 At[4][2], B0[2][2], B1[2][2];
    const char* cA = (const char*)g.A + (size_t)cur.pm * tstep; const char* cB = (const char*)g.Bt + (size_t)cur.pn * tstep;
    S.a_ready(cur);
    if constexpr (SP2) {
        PG8_STAGE(PG8_SB(0, 0), cB, voffB); PG8_STAGE(PG8_SB(0, 1), cB + hstep, voffB); PG8_STAGE(PG8_SA(0, 0), cA, voffA); PG8_STAGE(PG8_SA(0, 1), cA + hstep, voffA);
        if (wr == 1) PG8_BAR;
        PG8_WAIT_V(2); PG8_BAR;
        PG8_STAGE(PG8_SB(1, 0), cB + kstep, voffB); PG8_STAGE(PG8_SA(1, 0), cA + kstep, voffA); PG8_STAGE(PG8_SB(1, 1), cB + hstep + kstep, voffB);
        PG8_WAIT_V(6); PG8_BAR;
    } else {
        PG8_STAGE(PG8_SB(0, 0), cB, voffB); PG8_STAGE(PG8_SA(0, 0), cA, voffA); PG8_STAGE(PG8_SB(0, 1), cB + hstep, voffB); PG8_STAGE(PG8_SA(0, 1), cA + hstep, voffA);
        if (wr == 1) PG8_BAR;
        PG8_WAIT_V(4); PG8_BAR;
        PG8_STAGE(PG8_SB(1, 0), cB + kstep, voffB); PG8_STAGE(PG8_SA(1, 0), cA + kstep, voffA); PG8_STAGE(PG8_SB(1, 1), cB + hstep + kstep, voffB);
        PG8_WAIT_V(6); PG8_BAR;
    }
    for (;;) {
        const bool has_next = S.next(ui + 1, nxt);
        const char* nA = has_next ? (const char*)g.A + (size_t)nxt.pm * tstep : cA; const char* nB = has_next ? (const char*)g.Bt + (size_t)nxt.pn * tstep : cB;
        for (int t = 0; t < nt; t += 2) {
            const bool last = (t == nt - 2);
            const char* a1 = cA + (size_t)(t + 1) * kstep;
            const char* a2 = last ? nA : cA + (size_t)(t + 2) * kstep; const char* b2 = last ? nB : cB + (size_t)(t + 2) * kstep;
            const char* a3 = a2 + kstep; const char* b3 = b2 + kstep;
            if (last && has_next) S.a_ready(nxt);
            if constexpr (SP2) {
            PG8_LDB(B0, 0, 0); PG8_LDB(B1, 0, 1); PG8_SCHED; PG8_LDA(At, 0, 0); PG8_STAGE(PG8_SA(1, 1), a1 + hstep, voffA);
            PG8_WAIT_V(8); PG8_WAIT_L(0); PG8_BAR; PG8_MMA(0, 0, At, B0); PG8_MMA(0, 1, At, B1); PG8_BAR; PG8_SCHED;
            PG8_LDA(At, 0, 1); PG8_STAGE(PG8_SB(0, 0), b2, voffB); PG8_STAGE(PG8_SB(0, 1), b2 + hstep, voffB); PG8_STAGE(PG8_SA(0, 0), a2, voffA);
            PG8_WAIT_V(8); PG8_WAIT_L(0); PG8_BAR; PG8_MMA(1, 0, At, B0); PG8_MMA(1, 1, At, B1); PG8_BAR; PG8_SCHED;
            PG8_LDB(B0, 1, 0); PG8_LDB(B1, 1, 1); PG8_SCHED; PG8_LDA(At, 1, 0); PG8_STAGE(PG8_SA(0, 1), a2 + hstep, voffA);
            PG8_WAIT_V(8); PG8_WAIT_L(0); PG8_BAR; PG8_MMA(0, 0, At, B0); PG8_MMA(0, 1, At, B1); PG8_BAR; PG8_SCHED;
            PG8_LDA(At, 1, 1); PG8_STAGE(PG8_SB(1, 0), b3, voffB); PG8_STAGE(PG8_SB(1, 1), b3 + hstep, voffB); PG8_STAGE(PG8_SA(1, 0), a3, voffA);
            PG8_WAIT_V(8); PG8_WAIT_L(0); PG8_BAR; PG8_MMA(1, 0, At, B0); PG8_MMA(1, 1, At, B1); PG8_BAR; PG8_SCHED;
            } else {
            PG8_LDB(B0, 0, 0); PG8_SCHED; PG8_LDA(At, 0, 0); PG8_STAGE(PG8_SA(1, 1), a1 + hstep, voffA);
            PG8_WAIT_L(8); PG8_BAR; PG8_WAIT_L(0); PG8_MMA(0, 0, At, B0); PG8_BAR; PG8_SCHED;
            PG8_LDB(B1, 0, 1); PG8_STAGE(PG8_SB(0, 0), b2, voffB);
            PG8_BAR; PG8_WAIT_L(0); PG8_MMA(0, 1, At, B1); PG8_BAR;
            PG8_LDA(At, 0, 1); PG8_STAGE(PG8_SA(0, 0), a2, voffA);
            PG8_BAR; PG8_WAIT_L(0); PG8_MMA(1, 0, At, B0); PG8_BAR; PG8_SCHED;
            PG8_STAGE(PG8_SB(0, 1), b2 + hstep, voffB);
            PG8_WAIT_V(6); PG8_BAR; PG8_MMA(1, 1, At, B1); PG8_BAR;
            PG8_LDB(B0, 1, 0); PG8_SCHED; PG8_LDA(At, 1, 0); PG8_STAGE(PG8_SA(0, 1), a2 + hstep, voffA);
            PG8_WAIT_L(8); PG8_BAR; PG8_WAIT_L(0); PG8_MMA(0, 0, At, B0); PG8_BAR; PG8_SCHED;
            PG8_LDB(B1, 1, 1); PG8_STAGE(PG8_SB(1, 0), b3, voffB);
            PG8_BAR; PG8_WAIT_L(0); PG8_MMA(0, 1, At, B1); PG8_BAR;
            PG8_LDA(At, 1, 1); PG8_STAGE(PG8_SA(1, 0), a3, voffA);
            PG8_BAR; PG8_WAIT_L(0); PG8_MMA(1, 0, At, B0); PG8_BAR; PG8_SCHED;
            PG8_STAGE(PG8_SB(1, 1), b3 + hstep, voffB);
            PG8_WAIT_V(6); PG8_BAR; PG8_MMA(1, 1, At, B1); PG8_BAR;
            }
        }
        if constexpr (ALIGN_EPI) { if (wr == 0) PG8_BAR; }
        if constexpr (!Epi::AFTER_DRAIN) { E(acc, cur, wr, wc, fr, fq); S.done(cur); }
        if (!has_next) break;
#pragma unroll
        for (int a = 0; a < 2; ++a)
#pragma unroll
            for (int b = 0; b < 2; ++b)
#pragma unroll
                for (int m = 0; m < 4; ++m)
#pragma unroll
                    for (int n = 0; n < 2; ++n) acc[a][b][m][n] = (f32x4){0.f, 0.f, 0.f, 0.f};
        cur = nxt; cA = nA; cB = nB; ++ui;
        if constexpr (ALIGN_EPI) { if (wr == 1) PG8_BAR; }
    }
    PG8_WAIT_V(0);
    if constexpr (!ALIGN_EPI) { if (wr == 0) PG8_BAR; }
    PG8_BAR;
    if constexpr (Epi::AFTER_DRAIN) { E.fused(acc, cur, wr, wc, fr, fq, lds, wid, lane); S.done(cur); }
#undef PG8_SA
#undef PG8_SB
#undef PG8_STAGE
#undef PG8_LDA
#undef PG8_LDB
#undef PG8_MMA
#undef PG8_WAIT_V
#undef PG8_WAIT_L
#undef PG8_BAR
#undef PG8_SCHED
}
}
namespace xb {
#define LAS __attribute__((address_space(3)))
#define XB_TMO      128
#define XB_XCNT(j)  (256  + 64 * (j))
#define XB_XSUB(j)  (1280 + 64 * (j))
#define XB_XGEN(j)  (2304 + 64 * (j))
#define XB_TOP      3328
#define XB_TOPGEN   3392
#define XCD_BAR_WORDS 3456
#define XB_SPIN_CAP (1u << 18)

__device__ __forceinline__ unsigned xb_ld(unsigned* p)              { return __hip_atomic_load(p, __ATOMIC_RELAXED, __HIP_MEMORY_SCOPE_AGENT); }
__device__ __forceinline__ unsigned xb_add(unsigned* p, unsigned v) { return __hip_atomic_fetch_add(p, v, __ATOMIC_RELAXED, __HIP_MEMORY_SCOPE_AGENT); }
__device__ __forceinline__ unsigned xb_xcc_id() { return (unsigned)__builtin_amdgcn_s_getreg((3 << 11) | 20) & 0xFu; }
#define XB_SPIN(cond, bar) do { unsigned _sp = 0; while (cond) { __builtin_amdgcn_s_sleep(1); \
    if ((++_sp & 255u) == 0u) { if (xb_ld(&(bar)[XB_TMO])) break; if (_sp > XB_SPIN_CAP) { atomicAdd(&(bar)[XB_TMO], 1u); break; } } } } while (0)

struct XcdBarrier {
    unsigned* bar; unsigned x;
    volatile LAS unsigned* st;
};

__device__ __forceinline__ XcdBarrier xcd_barrier_post(unsigned* bar, volatile LAS unsigned* st) {
    XcdBarrier b; b.bar = bar; b.x = xb_xcc_id(); b.st = st;
    if (threadIdx.x == 0) st[2] = xb_add(&bar[XB_XCNT(b.x)], 1u);
    return b;
}
__device__ __forceinline__ void xcd_barrier_complete(unsigned* bar, unsigned x, unsigned& nloc, unsigned& nx) {
    const unsigned G = gridDim.x * gridDim.y * gridDim.z;
    unsigned sum, cnt, mine, sp = 0u;
    for (;;) {
        sum = 0u; cnt = 0u; mine = 0u;
#pragma unroll
        for (unsigned j = 0; j < 16; ++j) { const unsigned c = xb_ld(&bar[XB_XCNT(j)]); sum += c; cnt += (c > 0u) ? 1u : 0u; mine = (j == x) ? c : mine; }
        if (sum == G) break;
        __builtin_amdgcn_s_sleep(1);
        if ((++sp & 255u) == 0u) { if (xb_ld(&bar[XB_TMO])) break; if (sp > XB_SPIN_CAP) { atomicAdd(&bar[XB_TMO], 1u); break; } }
    }
    nloc = mine > 0u ? mine : 1u; nx = cnt > 0u ? cnt : 1u;
}

__device__ __forceinline__ void xcd_barrier(const XcdBarrier& b) {
    asm volatile("s_waitcnt vmcnt(0)" ::: "memory");
    __syncthreads();
    if (threadIdx.x == 0) {
        unsigned* bar = b.bar;
        __builtin_amdgcn_s_waitcnt(0);
        unsigned nloc = b.st[0], nx = b.st[1];
        if (nloc == 0u) { xcd_barrier_complete(bar, b.x, nloc, nx); b.st[0] = nloc; b.st[1] = nx; }
        const unsigned old = xb_add(&bar[XB_XSUB(b.x)], 1u);
        const unsigned gen = old / nloc;
        if (old + 1u == (gen + 1u) * nloc) {
            __builtin_amdgcn_fence(__ATOMIC_RELEASE, "agent");
            asm volatile("s_waitcnt vmcnt(0)" ::: "memory");
            const unsigned og = xb_add(&bar[XB_TOP], 1u);
            const unsigned tg = og / nx;
            if (og + 1u == (tg + 1u) * nx) xb_add(&bar[XB_TOPGEN], 1u);
            else XB_SPIN(xb_ld(&bar[XB_TOPGEN]) == tg, bar);
            __builtin_amdgcn_fence(__ATOMIC_ACQUIRE, "agent");
            xb_add(&bar[XB_XGEN(b.x)], 1u);
            asm volatile("s_waitcnt vmcnt(0)" ::: "memory");
        } else {
            XB_SPIN(xb_ld(&bar[XB_XGEN(b.x)]) == gen, bar);
            __builtin_amdgcn_fence(__ATOMIC_ACQUIRE, "agent");
            asm volatile("s_waitcnt vmcnt(0)" ::: "memory");
        }
    }
    __syncthreads();
}

}
namespace mk {
#define LAS __attribute__((address_space(3)))
typedef unsigned short bf16_t;
typedef short bf16x8 __attribute__((ext_vector_type(8)));
typedef short s16x4 __attribute__((ext_vector_type(4)));
typedef float f32x4 __attribute__((ext_vector_type(4)));
typedef float f32x16 __attribute__((ext_vector_type(16)));
typedef unsigned u32x4 __attribute__((ext_vector_type(4)));
typedef unsigned u32x2 __attribute__((ext_vector_type(2)));
constexpr int NB = 8, S = 4096, D = 1024, M = NB * S, NH = 4, DFF = 2816, DIN = 2560, NWAVES = 8;
constexpr float EPS = 1e-6f, LOG2E = 1.4426950408889634f;
constexpr float QSCALE = 0.125f * LOG2E;
constexpr size_t MiB = 1u << 20;
constexpr size_t WS_WIN = 1 * MiB, WS_WOUT = 6 * MiB, WS_WGU = 8 * MiB, WS_WDN = 19 * MiB, WS_RSS1 = 25 * MiB, WS_RSS2 = 27 * MiB, WS_RSTD = 29 * MiB;
constexpr size_t WS_XN = 32 * MiB, WS_Q = 96 * MiB, WS_KT = 128 * MiB, WS_VT = 160 * MiB, WS_XR = 192 * MiB, WS_GR = 224 * MiB, WS_HF = 256 * MiB, WS_MIXED = 320 * MiB, WS_ACT = 96 * MiB, WS_XC = 384 * MiB, WS_OX = 416 * MiB, WS_END = 480 * MiB;
static_assert(WS_ACT + (size_t)M * DFF * 2 <= WS_MIXED, "act overlays Q..HF only");
constexpr int RING_BYTES = 131072, LDS_MISC = 131072, LDS_BYTES = 147456;

__device__ __forceinline__ unsigned cvt_pk_bf16(float lo, float hi) { return pg8::cvt_pk_bf16(lo, hi); }
__device__ __forceinline__ float bf2f(unsigned short b) { return __uint_as_float(((unsigned)b) << 16); }
__device__ __forceinline__ float wave_sum(float v) {
#pragma unroll
    for (int o = 1; o < 64; o <<= 1) v += __shfl_xor(v, o);
    return v;
}
__device__ __forceinline__ float fast_sigmoid(float x) { return __builtin_amdgcn_rcpf(1.0f + __builtin_amdgcn_exp2f(-LOG2E * x)); }

template <int MAP  >
__device__ __forceinline__ void p0_transpose_item(const float* W, int K, int N, bf16_t* WT, const float* gk, LAS float* scr, int item, int lane) {
    const int nblk = N / 32, kb = item / nblk, nb = item % nblk, k0 = 64 * kb, n0 = 32 * nb;
#pragma unroll
    for (int i = 0; i < 32; ++i) { const int kk = 2 * i + (lane >> 5); float v = W[(size_t)(k0 + kk) * N + n0 + (lane & 31)]; if (gk) v *= gk[k0 + kk]; scr[kk * 33 + (lane & 31)] = v; }
    asm volatile("s_waitcnt lgkmcnt(0)" ::: "memory");
    const int c = lane & 7;
#pragma unroll
    for (int j = 0; j < 4; ++j) { const int n = (lane >> 3) + 8 * j; const LAS float* s = scr + (8 * c) * 33 + n;
        u32x4 o; o.x = cvt_pk_bf16(s[0 * 33], s[1 * 33]); o.y = cvt_pk_bf16(s[2 * 33], s[3 * 33]); o.z = cvt_pk_bf16(s[4 * 33], s[5 * 33]); o.w = cvt_pk_bf16(s[6 * 33], s[7 * 33]);
        const int f = n0 + n; const int drow = (MAP == 0) ? f : (256 * (f >> 7) + (f & 127) + (MAP == 2 ? 128 : 0));
        *(u32x4*)(WT + (size_t)drow * K + k0 + 8 * c) = o; }
    asm volatile("s_waitcnt lgkmcnt(0)" ::: "memory");
}
template <int NR>
__device__ __forceinline__ void rms_rows_to_bf16(const float* xrow, const float* g, bf16_t* orow, int lane) {
    const f32x4* gr = (const f32x4*)g + lane;
    f32x4 v[NR][4]; float s[NR];
#pragma unroll
    for (int q = 0; q < NR; ++q) { const f32x4* xr = (const f32x4*)(xrow + (size_t)q * D) + lane;
#pragma unroll
        for (int j = 0; j < 4; ++j) v[q][j] = __builtin_nontemporal_load(xr + 64 * j); }
#pragma unroll
    for (int q = 0; q < NR; ++q) { float a = 0.f;
#pragma unroll
        for (int j = 0; j < 4; ++j) a += (v[q][j][0] * v[q][j][0] + v[q][j][1] * v[q][j][1]) + (v[q][j][2] * v[q][j][2] + v[q][j][3] * v[q][j][3]);
        s[q] = a; }
#pragma unroll
    for (int o = 1; o < 64; o <<= 1)
#pragma unroll
        for (int q = 0; q < NR; ++q) s[q] += __shfl_xor(s[q], o);
    f32x4 gg[4];
#pragma unroll
    for (int j = 0; j < 4; ++j) gg[j] = gr[64 * j];
#pragma unroll
    for (int q = 0; q < NR; ++q) { const float rstd = 1.0f / sqrtf(s[q] * (1.f / D) + EPS); u32x2* o8 = (u32x2*)(orow + (size_t)q * D) + lane;
#pragma unroll
        for (int j = 0; j < 4; ++j) { u32x2 w; w.x = cvt_pk_bf16(v[q][j][0] * rstd * gg[j][0], v[q][j][1] * rstd * gg[j][1]); w.y = cvt_pk_bf16(v[q][j][2] * rstd * gg[j][2], v[q][j][3] * rstd * gg[j][3]); o8[64 * j] = w; } }
}

namespace att {
constexpr int NT = S / 64, SLOT = 16384, KSLOT = 8192, LDS_K = 0, LDS_V = 3 * KSLOT, LDS_OST = 0;
constexpr int LDS_WSF = LDS_MISC, LDS_BIAS = LDS_MISC + 2048, LDS_TOT = LDS_MISC + 3072, LDS_CW = LDS_MISC + 5120, LDS_BIAS2 = LDS_MISC + 8704;
constexpr int THR = 8;
typedef LAS const char* lds_cptr;
typedef short v4i16_t __attribute__((ext_vector_type(4)));
__device__ __forceinline__ int crow(int r, int hi) { return (r & 3) + 8 * (r >> 2) + 4 * hi; }
__device__ __forceinline__ void glds16(const void* gsrc, unsigned lds_dst) { unsigned keep;
    asm volatile("s_mov_b32 %0, m0\n\ts_mov_b32 m0, %2\n\ts_nop 0\n\tglobal_load_lds_dwordx4 %1, off\n\ts_mov_b32 m0, %0" : "=&s"(keep) : "v"(gsrc), "s"(lds_dst) : "memory"); }
__device__ __forceinline__ s16x4 vtr(lds_cptr p) { return __builtin_bit_cast(s16x4, __builtin_amdgcn_ds_read_tr16_b64_v4i16((LAS v4i16_t*)p)); }
#define ATT_MX3(a, b, c) __builtin_fmaxf(__builtin_fmaxf((a), (b)), (c))
__device__ __forceinline__ float rowmax(const f32x16& p0, const f32x16& p1) {
    float a = ATT_MX3(p0[0], p0[1], p1[0]), b = ATT_MX3(p0[2], p0[3], p1[1]); a = ATT_MX3(a, p1[2], p1[3]);
#pragma unroll
    for (int r = 4; r < 16; r += 4) { a = ATT_MX3(a, p0[r], p0[r + 1]); b = ATT_MX3(b, p0[r + 2], p0[r + 3]); a = ATT_MX3(a, p1[r], p1[r + 1]); b = ATT_MX3(b, p1[r + 2], p1[r + 3]); }
    float m = __builtin_fmaxf(a, b); auto rr = __builtin_amdgcn_permlane32_swap(__float_as_uint(m), __float_as_uint(m), false, false);
    return __builtin_fmaxf(__uint_as_float(rr[0]), __uint_as_float(rr[1]));
}
#define ATT_WAIT_BAR(N) do { if (ABL == 4) asm volatile("s_waitcnt vmcnt(" #N ") lgkmcnt(0)" ::: "memory"); else asm volatile("s_waitcnt vmcnt(" #N ") lgkmcnt(0)\n\ts_barrier" ::: "memory"); } while (0)
#define ATT_MFMA(a, b, c) __builtin_amdgcn_mfma_f32_32x32x16_bf16(a, b, c, 0, 0, 0)

template <bool FIRST>
__device__ __forceinline__ void tile_h1(int t, lds_cptr kp, const bf16x8 (&qr)[4], f32x16 (&o)[4], u32x4 (&pw)[4], float& mhat, float& l_reg,
                                        LAS float* wsf, const LAS float* btab, int qrow, int qw0, float c_left, float c_right, int r32, int hi) {
    const int relmin = 64 * t - qw0 - 31, relmax = 64 * t + 63 - qw0;
    const bool band = !(relmax <= -91 || relmin >= 91);
    const float cb = band ? 0.f : (relmin >= 91 ? c_right : c_left);
    f32x16 p0, p1;
    const f32x16 z16 = (f32x16){0.f, 0.f, 0.f, 0.f, 0.f, 0.f, 0.f, 0.f, 0.f, 0.f, 0.f, 0.f, 0.f, 0.f, 0.f, 0.f};
#pragma unroll
    for (int d0 = 0; d0 < 4; ++d0) {
        const bf16x8 k0 = *(const LAS bf16x8*)(kp + d0 * 2048), k1 = *(const LAS bf16x8*)(kp + d0 * 2048 + 512);
        if (d0 == 0) { p0 = ATT_MFMA(k0, qr[0], z16); p1 = ATT_MFMA(k1, qr[0], z16); }
        else { p0 = ATT_MFMA(k0, qr[d0], p0); p1 = ATT_MFMA(k1, qr[d0], p1); }
    }
    if (band) {
        const int relb = 64 * t + 4 * hi - qrow + 128;
#pragma unroll
        for (int r = 0; r < 16; ++r) { const int i0 = relb + (r & 3) + 8 * (r >> 2); const int a0 = i0 < 0 ? 0 : (i0 > 255 ? 255 : i0); const int i1 = i0 + 32; const int a1 = i1 < 0 ? 0 : (i1 > 255 ? 255 : i1);
            p0[r] += btab[a0]; p1[r] += btab[a1]; }
    }
    const float rm = rowmax(p0, p1) + cb;
    if (FIRST) { mhat = rm; }
    else if (__builtin_expect(__any(rm - mhat > (float)THR), 0)) {
        const float dl = __builtin_fmaxf(rm - mhat, 0.f); mhat += dl;
        const float f = __builtin_amdgcn_exp2f(-dl); l_reg *= f;
        if (hi == 0) wsf[r32] = f;
        asm volatile("s_waitcnt lgkmcnt(0)" ::: "memory");
        float fr[16];
#pragma unroll
        for (int r = 0; r < 16; ++r) fr[r] = wsf[crow(r, hi)];
#pragma unroll
        for (int db = 0; db < 4; ++db)
#pragma unroll
            for (int r = 0; r < 16; ++r) o[db][r] *= fr[r];
        asm volatile("s_waitcnt lgkmcnt(0)" ::: "memory");
    }
    const float off = cb - mhat;
    float sacc = 0.f;
#pragma unroll
    for (int r = 0; r < 16; ++r) { p0[r] = __builtin_amdgcn_exp2f(p0[r] + off); p1[r] = __builtin_amdgcn_exp2f(p1[r] + off); sacc += p0[r] + p1[r]; }
    l_reg += sacc;
#pragma unroll
    for (int ks = 0; ks < 4; ++ks) { const f32x16& P = (ks < 2) ? p0 : p1; const int b = 8 * (ks & 1);
        pw[ks] = (u32x4){cvt_pk_bf16(P[b], P[b + 1]), cvt_pk_bf16(P[b + 2], P[b + 3]), cvt_pk_bf16(P[b + 4], P[b + 5]), cvt_pk_bf16(P[b + 6], P[b + 7])}; }
}
__device__ __forceinline__ void tile_h2(lds_cptr vp, f32x16 (&o)[4], const u32x4 (&pw)[4]) {
#pragma unroll
    for (int ks = 0; ks < 4; ++ks)
#pragma unroll
        for (int db = 0; db < 4; ++db) {
            const s16x4 lo = vtr(vp + db * 4096 + ks * 1024), h4 = vtr(vp + db * 4096 + ks * 1024 + 512);
            const bf16x8 vf = (bf16x8){lo[0], lo[1], lo[2], lo[3], h4[0], h4[1], h4[2], h4[3]};
            o[db] = ATT_MFMA(__builtin_bit_cast(bf16x8, pw[ks]), vf, o[db]);
        }
}

struct VFrag { s16x4 lo, hi; };
template <int I> __device__ __forceinline__ VFrag vload(lds_cptr vp) {
    constexpr int off_ = (I & 3) * 4096 + (I >> 2) * 1024; VFrag f; f.lo = vtr(vp + off_); f.hi = vtr(vp + off_ + 512); return f;
}
template <int ABL, int MODE, int mp>
__device__ __forceinline__ bool attn_unit(int b, int h, int qb, const bf16_t* Q, const bf16_t* KT, const bf16_t* VT, bf16_t* MIXED, float* OX, LAS unsigned char* lds, float lam, const float* subln_g, const float* rel_bias) {
    const int tid = threadIdx.x, lane = tid & 63, r32 = lane & 31, hi = lane >> 5; const int wid = __builtin_amdgcn_readfirstlane(tid >> 6);
    const size_t rowbase = (size_t)b * S; const int q0 = qb * 256, qw0 = q0 + 32 * wid, qrow = qw0 + r32;
    LAS float* btab = (LAS float*)(lds + LDS_BIAS2); LAS float* wsf = (LAS float*)(lds + LDS_WSF) + wid * 64;
    { const int rel = tid - 256; const int n = rel < 0 ? -rel : rel; int bk; if (n < 8) bk = n; else { bk = 2 + (31 - __clz(n * n)); if (bk > 15) bk = 15; } if (rel > 0) bk += 16;
        btab[tid] = rel_bias[bk * NH + h] * LOG2E; }
    if (tid == 0) *(LAS unsigned*)(lds + LDS_WSF + 2040) = 0u;
    const float c_left = rel_bias[15 * NH + h] * LOG2E, c_right = rel_bias[31 * NH + h] * LOG2E;
    const bf16_t* Qw = Q + (rowbase + qw0) * 512 + h * 128 + mp * 64;
    bf16x8 qr[4];
#pragma unroll
    for (int d0 = 0; d0 < 4; ++d0) qr[d0] = *(const bf16x8*)(Qw + (size_t)r32 * 512 + d0 * 16 + hi * 8);
    const char* ksrc = (const char*)KT + ((size_t)((b * 4 + h) * 2 + mp) * 64) * 8192 + wid * 1024 + lane * 16;
    const char* vsrc = (const char*)VT + ((size_t)(b * 4 + h) * 64) * 16384 + wid * 1024 + lane * 16;
    const unsigned lds0 = (unsigned)(uintptr_t)(unsigned char*)lds;
    const unsigned kdst = lds0 + LDS_K + wid * 1024, vdst = lds0 + LDS_V + wid * 1024;
    const lds_cptr kp0 = (lds_cptr)lds + LDS_K + hi * 1024 + r32 * 16;
    const lds_cptr vp0 = (lds_cptr)lds + LDS_V + ((lane >> 4) & 1) * 32 + (lane & 3) * 8 + (4 * hi + ((lane & 15) >> 2)) * 64;
#define ATT_DMA_TILE(t, ks_, vs_) do { if (ABL == 3) break; glds16(ksrc + (size_t)(t) * 8192, (unsigned)__builtin_amdgcn_readfirstlane(kdst + (ks_))); \
        glds16(vsrc + (size_t)(t) * 16384, (unsigned)__builtin_amdgcn_readfirstlane(vdst + (vs_))); glds16(vsrc + (size_t)(t) * 16384 + 8192, (unsigned)__builtin_amdgcn_readfirstlane(vdst + (vs_) + 8192)); } while (0)
    ATT_DMA_TILE(0, 0, 0); ATT_DMA_TILE(1, KSLOT, SLOT);
    float mhat = 0.f, l_reg = 0.f; f32x16 o[4]; u32x4 pw[4];
#pragma unroll
    for (int db = 0; db < 4; ++db)
#pragma unroll
        for (int r = 0; r < 16; ++r) o[db][r] = 0.f;
    int ksl = 0, ksl2 = 2 * KSLOT, vsl = 0, vsl2 = 2 * SLOT, vprev = 0;
#define ATT_ROT() do { ksl = (ksl == 2 * KSLOT) ? 0 : ksl + KSLOT; ksl2 = (ksl2 == 2 * KSLOT) ? 0 : ksl2 + KSLOT; vprev = vsl; vsl = (vsl + SLOT) & (4 * SLOT - 1); vsl2 = (vsl2 + SLOT) & (4 * SLOT - 1); } while (0)
#define ATT_SB() __builtin_amdgcn_sched_barrier(0)
#define ATT_PIN(x) asm volatile("" : "+v"(x))
#define ATT_F(T0, T1, e) (((e) < 16) ? T0[(e) & 15] : T1[(e) & 15])
#define ATT_KRD(f) (*(const LAS bf16x8*)(kp_ + ((f) >> 1) * 2048 + ((f) & 1) * 512))
    const f32x16 z16 = (f32x16){0.f, 0.f, 0.f, 0.f, 0.f, 0.f, 0.f, 0.f, 0.f, 0.f, 0.f, 0.f, 0.f, 0.f, 0.f, 0.f};
#define ATT_GA(C0, C1, P0, P1, f) do { \
        if (((f) & 1) == 0) C0 = ATT_MFMA(kq[(f) % 3], qr[(f) >> 1], ((f) < 2) ? z16 : C0); else C1 = ATT_MFMA(kq[(f) % 3], qr[(f) >> 1], ((f) < 2) ? z16 : C1); \
        if (ABL != 5 && (f) + 3 < 8) kq[(f) % 3] = ATT_KRD((f) + 3); \
        if (ABL != 6) { sacc += ATT_F(P0, P1, 4 * (f)); sacc += ATT_F(P0, P1, 4 * (f) + 1); sacc += ATT_F(P0, P1, 4 * (f) + 2); sacc += ATT_F(P0, P1, 4 * (f) + 3); ATT_PIN(sacc); } \
        if (ABL != 6) pw[(f) >> 1][2 * ((f) & 1)] = cvt_pk_bf16(ATT_F(P0, P1, 4 * (f)), ATT_F(P0, P1, 4 * (f) + 1)); if (ABL != 6) pw[(f) >> 1][2 * ((f) & 1) + 1] = cvt_pk_bf16(ATT_F(P0, P1, 4 * (f) + 2), ATT_F(P0, P1, 4 * (f) + 3)); ATT_PIN(pw[(f) >> 1]); \
        ATT_SB(); } while (0)
#define ATT_VRD(I) vload<(I) & 15>(vp_)
#define ATT_GBF(I, FILL) do { \
        { const VFrag& vv = vq[(I) % 3]; const bf16x8 vf = (bf16x8){vv.lo[0], vv.lo[1], vv.lo[2], vv.lo[3], vv.hi[0], vv.hi[1], vv.hi[2], vv.hi[3]}; \
          if (ABL != 7) o[(I) & 3] = ATT_MFMA(__builtin_bit_cast(bf16x8, pw[(I) >> 2]), vf, o[(I) & 3]); else asm volatile("" :: "v"(vf)); } \
        if (ABL != 1 && (I) + 3 < 16) vq[(I) % 3] = ATT_VRD((I) + 3); \
        FILL; ATT_SB(); } while (0)
#define ATT_EXF(x) ((ABL == 2) ? (x) : __builtin_amdgcn_exp2f(x))
#define ATT_EX(C0, C1, e) do { if ((e) < 16) { C0[(e) & 15] = ATT_EXF(C0[(e) & 15] + off); } else { C1[(e) & 15] = ATT_EXF(C1[(e) & 15] + off); } } while (0)
#define ATT_EX3(C0, C1, e) do { ATT_EX(C0, C1, e); ATT_EX(C0, C1, (e) + 1); ATT_EX(C0, C1, (e) + 2); ATT_PIN(C0); ATT_PIN(C1); } while (0)
#define ATT_EX2(C0, C1, e) do { ATT_EX(C0, C1, e); ATT_EX(C0, C1, (e) + 1); ATT_PIN(C0); ATT_PIN(C1); } while (0)
#define ATT_MX3(a, b, c) __builtin_fmaxf(__builtin_fmaxf((a), (b)), (c))
#define ATT_BIAS(C0, C1, t) \
        const int relmin_ = 64 * (t) - qw0 - 31, relmax_ = 64 * (t) + 63 - qw0; const bool band_ = !(relmax_ <= -91 || relmin_ >= 91); const float cb_ = band_ ? 0.f : (relmin_ >= 91 ? c_right : c_left); \
        if (band_) { const LAS float* bp_ = btab + (64 * (t) + 4 * hi - qrow + 256);       \
            _Pragma("unroll") for (int r = 0; r < 16; ++r) { C0[r] += bp_[(r & 3) + 8 * (r >> 2)]; C1[r] += bp_[(r & 3) + 8 * (r >> 2) + 32]; } }
#define ATT_MAXP(C0, C1, g) do { if ((g) == 0) { ma_ = ATT_MX3(C0[0], C0[1], C1[0]); mb_ = ATT_MX3(C0[2], C0[3], C1[1]); ma_ = ATT_MX3(ma_, C1[2], C1[3]); } \
        else { ma_ = ATT_MX3(ma_, C0[4 * (g)], C0[4 * (g) + 1]); mb_ = ATT_MX3(mb_, C0[4 * (g) + 2], C0[4 * (g) + 3]); ma_ = ATT_MX3(ma_, C1[4 * (g)], C1[4 * (g) + 1]); mb_ = ATT_MX3(mb_, C1[4 * (g) + 2], C1[4 * (g) + 3]); } \
        ATT_PIN(ma_); ATT_PIN(mb_); } while (0)
#define ATT_DECIDE2(FIRST_) do { float rm_ = __builtin_fmaxf(ma_, mb_); { auto rr = __builtin_amdgcn_permlane32_swap(__float_as_uint(rm_), __float_as_uint(rm_), false, false); rm_ = __builtin_fmaxf(__uint_as_float(rr[0]), __uint_as_float(rr[1])); } \
        rm_ += cb_; resc = false; \
        if (FIRST_) { mhat = rm_; } \
        else if (__builtin_expect(__any(rm_ - mhat > (float)THR), 0)) { const float dl_ = __builtin_fmaxf(rm_ - mhat, 0.f); mhat += dl_; const float f_ = __builtin_amdgcn_exp2f(-dl_); l_reg *= f_; if (hi == 0) wsf[r32] = f_; resc = true; } \
        off = cb_ - mhat; ATT_SB(); } while (0)
#define ATT_RESC() do { if (resc) { asm volatile("s_waitcnt lgkmcnt(0)" ::: "memory"); float fr_[16]; \
        _Pragma("unroll") for (int r = 0; r < 16; ++r) fr_[r] = wsf[crow(r, hi)]; \
        _Pragma("unroll") for (int db = 0; db < 4; ++db) _Pragma("unroll") for (int r = 0; r < 16; ++r) o[db][r] *= fr_[r]; \
        asm volatile("s_waitcnt lgkmcnt(0)" ::: "memory"); } \
        if (MODE == 1 && cb_ != cc) { const float sc_ = __builtin_amdgcn_exp2f(cc - cb_); cc = cb_; l_reg *= sc_;       \
            _Pragma("unroll") for (int db = 0; db < 4; ++db) _Pragma("unroll") for (int r = 0; r < 16; ++r) o[db][r] *= sc_; } } while (0)
#define ATT_EX0(C0, C1, e) do { if ((e) < 16) { C0[(e) & 15] = ATT_EXF(C0[(e) & 15]); } else { C1[(e) & 15] = ATT_EXF(C1[(e) & 15]); } } while (0)
#define ATT_EX0P(C0, C1, e) do { ATT_EX0(C0, C1, e); ATT_EX0(C0, C1, (e) + 1); ATT_PIN(C0); ATT_PIN(C1); } while (0)
#define ATT_STEP(C0, C1, P0, P1, t) do { \
        const lds_cptr kp_ = kp0 + ksl; const lds_cptr vp_ = vp0 + vprev; float sacc = 0.f, ma_, mb_; \
        kq[0] = ATT_KRD(0); kq[1] = ATT_KRD(1); kq[2] = ATT_KRD(2); ATT_SB(); \
        ATT_GA(C0, C1, P0, P1, 0); ATT_GA(C0, C1, P0, P1, 1); ATT_GA(C0, C1, P0, P1, 2); ATT_GA(C0, C1, P0, P1, 3); \
        vq[0] = ATT_VRD(0); vq[1] = ATT_VRD(1); vq[2] = ATT_VRD(2); ATT_SB(); \
        ATT_GA(C0, C1, P0, P1, 4); ATT_GA(C0, C1, P0, P1, 5); ATT_GA(C0, C1, P0, P1, 6); ATT_GA(C0, C1, P0, P1, 7); \
        l_reg += sacc; \
        ATT_BIAS(C0, C1, t) ATT_SB(); \
        if (MODE == 0) { \
        ATT_GBF(0, ATT_MAXP(C0, C1, 0)); ATT_GBF(1, ATT_MAXP(C0, C1, 1)); ATT_GBF(2, ATT_MAXP(C0, C1, 2)); ATT_GBF(3, ATT_MAXP(C0, C1, 3)); \
        ATT_DECIDE2(false); \
        ATT_GBF(4, ATT_EX3(C0, C1, 0)); ATT_GBF(5, ATT_EX3(C0, C1, 3)); ATT_GBF(6, ATT_EX3(C0, C1, 6)); ATT_GBF(7, ATT_EX3(C0, C1, 9)); \
        ATT_GBF(8, ATT_EX3(C0, C1, 12)); ATT_GBF(9, ATT_EX3(C0, C1, 15)); ATT_GBF(10, ATT_EX3(C0, C1, 18)); ATT_GBF(11, ATT_EX3(C0, C1, 21)); \
        ATT_GBF(12, ATT_EX2(C0, C1, 24)); ATT_GBF(13, ATT_EX2(C0, C1, 26)); ATT_GBF(14, ATT_EX2(C0, C1, 28)); ATT_GBF(15, ATT_EX2(C0, C1, 30)); \
        } else { \
        ATT_GBF(0, ATT_EX0P(C0, C1, 0)); ATT_GBF(1, ATT_EX0P(C0, C1, 2)); ATT_GBF(2, ATT_EX0P(C0, C1, 4)); ATT_GBF(3, ATT_EX0P(C0, C1, 6)); ATT_GBF(4, ATT_EX0P(C0, C1, 8)); ATT_GBF(5, ATT_EX0P(C0, C1, 10)); ATT_GBF(6, ATT_EX0P(C0, C1, 12)); ATT_GBF(7, ATT_EX0P(C0, C1, 14)); \
        ATT_GBF(8, ATT_EX0P(C0, C1, 16)); ATT_GBF(9, ATT_EX0P(C0, C1, 18)); ATT_GBF(10, ATT_EX0P(C0, C1, 20)); ATT_GBF(11, ATT_EX0P(C0, C1, 22)); ATT_GBF(12, ATT_EX0P(C0, C1, 24)); ATT_GBF(13, ATT_EX0P(C0, C1, 26)); ATT_GBF(14, ATT_EX0P(C0, C1, 28)); ATT_GBF(15, ATT_EX0P(C0, C1, 30)); } \
        ATT_RESC(); ATT_ROT(); } while (0)
    f32x16 sa0, sa1, sb0, sb1; bf16x8 kq[3]; VFrag vq[3]; float off = 0.f, cc = 0.f; bool resc = false;
    ATT_WAIT_BAR(3); ATT_DMA_TILE(2, ksl2, vsl2);
    { const lds_cptr kp_ = kp0 + ksl;
#pragma unroll
      for (int d0 = 0; d0 < 4; ++d0) { const bf16x8 k0 = ATT_KRD(2 * d0), k1 = ATT_KRD(2 * d0 + 1);
          if (d0 == 0) { sa0 = ATT_MFMA(k0, qr[0], z16); sa1 = ATT_MFMA(k1, qr[0], z16); } else { sa0 = ATT_MFMA(k0, qr[d0], sa0); sa1 = ATT_MFMA(k1, qr[d0], sa1); } }
      float ma_, mb_; ATT_BIAS(sa0, sa1, 0)
      if (MODE == 0) { ATT_MAXP(sa0, sa1, 0); ATT_MAXP(sa0, sa1, 1); ATT_MAXP(sa0, sa1, 2); ATT_MAXP(sa0, sa1, 3); ATT_DECIDE2(true); } else { cc = cb_; off = 0.f; (void)ma_; (void)mb_; }
#pragma unroll
      for (int r = 0; r < 16; ++r) { sa0[r] = __builtin_amdgcn_exp2f(sa0[r] + off); sa1[r] = __builtin_amdgcn_exp2f(sa1[r] + off); }
      ATT_ROT(); }
    for (int t = 1; t < NT - 3; t += 2) {
        ATT_WAIT_BAR(3); ATT_DMA_TILE(t + 2, ksl2, vsl2); ATT_STEP(sb0, sb1, sa0, sa1, t);
        ATT_WAIT_BAR(3); ATT_DMA_TILE(t + 3, ksl2, vsl2); ATT_STEP(sa0, sa1, sb0, sb1, t + 1);
    }
    ATT_WAIT_BAR(3); ATT_DMA_TILE(NT - 1, ksl2, vsl2); ATT_STEP(sb0, sb1, sa0, sa1, NT - 3);
    ATT_WAIT_BAR(3); ATT_STEP(sa0, sa1, sb0, sb1, NT - 2);
    ATT_WAIT_BAR(0); ATT_STEP(sb0, sb1, sa0, sa1, NT - 1);
    { float sacc = 0.f;
#pragma unroll
      for (int r = 0; r < 16; ++r) sacc += sb0[r] + sb1[r];
      l_reg += sacc;
#pragma unroll
      for (int g = 0; g < 16; ++g) pw[g >> 2][g & 3] = cvt_pk_bf16(ATT_F(sb0, sb1, 2 * g), ATT_F(sb0, sb1, 2 * g + 1));
      const lds_cptr vp_ = vp0 + vprev;
#pragma unroll
      for (int ks = 0; ks < 4; ++ks)
#pragma unroll
          for (int db = 0; db < 4; ++db) { const s16x4 lo = vtr(vp_ + db * 4096 + ks * 1024), h4 = vtr(vp_ + db * 4096 + ks * 1024 + 512);
              const bf16x8 vf = (bf16x8){lo[0], lo[1], lo[2], lo[3], h4[0], h4[1], h4[2], h4[3]}; o[db] = ATT_MFMA(__builtin_bit_cast(bf16x8, pw[ks]), vf, o[db]); } }
#undef ATT_STEP
#undef ATT_RESC
#undef ATT_DECIDE2
#undef ATT_MAXP
#undef ATT_BIAS
#undef ATT_EX2
#undef ATT_EX3
#undef ATT_EX
#undef ATT_EX0
#undef ATT_EX0P
#undef ATT_EXF
#undef ATT_GBF
#undef ATT_GA
#undef ATT_VRD
#undef ATT_KRD
#undef ATT_F
#undef ATT_PIN
#undef ATT_SB
    { auto rr = __builtin_amdgcn_permlane32_swap(__float_as_uint(l_reg), __float_as_uint(l_reg), false, false); l_reg = __uint_as_float(rr[0]) + __uint_as_float(rr[1]); }
    LAS unsigned* redo_w = (LAS unsigned*)(lds + LDS_WSF + 2040);
    if (MODE == 1) { const bool bad_ = !(l_reg > 7.8886e-31f && l_reg < 1.2676e30f); if (__any(bad_) && lane == 0) *redo_w = 1u; }
    int lane_e = lane; asm volatile("" : "+v"(lane_e));
    const int r32_e = lane_e & 31, hi_e = lane_e >> 5;
    const float scale_q = (mp == 0 ? 1.0f : lam) * __builtin_amdgcn_rcpf(l_reg);
    if (hi_e == 0) wsf[r32_e] = scale_q;
    asm volatile("s_waitcnt lgkmcnt(0)" ::: "memory");
    float sc[16];
#pragma unroll
    for (int r = 0; r < 16; ++r) sc[r] = wsf[crow(r, hi_e)];
    f32x4* OXw = (f32x4*)OX + (size_t)wid * 16 * 64 + lane_e;
    if (mp == 1) {
#pragma unroll
        for (int db = 0; db < 4; ++db)
#pragma unroll
            for (int q4 = 0; q4 < 4; ++q4) OXw[(db * 4 + q4) * 64] = (f32x4){o[db][4 * q4] * sc[4 * q4], o[db][4 * q4 + 1] * sc[4 * q4 + 1], o[db][4 * q4 + 2] * sc[4 * q4 + 2], o[db][4 * q4 + 3] * sc[4 * q4 + 3]};
        asm volatile("s_waitcnt lgkmcnt(0)\n\ts_barrier" ::: "memory");
    } else {
        float ss[16];
#pragma unroll
        for (int r = 0; r < 16; ++r) ss[r] = 0.f;
#pragma unroll
        for (int db = 0; db < 4; ++db)
#pragma unroll
            for (int q4 = 0; q4 < 4; ++q4) { const f32x4 xv = OXw[(db * 4 + q4) * 64];
#pragma unroll
                for (int e = 0; e < 4; ++e) { const int r = 4 * q4 + e; const float d = o[db][r] * sc[r] - xv[e]; o[db][r] = d; ss[r] += d * d; } }
#pragma unroll
        for (int r = 0; r < 16; ++r) {
#pragma unroll
            for (int x = 1; x < 32; x <<= 1) ss[r] += __shfl_xor(ss[r], x);
            ss[r] = __builtin_amdgcn_rsqf(ss[r] * (1.0f / 128.0f) + EPS) * 0.8f;
        }
        asm volatile("s_waitcnt lgkmcnt(0)\n\ts_barrier" ::: "memory");
        LAS bf16_t* stg = (LAS bf16_t*)(lds + LDS_OST) + wid * 4096;
#pragma unroll
        for (int db = 0; db < 4; ++db) { const float g = subln_g[db * 32 + r32_e];
#pragma unroll
            for (int r = 0; r < 16; ++r) { const unsigned w = cvt_pk_bf16(o[db][r] * ss[r] * g, 0.f); stg[crow(r, hi_e) * 128 + db * 32 + r32_e] = (bf16_t)(w & 0xffffu); } }
        asm volatile("s_waitcnt lgkmcnt(0)" ::: "memory");
        bf16_t* Ow = MIXED + (rowbase + qw0) * 1024 + h * 128;
#pragma unroll
        for (int i = 0; i < 8; ++i) { const int row = i * 4 + (lane_e >> 4), ch = lane_e & 15; const u32x4 v = *(const LAS u32x4*)(stg + row * 128 + ch * 8); *(u32x4*)(Ow + (size_t)row * 1024 + ch * 8) = v; }
    }
    asm volatile("s_waitcnt vmcnt(0) lgkmcnt(0)\n\ts_barrier" ::: "memory");
    const bool redo_ = (MODE == 1) && (*(volatile LAS unsigned*)(lds + LDS_WSF + 2040) != 0u);
    asm volatile("s_waitcnt lgkmcnt(0)\n\ts_barrier" ::: "memory");
    return redo_;
#undef ATT_DMA_TILE
#undef ATT_ROT
}
}

namespace lru {
template <int N> __device__ __forceinline__ float dpp_shr(float v, float ident) {
    return __int_as_float(__builtin_amdgcn_update_dpp(__float_as_int(ident), __float_as_int(v), 0x110 + N, 0xF, 0xF, false));
}
#define LRU_MFMA16(a, b, c) __builtin_amdgcn_mfma_f32_16x16x32_bf16(a, b, c, 0, 0, 0)
__device__ __forceinline__ void lru_rows(bf16x8 (&rowv)[2][7], __amdgpu_buffer_rsrc_t xsrd, int dir, int Pb, int ch0) {
#pragma unroll
    for (int k = 0; k < 7; ++k) {
        const int tt = dir ? (S - Pb - k) : (Pb - 2 + k);
#pragma unroll
        for (int ks = 0; ks < 2; ++ks) rowv[ks][k] = __builtin_bit_cast(bf16x8, __builtin_amdgcn_raw_buffer_load_b128(xsrd, (tt * 512 + ch0 + 32 * ks) * 2, 0, 0));
    }
}
__device__ __forceinline__ void lru_item(int b, int cg, const bf16_t* XR, const bf16_t* GR, float* HF, bf16_t* MIXED, bf16_t* XC, unsigned* sib_cnt, LAS unsigned char* lds,
                                         const float* conv_w, const float* conv_b, const float* w_rg, const float* b_rg, const float* w_ig, const float* b_ig, const float* lru_lambda) {
    const int tid = threadIdx.x, lane = tid & 63, p = lane & 15, g = lane >> 4; const int wid = __builtin_amdgcn_readfirstlane(tid >> 6);
    const int n = cg >> 2, e16 = cg & 3, c0 = n * 64 + e16 * 16;
    const size_t rowbase = (size_t)b * S;
    const __amdgpu_buffer_rsrc_t XRb = __builtin_amdgcn_make_buffer_rsrc((void*)(XR + rowbase * 512), (short)0, S * 512 * 2, 0x00020000); const int ch0 = n * 64 + 8 * g;
    float* HFi = HF + ((size_t)(b * 32 + cg) * S) * 16;
    LAS float* tot = (LAS float*)(lds + att::LDS_TOT);
    bf16x8 idf;
#pragma unroll
    for (int j = 0; j < 8; ++j) idf[j] = ((8 * g + j) == (16 * (e16 & 1) + p)) ? (short)0x3f80 : (short)0;
    int par = 0;
    LAS float* cwl = (LAS float*)(lds + att::LDS_CW);
    if (tid < 320) { const int j = tid >> 6, c = tid & 63; cwl[tid] = (j < 4) ? conv_w[j * 512 + n * 64 + c] : conv_b[n * 64 + c]; }
    __syncthreads();
    {
        const int g8 = tid & 7, trow = tid >> 3;
        const int c8 = n * 64 + 8 * g8;
        f32x4 w0[4], w1[4];
#pragma unroll
        for (int j = 0; j < 4; ++j) { w0[j] = *(const LAS f32x4*)(cwl + j * 64 + 8 * g8); w1[j] = *(const LAS f32x4*)(cwl + j * 64 + 8 * g8 + 4); }
        const f32x4 bb0 = *(const LAS f32x4*)(cwl + 256 + 8 * g8), bb1 = *(const LAS f32x4*)(cwl + 256 + 8 * g8 + 4);
        for (int st = 0; st < 16; ++st) {
            const int tok = e16 * 1024 + st * 64 + trow;
            f32x4 a0 = bb0, a1 = bb1;
#pragma unroll
            for (int j = 0; j < 4; ++j) {
                const u32x4 rw = __builtin_amdgcn_raw_buffer_load_b128(XRb, ((tok + j - 2) * 512 + c8) * 2, 0, 0);
                a0 += w0[j] * (f32x4){__uint_as_float(rw[0] << 16), __uint_as_float(rw[0] & 0xffff0000u), __uint_as_float(rw[1] << 16), __uint_as_float(rw[1] & 0xffff0000u)};
                a1 += w1[j] * (f32x4){__uint_as_float(rw[2] << 16), __uint_as_float(rw[2] & 0xffff0000u), __uint_as_float(rw[3] << 16), __uint_as_float(rw[3] & 0xffff0000u)};
            }
            *(u32x4*)(XC + (rowbase + tok) * 512 + c8) = (u32x4){cvt_pk_bf16(a0[0], a0[1]), cvt_pk_bf16(a0[2], a0[3]), cvt_pk_bf16(a1[0], a1[1]), cvt_pk_bf16(a1[2], a1[3])};
        }
        asm volatile("s_waitcnt vmcnt(0)" ::: "memory");
        __syncthreads();
        if (tid == 0) {
            __builtin_amdgcn_fence(__ATOMIC_RELEASE, "agent");
            asm volatile("s_waitcnt vmcnt(0)" ::: "memory");
            __hip_atomic_fetch_add(sib_cnt, 1u, __ATOMIC_RELAXED, __HIP_MEMORY_SCOPE_AGENT);
            unsigned sp = 0;
            while (__hip_atomic_load(sib_cnt, __ATOMIC_RELAXED, __HIP_MEMORY_SCOPE_AGENT) < 4u) { __builtin_amdgcn_s_sleep(2); if (++sp > (1u << 22)) break; }
            __builtin_amdgcn_fence(__ATOMIC_ACQUIRE, "agent");
            asm volatile("s_waitcnt vmcnt(0)" ::: "memory");
        }
        __syncthreads();
    }
#pragma unroll
    for (int dir = 0; dir < 2; ++dir) {
        bf16x8 wrf[2], wif[2];
#pragma unroll
        for (int ks = 0; ks < 2; ++ks) {
            unsigned wr_[4], wi_[4];
#pragma unroll
            for (int j2 = 0; j2 < 4; ++j2) { const int d = 32 * ks + 8 * g + 2 * j2; const size_t i0 = ((size_t)((dir * 8 + n) * 64 + d)) * 64 + e16 * 16 + p;
                wr_[j2] = cvt_pk_bf16(w_rg[i0], w_rg[i0 + 64]); wi_[j2] = cvt_pk_bf16(w_ig[i0], w_ig[i0 + 64]); }
            wrf[ks] = __builtin_bit_cast(bf16x8, (u32x4){wr_[0], wr_[1], wr_[2], wr_[3]}); wif[ks] = __builtin_bit_cast(bf16x8, (u32x4){wi_[0], wi_[1], wi_[2], wi_[3]});
        }
        float br[4], bi[4], sp8[4], carry[4];
#pragma unroll
        for (int r = 0; r < 4; ++r) { const int c = dir * 512 + c0 + 4 * g + r; br[r] = b_rg[c] * -LOG2E; bi[r] = b_ig[c] * -LOG2E; const float lm = lru_lambda[c]; sp8[r] = 8.0f * LOG2E * ((-lm > 20.0f) ? -lm : log1pf(expf(-lm)));     carry[r] = 0.f; }
        LAS u32x4* lst = (LAS u32x4*)lds + tid;
        lst[0 * 512] = __builtin_bit_cast(u32x4, wrf[0]); lst[1 * 512] = __builtin_bit_cast(u32x4, wrf[1]); lst[2 * 512] = __builtin_bit_cast(u32x4, wif[0]); lst[3 * 512] = __builtin_bit_cast(u32x4, wif[1]);
        lst[4 * 512] = __builtin_bit_cast(u32x4, (f32x4){br[0], br[1], br[2], br[3]}); lst[5 * 512] = __builtin_bit_cast(u32x4, (f32x4){bi[0], bi[1], bi[2], bi[3]}); lst[6 * 512] = __builtin_bit_cast(u32x4, (f32x4){sp8[0], sp8[1], sp8[2], sp8[3]}); lst[7 * 512] = __builtin_bit_cast(u32x4, idf);
        bf16x8 xf[4][2];
#define LRU_XLOAD(PB_) do { _Pragma("unroll") for (int i = 0; i < 4; ++i) { const int tok_ = dir ? (S - 1 - ((PB_) + i)) : ((PB_) + i); \
            _Pragma("unroll") for (int ks = 0; ks < 2; ++ks) xf[i][ks] = *(const bf16x8*)(XC + (rowbase + tok_) * 512 + ch0 + 32 * ks); } } while (0)
        LRU_XLOAD(wid * 64 + 4 * p);
        for (int sc = 0; sc < 8; ++sc) {
            const int P0 = sc * 512 + wid * 64, Pb = P0 + 4 * p;
            f32x4 ar[4], ai[4], ax[4];
            {
                int zoff = 0; asm volatile("" : "+v"(zoff));
                const LAS u32x4* lsi = (const LAS u32x4*)lds + tid + zoff;
                const bf16x8 wrf0 = __builtin_bit_cast(bf16x8, lsi[0 * 512]), wrf1 = __builtin_bit_cast(bf16x8, lsi[1 * 512]), wif0 = __builtin_bit_cast(bf16x8, lsi[2 * 512]), wif1 = __builtin_bit_cast(bf16x8, lsi[3 * 512]), idf_ = __builtin_bit_cast(bf16x8, lsi[7 * 512]);
                const f32x4 z = (f32x4){0.f, 0.f, 0.f, 0.f};
#pragma unroll
                for (int i = 0; i < 4; ++i) {
                    ar[i] = LRU_MFMA16(wrf0, xf[i][0], z); ar[i] = LRU_MFMA16(wrf1, xf[i][1], ar[i]);
                    ai[i] = LRU_MFMA16(wif0, xf[i][0], z); ai[i] = LRU_MFMA16(wif1, xf[i][1], ai[i]);
                    ax[i] = LRU_MFMA16(idf_, (e16 & 2) ? xf[i][1] : xf[i][0], z);
                }
                __builtin_amdgcn_sched_barrier(0);
                if (sc < 7) LRU_XLOAD(Pb + 512);
            }
            float hh[4][4], cpp[4][4], Al[4], Hl[4];
            int zoff2 = 0; asm volatile("" : "+v"(zoff2));
            const LAS f32x4* lsg = (const LAS f32x4*)lds + tid + zoff2;
            const f32x4 brv = lsg[4 * 512], biv = lsg[5 * 512], spv = lsg[6 * 512];
#pragma unroll
            for (int r = 0; r < 4; ++r) {
                float h = 0.f, cp = 1.f;
#pragma unroll
                for (int i = 0; i < 4; ++i) {
                    const float rg = __builtin_amdgcn_rcpf(1.0f + __builtin_amdgcn_exp2f(ar[i][r] * -LOG2E + brv[r])), ig = __builtin_amdgcn_rcpf(1.0f + __builtin_amdgcn_exp2f(ai[i][r] * -LOG2E + biv[r]));
                    const float a_ = __builtin_amdgcn_exp2f(-rg * spv[r]);
                    const float om = __builtin_fmaf(-a_, a_, 1.0f);
                    const float u_ = __builtin_amdgcn_sqrtf(om) * (ig * ax[i][r]);
                    h = a_ * h + u_; cp = a_ * cp; hh[i][r] = h; cpp[i][r] = cp;
                }
                Al[r] = cp; Hl[r] = h;
            }
#define LRU_KS(NN) asm volatile("s_nop 1\n\t" \
        "v_fmac_f32_dpp %0, %0, %4 row_shr:" #NN " row_mask:0xf bank_mask:0xf\n\tv_fmac_f32_dpp %1, %1, %5 row_shr:" #NN " row_mask:0xf bank_mask:0xf\n\t" \
        "v_fmac_f32_dpp %2, %2, %6 row_shr:" #NN " row_mask:0xf bank_mask:0xf\n\tv_fmac_f32_dpp %3, %3, %7 row_shr:" #NN " row_mask:0xf bank_mask:0xf\n\t" \
        "v_mul_f32_dpp %4, %4, %4 row_shr:" #NN " row_mask:0xf bank_mask:0xf\n\tv_mul_f32_dpp %5, %5, %5 row_shr:" #NN " row_mask:0xf bank_mask:0xf\n\t" \
        "v_mul_f32_dpp %6, %6, %6 row_shr:" #NN " row_mask:0xf bank_mask:0xf\n\tv_mul_f32_dpp %7, %7, %7 row_shr:" #NN " row_mask:0xf bank_mask:0xf\n\ts_nop 1" \
        : "+v"(Hl[0]), "+v"(Hl[1]), "+v"(Hl[2]), "+v"(Hl[3]), "+v"(Al[0]), "+v"(Al[1]), "+v"(Al[2]), "+v"(Al[3]))
            LRU_KS(1); LRU_KS(2); LRU_KS(4); LRU_KS(8);
#undef LRU_KS
            float Aex[4], Hex[4];
#pragma unroll
            for (int r = 0; r < 4; ++r) { Aex[r] = dpp_shr<1>(Al[r], 1.0f); Hex[r] = dpp_shr<1>(Hl[r], 0.0f); }
            if (p == 15) {
#pragma unroll
                for (int r = 0; r < 4; ++r) { tot[((par * 8 + wid) * 16 + 4 * g + r) * 2] = Al[r]; tot[((par * 8 + wid) * 16 + 4 * g + r) * 2 + 1] = Hl[r]; }
            }
            asm volatile("s_waitcnt lgkmcnt(0)\n\ts_barrier" ::: "memory");
            float cin[4];
#pragma unroll
            for (int r = 0; r < 4; ++r) cin[r] = 0.f;
#pragma unroll
            for (int w = 0; w < 8; ++w) {
                const f32x4 t0 = *(const LAS f32x4*)(tot + ((par * 8 + w) * 16 + 4 * g) * 2), t1 = *(const LAS f32x4*)(tot + ((par * 8 + w) * 16 + 4 * g) * 2 + 4);
                const float Aw[4] = {t0[0], t0[2], t1[0], t1[2]}, Hw[4] = {t0[1], t0[3], t1[1], t1[3]};
#pragma unroll
                for (int r = 0; r < 4; ++r) { if (w == wid) cin[r] = carry[r]; carry[r] = Aw[r] * carry[r] + Hw[r]; }
            }
            par ^= 1;
            f32x4 hfv[4]; u32x2 gv[4];
            if (dir) {
#pragma unroll
                for (int i = 0; i < 4; ++i) { const int tok = S - 1 - (Pb + i); hfv[i] = *(const f32x4*)(HFi + (size_t)tok * 16 + 4 * g); gv[i] = *(const u32x2*)(GR + (rowbase + tok) * 512 + c0 + 4 * g); }
            }
            float cl[4];
#pragma unroll
            for (int r = 0; r < 4; ++r) cl[r] = Aex[r] * cin[r] + Hex[r];
#pragma unroll
            for (int i = 0; i < 4; ++i) {
                const int P = Pb + i; const int tok = dir ? (S - 1 - P) : P;
                f32x4 hv;
#pragma unroll
                for (int r = 0; r < 4; ++r) hv[r] = hh[i][r] + cpp[i][r] * cl[r];
                if (dir == 0) *(f32x4*)(HFi + (size_t)tok * 16 + 4 * g) = hv;
                else {
                    const float gr4[4] = {__uint_as_float(gv[i].x << 16), __uint_as_float(gv[i].x & 0xffff0000u), __uint_as_float(gv[i].y << 16), __uint_as_float(gv[i].y & 0xffff0000u)};
                    float y[4];
#pragma unroll
                    for (int r = 0; r < 4; ++r) { const float x = gr4[r]; const float gl = x * fast_sigmoid(1.5957691216057308f * (x + 0.044715f * x * x * x)); y[r] = gl * (hv[r] + hfv[i][r]); }
                    u32x2 w; w.x = cvt_pk_bf16(y[0], y[1]); w.y = cvt_pk_bf16(y[2], y[3]);
                    *(u32x2*)(MIXED + (rowbase + tok) * 1024 + 512 + c0 + 4 * g) = w;
                }
            }
        }
        __syncthreads();
    }
}
}
struct Args { const float* in[22]; float* out; unsigned char* ws; int ph_lo, ph_hi; };
constexpr int N_PHASES = 6;

__global__ void __launch_bounds__(NWAVES * 64, 2) mk_fwd(Args args) {
    extern __shared__ __attribute__((aligned(16))) unsigned char lds_raw[];
    LAS unsigned char* lds = (LAS unsigned char*)lds_raw;
    const int tid = threadIdx.x, lane = tid & 63; const int wave = __builtin_amdgcn_readfirstlane(tid >> 6);
    const int G = gridDim.x, bx = blockIdx.x; const int vcu = (G % 8 == 0) ? (bx % 8) * (G / 8) + bx / 8 : bx;
    unsigned char* ws = args.ws;
    const float* x = args.in[0]; float* out = args.out;
    bf16_t* WIN = (bf16_t*)(ws + WS_WIN); bf16_t* WOUT = (bf16_t*)(ws + WS_WOUT); bf16_t* WGU = (bf16_t*)(ws + WS_WGU); bf16_t* WDN = (bf16_t*)(ws + WS_WDN);
    float* RSS1 = (float*)(ws + WS_RSS1); float* RSS2 = (float*)(ws + WS_RSS2);
    bf16_t* XN = (bf16_t*)(ws + WS_XN); bf16_t* HB = XN;
    bf16_t* Qb = (bf16_t*)(ws + WS_Q); bf16_t* KT = (bf16_t*)(ws + WS_KT); bf16_t* VT = (bf16_t*)(ws + WS_VT); bf16_t* XR = (bf16_t*)(ws + WS_XR); bf16_t* GR = (bf16_t*)(ws + WS_GR);
    float* HF = (float*)(ws + WS_HF); bf16_t* MIXED = (bf16_t*)(ws + WS_MIXED); bf16_t* ACT = (bf16_t*)(ws + WS_ACT);
    const int lo = args.ph_lo, hi = args.ph_hi;
    volatile LAS unsigned* bst = (volatile LAS unsigned*)(lds + LDS_MISC + 8192);
    if (tid == 0) { bst[0] = 0u; bst[1] = 0u; bst[2] = 0u; }
    __syncthreads();
    xb::XcdBarrier bar = xb::xcd_barrier_post((unsigned*)ws, bst);
    if (lo > 1000) cooperative_groups::this_grid().sync();
#define IN(k) (lo <= (k) && (k) < hi)
#ifndef REP_PHASE
#define REP_PHASE -1
#endif
#define REPS(k) ((REP_PHASE == (k)) ? 2 : 1)
#define REPSYNC(k, rep) do { if ((rep) + 1 < REPS(k)) xb::xcd_barrier(bar); } while (0)
#define SEAM(k) do { if (IN(k) && IN((k) + 1)) { xb::xcd_barrier(bar); } } while (0)

    if (IN(0)) for (int rep = 0; rep < REPS(0); ++rep) {
        LAS float* scr = (LAS float*)(lds + wave * 16384);
        const int gw = vcu * NWAVES + wave, NGW = G * NWAVES;
        constexpr int I_IN = (D / 64) * (DIN / 32), I_OUT = (D / 64) * (D / 32), I_G = (D / 64) * (DFF / 32), I_DN = (DFF / 64) * (D / 32);
        constexpr int NITEMS = I_IN + I_OUT + 2 * I_G + I_DN;
        for (int it = gw; it < NITEMS; it += NGW) {
            int r = it;
            if (r < I_IN) { p0_transpose_item<0>(args.in[2], D, DIN, WIN, nullptr, scr, r, lane); continue; } r -= I_IN;
            if (r < I_OUT) { p0_transpose_item<0>(args.in[16], D, D, WOUT, nullptr, scr, r, lane); continue; } r -= I_OUT;
            if (r < I_G) { p0_transpose_item<1>(args.in[18], D, DFF, WGU, args.in[17], scr, r, lane); continue; } r -= I_G;
            if (r < I_G) { p0_transpose_item<2>(args.in[19], D, DFF, WGU, args.in[17], scr, r, lane); continue; } r -= I_G;
            p0_transpose_item<0>(args.in[20], DFF, D, WDN, nullptr, scr, r, lane);
        }
        for (int m = gw * 4; m < M; m += NGW * 4) rms_rows_to_bf16<4>(x + (size_t)m * D, args.in[1], XN + (size_t)m * D, lane);
        REPSYNC(0, rep);
    }
    SEAM(0);
    if (IN(1)) for (int rep = 0; rep < REPS(1); ++rep) {
        pg8::Gemm g{XN, WIN, M, DIN, D}; pg8::StaticOrder So; So.init(M, DIN, G, bx); So.rep = (REP_PHASE == 10) ? 2 : 1;
        pg8::EpiInProj E{Qb, KT, VT, XR, GR, QSCALE};
        pg8::gemm_phase<pg8::EpiInProj, pg8::StaticOrder, true, true>(lds, g, So, E);
        REPSYNC(1, rep);
    }
    SEAM(1);
    if (IN(2)) {
        float lam;
        { float s1 = 0.f, s2 = 0.f; for (int i = 0; i < 64; ++i) { s1 += args.in[3][i] * args.in[4][i]; s2 += args.in[5][i] * args.in[6][i]; } lam = expf(s1) - expf(s2) + 0.2f; }
#if REP_PHASE == 79
        { const long long pr0 = wall_clock64();
          for (int rnd = 0; rnd * G + vcu < NB * NH * 32; ++rnd) { (void)att::attn_unit<ATT_PROBE, 0, 1>(vcu >> 5, rnd, (vcu & 31) >> 1, Qb, KT, VT, (bf16_t*)(ws + WS_XC), (float*)(ws + WS_OX) + (size_t)vcu * 32768, lds, lam, args.in[7], args.in[8]); }
          __syncthreads();
          if (bx == 0 && tid == 0) { const long long dr = wall_clock64() - pr0; ((float*)ws)[30000] = (float)dr * 2.0e-6f; } }
#endif
#if REP_PHASE == 77 || REP_PHASE == 78
        const long long pc0 = clock64(), pr0 = wall_clock64();
#endif
        for (int rep = 0; rep < REPS(20); ++rep)
        for (int pr = vcu; pr < NB * NH * 16; pr += G) {
            int b_, h_, qb_; if (G == 256) { const int l = vcu & 31, rp = pr / G; b_ = vcu >> 5; h_ = 2 * rp + (l >> 4); qb_ = l & 15; } else { qb_ = pr & 15; h_ = (pr >> 4) & 3; b_ = pr >> 6; }
            const float* const* kin = (const float* const*)__builtin_amdgcn_kernarg_segment_ptr(); asm volatile("" : "+s"(kin));
            unsigned char* ws2 = *(unsigned char* const*)((const char*)kin + 23 * 8);
            const bf16_t* Qb2 = (const bf16_t*)(ws2 + WS_Q); const bf16_t* KT2 = (const bf16_t*)(ws2 + WS_KT); const bf16_t* VT2 = (const bf16_t*)(ws2 + WS_VT); bf16_t* MX2 = (bf16_t*)(ws2 + WS_MIXED);
            float* OXc = (float*)(ws2 + WS_OX) + ((size_t)vcu * 2 + (size_t)(pr / G)) * 32768; const float* sg2 = kin[7]; const float* rb2 = kin[8];
            if (att::attn_unit<0, 1, 1>(b_, h_, qb_, Qb2, KT2, VT2, MX2, OXc, lds, lam, sg2, rb2))
                (void)att::attn_unit<0, 0, 1>(b_, h_, qb_, Qb2, KT2, VT2, MX2, OXc, lds, lam, sg2, rb2);
            if (att::attn_unit<0, 1, 0>(b_, h_, qb_, Qb2, KT2, VT2, MX2, OXc, lds, lam, sg2, rb2))
                (void)att::attn_unit<0, 0, 0>(b_, h_, qb_, Qb2, KT2, VT2, MX2, OXc, lds, lam, sg2, rb2);
        }
        for (int rep = 0; rep < REPS(21); ++rep)
        for (int it = vcu; it < NB * 32; it += G) {
            const int b_ = it >> 5, cg = it & 31;
            lru::lru_item(b_, cg, XR, GR, HF, MIXED, (bf16_t*)(ws + WS_XC), (unsigned*)ws + 16384 + 64 * (it >> 2), lds, args.in[9], args.in[10], args.in[11], args.in[12], args.in[13], args.in[14], args.in[15]);
        }
    }
#if REP_PHASE == 78
    if (IN(2) && bx == 0 && tid == 0) { const long long dc = clock64() - pc0_, dr = wall_clock64() - pr0_; ((float*)ws)[30000] = (float)dc / ((float)dr * 10.0f) * 0.05f; }
#endif
    SEAM(2);
    if (IN(3)) for (int rep = 0; rep < REPS(3); ++rep) {
        pg8::Gemm g{MIXED, WOUT, M, D, D}; pg8::StaticOrder So; So.init(M, D, G, bx);
        pg8::EpiResid<true, false> E{x, out, HB, RSS1, D};
        pg8::gemm_phase<pg8::EpiResid<true, false>, pg8::StaticOrder, true, true>(lds, g, So, E);
        REPSYNC(3, rep);
    }
    SEAM(3);
    if (IN(4)) for (int rep = 0; rep < REPS(4); ++rep) {
        float* RSTD = (float*)(ws + WS_RSTD);
        for (int r = vcu * 128 + (tid >> 2); r < M; r += G * 128) {
            const f32x4 sv = *(const f32x4*)(RSS1 + (size_t)r * 16 + 4 * (tid & 3)); float s = (sv[0] + sv[1]) + (sv[2] + sv[3]);
            s += __shfl_xor(s, 1); s += __shfl_xor(s, 2);
            if ((tid & 3) == 0) RSTD[r] = __builtin_amdgcn_rsqf(s * (1.0f / D) + EPS);
        }
        xb::xcd_barrier(bar);
        pg8::Gemm g{HB, WGU, M, 2 * DFF, D}; pg8::StaticOrder So; So.init(M, 2 * DFF, G, bx); So.rep = (REP_PHASE == 40) ? 2 : 1;
        pg8::EpiGateUp E{ACT, RSTD, DFF};
        pg8::gemm_phase<pg8::EpiGateUp, pg8::StaticOrder, true, true>(lds, g, So, E);
        REPSYNC(4, rep);
    }
    SEAM(4);
    if (IN(5)) for (int rep = 0; rep < REPS(5); ++rep) {
        if (G == 256) {
#pragma unroll 1
            for (int half = 0; half < 2; ++half) {
                const size_t r0 = (size_t)half * (M / 2);
                pg8::Gemm g{ACT + r0 * DFF, WDN, M / 2, D, DFF}; pg8::StaticOrder So; So.init(M / 2, D, G, bx);
                pg8::EpiDownNorm E{HB + r0 * D, out + r0 * D, args.in[21], RSS2 + r0 * 4, (unsigned*)ws + 4096 + 64 * 64 * half, D, EPS, ws};
                pg8::gemm_phase<pg8::EpiDownNorm, pg8::StaticOrder, false, true>(lds, g, So, E);
                __syncthreads();
            }
        }
        REPSYNC(5, rep);
    }
#if REP_PHASE == 99
    for (int i = 0; i < 20; ++i) xb::xcd_barrier(bar);
#endif
#undef IN
#undef SEAM
}
}
namespace dbg {
using namespace mk;
__global__ void __launch_bounds__(256) k_unpack_proj(const bf16_t* Qb, const bf16_t* KT, const bf16_t* VT, const bf16_t* XR, const bf16_t* GR, float* q, float* k, float* v, float* xr, float* gr) {
    const size_t idx = (size_t)blockIdx.x * 256 + threadIdx.x;
    const int c = (int)(idx & 511); const int row = (int)(idx >> 9); const int b = row >> 12, tok = row & 4095, t = tok >> 6, rr = tok & 63;
    q[idx] = bf2f(Qb[idx]) * (1.0f / QSCALE);
    { const int h = c >> 7, w = c & 127, s = w >> 6, d = w & 63, chunk = d >> 3, j = d & 7;
      k[idx] = bf2f(KT[((((size_t)(b * 4 + h) * 2 + s) * 64 + t) * 8 + chunk) * 512 + rr * 8 + j]); }
    { const int h = c >> 7, dv = c & 127, db = dv >> 5, cc = dv & 31;
      v[idx] = bf2f(VT[(((size_t)(b * 4 + h) * 64 + t) * 4 + db) * 2048 + rr * 32 + cc]); }
    xr[idx] = bf2f(XR[idx]); gr[idx] = bf2f(GR[idx]);
}
__global__ void __launch_bounds__(256) k_unpack_bf16(const bf16_t* src, float* dst) { const size_t idx = (size_t)blockIdx.x * 256 + threadIdx.x; dst[idx] = bf2f(src[idx]); }
}

#ifndef STAGE
#define STAGE 4
#endif
static void mk_launch_phases(const mk::Args& a0, int lo, int hi, int grid, hipStream_t stream, bool coop) {
    mk::Args a = a0; a.ph_lo = lo; a.ph_hi = hi;
    if (coop) { void* args[] = {&a}; hipError_t e = hipLaunchCooperativeKernel((const void*)mk::mk_fwd, dim3(grid), dim3(mk::NWAVES * 64), args, mk::LDS_BYTES, stream);
        if (e != hipSuccess) fprintf(stderr, "cooperative launch failed: %s (grid %d)\n", hipGetErrorString(e), grid); }
    else { hipLaunchKernelGGL(mk::mk_fwd, dim3(grid), dim3(mk::NWAVES * 64), mk::LDS_BYTES, stream, a); }
}

extern "C" void kernel_launch(void* const* d_in, const int* in_sizes, int n_in, void* d_out, int out_size, void* d_ws, size_t ws_size, hipStream_t stream) {
    static int grid = 0;
    if (grid == 0) {
        int dev = 0, cus = 0, per_cu = 0;
        hipGetDevice(&dev); hipDeviceGetAttribute(&cus, hipDeviceAttributeMultiprocessorCount, dev);
        if (hipFuncSetAttribute((const void*)mk::mk_fwd, hipFuncAttributeMaxDynamicSharedMemorySize, mk::LDS_BYTES) != hipSuccess) { fprintf(stderr, "hipFuncSetAttribute failed\n"); grid = -1; return; }
        if (hipOccupancyMaxActiveBlocksPerMultiprocessor(&per_cu, (const void*)mk::mk_fwd, mk::NWAVES * 64, mk::LDS_BYTES) != hipSuccess || per_cu < 1) { fprintf(stderr, "occupancy query: %d\n", per_cu); per_cu = 1; }
        (void)hipGetLastError();
        grid = cus * 1;
        if (n_in != 22 || ws_size < 512u * mk::MiB) fprintf(stderr, "kernel_launch: unexpected n_in %d / ws_size %zu\n", n_in, ws_size);
    }
    if (grid < 0) return;
    if (hipMemsetAsync(d_ws, 0, 131072, stream) != hipSuccess) { fprintf(stderr, "memset failed\n"); return; }
    mk::Args a{};
    for (int i = 0; i < 22; ++i) a.in[i] = (const float*)d_in[i];
    a.out = (float*)d_out; a.ws = (unsigned char*)d_ws;
    char* ws = (char*)d_ws; const size_t MiB = 1u << 20;
#if STAGE == 4
    mk_launch_phases(a, 0, mk::N_PHASES, grid, stream, true);
#elif STAGE == 3
    for (int p = 0; p < mk::N_PHASES; ++p) mk_launch_phases(a, p, p + 1, grid, stream, false);
#elif STAGE == 1
    for (int p = 0; p < 2; ++p) mk_launch_phases(a, p, p + 1, grid, stream, false);
    float* q = (float*)(ws + 32 * MiB), *k = (float*)(ws + 256 * MiB), *v = (float*)(ws + 320 * MiB), *xr = (float*)(ws + 384 * MiB), *gr = (float*)(ws + 448 * MiB);
    dbg::k_unpack_proj<<<mk::M * 512 / 256, 256, 0, stream>>>((const mk::bf16_t*)(ws + mk::WS_Q), (const mk::bf16_t*)(ws + mk::WS_KT), (const mk::bf16_t*)(ws + mk::WS_VT), (const mk::bf16_t*)(ws + mk::WS_XR), (const mk::bf16_t*)(ws + mk::WS_GR), q, k, v, xr, gr);
    float* mixed = (float*)(ws + 96 * MiB);
    nv::naive_mid(d_in, q, k, v, xr, gr, mixed, stream);
    nv::naive_tail(d_in, mixed, (float*)d_out, (float*)(ws + 0), (float*)(ws + 128 * MiB), stream);
#elif STAGE == 2
    for (int p = 0; p < 3; ++p) mk_launch_phases(a, p, p + 1, grid, stream, false);
    float* mixed = (float*)(ws + 0);
    dbg::k_unpack_bf16<<<mk::M * 1024 / 256, 256, 0, stream>>>((const mk::bf16_t*)(ws + mk::WS_MIXED), mixed);
    nv::naive_tail(d_in, mixed, (float*)d_out, (float*)(ws + 0), (float*)(ws + 128 * MiB), stream);
#endif
}
```

```cpp
#include <hip/hip_runtime.h>
#include <hip/hip_cooperative_groups.h>
#include <cstdio>
#include <cstdint>
#include <cmath>
#define STAGE 4
namespace pg8 {
#define PG8_LAS __attribute__((address_space(3)))
typedef unsigned short bf16_t;
typedef short bf16x8 __attribute__((ext_vector_type(8)));
typedef float f32x4 __attribute__((ext_vector_type(4)));
typedef unsigned u32x4 __attribute__((ext_vector_type(4)));
constexpr int BM = 256, BK = 64, HALF = 128, HTB = HALF * BK * 2  , STAGE_BYTES = 8 * HTB, NXCD = 8, WGM = 8;

__host__ __device__ __forceinline__ int lds_byte(int r, int c) { const int st = (r >> 4) * 2 + (c >> 5), rr = r & 15, cc = c & 31, ob = rr * 64 + cc * 2; return st * 1024 + (ob ^ (((ob >> 9) & 1) << 5)); }
__host__ __device__ __forceinline__ void stage_rc(int b, int& R, int& C) { const int st = b / 1024, sb = b % 1024, swz = sb ^ (((sb >> 9) & 1) << 5); R = (st >> 1) * 16 + swz / 64; C = (st & 1) * 32 + (swz % 64) / 2; }
__host__ __device__ __forceinline__ int perm32(int rho) { const int n = rho >> 4, i = rho & 15; return 8 * (i >> 2) + 4 * n + (i & 3); }

struct Unit { int pm, pn; };
struct Gemm { const bf16_t* A; const bf16_t* Bt; int M, N, K; };

struct StaticOrder {
    int nM, nN, nwg, G, c, rep;
    __host__ __device__ void init(int M, int N, int G_, int c_) { nM = M / BM; nN = N / BM; nwg = nM * nN; G = G_; c = c_; rep = 1; }
    __host__ __device__ bool next(int i, Unit& u) const {
        const long L = (long)(i / rep) * G + c; if (L >= nwg) return false;
        int wgid = (int)L; { const int q = nwg / NXCD, r = nwg % NXCD, xcd = wgid % NXCD, off = wgid / NXCD; wgid = (xcd < r ? xcd * (q + 1) : r * (q + 1) + (xcd - r) * q) + off; }
        const int nig = WGM * nN, gid = wgid / nig, fm = gid * WGM, gsz = (nM - fm) < WGM ? (nM - fm) : WGM;
        u.pm = fm + ((wgid % nig) % gsz); u.pn = (wgid % nig) / gsz; return true;
    }
    __device__ __forceinline__ void a_ready(const Unit&) const {}
    __device__ __forceinline__ void done(const Unit&) const {}
};

struct SegOrder {
    int pm0, pn0, c0, pm1, pn1, c1, st;
    __host__ __device__ bool next(int i, Unit& u) const { if (i < c0) { u.pm = pm0; u.pn = pn0 + st * i; return true; } i -= c0; if (i < c1) { u.pm = pm1; u.pn = pn1 + st * i; return true; } return false; }
    __device__ __forceinline__ void a_ready(const Unit&) const {}
    __device__ __forceinline__ void done(const Unit&) const {}
};

typedef float f32x2_cv __attribute__((ext_vector_type(2))); typedef __bf16 bf16x2_cv __attribute__((ext_vector_type(2)));
__device__ __forceinline__ unsigned cvt_pk_bf16(float lo, float hi) { f32x2_cv v = {lo, hi}; bf16x2_cv b = __builtin_convertvector(v, bf16x2_cv); return __builtin_bit_cast(unsigned, b); }
typedef float f32x2 __attribute__((ext_vector_type(2)));
typedef unsigned u32x2 __attribute__((ext_vector_type(2)));
__device__ __forceinline__ u32x4 pack8(f32x4 v0, f32x4 v1) { u32x4 w; w.x = cvt_pk_bf16(v0[0], v0[1]); w.y = cvt_pk_bf16(v0[2], v0[3]); w.z = cvt_pk_bf16(v1[0], v1[1]); w.w = cvt_pk_bf16(v1[2], v1[3]); return w; }
struct EpiInProj {
    static constexpr bool PERM = true, AFTER_DRAIN = false;
    bf16_t *Q, *KT, *VT, *XR, *GR; float qscale;
    __device__ __forceinline__ void operator()(const f32x4 (&acc)[2][2][4][2], const Unit& u, int wr, int wc, int fr, int fq) const {
        const int sec = u.pn >> 1, half = u.pn & 1;
#pragma unroll
        for (int ai = 0; ai < 2; ++ai)
#pragma unroll
            for (int m = 0; m < 4; ++m) {
                const int row = u.pm * BM + ai * HALF + wr * 64 + m * 16 + fr;
                const int b = row >> 12, tok = row & 4095, t = tok >> 6, rr = tok & 63;
#pragma unroll
                for (int bj = 0; bj < 2; ++bj) {
                    f32x4 v0 = acc[ai][bj][m][0], v1 = acc[ai][bj][m][1];
                    const int cs = half * 256 + bj * HALF + wc * 32 + 8 * fq;
                    if (sec == 0) { v0 = v0 * qscale; v1 = v1 * qscale; *(u32x4*)(Q + (size_t)row * 512 + cs) = pack8(v0, v1); }
                    else if (sec == 1) { const int h = half * 2 + bj, s = wc >> 1, chunk = 4 * (wc & 1) + fq;
                        *(u32x4*)(KT + ((((size_t)(b * 4 + h) * 2 + s) * 64 + t) * 8 + chunk) * 512 + rr * 8) = pack8(v0, v1); }
                    else if (sec == 2) { const int h = half * 2 + bj;
                        *(u32x4*)(VT + (((size_t)(b * 4 + h) * 64 + t) * 4 + wc) * 2048 + rr * 32 + 8 * fq) = pack8(v0, v1); }
                    else if (sec == 3) { *(u32x4*)(XR + (size_t)row * 512 + cs) = pack8(v0, v1); }
                    else { *(u32x4*)(GR + (size_t)row * 512 + cs) = pack8(v0, v1); }
                }
            }
    }
};
template <bool WRITE_HB, bool WRITE_F32 = true> struct EpiResid {
    static constexpr bool PERM = false, AFTER_DRAIN = false;
    const float* base; float* out; bf16_t* hb; float* rss; int ldc;
    __device__ __forceinline__ void operator()(const f32x4 (&acc)[2][2][4][2], const Unit& u, int wr, int wc, int fr, int fq) const {
        const int col0 = u.pn * BM + wc * 32 + 4 * fq;
        f32x4 nx[2][2];
        { const size_t off0 = (size_t)(u.pm * BM + wr * 64 + fr) * ldc + col0;
#pragma unroll
          for (int bj = 0; bj < 2; ++bj)
#pragma unroll
              for (int n = 0; n < 2; ++n) nx[bj][n] = *(const f32x4*)(base + off0 + bj * HALF + n * 16); }
#pragma unroll
        for (int gi = 0; gi < 8; ++gi) {
            const int ai = gi >> 2, m = gi & 3;
            const int row = u.pm * BM + ai * HALF + wr * 64 + m * 16 + fr; const size_t off = (size_t)row * ldc + col0; float ss = 0.f;
            f32x4 cur[2][2];
#pragma unroll
            for (int bj = 0; bj < 2; ++bj)
#pragma unroll
                for (int n = 0; n < 2; ++n) cur[bj][n] = nx[bj][n];
            if (gi < 7) { const int ai2 = (gi + 1) >> 2, m2 = (gi + 1) & 3; const size_t off2 = (size_t)(u.pm * BM + ai2 * HALF + wr * 64 + m2 * 16 + fr) * ldc + col0;
#pragma unroll
                for (int bj = 0; bj < 2; ++bj)
#pragma unroll
                    for (int n = 0; n < 2; ++n) nx[bj][n] = *(const f32x4*)(base + off2 + bj * HALF + n * 16); }
#pragma unroll
            for (int bj = 0; bj < 2; ++bj)
#pragma unroll
                for (int n = 0; n < 2; ++n) {
                    const f32x4 o = acc[ai][bj][m][n] + cur[bj][n];
                    if (WRITE_F32) *(f32x4*)(out + off + bj * HALF + n * 16) = o;
                    if (WRITE_HB) { u32x2 w; w.x = cvt_pk_bf16(o[0], o[1]); w.y = cvt_pk_bf16(o[2], o[3]); *(u32x2*)(hb + off + bj * HALF + n * 16) = w; }
                    ss += (o[0] * o[0] + o[1] * o[1]) + (o[2] * o[2] + o[3] * o[3]);
                }
            ss += __shfl_xor(ss, 16); ss += __shfl_xor(ss, 32);
            if (fq == 0) rss[(size_t)row * 16 + u.pn * 4 + wc] = ss;
        }
    }
};
struct EpiGateUp {
    static constexpr bool PERM = true, AFTER_DRAIN = false;
    bf16_t* act; const float* rstd; int ldo;
    __device__ __forceinline__ void operator()(const f32x4 (&acc)[2][2][4][2], const Unit& u, int wr, int wc, int fr, int fq) const {
        const int col0 = u.pn * HALF + wc * 32 + 8 * fq;
        float rs[2][4];
#pragma unroll
        for (int ai = 0; ai < 2; ++ai)
#pragma unroll
            for (int m = 0; m < 4; ++m) rs[ai][m] = rstd[u.pm * BM + ai * HALF + wr * 64 + m * 16 + fr];
#pragma unroll
        for (int ai = 0; ai < 2; ++ai)
#pragma unroll
            for (int m = 0; m < 4; ++m) {
                const int row = u.pm * BM + ai * HALF + wr * 64 + m * 16 + fr;
                const float r_ = rs[ai][m], c1 = r_ * -1.4426950408889634f, r2 = r_ * r_;
                f32x4 o[2];
#pragma unroll
                for (int n = 0; n < 2; ++n) {
                    const f32x4 g = acc[ai][0][m][n], up = acc[ai][1][m][n];
#pragma unroll
                    for (int i = 0; i < 4; ++i) { const float e = __builtin_amdgcn_exp2f(g[i] * c1); o[n][i] = (g[i] * up[i]) * (r2 * __builtin_amdgcn_rcpf(1.0f + e)); }
                }
                *(u32x4*)(act + (size_t)row * ldo + col0) = pack8(o[0], o[1]);
            }
    }
};
struct EpiGateUpL {
    static constexpr bool PERM = true, AFTER_DRAIN = false;
    bf16_t* act; const PG8_LAS float* rl; int pm0; int ldo;
    __device__ __forceinline__ void operator()(const f32x4 (&acc)[2][2][4][2], const Unit& u, int wr, int wc, int fr, int fq) const {
        const int col0 = u.pn * HALF + wc * 32 + 8 * fq;
        float rs[2][4];
#pragma unroll
        for (int ai = 0; ai < 2; ++ai)
#pragma unroll
            for (int m = 0; m < 4; ++m) rs[ai][m] = rl[((u.pm != pm0) ? 256 : 0) + ai * HALF + wr * 64 + m * 16 + fr];
#pragma unroll
        for (int ai = 0; ai < 2; ++ai)
#pragma unroll
            for (int m = 0; m < 4; ++m) {
                const int row = u.pm * BM + ai * HALF + wr * 64 + m * 16 + fr;
                const float r_ = rs[ai][m], c1 = r_ * -1.4426950408889634f, r2 = r_ * r_;
                f32x4 o[2];
#pragma unroll
                for (int n = 0; n < 2; ++n) {
                    const f32x4 g = acc[ai][0][m][n], up = acc[ai][1][m][n];
#pragma unroll
                    for (int i = 0; i < 4; ++i) { const float e = __builtin_amdgcn_exp2f(g[i] * c1); o[n][i] = (g[i] * up[i]) * (r2 * __builtin_amdgcn_rcpf(1.0f + e)); }
                }
                *(u32x4*)(act + (size_t)row * ldo + col0) = pack8(o[0], o[1]);
            }
    }
};

struct EpiDownNorm {
    static constexpr bool PERM = false, AFTER_DRAIN = true;
    const bf16_t* hb; float* out; const float* gain; float* xbuf; unsigned* cnt; int ldc; float eps; const void* cnt_base_probe;
    __device__ __forceinline__ void fused(f32x4 (&acc)[2][2][4][2], const Unit& u, int wr, int wc, int fr, int fq, PG8_LAS unsigned char* lds, int wid, int lane) const {
        PG8_LAS float* P = (PG8_LAS float*)lds;
        PG8_LAS float* Sx = (PG8_LAS float*)(lds + 4096);
        PG8_LAS unsigned* flag = (PG8_LAS unsigned*)(lds + 4096 + 1024);
        const int col0 = u.pn * BM + wc * 32 + 4 * fq;
        u32x2 nx[2][2];
        { const size_t off0 = (size_t)(u.pm * BM + wr * 64 + fr) * ldc + col0;
#pragma unroll
          for (int bj = 0; bj < 2; ++bj)
#pragma unroll
              for (int n = 0; n < 2; ++n) nx[bj][n] = *(const u32x2*)(hb + off0 + bj * HALF + n * 16); }
#pragma unroll
        for (int gi = 0; gi < 8; ++gi) {
            const int ai = gi >> 2, m = gi & 3;
            const int r = ai * HALF + wr * 64 + m * 16 + fr; float ss = 0.f;
            u32x2 cur[2][2];
#pragma unroll
            for (int bj = 0; bj < 2; ++bj)
#pragma unroll
                for (int n = 0; n < 2; ++n) cur[bj][n] = nx[bj][n];
            if (gi < 7) { const int ai2 = (gi + 1) >> 2, m2 = (gi + 1) & 3; const size_t off2 = (size_t)(u.pm * BM + ai2 * HALF + wr * 64 + m2 * 16 + fr) * ldc + col0;
#pragma unroll
                for (int bj = 0; bj < 2; ++bj)
#pragma unroll
                    for (int n = 0; n < 2; ++n) nx[bj][n] = *(const u32x2*)(hb + off2 + bj * HALF + n * 16); }
#pragma unroll
            for (int bj = 0; bj < 2; ++bj)
#pragma unroll
                for (int n = 0; n < 2; ++n) {
                    const u32x2 hv = cur[bj][n];
                    const f32x4 h4 = (f32x4){__uint_as_float(hv.x << 16), __uint_as_float(hv.x & 0xffff0000u), __uint_as_float(hv.y << 16), __uint_as_float(hv.y & 0xffff0000u)};
                    const f32x4 o = acc[ai][bj][m][n] + h4; acc[ai][bj][m][n] = o;
                    ss += (o[0] * o[0] + o[1] * o[1]) + (o[2] * o[2] + o[3] * o[3]);
                }
            ss += __shfl_xor(ss, 16); ss += __shfl_xor(ss, 32);
            if (fq == 0) P[r * 4 + wc] = ss;
        }
        asm volatile("s_waitcnt lgkmcnt(0)" ::: "memory"); __builtin_amdgcn_s_barrier(); asm volatile("" ::: "memory");
        const int row = wid * 32 + (lane & 31);
        if (lane < 32) {
            const float s = (P[row * 4 + 0] + P[row * 4 + 1]) + (P[row * 4 + 2] + P[row * 4 + 3]);
            __hip_atomic_store(xbuf + (size_t)(u.pm * BM + row) * 4 + u.pn, s, __ATOMIC_RELAXED, __HIP_MEMORY_SCOPE_AGENT);
        }
        asm volatile("s_waitcnt vmcnt(0)" ::: "memory");
        if (lane == 0) __hip_atomic_fetch_add(cnt + 64 * u.pm, 1u, __ATOMIC_RELAXED, __HIP_MEMORY_SCOPE_AGENT);
        if (wid == 0) {
            unsigned sp = 0;
            for (;;) {
                if ((unsigned)__builtin_amdgcn_readfirstlane(__hip_atomic_load(cnt + 64 * u.pm, __ATOMIC_RELAXED, __HIP_MEMORY_SCOPE_AGENT)) >= 32u) break;
                if (++sp > (1u << 22)) break;
                __builtin_amdgcn_s_sleep(2);
            }
            __builtin_amdgcn_fence(__ATOMIC_ACQUIRE, "agent");
            if (lane == 0) flag[0] = 0u;
        }
        asm volatile("s_waitcnt vmcnt(0) lgkmcnt(0)" ::: "memory"); __builtin_amdgcn_s_barrier(); asm volatile("" ::: "memory");
        if (lane < 32) {
            const float* slot = xbuf + (size_t)(u.pm * BM + row) * 4;
            const float a = __hip_atomic_load(slot + 0, __ATOMIC_RELAXED, __HIP_MEMORY_SCOPE_AGENT), b = __hip_atomic_load(slot + 1, __ATOMIC_RELAXED, __HIP_MEMORY_SCOPE_AGENT),
                        c = __hip_atomic_load(slot + 2, __ATOMIC_RELAXED, __HIP_MEMORY_SCOPE_AGENT), d = __hip_atomic_load(slot + 3, __ATOMIC_RELAXED, __HIP_MEMORY_SCOPE_AGENT);
            Sx[row] = 1.0f / sqrtf(((a + b) + (c + d)) * (1.0f / 1024.0f) + eps);
        }
        asm volatile("s_waitcnt lgkmcnt(0)" ::: "memory"); __builtin_amdgcn_s_barrier(); asm volatile("" ::: "memory");
        f32x4 gv[2][2];
#pragma unroll
        for (int bj = 0; bj < 2; ++bj)
#pragma unroll
            for (int n = 0; n < 2; ++n) gv[bj][n] = *(const f32x4*)(gain + col0 + bj * HALF + n * 16);
#if defined(REP_PHASE) && (REP_PHASE == 77 || REP_PHASE == 79 || REP_PHASE == 80)
        { const float sc_ = 1.0f + ((const float*)cnt_base_probe)[30000];
#pragma unroll
          for (int bj = 0; bj < 2; ++bj)
#pragma unroll
              for (int n = 0; n < 2; ++n) gv[bj][n] = gv[bj][n] * sc_; }
#endif
#pragma unroll
        for (int ai = 0; ai < 2; ++ai)
#pragma unroll
            for (int m = 0; m < 4; ++m) {
                const int r = ai * HALF + wr * 64 + m * 16 + fr; const float rs = Sx[r]; const size_t off = (size_t)(u.pm * BM + r) * ldc + col0;
#pragma unroll
                for (int bj = 0; bj < 2; ++bj)
#pragma unroll
                    for (int n = 0; n < 2; ++n) *(f32x4*)(out + off + bj * HALF + n * 16) = acc[ai][bj][m][n] * rs * gv[bj][n];
            }
    }
};
struct EpiDownNormStream {
    static constexpr bool PERM = false, AFTER_DRAIN = false;
    const bf16_t* hb; float* out; const float* gain; float* xbuf; unsigned* cnt; int ldc; float eps; const void* cnt_base_probe; PG8_LAS unsigned char* lds_x;
    __device__ __forceinline__ void operator()(const f32x4 (&acc_in)[2][2][4][2], const Unit& u, int wr, int wc, int fr, int fq) const {
        PG8_LAS unsigned char* lds = lds_x; const int lane = threadIdx.x & 63, wid = __builtin_amdgcn_readfirstlane(threadIdx.x >> 6);
        f32x4 acc[2][2][4][2];
#pragma unroll
        for (int a_ = 0; a_ < 2; ++a_)
#pragma unroll
            for (int b_ = 0; b_ < 2; ++b_)
#pragma unroll
                for (int m_ = 0; m_ < 4; ++m_)
#pragma unroll
                    for (int n_ = 0; n_ < 2; ++n_) acc[a_][b_][m_][n_] = acc_in[a_][b_][m_][n_];
        PG8_LAS float* P = (PG8_LAS float*)lds;
        PG8_LAS float* Sx = (PG8_LAS float*)(lds + 4096);
        PG8_LAS unsigned* flag = (PG8_LAS unsigned*)(lds + 4096 + 1024);
        const int col0 = u.pn * BM + wc * 32 + 4 * fq;
        u32x2 nx[2][2];
        { const size_t off0 = (size_t)(u.pm * BM + wr * 64 + fr) * ldc + col0;
#pragma unroll
          for (int bj = 0; bj < 2; ++bj)
#pragma unroll
              for (int n = 0; n < 2; ++n) nx[bj][n] = *(const u32x2*)(hb + off0 + bj * HALF + n * 16); }
#pragma unroll
        for (int gi = 0; gi < 8; ++gi) {
            const int ai = gi >> 2, m = gi & 3;
            const int r = ai * HALF + wr * 64 + m * 16 + fr; float ss = 0.f;
            u32x2 cur[2][2];
#pragma unroll
            for (int bj = 0; bj < 2; ++bj)
#pragma unroll
                for (int n = 0; n < 2; ++n) cur[bj][n] = nx[bj][n];
            if (gi < 7) { const int ai2 = (gi + 1) >> 2, m2 = (gi + 1) & 3; const size_t off2 = (size_t)(u.pm * BM + ai2 * HALF + wr * 64 + m2 * 16 + fr) * ldc + col0;
#pragma unroll
                for (int bj = 0; bj < 2; ++bj)
#pragma unroll
                    for (int n = 0; n < 2; ++n) nx[bj][n] = *(const u32x2*)(hb + off2 + bj * HALF + n * 16); }
#pragma unroll
            for (int bj = 0; bj < 2; ++bj)
#pragma unroll
                for (int n = 0; n < 2; ++n) {
                    const u32x2 hv = cur[bj][n];
                    const f32x4 h4 = (f32x4){__uint_as_float(hv.x << 16), __uint_as_float(hv.x & 0xffff0000u), __uint_as_float(hv.y << 16), __uint_as_float(hv.y & 0xffff0000u)};
                    const f32x4 o = acc[ai][bj][m][n] + h4; acc[ai][bj][m][n] = o;
                    ss += (o[0] * o[0] + o[1] * o[1]) + (o[2] * o[2] + o[3] * o[3]);
                }
            ss += __shfl_xor(ss, 16); ss += __shfl_xor(ss, 32);
            if (fq == 0) P[r * 4 + wc] = ss;
        }
        asm volatile("s_waitcnt lgkmcnt(0)" ::: "memory"); __builtin_amdgcn_s_barrier(); asm volatile("" ::: "memory");
        const int row = wid * 32 + (lane & 31);
        if (lane < 32) {
            const float s = (P[row * 4 + 0] + P[row * 4 + 1]) + (P[row * 4 + 2] + P[row * 4 + 3]);
            __hip_atomic_store(xbuf + (size_t)(u.pm * BM + row) * 4 + u.pn, s, __ATOMIC_RELAXED, __HIP_MEMORY_SCOPE_AGENT);
        }
        asm volatile("s_waitcnt vmcnt(0)" ::: "memory");
        if (lane == 0) __hip_atomic_fetch_add(cnt + 64 * u.pm, 1u, __ATOMIC_RELAXED, __HIP_MEMORY_SCOPE_AGENT);
        if (wid == 0) {
            unsigned sp = 0;
            for (;;) {
                if ((unsigned)__builtin_amdgcn_readfirstlane(__hip_atomic_load(cnt + 64 * u.pm, __ATOMIC_RELAXED, __HIP_MEMORY_SCOPE_AGENT)) >= 32u) break;
                if (++sp > (1u << 22)) break;
                __builtin_amdgcn_s_sleep(2);
            }
            __builtin_amdgcn_fence(__ATOMIC_ACQUIRE, "agent");
            if (lane == 0) flag[0] = 0u;
        }
        asm volatile("s_waitcnt vmcnt(0) lgkmcnt(0)" ::: "memory"); __builtin_amdgcn_s_barrier(); asm volatile("" ::: "memory");
        if (lane < 32) {
            const float* slot = xbuf + (size_t)(u.pm * BM + row) * 4;
            const float a = __hip_atomic_load(slot + 0, __ATOMIC_RELAXED, __HIP_MEMORY_SCOPE_AGENT), b = __hip_atomic_load(slot + 1, __ATOMIC_RELAXED, __HIP_MEMORY_SCOPE_AGENT),
                        c = __hip_atomic_load(slot + 2, __ATOMIC_RELAXED, __HIP_MEMORY_SCOPE_AGENT), d = __hip_atomic_load(slot + 3, __ATOMIC_RELAXED, __HIP_MEMORY_SCOPE_AGENT);
            Sx[row] = 1.0f / sqrtf(((a + b) + (c + d)) * (1.0f / 1024.0f) + eps);
        }
        asm volatile("s_waitcnt lgkmcnt(0)" ::: "memory"); __builtin_amdgcn_s_barrier(); asm volatile("" ::: "memory");
        f32x4 gv[2][2];
#pragma unroll
        for (int bj = 0; bj < 2; ++bj)
#pragma unroll
            for (int n = 0; n < 2; ++n) gv[bj][n] = *(const f32x4*)(gain + col0 + bj * HALF + n * 16);
#if defined(REP_PHASE) && (REP_PHASE == 77 || REP_PHASE == 79 || REP_PHASE == 80)
        { const float sc_ = 1.0f + ((const float*)cnt_base_probe)[30000];
#pragma unroll
          for (int bj = 0; bj < 2; ++bj)
#pragma unroll
              for (int n = 0; n < 2; ++n) gv[bj][n] = gv[bj][n] * sc_; }
#endif
#pragma unroll
        for (int ai = 0; ai < 2; ++ai)
#pragma unroll
            for (int m = 0; m < 4; ++m) {
                const int r = ai * HALF + wr * 64 + m * 16 + fr; const float rs = Sx[r]; const size_t off = (size_t)(u.pm * BM + r) * ldc + col0;
#pragma unroll
                for (int bj = 0; bj < 2; ++bj)
#pragma unroll
                    for (int n = 0; n < 2; ++n) *(f32x4*)(out + off + bj * HALF + n * 16) = acc[ai][bj][m][n] * rs * gv[bj][n];
            }
    }
};
template <class Epi, class Sched, bool ALIGN_EPI = false, bool SP2 = false>
__device__ __forceinline__ void gemm_phase(PG8_LAS unsigned char* lds, const Gemm g, const Sched& S, const Epi& E, const int tid_in = -1) {
    const int tid = (tid_in >= 0) ? tid_in : (int)threadIdx.x, wid = __builtin_amdgcn_readfirstlane(tid >> 6), lane = tid & 63, wr = wid >> 2, wc = wid & 3, fr = lane & 15, fq = lane >> 4;
    const int K = g.K, nt = K / BK;
    unsigned voffA[2], voffB[2];
#pragma unroll
    for (int i = 0; i < 2; ++i) { int R, C; stage_rc(tid * 16 + i * 8192, R, C); const int Rb = Epi::PERM ? ((R & ~31) + perm32(R & 31)) : R;
        voffA[i] = (unsigned)(R * K + C) * 2u; voffB[i] = (unsigned)(Rb * K + C) * 2u; }
    const size_t kstep = (size_t)(BK * 2);
    const size_t hstep = (size_t)HALF * K * 2;
    const size_t tstep = 2 * hstep;
    const unsigned ldsw = (unsigned)wid * 1024u;
    const int aoff = lds_byte(wr * 64 + fr, fq * 8), boff = lds_byte(wc * 32 + fr, fq * 8);
#define PG8_SA(b, h) (((b) * 2 + (h)) * HTB)
#define PG8_SB(b, h) ((4 + (b) * 2 + (h)) * HTB)
#define PG8_STAGE(bufoff, gbase, voff) do { _Pragma("unroll") for (int _i = 0; _i < 2; ++_i) \
        __builtin_amdgcn_global_load_lds((const unsigned*)((const char*)(gbase) + (voff)[_i]), (PG8_LAS unsigned*)(lds + (bufoff) + ldsw + _i * 8192), 16, 0, 0); } while (0)
#define PG8_LDA(dst, b, h) do { _Pragma("unroll") for (int m = 0; m < 4; ++m) _Pragma("unroll") for (int k = 0; k < 2; ++k) dst[m][k] = *(const PG8_LAS bf16x8*)(lds + PG8_SA(b, h) + aoff + m * 2048 + k * 1024); } while (0)
#define PG8_LDB(dst, b, h) do { _Pragma("unroll") for (int n = 0; n < 2; ++n) _Pragma("unroll") for (int k = 0; k < 2; ++k) dst[n][k] = *(const PG8_LAS bf16x8*)(lds + PG8_SB(b, h) + boff + n * 2048 + k * 1024); } while (0)
#define PG8_MMA(ai, bj, At, Bt) do { __builtin_amdgcn_s_setprio(1); _Pragma("unroll") for (int m = 0; m < 4; ++m) _Pragma("unroll") for (int n = 0; n < 2; ++n) _Pragma("unroll") for (int k = 0; k < 2; ++k) \
        acc[ai][bj][m][n] = __builtin_amdgcn_mfma_f32_16x16x32_bf16(Bt[n][k], At[m][k], acc[ai][bj][m][n], 0, 0, 0); __builtin_amdgcn_s_setprio(0); } while (0)
#define PG8_WAIT_V(n) asm volatile("s_waitcnt vmcnt(" #n ")" ::: "memory")
#define PG8_WAIT_L(n) asm volatile("s_waitcnt lgkmcnt(" #n ")" ::: "memory")
#define PG8_BAR __builtin_amdgcn_s_barrier()
#define PG8_SCHED __builtin_amdgcn_sched_barrier(0)
    Unit cur, nxt; int ui = 0;
    if (!S.next(0, cur)) return;
    f32x4 acc[2][2][4][2];
#pragma unroll
    for (int a = 0; a < 2; ++a)
#pragma unroll
        for (int b = 0; b < 2; ++b)
#pragma unroll
            for (int m = 0; m < 4; ++m)
#pragma unroll
                for (int n = 0; n < 2; ++n) acc[a][b][m][n] = (f32x4){0.f, 0.f, 0.f, 0.f};
    bf16x8 At[4][2], B0[2][2], B1[2][2];
    const char* cA = (const char*)g.A + (size_t)cur.pm * tstep; const char* cB = (const char*)g.Bt + (size_t)cur.pn * tstep;
    S.a_ready(cur);
    if constexpr (SP2) {
        PG8_STAGE(PG8_SB(0, 0), cB, voffB); PG8_STAGE(PG8_SB(0, 1), cB + hstep, voffB); PG8_STAGE(PG8_SA(0, 0), cA, voffA); PG8_STAGE(PG8_SA(0, 1), cA + hstep, voffA);
        if (wr == 1) PG8_BAR;
        PG8_WAIT_V(2); PG8_BAR;
        PG8_STAGE(PG8_SB(1, 0), cB + kstep, voffB); PG8_STAGE(PG8_SA(1, 0), cA + kstep, voffA); PG8_STAGE(PG8_SB(1, 1), cB + hstep + kstep, voffB);
        PG8_WAIT_V(6); PG8_BAR;
    } else {
        PG8_STAGE(PG8_SB(0, 0), cB, voffB); PG8_STAGE(PG8_SA(0, 0), cA, voffA); PG8_STAGE(PG8_SB(0, 1), cB + hstep, voffB); PG8_STAGE(PG8_SA(0, 1), cA + hstep, voffA);
        if (wr == 1) PG8_BAR;
        PG8_WAIT_V(4); PG8_BAR;
        PG8_STAGE(PG8_SB(1, 0), cB + kstep, voffB); PG8_STAGE(PG8_SA(1, 0), cA + kstep, voffA); PG8_STAGE(PG8_SB(1, 1), cB + hstep + kstep, voffB);
        PG8_WAIT_V(6); PG8_BAR;
    }
    for (;;) {
        const bool has_next = S.next(ui + 1, nxt);
        const char* nA = has_next ? (const char*)g.A + (size_t)nxt.pm * tstep : cA; const char* nB = has_next ? (const char*)g.Bt + (size_t)nxt.pn * tstep : cB;
        for (int t = 0; t < nt; t += 2) {
            const bool last = (t == nt - 2);
            const char* a1 = cA + (size_t)(t + 1) * kstep;
            const char* a2 = last ? nA : cA + (size_t)(t + 2) * kstep; const char* b2 = last ? nB : cB + (size_t)(t + 2) * kstep;
            const char* a3 = a2 + kstep; const char* b3 = b2 + kstep;
            if (last && has_next) S.a_ready(nxt);
            if constexpr (SP2) {
            PG8_LDB(B0, 0, 0); PG8_LDB(B1, 0, 1); PG8_SCHED; PG8_LDA(At, 0, 0); PG8_STAGE(PG8_SA(1, 1), a1 + hstep, voffA);
            PG8_WAIT_V(8); PG8_WAIT_L(0); PG8_BAR; PG8_MMA(0, 0, At, B0); PG8_MMA(0, 1, At, B1); PG8_BAR; PG8_SCHED;
            PG8_LDA(At, 0, 1); PG8_STAGE(PG8_SB(0, 0), b2, voffB); PG8_STAGE(PG8_SB(0, 1), b2 + hstep, voffB); PG8_STAGE(PG8_SA(0, 0), a2, voffA);
            PG8_WAIT_V(8); PG8_WAIT_L(0); PG8_BAR; PG8_MMA(1, 0, At, B0); PG8_MMA(1, 1, At, B1); PG8_BAR; PG8_SCHED;
            PG8_LDB(B0, 1, 0); PG8_LDB(B1, 1, 1); PG8_SCHED; PG8_LDA(At, 1, 0); PG8_STAGE(PG8_SA(0, 1), a2 + hstep, voffA);
            PG8_WAIT_V(8); PG8_WAIT_L(0); PG8_BAR; PG8_MMA(0, 0, At, B0); PG8_MMA(0, 1, At, B1); PG8_BAR; PG8_SCHED;
            PG8_LDA(At, 1, 1); PG8_STAGE(PG8_SB(1, 0), b3, voffB); PG8_STAGE(PG8_SB(1, 1), b3 + hstep, voffB); PG8_STAGE(PG8_SA(1, 0), a3, voffA);
            PG8_WAIT_V(8); PG8_WAIT_L(0); PG8_BAR; PG8_MMA(1, 0, At, B0); PG8_MMA(1, 1, At, B1); PG8_BAR; PG8_SCHED;
            } else {
            PG8_LDB(B0, 0, 0); PG8_SCHED; PG8_LDA(At, 0, 0); PG8_STAGE(PG8_SA(1, 1), a1 + hstep, voffA);
            PG8_WAIT_L(8); PG8_BAR; PG8_WAIT_L(0); PG8_MMA(0, 0, At, B0); PG8_BAR; PG8_SCHED;
            PG8_LDB(B1, 0, 1); PG8_STAGE(PG8_SB(0, 0), b2, voffB);
            PG8_BAR; PG8_WAIT_L(0); PG8_MMA(0, 1, At, B1); PG8_BAR;
            PG8_LDA(At, 0, 1); PG8_STAGE(PG8_SA(0, 0), a2, voffA);
            PG8_BAR; PG8_WAIT_L(0); PG8_MMA(1, 0, At, B0); PG8_BAR; PG8_SCHED;
            PG8_STAGE(PG8_SB(0, 1), b2 + hstep, voffB);
            PG8_WAIT_V(6); PG8_BAR; PG8_MMA(1, 1, At, B1); PG8_BAR;
            PG8_LDB(B0, 1, 0); PG8_SCHED; PG8_LDA(At, 1, 0); PG8_STAGE(PG8_SA(0, 1), a2 + hstep, voffA);
            PG8_WAIT_L(8); PG8_BAR; PG8_WAIT_L(0); PG8_MMA(0, 0, At, B0); PG8_BAR; PG8_SCHED;
            PG8_LDB(B1, 1, 1); PG8_STAGE(PG8_SB(1, 0), b3, voffB);
            PG8_BAR; PG8_WAIT_L(0); PG8_MMA(0, 1, At, B1); PG8_BAR;
            PG8_LDA(At, 1, 1); PG8_STAGE(PG8_SA(1, 0), a3, voffA);
            PG8_BAR; PG8_WAIT_L(0); PG8_MMA(1, 0, At, B0); PG8_BAR; PG8_SCHED;
            PG8_STAGE(PG8_SB(1, 1), b3 + hstep, voffB);
            PG8_WAIT_V(6); PG8_BAR; PG8_MMA(1, 1, At, B1); PG8_BAR;
            }
        }
        if constexpr (ALIGN_EPI) { if (wr == 0) PG8_BAR; }
        if constexpr (!Epi::AFTER_DRAIN) { E(acc, cur, wr, wc, fr, fq); S.done(cur); }
        if (!has_next) break;
#pragma unroll
        for (int a = 0; a < 2; ++a)
#pragma unroll
            for (int b = 0; b < 2; ++b)
#pragma unroll
                for (int m = 0; m < 4; ++m)
#pragma unroll
                    for (int n = 0; n < 2; ++n) acc[a][b][m][n] = (f32x4){0.f, 0.f, 0.f, 0.f};
        cur = nxt; cA = nA; cB = nB; ++ui;
        if constexpr (ALIGN_EPI) { if (wr == 1) PG8_BAR; }
    }
    PG8_WAIT_V(0);
    if constexpr (!ALIGN_EPI) { if (wr == 0) PG8_BAR; }
    PG8_BAR;
    if constexpr (Epi::AFTER_DRAIN) { E.fused(acc, cur, wr, wc, fr, fq, lds, wid, lane); S.done(cur); }
#undef PG8_SA
#undef PG8_SB
#undef PG8_STAGE
#undef PG8_LDA
#undef PG8_LDB
#undef PG8_MMA
#undef PG8_WAIT_V
#undef PG8_WAIT_L
#undef PG8_BAR
#undef PG8_SCHED
}
}
namespace xb {
#define LAS __attribute__((address_space(3)))
#define XB_TMO      128
#define XB_XCNT(j)  (256  + 64 * (j))
#define XB_XSUB(j)  (1280 + 64 * (j))
#define XB_XGEN(j)  (2304 + 64 * (j))
#define XB_TOP      3328
#define XB_TOPGEN   3392
#define XCD_BAR_WORDS 3456
#define XB_SPIN_CAP (1u << 18)

__device__ __forceinline__ unsigned xb_ld(unsigned* p)              { return __hip_atomic_load(p, __ATOMIC_RELAXED, __HIP_MEMORY_SCOPE_AGENT); }
__device__ __forceinline__ unsigned xb_add(unsigned* p, unsigned v) { return __hip_atomic_fetch_add(p, v, __ATOMIC_RELAXED, __HIP_MEMORY_SCOPE_AGENT); }
__device__ __forceinline__ unsigned xb_xcc_id() { return (unsigned)__builtin_amdgcn_s_getreg((3 << 11) | 20) & 0xFu; }
#define XB_SPIN(cond, bar) do { unsigned _sp = 0; while (cond) { __builtin_amdgcn_s_sleep(1); \
    if ((++_sp & 255u) == 0u) { if (xb_ld(&(bar)[XB_TMO])) break; if (_sp > XB_SPIN_CAP) { atomicAdd(&(bar)[XB_TMO], 1u); break; } } } } while (0)

struct XcdBarrier {
    unsigned* bar; unsigned x;
    volatile LAS unsigned* st;
};

__device__ __forceinline__ XcdBarrier xcd_barrier_post(unsigned* bar, volatile LAS unsigned* st) {
    XcdBarrier b; b.bar = bar; b.x = xb_xcc_id(); b.st = st;
    if (threadIdx.x == 0) st[2] = xb_add(&bar[XB_XCNT(b.x)], 1u);
    return b;
}
__device__ __forceinline__ void xcd_barrier_complete(unsigned* bar, unsigned x, unsigned& nloc, unsigned& nx) {
    const unsigned G = gridDim.x * gridDim.y * gridDim.z;
    unsigned sum, cnt, mine, sp = 0u;
    for (;;) {
        sum = 0u; cnt = 0u; mine = 0u;
#pragma unroll
        for (unsigned j = 0; j < 16; ++j) { const unsigned c = xb_ld(&bar[XB_XCNT(j)]); sum += c; cnt += (c > 0u) ? 1u : 0u; mine = (j == x) ? c : mine; }
        if (sum == G) break;
        __builtin_amdgcn_s_sleep(1);
        if ((++sp & 255u) == 0u) { if (xb_ld(&bar[XB_TMO])) break; if (sp > XB_SPIN_CAP) { atomicAdd(&bar[XB_TMO], 1u); break; } }
    }
    nloc = mine > 0u ? mine : 1u; nx = cnt > 0u ? cnt : 1u;
}

__device__ __forceinline__ void xcd_barrier(const XcdBarrier& b) {
    asm volatile("s_waitcnt vmcnt(0)" ::: "memory");
    __syncthreads();
    if (threadIdx.x == 0) {
        unsigned* bar = b.bar;
        __builtin_amdgcn_s_waitcnt(0);
        unsigned nloc = b.st[0], nx = b.st[1];
        if (nloc == 0u) { xcd_barrier_complete(bar, b.x, nloc, nx); b.st[0] = nloc; b.st[1] = nx; }
        const unsigned old = xb_add(&bar[XB_XSUB(b.x)], 1u);
        const unsigned gen = old / nloc;
        if (old + 1u == (gen + 1u) * nloc) {
            __builtin_amdgcn_fence(__ATOMIC_RELEASE, "agent");
            asm volatile("s_waitcnt vmcnt(0)" ::: "memory");
            const unsigned og = xb_add(&bar[XB_TOP], 1u);
            const unsigned tg = og / nx;
            if (og + 1u == (tg + 1u) * nx) xb_add(&bar[XB_TOPGEN], 1u);
            else XB_SPIN(xb_ld(&bar[XB_TOPGEN]) == tg, bar);
            __builtin_amdgcn_fence(__ATOMIC_ACQUIRE, "agent");
            xb_add(&bar[XB_XGEN(b.x)], 1u);
            asm volatile("s_waitcnt vmcnt(0)" ::: "memory");
        } else {
            XB_SPIN(xb_ld(&bar[XB_XGEN(b.x)]) == gen, bar);
            __builtin_amdgcn_fence(__ATOMIC_ACQUIRE, "agent");
            asm volatile("s_waitcnt vmcnt(0)" ::: "memory");
        }
    }
    __syncthreads();
}

}
namespace mk {
#define LAS __attribute__((address_space(3)))
typedef unsigned short bf16_t;
typedef short bf16x8 __attribute__((ext_vector_type(8)));
typedef short s16x4 __attribute__((ext_vector_type(4)));
typedef float f32x4 __attribute__((ext_vector_type(4)));
typedef float f32x16 __attribute__((ext_vector_type(16)));
typedef unsigned u32x4 __attribute__((ext_vector_type(4)));
typedef unsigned u32x2 __attribute__((ext_vector_type(2)));
constexpr int NB = 8, S = 4096, D = 1024, M = NB * S, NH = 4, DFF = 2816, DIN = 2560, NWAVES = 8;
constexpr float EPS = 1e-6f, LOG2E = 1.4426950408889634f;
constexpr float QSCALE = 0.125f * LOG2E;
constexpr size_t MiB = 1u << 20;
constexpr size_t WS_WIN = 1 * MiB, WS_WOUT = 6 * MiB, WS_WGU = 8 * MiB, WS_WDN = 19 * MiB, WS_RSS1 = 25 * MiB, WS_RSS2 = 27 * MiB, WS_RSTD = 29 * MiB;
constexpr size_t WS_XN = 32 * MiB, WS_Q = 96 * MiB, WS_KT = 128 * MiB, WS_VT = 160 * MiB, WS_XR = 192 * MiB, WS_GR = 224 * MiB, WS_HF = 256 * MiB, WS_MIXED = 320 * MiB, WS_ACT = 96 * MiB, WS_XC = 384 * MiB, WS_OX = 416 * MiB, WS_END = 480 * MiB;
static_assert(WS_ACT + (size_t)M * DFF * 2 <= WS_MIXED, "act overlays Q..HF only");
constexpr int RING_BYTES = 131072, LDS_MISC = 131072, LDS_BYTES = 147456;

__device__ __forceinline__ unsigned cvt_pk_bf16(float lo, float hi) { return pg8::cvt_pk_bf16(lo, hi); }
__device__ __forceinline__ float bf2f(unsigned short b) { return __uint_as_float(((unsigned)b) << 16); }
__device__ __forceinline__ float wave_sum(float v) {
#pragma unroll
    for (int o = 1; o < 64; o <<= 1) v += __shfl_xor(v, o);
    return v;
}
__device__ __forceinline__ float fast_sigmoid(float x) { return __builtin_amdgcn_rcpf(1.0f + __builtin_amdgcn_exp2f(-LOG2E * x)); }

template <int MAP  >
__device__ __forceinline__ void p0_transpose_item(const float* W, int K, int N, bf16_t* WT, const float* gk, LAS float* scr, int item, int lane) {
    const int nblk = N / 32, kb = item / nblk, nb = item % nblk, k0 = 64 * kb, n0 = 32 * nb;
#pragma unroll
    for (int i = 0; i < 8; ++i) { const int kk = 8 * i + (lane >> 3); f32x4 v = __builtin_nontemporal_load((const f32x4*)(W + (size_t)(k0 + kk) * N + n0 + 4 * (lane & 7))); if (gk) v = v * gk[k0 + kk];
        LAS float* d = scr + kk * 33 + 4 * (lane & 7); d[0] = v[0]; d[1] = v[1]; d[2] = v[2]; d[3] = v[3]; }
    asm volatile("s_waitcnt lgkmcnt(0)" ::: "memory");
    const int c = lane & 7;
#pragma unroll
    for (int j = 0; j < 4; ++j) { const int n = (lane >> 3) + 8 * j; const LAS float* s = scr + (8 * c) * 33 + n;
        u32x4 o; o.x = cvt_pk_bf16(s[0 * 33], s[1 * 33]); o.y = cvt_pk_bf16(s[2 * 33], s[3 * 33]); o.z = cvt_pk_bf16(s[4 * 33], s[5 * 33]); o.w = cvt_pk_bf16(s[6 * 33], s[7 * 33]);
        const int f = n0 + n; const int drow = (MAP == 0) ? f : (256 * (f >> 7) + (f & 127) + (MAP == 2 ? 128 : 0));
        *(u32x4*)(WT + (size_t)drow * K + k0 + 8 * c) = o; }
    asm volatile("s_waitcnt lgkmcnt(0)" ::: "memory");
}
template <int NR>
__device__ __forceinline__ void rms_rows_to_bf16(const float* xrow, const float* g, bf16_t* orow, int lane) {
    const f32x4* gr = (const f32x4*)g + lane;
    f32x4 v[NR][4]; float s[NR];
#pragma unroll
    for (int q = 0; q < NR; ++q) { const f32x4* xr = (const f32x4*)(xrow + (size_t)q * D) + lane;
#pragma unroll
        for (int j = 0; j < 4; ++j) v[q][j] = __builtin_nontemporal_load(xr + 64 * j); }
#pragma unroll
    for (int q = 0; q < NR; ++q) { float a = 0.f;
#pragma unroll
        for (int j = 0; j < 4; ++j) a += (v[q][j][0] * v[q][j][0] + v[q][j][1] * v[q][j][1]) + (v[q][j][2] * v[q][j][2] + v[q][j][3] * v[q][j][3]);
        s[q] = a; }
#pragma unroll
    for (int o = 1; o < 64; o <<= 1)
#pragma unroll
        for (int q = 0; q < NR; ++q) s[q] += __shfl_xor(s[q], o);
    f32x4 gg[4];
#pragma unroll
    for (int j = 0; j < 4; ++j) gg[j] = gr[64 * j];
#pragma unroll
    for (int q = 0; q < NR; ++q) { const float rstd = 1.0f / sqrtf(s[q] * (1.f / D) + EPS); u32x2* o8 = (u32x2*)(orow + (size_t)q * D) + lane;
#pragma unroll
        for (int j = 0; j < 4; ++j) { u32x2 w; w.x = cvt_pk_bf16(v[q][j][0] * rstd * gg[j][0], v[q][j][1] * rstd * gg[j][1]); w.y = cvt_pk_bf16(v[q][j][2] * rstd * gg[j][2], v[q][j][3] * rstd * gg[j][3]); o8[64 * j] = w; } }
}

namespace att {
constexpr int NT = S / 64, SLOT = 16384, KSLOT = 8192, LDS_K = 0, LDS_V = 3 * KSLOT, LDS_OST = 0;
constexpr int LDS_WSF = LDS_MISC, LDS_BIAS = LDS_MISC + 2048, LDS_TOT = LDS_MISC + 3072, LDS_CW = LDS_MISC + 5120, LDS_BIAS2 = LDS_MISC + 8704;
constexpr int THR = 8;
typedef LAS const char* lds_cptr;
typedef short v4i16_t __attribute__((ext_vector_type(4)));
__device__ __forceinline__ int crow(int r, int hi) { return (r & 3) + 8 * (r >> 2) + 4 * hi; }
__device__ __forceinline__ void glds16(const void* gsrc, unsigned lds_dst) { unsigned keep;
    asm volatile("s_mov_b32 %0, m0\n\ts_mov_b32 m0, %2\n\ts_nop 0\n\tglobal_load_lds_dwordx4 %1, off\n\ts_mov_b32 m0, %0" : "=&s"(keep) : "v"(gsrc), "s"(lds_dst) : "memory"); }
__device__ __forceinline__ s16x4 vtr(lds_cptr p) { return __builtin_bit_cast(s16x4, __builtin_amdgcn_ds_read_tr16_b64_v4i16((LAS v4i16_t*)p)); }
#define ATT_MX3(a, b, c) __builtin_fmaxf(__builtin_fmaxf((a), (b)), (c))
__device__ __forceinline__ float rowmax(const f32x16& p0, const f32x16& p1) {
    float a = ATT_MX3(p0[0], p0[1], p1[0]), b = ATT_MX3(p0[2], p0[3], p1[1]); a = ATT_MX3(a, p1[2], p1[3]);
#pragma unroll
    for (int r = 4; r < 16; r += 4) { a = ATT_MX3(a, p0[r], p0[r + 1]); b = ATT_MX3(b, p0[r + 2], p0[r + 3]); a = ATT_MX3(a, p1[r], p1[r + 1]); b = ATT_MX3(b, p1[r + 2], p1[r + 3]); }
    float m = __builtin_fmaxf(a, b); auto rr = __builtin_amdgcn_permlane32_swap(__float_as_uint(m), __float_as_uint(m), false, false);
    return __builtin_fmaxf(__uint_as_float(rr[0]), __uint_as_float(rr[1]));
}
#define ATT_WAIT_BAR(N) do { if (ABL == 4) asm volatile("s_waitcnt vmcnt(" #N ") lgkmcnt(0)" ::: "memory"); else asm volatile("s_waitcnt vmcnt(" #N ") lgkmcnt(0)\n\ts_barrier" ::: "memory"); } while (0)
#define ATT_MFMA(a, b, c) __builtin_amdgcn_mfma_f32_32x32x16_bf16(a, b, c, 0, 0, 0)

template <bool FIRST>
__device__ __forceinline__ void tile_h1(int t, lds_cptr kp, const bf16x8 (&qr)[4], f32x16 (&o)[4], u32x4 (&pw)[4], float& mhat, float& l_reg,
                                        LAS float* wsf, const LAS float* btab, int qrow, int qw0, float c_left, float c_right, int r32, int hi) {
    const int relmin = 64 * t - qw0 - 31, relmax = 64 * t + 63 - qw0;
    const bool band = !(relmax <= -91 || relmin >= 91);
    const float cb = band ? 0.f : (relmin >= 91 ? c_right : c_left);
    f32x16 p0, p1;
    const f32x16 z16 = (f32x16){0.f, 0.f, 0.f, 0.f, 0.f, 0.f, 0.f, 0.f, 0.f, 0.f, 0.f, 0.f, 0.f, 0.f, 0.f, 0.f};
#pragma unroll
    for (int d0 = 0; d0 < 4; ++d0) {
        const bf16x8 k0 = *(const LAS bf16x8*)(kp + d0 * 2048), k1 = *(const LAS bf16x8*)(kp + d0 * 2048 + 512);
        if (d0 == 0) { p0 = ATT_MFMA(k0, qr[0], z16); p1 = ATT_MFMA(k1, qr[0], z16); }
        else { p0 = ATT_MFMA(k0, qr[d0], p0); p1 = ATT_MFMA(k1, qr[d0], p1); }
    }
    if (band) {
        const int relb = 64 * t + 4 * hi - qrow + 128;
#pragma unroll
        for (int r = 0; r < 16; ++r) { const int i0 = relb + (r & 3) + 8 * (r >> 2); const int a0 = i0 < 0 ? 0 : (i0 > 255 ? 255 : i0); const int i1 = i0 + 32; const int a1 = i1 < 0 ? 0 : (i1 > 255 ? 255 : i1);
            p0[r] += btab[a0]; p1[r] += btab[a1]; }
    }
    const float rm = rowmax(p0, p1) + cb;
    if (FIRST) { mhat = rm; }
    else if (__builtin_expect(__any(rm - mhat > (float)THR), 0)) {
        const float dl = __builtin_fmaxf(rm - mhat, 0.f); mhat += dl;
        const float f = __builtin_amdgcn_exp2f(-dl); l_reg *= f;
        if (hi == 0) wsf[r32] = f;
        asm volatile("s_waitcnt lgkmcnt(0)" ::: "memory");
        float fr[16];
#pragma unroll
        for (int r = 0; r < 16; ++r) fr[r] = wsf[crow(r, hi)];
#pragma unroll
        for (int db = 0; db < 4; ++db)
#pragma unroll
            for (int r = 0; r < 16; ++r) o[db][r] *= fr[r];
        asm volatile("s_waitcnt lgkmcnt(0)" ::: "memory");
    }
    const float off = cb - mhat;
    float sacc = 0.f;
#pragma unroll
    for (int r = 0; r < 16; ++r) { p0[r] = __builtin_amdgcn_exp2f(p0[r] + off); p1[r] = __builtin_amdgcn_exp2f(p1[r] + off); sacc += p0[r] + p1[r]; }
    l_reg += sacc;
#pragma unroll
    for (int ks = 0; ks < 4; ++ks) { const f32x16& P = (ks < 2) ? p0 : p1; const int b = 8 * (ks & 1);
        pw[ks] = (u32x4){cvt_pk_bf16(P[b], P[b + 1]), cvt_pk_bf16(P[b + 2], P[b + 3]), cvt_pk_bf16(P[b + 4], P[b + 5]), cvt_pk_bf16(P[b + 6], P[b + 7])}; }
}
__device__ __forceinline__ void tile_h2(lds_cptr vp, f32x16 (&o)[4], const u32x4 (&pw)[4]) {
#pragma unroll
    for (int ks = 0; ks < 4; ++ks)
#pragma unroll
        for (int db = 0; db < 4; ++db) {
            const s16x4 lo = vtr(vp + db * 4096 + ks * 1024), h4 = vtr(vp + db * 4096 + ks * 1024 + 512);
            const bf16x8 vf = (bf16x8){lo[0], lo[1], lo[2], lo[3], h4[0], h4[1], h4[2], h4[3]};
            o[db] = ATT_MFMA(__builtin_bit_cast(bf16x8, pw[ks]), vf, o[db]);
        }
}

struct VFrag { s16x4 lo, hi; };
template <int I> __device__ __forceinline__ VFrag vload(lds_cptr vp) {
    constexpr int off_ = (I & 3) * 4096 + (I >> 2) * 1024; VFrag f; f.lo = vtr(vp + off_); f.hi = vtr(vp + off_ + 512); return f;
}
template <int ABL, int MODE, int mp>
__device__ __forceinline__ bool attn_unit(int b, int h, int qb, const bf16_t* Q, const bf16_t* KT, const bf16_t* VT, bf16_t* MIXED, float* OX, LAS unsigned char* lds, float lam, const float* subln_g, const float* rel_bias) {
    const int tid = threadIdx.x, lane = tid & 63, r32 = lane & 31, hi = lane >> 5; const int wid = __builtin_amdgcn_readfirstlane(tid >> 6);
    const size_t rowbase = (size_t)b * S; const int q0 = qb * 256, qw0 = q0 + 32 * wid, qrow = qw0 + r32;
    LAS float* btab = (LAS float*)(lds + LDS_BIAS2); LAS float* wsf = (LAS float*)(lds + LDS_WSF) + wid * 64;
    { const int rel = tid - 256; const int n = rel < 0 ? -rel : rel; int bk; if (n < 8) bk = n; else { bk = 2 + (31 - __clz(n * n)); if (bk > 15) bk = 15; } if (rel > 0) bk += 16;
        btab[tid] = rel_bias[bk * NH + h] * LOG2E; }
    if (tid == 0) *(LAS unsigned*)(lds + LDS_WSF + 2040) = 0u;
    const float c_left = rel_bias[15 * NH + h] * LOG2E, c_right = rel_bias[31 * NH + h] * LOG2E;
    const bf16_t* Qw = Q + (rowbase + qw0) * 512 + h * 128 + mp * 64;
    bf16x8 qr[4];
#pragma unroll
    for (int d0 = 0; d0 < 4; ++d0) qr[d0] = *(const bf16x8*)(Qw + (size_t)r32 * 512 + d0 * 16 + hi * 8);
    const char* ksrc = (const char*)KT + ((size_t)((b * 4 + h) * 2 + mp) * 64) * 8192 + wid * 1024 + lane * 16;
    const char* vsrc = (const char*)VT + ((size_t)(b * 4 + h) * 64) * 16384 + wid * 1024 + lane * 16;
    const unsigned lds0 = (unsigned)(uintptr_t)(unsigned char*)lds;
    const unsigned kdst = lds0 + LDS_K + wid * 1024, vdst = lds0 + LDS_V + wid * 1024;
    const lds_cptr kp0 = (lds_cptr)lds + LDS_K + hi * 1024 + r32 * 16;
    const lds_cptr vp0 = (lds_cptr)lds + LDS_V + ((lane >> 4) & 1) * 32 + (lane & 3) * 8 + (4 * hi + ((lane & 15) >> 2)) * 64;
#define ATT_DMA_TILE(t, ks_, vs_) do { if (ABL == 3) break; glds16(ksrc + (size_t)(t) * 8192, (unsigned)__builtin_amdgcn_readfirstlane(kdst + (ks_))); \
        glds16(vsrc + (size_t)(t) * 16384, (unsigned)__builtin_amdgcn_readfirstlane(vdst + (vs_))); glds16(vsrc + (size_t)(t) * 16384 + 8192, (unsigned)__builtin_amdgcn_readfirstlane(vdst + (vs_) + 8192)); } while (0)
    ATT_DMA_TILE(0, 0, 0); ATT_DMA_TILE(1, KSLOT, SLOT);
    float mhat = 0.f, l_reg = 0.f; f32x16 o[4]; u32x4 pw[4];
#pragma unroll
    for (int db = 0; db < 4; ++db)
#pragma unroll
        for (int r = 0; r < 16; ++r) o[db][r] = 0.f;
    int ksl = 0, ksl2 = 2 * KSLOT, vsl = 0, vsl2 = 2 * SLOT, vprev = 0;
#define ATT_ROT() do { ksl = (ksl == 2 * KSLOT) ? 0 : ksl + KSLOT; ksl2 = (ksl2 == 2 * KSLOT) ? 0 : ksl2 + KSLOT; vprev = vsl; vsl = (vsl + SLOT) & (4 * SLOT - 1); vsl2 = (vsl2 + SLOT) & (4 * SLOT - 1); } while (0)
#define ATT_SB() __builtin_amdgcn_sched_barrier(0)
#define ATT_PIN(x) asm volatile("" : "+v"(x))
#define ATT_F(T0, T1, e) (((e) < 16) ? T0[(e) & 15] : T1[(e) & 15])
#define ATT_KRD(f) (*(const LAS bf16x8*)(kp_ + ((f) >> 1) * 2048 + ((f) & 1) * 512))
    const f32x16 z16 = (f32x16){0.f, 0.f, 0.f, 0.f, 0.f, 0.f, 0.f, 0.f, 0.f, 0.f, 0.f, 0.f, 0.f, 0.f, 0.f, 0.f};
#define ATT_GA(C0, C1, P0, P1, f) do { \
        if (((f) & 1) == 0) C0 = ATT_MFMA(kq[(f) % 3], qr[(f) >> 1], ((f) < 2) ? z16 : C0); else C1 = ATT_MFMA(kq[(f) % 3], qr[(f) >> 1], ((f) < 2) ? z16 : C1); \
        if (ABL != 5 && (f) + 3 < 8) kq[(f) % 3] = ATT_KRD((f) + 3); \
        if (ABL != 6) { sacc += ATT_F(P0, P1, 4 * (f)); sacc += ATT_F(P0, P1, 4 * (f) + 1); sacc += ATT_F(P0, P1, 4 * (f) + 2); sacc += ATT_F(P0, P1, 4 * (f) + 3); ATT_PIN(sacc); } \
        if (ABL != 6) pw[(f) >> 1][2 * ((f) & 1)] = cvt_pk_bf16(ATT_F(P0, P1, 4 * (f)), ATT_F(P0, P1, 4 * (f) + 1)); if (ABL != 6) pw[(f) >> 1][2 * ((f) & 1) + 1] = cvt_pk_bf16(ATT_F(P0, P1, 4 * (f) + 2), ATT_F(P0, P1, 4 * (f) + 3)); ATT_PIN(pw[(f) >> 1]); \
        ATT_SB(); } while (0)
#define ATT_VRD(I) vload<(I) & 15>(vp_)
#define ATT_GBF(I, FILL) do { \
        { const VFrag& vv = vq[(I) % 3]; const bf16x8 vf = (bf16x8){vv.lo[0], vv.lo[1], vv.lo[2], vv.lo[3], vv.hi[0], vv.hi[1], vv.hi[2], vv.hi[3]}; \
          if (ABL != 7) o[(I) & 3] = ATT_MFMA(__builtin_bit_cast(bf16x8, pw[(I) >> 2]), vf, o[(I) & 3]); else asm volatile("" :: "v"(vf)); } \
        if (ABL != 1 && (I) + 3 < 16) vq[(I) % 3] = ATT_VRD((I) + 3); \
        FILL; ATT_SB(); } while (0)
#define ATT_EXF(x) ((ABL == 2) ? (x) : __builtin_amdgcn_exp2f(x))
#define ATT_EX(C0, C1, e) do { if ((e) < 16) { C0[(e) & 15] = ATT_EXF(C0[(e) & 15] + off); } else { C1[(e) & 15] = ATT_EXF(C1[(e) & 15] + off); } } while (0)
#define ATT_EX3(C0, C1, e) do { ATT_EX(C0, C1, e); ATT_EX(C0, C1, (e) + 1); ATT_EX(C0, C1, (e) + 2); ATT_PIN(C0); ATT_PIN(C1); } while (0)
#define ATT_EX2(C0, C1, e) do { ATT_EX(C0, C1, e); ATT_EX(C0, C1, (e) + 1); ATT_PIN(C0); ATT_PIN(C1); } while (0)
#define ATT_MX3(a, b, c) __builtin_fmaxf(__builtin_fmaxf((a), (b)), (c))
#define ATT_BIAS(C0, C1, t) \
        const int relmin_ = 64 * (t) - qw0 - 31, relmax_ = 64 * (t) + 63 - qw0; const bool band_ = !(relmax_ <= -91 || relmin_ >= 91); const float cb_ = band_ ? 0.f : (relmin_ >= 91 ? c_right : c_left); \
        if (band_) { const LAS float* bp_ = btab + (64 * (t) + 4 * hi - qrow + 256);       \
            _Pragma("unroll") for (int r = 0; r < 16; ++r) { C0[r] += bp_[(r & 3) + 8 * (r >> 2)]; C1[r] += bp_[(r & 3) + 8 * (r >> 2) + 32]; } }
#define ATT_MAXP(C0, C1, g) do { if ((g) == 0) { ma_ = ATT_MX3(C0[0], C0[1], C1[0]); mb_ = ATT_MX3(C0[2], C0[3], C1[1]); ma_ = ATT_MX3(ma_, C1[2], C1[3]); } \
        else { ma_ = ATT_MX3(ma_, C0[4 * (g)], C0[4 * (g) + 1]); mb_ = ATT_MX3(mb_, C0[4 * (g) + 2], C0[4 * (g) + 3]); ma_ = ATT_MX3(ma_, C1[4 * (g)], C1[4 * (g) + 1]); mb_ = ATT_MX3(mb_, C1[4 * (g) + 2], C1[4 * (g) + 3]); } \
        ATT_PIN(ma_); ATT_PIN(mb_); } while (0)
#define ATT_DECIDE2(FIRST_) do { float rm_ = __builtin_fmaxf(ma_, mb_); { auto rr = __builtin_amdgcn_permlane32_swap(__float_as_uint(rm_), __float_as_uint(rm_), false, false); rm_ = __builtin_fmaxf(__uint_as_float(rr[0]), __uint_as_float(rr[1])); } \
        rm_ += cb_; resc = false; \
        if (FIRST_) { mhat = rm_; } \
        else if (__builtin_expect(__any(rm_ - mhat > (float)THR), 0)) { const float dl_ = __builtin_fmaxf(rm_ - mhat, 0.f); mhat += dl_; const float f_ = __builtin_amdgcn_exp2f(-dl_); l_reg *= f_; if (hi == 0) wsf[r32] = f_; resc = true; } \
        off = cb_ - mhat; ATT_SB(); } while (0)
#define ATT_RESC() do { if (resc) { asm volatile("s_waitcnt lgkmcnt(0)" ::: "memory"); float fr_[16]; \
        _Pragma("unroll") for (int r = 0; r < 16; ++r) fr_[r] = wsf[crow(r, hi)]; \
        _Pragma("unroll") for (int db = 0; db < 4; ++db) _Pragma("unroll") for (int r = 0; r < 16; ++r) o[db][r] *= fr_[r]; \
        asm volatile("s_waitcnt lgkmcnt(0)" ::: "memory"); } \
        if (MODE == 1 && cb_ != cc) { const float sc_ = __builtin_amdgcn_exp2f(cc - cb_); cc = cb_; l_reg *= sc_;       \
            _Pragma("unroll") for (int db = 0; db < 4; ++db) _Pragma("unroll") for (int r = 0; r < 16; ++r) o[db][r] *= sc_; } } while (0)
#define ATT_EX0(C0, C1, e) do { if ((e) < 16) { C0[(e) & 15] = ATT_EXF(C0[(e) & 15]); } else { C1[(e) & 15] = ATT_EXF(C1[(e) & 15]); } } while (0)
#define ATT_EX0P(C0, C1, e) do { ATT_EX0(C0, C1, e); ATT_EX0(C0, C1, (e) + 1); ATT_PIN(C0); ATT_PIN(C1); } while (0)
#define ATT_STEP(C0, C1, P0, P1, t) do { \
        const lds_cptr kp_ = kp0 + ksl; const lds_cptr vp_ = vp0 + vprev; float sacc = 0.f, ma_, mb_; \
        kq[0] = ATT_KRD(0); kq[1] = ATT_KRD(1); kq[2] = ATT_KRD(2); ATT_SB(); \
        ATT_GA(C0, C1, P0, P1, 0); ATT_GA(C0, C1, P0, P1, 1); ATT_GA(C0, C1, P0, P1, 2); ATT_GA(C0, C1, P0, P1, 3); \
        vq[0] = ATT_VRD(0); vq[1] = ATT_VRD(1); vq[2] = ATT_VRD(2); ATT_SB(); \
        ATT_GA(C0, C1, P0, P1, 4); ATT_GA(C0, C1, P0, P1, 5); ATT_GA(C0, C1, P0, P1, 6); ATT_GA(C0, C1, P0, P1, 7); \
        l_reg += sacc; \
        ATT_BIAS(C0, C1, t) ATT_SB(); \
        if (MODE == 0) { \
        ATT_GBF(0, ATT_MAXP(C0, C1, 0)); ATT_GBF(1, ATT_MAXP(C0, C1, 1)); ATT_GBF(2, ATT_MAXP(C0, C1, 2)); ATT_GBF(3, ATT_MAXP(C0, C1, 3)); \
        ATT_DECIDE2(false); \
        ATT_GBF(4, ATT_EX3(C0, C1, 0)); ATT_GBF(5, ATT_EX3(C0, C1, 3)); ATT_GBF(6, ATT_EX3(C0, C1, 6)); ATT_GBF(7, ATT_EX3(C0, C1, 9)); \
        ATT_GBF(8, ATT_EX3(C0, C1, 12)); ATT_GBF(9, ATT_EX3(C0, C1, 15)); ATT_GBF(10, ATT_EX3(C0, C1, 18)); ATT_GBF(11, ATT_EX3(C0, C1, 21)); \
        ATT_GBF(12, ATT_EX2(C0, C1, 24)); ATT_GBF(13, ATT_EX2(C0, C1, 26)); ATT_GBF(14, ATT_EX2(C0, C1, 28)); ATT_GBF(15, ATT_EX2(C0, C1, 30)); \
        } else { \
        ATT_GBF(0, ATT_EX0P(C0, C1, 0)); ATT_GBF(1, ATT_EX0P(C0, C1, 2)); ATT_GBF(2, ATT_EX0P(C0, C1, 4)); ATT_GBF(3, ATT_EX0P(C0, C1, 6)); ATT_GBF(4, ATT_EX0P(C0, C1, 8)); ATT_GBF(5, ATT_EX0P(C0, C1, 10)); ATT_GBF(6, ATT_EX0P(C0, C1, 12)); ATT_GBF(7, ATT_EX0P(C0, C1, 14)); \
        ATT_GBF(8, ATT_EX0P(C0, C1, 16)); ATT_GBF(9, ATT_EX0P(C0, C1, 18)); ATT_GBF(10, ATT_EX0P(C0, C1, 20)); ATT_GBF(11, ATT_EX0P(C0, C1, 22)); ATT_GBF(12, ATT_EX0P(C0, C1, 24)); ATT_GBF(13, ATT_EX0P(C0, C1, 26)); ATT_GBF(14, ATT_EX0P(C0, C1, 28)); ATT_GBF(15, ATT_EX0P(C0, C1, 30)); } \
        ATT_RESC(); ATT_ROT(); } while (0)
    f32x16 sa0, sa1, sb0, sb1; bf16x8 kq[3]; VFrag vq[3]; float off = 0.f, cc = 0.f; bool resc = false;
    ATT_WAIT_BAR(3); ATT_DMA_TILE(2, ksl2, vsl2);
    { const lds_cptr kp_ = kp0 + ksl;
#pragma unroll
      for (int d0 = 0; d0 < 4; ++d0) { const bf16x8 k0 = ATT_KRD(2 * d0), k1 = ATT_KRD(2 * d0 + 1);
          if (d0 == 0) { sa0 = ATT_MFMA(k0, qr[0], z16); sa1 = ATT_MFMA(k1, qr[0], z16); } else { sa0 = ATT_MFMA(k0, qr[d0], sa0); sa1 = ATT_MFMA(k1, qr[d0], sa1); } }
      float ma_, mb_; ATT_BIAS(sa0, sa1, 0)
      if (MODE == 0) { ATT_MAXP(sa0, sa1, 0); ATT_MAXP(sa0, sa1, 1); ATT_MAXP(sa0, sa1, 2); ATT_MAXP(sa0, sa1, 3); ATT_DECIDE2(true); } else { cc = cb_; off = 0.f; (void)ma_; (void)mb_; }
#pragma unroll
      for (int r = 0; r < 16; ++r) { sa0[r] = __builtin_amdgcn_exp2f(sa0[r] + off); sa1[r] = __builtin_amdgcn_exp2f(sa1[r] + off); }
      ATT_ROT(); }
    for (int t = 1; t < NT - 3; t += 2) {
        ATT_WAIT_BAR(3); ATT_DMA_TILE(t + 2, ksl2, vsl2); ATT_STEP(sb0, sb1, sa0, sa1, t);
        ATT_WAIT_BAR(3); ATT_DMA_TILE(t + 3, ksl2, vsl2); ATT_STEP(sa0, sa1, sb0, sb1, t + 1);
    }
    ATT_WAIT_BAR(3); ATT_DMA_TILE(NT - 1, ksl2, vsl2); ATT_STEP(sb0, sb1, sa0, sa1, NT - 3);
    ATT_WAIT_BAR(3); ATT_STEP(sa0, sa1, sb0, sb1, NT - 2);
    ATT_WAIT_BAR(0); ATT_STEP(sb0, sb1, sa0, sa1, NT - 1);
    { float sacc = 0.f;
#pragma unroll
      for (int r = 0; r < 16; ++r) sacc += sb0[r] + sb1[r];
      l_reg += sacc;
#pragma unroll
      for (int g = 0; g < 16; ++g) pw[g >> 2][g & 3] = cvt_pk_bf16(ATT_F(sb0, sb1, 2 * g), ATT_F(sb0, sb1, 2 * g + 1));
      const lds_cptr vp_ = vp0 + vprev;
#pragma unroll
      for (int ks = 0; ks < 4; ++ks)
#pragma unroll
          for (int db = 0; db < 4; ++db) { const s16x4 lo = vtr(vp_ + db * 4096 + ks * 1024), h4 = vtr(vp_ + db * 4096 + ks * 1024 + 512);
              const bf16x8 vf = (bf16x8){lo[0], lo[1], lo[2], lo[3], h4[0], h4[1], h4[2], h4[3]}; o[db] = ATT_MFMA(__builtin_bit_cast(bf16x8, pw[ks]), vf, o[db]); } }
#undef ATT_STEP
#undef ATT_RESC
#undef ATT_DECIDE2
#undef ATT_MAXP
#undef ATT_BIAS
#undef ATT_EX2
#undef ATT_EX3
#undef ATT_EX
#undef ATT_EX0
#undef ATT_EX0P
#undef ATT_EXF
#undef ATT_GBF
#undef ATT_GA
#undef ATT_VRD
#undef ATT_KRD
#undef ATT_F
#undef ATT_PIN
#undef ATT_SB
    { auto rr = __builtin_amdgcn_permlane32_swap(__float_as_uint(l_reg), __float_as_uint(l_reg), false, false); l_reg = __uint_as_float(rr[0]) + __uint_as_float(rr[1]); }
    LAS unsigned* redo_w = (LAS unsigned*)(lds + LDS_WSF + 2040);
    if (MODE == 1) { const bool bad_ = !(l_reg > 7.8886e-31f && l_reg < 1.2676e30f); if (__any(bad_) && lane == 0) *redo_w = 1u; }
    int lane_e = lane; asm volatile("" : "+v"(lane_e));
    const int r32_e = lane_e & 31, hi_e = lane_e >> 5;
    const float scale_q = (mp == 0 ? 1.0f : lam) * __builtin_amdgcn_rcpf(l_reg);
    if (hi_e == 0) wsf[r32_e] = scale_q;
    asm volatile("s_waitcnt lgkmcnt(0)" ::: "memory");
    float sc[16];
#pragma unroll
    for (int r = 0; r < 16; ++r) sc[r] = wsf[crow(r, hi_e)];
    f32x4* OXw = (f32x4*)OX + (size_t)wid * 16 * 64 + lane_e;
    if (mp == 1) {
#pragma unroll
        for (int db = 0; db < 4; ++db)
#pragma unroll
            for (int q4 = 0; q4 < 4; ++q4) OXw[(db * 4 + q4) * 64] = (f32x4){o[db][4 * q4] * sc[4 * q4], o[db][4 * q4 + 1] * sc[4 * q4 + 1], o[db][4 * q4 + 2] * sc[4 * q4 + 2], o[db][4 * q4 + 3] * sc[4 * q4 + 3]};
        asm volatile("s_waitcnt lgkmcnt(0)\n\ts_barrier" ::: "memory");
    } else {
        float ss[16];
#pragma unroll
        for (int r = 0; r < 16; ++r) ss[r] = 0.f;
#pragma unroll
        for (int db = 0; db < 4; ++db)
#pragma unroll
            for (int q4 = 0; q4 < 4; ++q4) { const f32x4 xv = OXw[(db * 4 + q4) * 64];
#pragma unroll
                for (int e = 0; e < 4; ++e) { const int r = 4 * q4 + e; const float d = o[db][r] * sc[r] - xv[e]; o[db][r] = d; ss[r] += d * d; } }
#pragma unroll
        for (int r = 0; r < 16; ++r) {
#pragma unroll
            for (int x = 1; x < 32; x <<= 1) ss[r] += __shfl_xor(ss[r], x);
            ss[r] = __builtin_amdgcn_rsqf(ss[r] * (1.0f / 128.0f) + EPS) * 0.8f;
        }
        asm volatile("s_waitcnt lgkmcnt(0)\n\ts_barrier" ::: "memory");
        LAS bf16_t* stg = (LAS bf16_t*)(lds + LDS_OST) + wid * 4096;
#pragma unroll
        for (int db = 0; db < 4; ++db) { const float g = subln_g[db * 32 + r32_e];
#pragma unroll
            for (int r = 0; r < 16; ++r) { const unsigned w = cvt_pk_bf16(o[db][r] * ss[r] * g, 0.f); stg[crow(r, hi_e) * 128 + db * 32 + r32_e] = (bf16_t)(w & 0xffffu); } }
        asm volatile("s_waitcnt lgkmcnt(0)" ::: "memory");
        bf16_t* Ow = MIXED + (rowbase + qw0) * 1024 + h * 128;
#pragma unroll
        for (int i = 0; i < 8; ++i) { const int row = i * 4 + (lane_e >> 4), ch = lane_e & 15; const u32x4 v = *(const LAS u32x4*)(stg + row * 128 + ch * 8); *(u32x4*)(Ow + (size_t)row * 1024 + ch * 8) = v; }
    }
    asm volatile("s_waitcnt vmcnt(0) lgkmcnt(0)\n\ts_barrier" ::: "memory");
    const bool redo_ = (MODE == 1) && (*(volatile LAS unsigned*)(lds + LDS_WSF + 2040) != 0u);
    asm volatile("s_waitcnt lgkmcnt(0)\n\ts_barrier" ::: "memory");
    return redo_;
#undef ATT_DMA_TILE
#undef ATT_ROT
}
}

namespace lru {
template <int N> __device__ __forceinline__ float dpp_shr(float v, float ident) {
    return __int_as_float(__builtin_amdgcn_update_dpp(__float_as_int(ident), __float_as_int(v), 0x110 + N, 0xF, 0xF, false));
}
#define LRU_MFMA16(a, b, c) __builtin_amdgcn_mfma_f32_16x16x32_bf16(a, b, c, 0, 0, 0)
__device__ __forceinline__ void lru_rows(bf16x8 (&rowv)[2][7], __amdgpu_buffer_rsrc_t xsrd, int dir, int Pb, int ch0) {
#pragma unroll
    for (int k = 0; k < 7; ++k) {
        const int tt = dir ? (S - Pb - k) : (Pb - 2 + k);
#pragma unroll
        for (int ks = 0; ks < 2; ++ks) rowv[ks][k] = __builtin_bit_cast(bf16x8, __builtin_amdgcn_raw_buffer_load_b128(xsrd, (tt * 512 + ch0 + 32 * ks) * 2, 0, 0));
    }
}
__device__ __forceinline__ void lru_item(int b, int cg, const bf16_t* XR, const bf16_t* GR, float* HF, bf16_t* MIXED, bf16_t* XC, unsigned* sib_cnt, LAS unsigned char* lds,
                                         const float* conv_w, const float* conv_b, const float* w_rg, const float* b_rg, const float* w_ig, const float* b_ig, const float* lru_lambda) {
    const int tid = threadIdx.x, lane = tid & 63, p = lane & 15, g = lane >> 4; const int wid = __builtin_amdgcn_readfirstlane(tid >> 6);
    const int n = cg >> 2, e16 = cg & 3, c0 = n * 64 + e16 * 16;
    const size_t rowbase = (size_t)b * S;
    const __amdgpu_buffer_rsrc_t XRb = __builtin_amdgcn_make_buffer_rsrc((void*)(XR + rowbase * 512), (short)0, S * 512 * 2, 0x00020000); const int ch0 = n * 64 + 8 * g;
    float* HFi = HF + ((size_t)(b * 32 + cg) * S) * 16;
    LAS float* tot = (LAS float*)(lds + att::LDS_TOT);
    bf16x8 idf;
#pragma unroll
    for (int j = 0; j < 8; ++j) idf[j] = ((8 * g + j) == (16 * (e16 & 1) + p)) ? (short)0x3f80 : (short)0;
    int par = 0;
    LAS float* cwl = (LAS float*)(lds + att::LDS_CW);
    if (tid < 320) { const int j = tid >> 6, c = tid & 63; cwl[tid] = (j < 4) ? conv_w[j * 512 + n * 64 + c] : conv_b[n * 64 + c]; }
    __syncthreads();
    {
        const int g8 = tid & 7, trow = tid >> 3;
        const int c8 = n * 64 + 8 * g8;
        f32x4 w0[4], w1[4];
#pragma unroll
        for (int j = 0; j < 4; ++j) { w0[j] = *(const LAS f32x4*)(cwl + j * 64 + 8 * g8); w1[j] = *(const LAS f32x4*)(cwl + j * 64 + 8 * g8 + 4); }
        const f32x4 bb0 = *(const LAS f32x4*)(cwl + 256 + 8 * g8), bb1 = *(const LAS f32x4*)(cwl + 256 + 8 * g8 + 4);
        for (int st = 0; st < 16; ++st) {
            const int tok = e16 * 1024 + st * 64 + trow;
            f32x4 a0 = bb0, a1 = bb1;
#pragma unroll
            for (int j = 0; j < 4; ++j) {
                const u32x4 rw = __builtin_amdgcn_raw_buffer_load_b128(XRb, ((tok + j - 2) * 512 + c8) * 2, 0, 0);
                a0 += w0[j] * (f32x4){__uint_as_float(rw[0] << 16), __uint_as_float(rw[0] & 0xffff0000u), __uint_as_float(rw[1] << 16), __uint_as_float(rw[1] & 0xffff0000u)};
                a1 += w1[j] * (f32x4){__uint_as_float(rw[2] << 16), __uint_as_float(rw[2] & 0xffff0000u), __uint_as_float(rw[3] << 16), __uint_as_float(rw[3] & 0xffff0000u)};
            }
            *(u32x4*)(XC + (rowbase + tok) * 512 + c8) = (u32x4){cvt_pk_bf16(a0[0], a0[1]), cvt_pk_bf16(a0[2], a0[3]), cvt_pk_bf16(a1[0], a1[1]), cvt_pk_bf16(a1[2], a1[3])};
        }
        asm volatile("s_waitcnt vmcnt(0)" ::: "memory");
        __syncthreads();
        if (tid == 0) {
            __builtin_amdgcn_fence(__ATOMIC_RELEASE, "agent");
            asm volatile("s_waitcnt vmcnt(0)" ::: "memory");
            __hip_atomic_fetch_add(sib_cnt, 1u, __ATOMIC_RELAXED, __HIP_MEMORY_SCOPE_AGENT);
            unsigned sp = 0;
            while (__hip_atomic_load(sib_cnt, __ATOMIC_RELAXED, __HIP_MEMORY_SCOPE_AGENT) < 4u) { __builtin_amdgcn_s_sleep(2); if (++sp > (1u << 22)) break; }
            __builtin_amdgcn_fence(__ATOMIC_ACQUIRE, "agent");
            asm volatile("s_waitcnt vmcnt(0)" ::: "memory");
        }
        __syncthreads();
    }
#pragma unroll
    for (int dir = 0; dir < 2; ++dir) {
        bf16x8 wrf[2], wif[2];
#pragma unroll
        for (int ks = 0; ks < 2; ++ks) {
            unsigned wr_[4], wi_[4];
#pragma unroll
            for (int j2 = 0; j2 < 4; ++j2) { const int d = 32 * ks + 8 * g + 2 * j2; const size_t i0 = ((size_t)((dir * 8 + n) * 64 + d)) * 64 + e16 * 16 + p;
                wr_[j2] = cvt_pk_bf16(w_rg[i0], w_rg[i0 + 64]); wi_[j2] = cvt_pk_bf16(w_ig[i0], w_ig[i0 + 64]); }
            wrf[ks] = __builtin_bit_cast(bf16x8, (u32x4){wr_[0], wr_[1], wr_[2], wr_[3]}); wif[ks] = __builtin_bit_cast(bf16x8, (u32x4){wi_[0], wi_[1], wi_[2], wi_[3]});
        }
        float br[4], bi[4], sp8[4], carry[4];
#pragma unroll
        for (int r = 0; r < 4; ++r) { const int c = dir * 512 + c0 + 4 * g + r; br[r] = b_rg[c] * -LOG2E; bi[r] = b_ig[c] * -LOG2E; const float lm = lru_lambda[c]; sp8[r] = 8.0f * LOG2E * ((-lm > 20.0f) ? -lm : log1pf(expf(-lm)));     carry[r] = 0.f; }
        LAS u32x4* lst = (LAS u32x4*)lds + tid;
        lst[0 * 512] = __builtin_bit_cast(u32x4, wrf[0]); lst[1 * 512] = __builtin_bit_cast(u32x4, wrf[1]); lst[2 * 512] = __builtin_bit_cast(u32x4, wif[0]); lst[3 * 512] = __builtin_bit_cast(u32x4, wif[1]);
        lst[4 * 512] = __builtin_bit_cast(u32x4, (f32x4){br[0], br[1], br[2], br[3]}); lst[5 * 512] = __builtin_bit_cast(u32x4, (f32x4){bi[0], bi[1], bi[2], bi[3]}); lst[6 * 512] = __builtin_bit_cast(u32x4, (f32x4){sp8[0], sp8[1], sp8[2], sp8[3]}); lst[7 * 512] = __builtin_bit_cast(u32x4, idf);
        bf16x8 xf[4][2];
#define LRU_XLOAD(PB_) do { _Pragma("unroll") for (int i = 0; i < 4; ++i) { const int tok_ = dir ? (S - 1 - ((PB_) + i)) : ((PB_) + i); \
            _Pragma("unroll") for (int ks = 0; ks < 2; ++ks) xf[i][ks] = *(const bf16x8*)(XC + (rowbase + tok_) * 512 + ch0 + 32 * ks); } } while (0)
        LRU_XLOAD(wid * 64 + 4 * p);
        for (int sc = 0; sc < 8; ++sc) {
            const int P0 = sc * 512 + wid * 64, Pb = P0 + 4 * p;
            f32x4 ar[4], ai[4], ax[4];
            {
                int zoff = 0; asm volatile("" : "+v"(zoff));
                const LAS u32x4* lsi = (const LAS u32x4*)lds + tid + zoff;
                const bf16x8 wrf0 = __builtin_bit_cast(bf16x8, lsi[0 * 512]), wrf1 = __builtin_bit_cast(bf16x8, lsi[1 * 512]), wif0 = __builtin_bit_cast(bf16x8, lsi[2 * 512]), wif1 = __builtin_bit_cast(bf16x8, lsi[3 * 512]), idf_ = __builtin_bit_cast(bf16x8, lsi[7 * 512]);
                const f32x4 z = (f32x4){0.f, 0.f, 0.f, 0.f};
#pragma unroll
                for (int i = 0; i < 4; ++i) {
                    ar[i] = LRU_MFMA16(wrf0, xf[i][0], z); ar[i] = LRU_MFMA16(wrf1, xf[i][1], ar[i]);
                    ai[i] = LRU_MFMA16(wif0, xf[i][0], z); ai[i] = LRU_MFMA16(wif1, xf[i][1], ai[i]);
                    ax[i] = LRU_MFMA16(idf_, (e16 & 2) ? xf[i][1] : xf[i][0], z);
                }
                __builtin_amdgcn_sched_barrier(0);
                if (sc < 7) LRU_XLOAD(Pb + 512);
            }
            float hh[4][4], cpp[4][4], Al[4], Hl[4];
            int zoff2 = 0; asm volatile("" : "+v"(zoff2));
            const LAS f32x4* lsg = (const LAS f32x4*)lds + tid + zoff2;
            const f32x4 brv = lsg[4 * 512], biv = lsg[5 * 512], spv = lsg[6 * 512];
#pragma unroll
            for (int r = 0; r < 4; ++r) {
                float h = 0.f, cp = 1.f;
#pragma unroll
                for (int i = 0; i < 4; ++i) {
                    const float rg = __builtin_amdgcn_rcpf(1.0f + __builtin_amdgcn_exp2f(ar[i][r] * -LOG2E + brv[r])), ig = __builtin_amdgcn_rcpf(1.0f + __builtin_amdgcn_exp2f(ai[i][r] * -LOG2E + biv[r]));
                    const float a_ = __builtin_amdgcn_exp2f(-rg * spv[r]);
                    const float om = __builtin_fmaf(-a_, a_, 1.0f);
                    const float u_ = __builtin_amdgcn_sqrtf(om) * (ig * ax[i][r]);
                    h = a_ * h + u_; cp = a_ * cp; hh[i][r] = h; cpp[i][r] = cp;
                }
                Al[r] = cp; Hl[r] = h;
            }
#define LRU_KS(NN) asm volatile("s_nop 1\n\t" \
        "v_fmac_f32_dpp %0, %0, %4 row_shr:" #NN " row_mask:0xf bank_mask:0xf\n\tv_fmac_f32_dpp %1, %1, %5 row_shr:" #NN " row_mask:0xf bank_mask:0xf\n\t" \
        "v_fmac_f32_dpp %2, %2, %6 row_shr:" #NN " row_mask:0xf bank_mask:0xf\n\tv_fmac_f32_dpp %3, %3, %7 row_shr:" #NN " row_mask:0xf bank_mask:0xf\n\t" \
        "v_mul_f32_dpp %4, %4, %4 row_shr:" #NN " row_mask:0xf bank_mask:0xf\n\tv_mul_f32_dpp %5, %5, %5 row_shr:" #NN " row_mask:0xf bank_mask:0xf\n\t" \
        "v_mul_f32_dpp %6, %6, %6 row_shr:" #NN " row_mask:0xf bank_mask:0xf\n\tv_mul_f32_dpp %7, %7, %7 row_shr:" #NN " row_mask:0xf bank_mask:0xf\n\ts_nop 1" \
        : "+v"(Hl[0]), "+v"(Hl[1]), "+v"(Hl[2]), "+v"(Hl[3]), "+v"(Al[0]), "+v"(Al[1]), "+v"(Al[2]), "+v"(Al[3]))
            LRU_KS(1); LRU_KS(2); LRU_KS(4); LRU_KS(8);
#undef LRU_KS
            float Aex[4], Hex[4];
#pragma unroll
            for (int r = 0; r < 4; ++r) { Aex[r] = dpp_shr<1>(Al[r], 1.0f); Hex[r] = dpp_shr<1>(Hl[r], 0.0f); }
            if (p == 15) {
#pragma unroll
                for (int r = 0; r < 4; ++r) { tot[((par * 8 + wid) * 16 + 4 * g + r) * 2] = Al[r]; tot[((par * 8 + wid) * 16 + 4 * g + r) * 2 + 1] = Hl[r]; }
            }
            asm volatile("s_waitcnt lgkmcnt(0)\n\ts_barrier" ::: "memory");
            float cin[4];
#pragma unroll
            for (int r = 0; r < 4; ++r) cin[r] = 0.f;
#pragma unroll
            for (int w = 0; w < 8; ++w) {
                const f32x4 t0 = *(const LAS f32x4*)(tot + ((par * 8 + w) * 16 + 4 * g) * 2), t1 = *(const LAS f32x4*)(tot + ((par * 8 + w) * 16 + 4 * g) * 2 + 4);
                const float Aw[4] = {t0[0], t0[2], t1[0], t1[2]}, Hw[4] = {t0[1], t0[3], t1[1], t1[3]};
#pragma unroll
                for (int r = 0; r < 4; ++r) { if (w == wid) cin[r] = carry[r]; carry[r] = Aw[r] * carry[r] + Hw[r]; }
            }
            par ^= 1;
            f32x4 hfv[4]; u32x2 gv[4];
            if (dir) {
#pragma unroll
                for (int i = 0; i < 4; ++i) { const int tok = S - 1 - (Pb + i); hfv[i] = *(const f32x4*)(HFi + (size_t)tok * 16 + 4 * g); gv[i] = *(const u32x2*)(GR + (rowbase + tok) * 512 + c0 + 4 * g); }
            }
            float cl[4];
#pragma unroll
            for (int r = 0; r < 4; ++r) cl[r] = Aex[r] * cin[r] + Hex[r];
#pragma unroll
            for (int i = 0; i < 4; ++i) {
                const int P = Pb + i; const int tok = dir ? (S - 1 - P) : P;
                f32x4 hv;
#pragma unroll
                for (int r = 0; r < 4; ++r) hv[r] = hh[i][r] + cpp[i][r] * cl[r];
                if (dir == 0) *(f32x4*)(HFi + (size_t)tok * 16 + 4 * g) = hv;
                else {
                    const float gr4[4] = {__uint_as_float(gv[i].x << 16), __uint_as_float(gv[i].x & 0xffff0000u), __uint_as_float(gv[i].y << 16), __uint_as_float(gv[i].y & 0xffff0000u)};
                    float y[4];
#pragma unroll
                    for (int r = 0; r < 4; ++r) { const float x = gr4[r]; const float gl = x * fast_sigmoid(1.5957691216057308f * (x + 0.044715f * x * x * x)); y[r] = gl * (hv[r] + hfv[i][r]); }
                    u32x2 w; w.x = cvt_pk_bf16(y[0], y[1]); w.y = cvt_pk_bf16(y[2], y[3]);
                    *(u32x2*)(MIXED + (rowbase + tok) * 1024 + 512 + c0 + 4 * g) = w;
                }
            }
        }
        __syncthreads();
    }
}
}
struct Args { const float* in[22]; float* out; unsigned char* ws; int ph_lo, ph_hi; };
constexpr int N_PHASES = 6;

__global__ void __launch_bounds__(NWAVES * 64, 2) mk_fwd(Args args) {
    extern __shared__ __attribute__((aligned(16))) unsigned char lds_raw[];
    LAS unsigned char* lds = (LAS unsigned char*)lds_raw;
    const int tid = threadIdx.x, lane = tid & 63; const int wave = __builtin_amdgcn_readfirstlane(tid >> 6);
    const int G = gridDim.x, bx = blockIdx.x; const int vcu = (G % 8 == 0) ? (bx % 8) * (G / 8) + bx / 8 : bx;
    unsigned char* ws = args.ws;
    const float* x = args.in[0]; float* out = args.out;
    bf16_t* WIN = (bf16_t*)(ws + WS_WIN); bf16_t* WOUT = (bf16_t*)(ws + WS_WOUT); bf16_t* WGU = (bf16_t*)(ws + WS_WGU); bf16_t* WDN = (bf16_t*)(ws + WS_WDN);
    float* RSS1 = (float*)(ws + WS_RSS1); float* RSS2 = (float*)(ws + WS_RSS2);
    bf16_t* XN = (bf16_t*)(ws + WS_XN); bf16_t* HB = XN;
    bf16_t* Qb = (bf16_t*)(ws + WS_Q); bf16_t* KT = (bf16_t*)(ws + WS_KT); bf16_t* VT = (bf16_t*)(ws + WS_VT); bf16_t* XR = (bf16_t*)(ws + WS_XR); bf16_t* GR = (bf16_t*)(ws + WS_GR);
    float* HF = (float*)(ws + WS_HF); bf16_t* MIXED = (bf16_t*)(ws + WS_MIXED); bf16_t* ACT = (bf16_t*)(ws + WS_ACT);
    const int lo = args.ph_lo, hi = args.ph_hi;
    volatile LAS unsigned* bst = (volatile LAS unsigned*)(lds + LDS_MISC + 8192);
    if (tid == 0) { bst[0] = 0u; bst[1] = 0u; bst[2] = 0u; }
    __syncthreads();
    xb::XcdBarrier bar = xb::xcd_barrier_post((unsigned*)ws, bst);
    if (lo > 1000) cooperative_groups::this_grid().sync();
#define IN(k) (lo <= (k) && (k) < hi)
#ifndef REP_PHASE
#define REP_PHASE -1
#endif
#define REPS(k) ((REP_PHASE == (k)) ? 2 : 1)
#define REPSYNC(k, rep) do { if ((rep) + 1 < REPS(k)) xb::xcd_barrier(bar); } while (0)
#define SEAM(k) do { if (IN(k) && IN((k) + 1)) { xb::xcd_barrier(bar); } } while (0)

    if (IN(0)) for (int rep = 0; rep < REPS(0); ++rep) {
        LAS float* scr = (LAS float*)(lds + wave * 16384);
        const int gw = vcu * NWAVES + wave, NGW = G * NWAVES;
        constexpr int I_IN = (D / 64) * (DIN / 32), I_OUT = (D / 64) * (D / 32), I_G = (D / 64) * (DFF / 32), I_DN = (DFF / 64) * (D / 32);
        constexpr int NITEMS = I_IN + I_OUT + 2 * I_G + I_DN;
        for (int it = gw; it < NITEMS; it += NGW) {
            int r = it;
            if (r < I_IN) { p0_transpose_item<0>(args.in[2], D, DIN, WIN, nullptr, scr, r, lane); continue; } r -= I_IN;
            if (r < I_OUT) { p0_transpose_item<0>(args.in[16], D, D, WOUT, nullptr, scr, r, lane); continue; } r -= I_OUT;
            if (r < I_G) { p0_transpose_item<1>(args.in[18], D, DFF, WGU, args.in[17], scr, r, lane); continue; } r -= I_G;
            if (r < I_G) { p0_transpose_item<2>(args.in[19], D, DFF, WGU, args.in[17], scr, r, lane); continue; } r -= I_G;
            p0_transpose_item<0>(args.in[20], DFF, D, WDN, nullptr, scr, r, lane);
        }
        for (int m = gw * 4; m < M; m += NGW * 4) rms_rows_to_bf16<4>(x + (size_t)m * D, args.in[1], XN + (size_t)m * D, lane);
        REPSYNC(0, rep);
    }
    SEAM(0);
    if (IN(1)) for (int rep = 0; rep < REPS(1); ++rep) {
        pg8::Gemm g{XN, WIN, M, DIN, D}; pg8::StaticOrder So; So.init(M, DIN, G, bx); So.rep = (REP_PHASE == 10) ? 2 : 1;
        pg8::EpiInProj E{Qb, KT, VT, XR, GR, QSCALE};
        pg8::gemm_phase<pg8::EpiInProj, pg8::StaticOrder, true, true>(lds, g, So, E);
        REPSYNC(1, rep);
    }
    SEAM(1);
    if (IN(2)) {
        float lam;
        { float s1 = 0.f, s2 = 0.f; for (int i = 0; i < 64; ++i) { s1 += args.in[3][i] * args.in[4][i]; s2 += args.in[5][i] * args.in[6][i]; } lam = expf(s1) - expf(s2) + 0.2f; }
#if REP_PHASE == 79
        { const long long pr0 = wall_clock64();
          for (int rnd = 0; rnd * G + vcu < NB * NH * 32; ++rnd) { (void)att::attn_unit<ATT_PROBE, 0, 1>(vcu >> 5, rnd, (vcu & 31) >> 1, Qb, KT, VT, (bf16_t*)(ws + WS_XC), (float*)(ws + WS_OX) + (size_t)vcu * 32768, lds, lam, args.in[7], args.in[8]); }
          __syncthreads();
          if (bx == 0 && tid == 0) { const long long dr = wall_clock64() - pr0; ((float*)ws)[30000] = (float)dr * 2.0e-6f; } }
#endif
#if REP_PHASE == 77 || REP_PHASE == 78
        const long long pc0 = clock64(), pr0 = wall_clock64();
#endif
        for (int rep = 0; rep < REPS(20); ++rep)
        for (int pr = vcu; pr < NB * NH * 16; pr += G) {
            int b_, h_, qb_; if (G == 256) { const int l = vcu & 31, rp = pr / G; b_ = vcu >> 5; h_ = 2 * rp + (l >> 4); qb_ = l & 15; } else { qb_ = pr & 15; h_ = (pr >> 4) & 3; b_ = pr >> 6; }
            const float* const* kin = (const float* const*)__builtin_amdgcn_kernarg_segment_ptr(); asm volatile("" : "+s"(kin));
            unsigned char* ws2 = *(unsigned char* const*)((const char*)kin + 23 * 8);
            const bf16_t* Qb2 = (const bf16_t*)(ws2 + WS_Q); const bf16_t* KT2 = (const bf16_t*)(ws2 + WS_KT); const bf16_t* VT2 = (const bf16_t*)(ws2 + WS_VT); bf16_t* MX2 = (bf16_t*)(ws2 + WS_MIXED);
            float* OXc = (float*)(ws2 + WS_OX) + ((size_t)vcu * 2 + (size_t)(pr / G)) * 32768; const float* sg2 = kin[7]; const float* rb2 = kin[8];
            if (att::attn_unit<0, 1, 1>(b_, h_, qb_, Qb2, KT2, VT2, MX2, OXc, lds, lam, sg2, rb2))
                (void)att::attn_unit<0, 0, 1>(b_, h_, qb_, Qb2, KT2, VT2, MX2, OXc, lds, lam, sg2, rb2);
            if (att::attn_unit<0, 1, 0>(b_, h_, qb_, Qb2, KT2, VT2, MX2, OXc, lds, lam, sg2, rb2))
                (void)att::attn_unit<0, 0, 0>(b_, h_, qb_, Qb2, KT2, VT2, MX2, OXc, lds, lam, sg2, rb2);
        }
        for (int rep = 0; rep < REPS(21); ++rep)
        for (int it = vcu; it < NB * 32; it += G) {
            const int b_ = it >> 5, cg = it & 31;
            lru::lru_item(b_, cg, XR, GR, HF, MIXED, (bf16_t*)(ws + WS_XC), (unsigned*)ws + 16384 + 64 * (it >> 2), lds, args.in[9], args.in[10], args.in[11], args.in[12], args.in[13], args.in[14], args.in[15]);
        }
    }
#if REP_PHASE == 78
    if (IN(2) && bx == 0 && tid == 0) { const long long dc = clock64() - pc0_, dr = wall_clock64() - pr0_; ((float*)ws)[30000] = (float)dc / ((float)dr * 10.0f) * 0.05f; }
#endif
    SEAM(2);
    if (IN(3)) for (int rep = 0; rep < REPS(3); ++rep) {
        pg8::Gemm g{MIXED, WOUT, M, D, D}; pg8::StaticOrder So; So.init(M, D, G, bx);
        pg8::EpiResid<true, false> E{x, out, HB, RSS1, D};
        pg8::gemm_phase<pg8::EpiResid<true, false>, pg8::StaticOrder, true, true>(lds, g, So, E);
        REPSYNC(3, rep);
    }
    SEAM(3);
    if (IN(4)) for (int rep = 0; rep < REPS(4); ++rep) {
        float* RSTD = (float*)(ws + WS_RSTD);
        for (int r = vcu * 128 + (tid >> 2); r < M; r += G * 128) {
            const f32x4 sv = *(const f32x4*)(RSS1 + (size_t)r * 16 + 4 * (tid & 3)); float s = (sv[0] + sv[1]) + (sv[2] + sv[3]);
            s += __shfl_xor(s, 1); s += __shfl_xor(s, 2);
            if ((tid & 3) == 0) RSTD[r] = __builtin_amdgcn_rsqf(s * (1.0f / D) + EPS);
        }
        xb::xcd_barrier(bar);
        pg8::Gemm g{HB, WGU, M, 2 * DFF, D}; pg8::StaticOrder So; So.init(M, 2 * DFF, G, bx); So.rep = (REP_PHASE == 40) ? 2 : 1;
        pg8::EpiGateUp E{ACT, RSTD, DFF};
        pg8::gemm_phase<pg8::EpiGateUp, pg8::StaticOrder, true, true>(lds, g, So, E);
        REPSYNC(4, rep);
    }
    SEAM(4);
    if (IN(5)) for (int rep = 0; rep < REPS(5); ++rep) {
        if (G == 256) {
#pragma unroll 1
            for (int half = 0; half < 2; ++half) {
                const size_t r0 = (size_t)half * (M / 2);
                pg8::Gemm g{ACT + r0 * DFF, WDN, M / 2, D, DFF}; pg8::StaticOrder So; So.init(M / 2, D, G, bx);
                pg8::EpiDownNorm E{HB + r0 * D, out + r0 * D, args.in[21], RSS2 + r0 * 4, (unsigned*)ws + 4096 + 64 * 64 * half, D, EPS, ws};
                pg8::gemm_phase<pg8::EpiDownNorm, pg8::StaticOrder, false, true>(lds, g, So, E);
                __syncthreads();
            }
        }
        REPSYNC(5, rep);
    }
#if REP_PHASE == 99
    for (int i = 0; i < 20; ++i) xb::xcd_barrier(bar);
#endif
#undef IN
#undef SEAM
}
}
namespace dbg {
using namespace mk;
__global__ void __launch_bounds__(256) k_unpack_proj(const bf16_t* Qb, const bf16_t* KT, const bf16_t* VT, const bf16_t* XR, const bf16_t* GR, float* q, float* k, float* v, float* xr, float* gr) {
    const size_t idx = (size_t)blockIdx.x * 256 + threadIdx.x;
    const int c = (int)(idx & 511); const int row = (int)(idx >> 9); const int b = row >> 12, tok = row & 4095, t = tok >> 6, rr = tok & 63;
    q[idx] = bf2f(Qb[idx]) * (1.0f / QSCALE);
    { const int h = c >> 7, w = c & 127, s = w >> 6, d = w & 63, chunk = d >> 3, j = d & 7;
      k[idx] = bf2f(KT[((((size_t)(b * 4 + h) * 2 + s) * 64 + t) * 8 + chunk) * 512 + rr * 8 + j]); }
    { const int h = c >> 7, dv = c & 127, db = dv >> 5, cc = dv & 31;
      v[idx] = bf2f(VT[(((size_t)(b * 4 + h) * 64 + t) * 4 + db) * 2048 + rr * 32 + cc]); }
    xr[idx] = bf2f(XR[idx]); gr[idx] = bf2f(GR[idx]);
}
__global__ void __launch_bounds__(256) k_unpack_bf16(const bf16_t* src, float* dst) { const size_t idx = (size_t)blockIdx.x * 256 + threadIdx.x; dst[idx] = bf2f(src[idx]); }
}

#ifndef STAGE
#define STAGE 4
#endif
static void mk_launch_phases(const mk::Args& a0, int lo, int hi, int grid, hipStream_t stream, bool coop) {
    mk::Args a = a0; a.ph_lo = lo; a.ph_hi = hi;
    if (coop) { void* args[] = {&a}; hipError_t e = hipLaunchCooperativeKernel((const void*)mk::mk_fwd, dim3(grid), dim3(mk::NWAVES * 64), args, mk::LDS_BYTES, stream);
        if (e != hipSuccess) fprintf(stderr, "cooperative launch failed: %s (grid %d)\n", hipGetErrorString(e), grid); }
    else { hipLaunchKernelGGL(mk::mk_fwd, dim3(grid), dim3(mk::NWAVES * 64), mk::LDS_BYTES, stream, a); }
}

extern "C" void kernel_launch(void* const* d_in, const int* in_sizes, int n_in, void* d_out, int out_size, void* d_ws, size_t ws_size, hipStream_t stream) {
    static int grid = 0;
    if (grid == 0) {
        int dev = 0, cus = 0, per_cu = 0;
        hipGetDevice(&dev); hipDeviceGetAttribute(&cus, hipDeviceAttributeMultiprocessorCount, dev);
        if (hipFuncSetAttribute((const void*)mk::mk_fwd, hipFuncAttributeMaxDynamicSharedMemorySize, mk::LDS_BYTES) != hipSuccess) { fprintf(stderr, "hipFuncSetAttribute failed\n"); grid = -1; return; }
        if (hipOccupancyMaxActiveBlocksPerMultiprocessor(&per_cu, (const void*)mk::mk_fwd, mk::NWAVES * 64, mk::LDS_BYTES) != hipSuccess || per_cu < 1) { fprintf(stderr, "occupancy query: %d\n", per_cu); per_cu = 1; }
        (void)hipGetLastError();
        grid = cus * 1;
        if (n_in != 22 || ws_size < 512u * mk::MiB) fprintf(stderr, "kernel_launch: unexpected n_in %d / ws_size %zu\n", n_in, ws_size);
    }
    if (grid < 0) return;
    if (hipMemsetAsync(d_ws, 0, 131072, stream) != hipSuccess) { fprintf(stderr, "memset failed\n"); return; }
    mk::Args a{};
    for (int i = 0; i < 22; ++i) a.in[i] = (const float*)d_in[i];
    a.out = (float*)d_out; a.ws = (unsigned char*)d_ws;
    char* ws = (char*)d_ws; const size_t MiB = 1u << 20;
#if STAGE == 4
    mk_launch_phases(a, 0, mk::N_PHASES, grid, stream, true);
#elif STAGE == 3
    for (int p = 0; p < mk::N_PHASES; ++p) mk_launch_phases(a, p, p + 1, grid, stream, false);
#elif STAGE == 1
    for (int p = 0; p < 2; ++p) mk_launch_phases(a, p, p + 1, grid, stream, false);
    float* q = (float*)(ws + 32 * MiB), *k = (float*)(ws + 256 * MiB), *v = (float*)(ws + 320 * MiB), *xr = (float*)(ws + 384 * MiB), *gr = (float*)(ws + 448 * MiB);
    dbg::k_unpack_proj<<<mk::M * 512 / 256, 256, 0, stream>>>((const mk::bf16_t*)(ws + mk::WS_Q), (const mk::bf16_t*)(ws + mk::WS_KT), (const mk::bf16_t*)(ws + mk::WS_VT), (const mk::bf16_t*)(ws + mk::WS_XR), (const mk::bf16_t*)(ws + mk::WS_GR), q, k, v, xr, gr);
    float* mixed = (float*)(ws + 96 * MiB);
    nv::naive_mid(d_in, q, k, v, xr, gr, mixed, stream);
    nv::naive_tail(d_in, mixed, (float*)d_out, (float*)(ws + 0), (float*)(ws + 128 * MiB), stream);
#elif STAGE == 2
    for (int p = 0; p < 3; ++p) mk_launch_phases(a, p, p + 1, grid, stream, false);
    float* mixed = (float*)(ws + 0);
    dbg::k_unpack_bf16<<<mk::M * 1024 / 256, 256, 0, stream>>>((const mk::bf16_t*)(ws + mk::WS_MIXED), mixed);
    nv::naive_tail(d_in, mixed, (float*)d_out, (float*)(ws + 0), (float*)(ws + 128 * MiB), stream);
#endif
}
```

```cpp
#include <hip/hip_runtime.h>
#include <hip/hip_cooperative_groups.h>
#include <cstdio>
#include <cstdint>
#include <cmath>
#define STAGE 4
namespace pg8 {
#define PG8_LAS __attribute__((address_space(3)))
typedef unsigned short bf16_t;
typedef short bf16x8 __attribute__((ext_vector_type(8)));
typedef float f32x4 __attribute__((ext_vector_type(4)));
typedef unsigned u32x4 __attribute__((ext_vector_type(4)));
constexpr int BM = 256, BK = 64, HALF = 128, HTB = HALF * BK * 2  , STAGE_BYTES = 8 * HTB, NXCD = 8, WGM = 8;

__host__ __device__ __forceinline__ int lds_byte(int r, int c) { const int st = (r >> 4) * 2 + (c >> 5), rr = r & 15, cc = c & 31, ob = rr * 64 + cc * 2; return st * 1024 + (ob ^ (((ob >> 9) & 1) << 5)); }
__host__ __device__ __forceinline__ void stage_rc(int b, int& R, int& C) { const int st = b / 1024, sb = b % 1024, swz = sb ^ (((sb >> 9) & 1) << 5); R = (st >> 1) * 16 + swz / 64; C = (st & 1) * 32 + (swz % 64) / 2; }
__host__ __device__ __forceinline__ int perm32(int rho) { const int n = rho >> 4, i = rho & 15; return 8 * (i >> 2) + 4 * n + (i & 3); }

struct Unit { int pm, pn; };
struct Gemm { const bf16_t* A; const bf16_t* Bt; int M, N, K; };

struct StaticOrder {
    int nM, nN, nwg, G, c, rep;
    __host__ __device__ void init(int M, int N, int G_, int c_) { nM = M / BM; nN = N / BM; nwg = nM * nN; G = G_; c = c_; rep = 1; }
    __host__ __device__ bool next(int i, Unit& u) const {
        const long L = (long)(i / rep) * G + c; if (L >= nwg) return false;
        int wgid = (int)L; { const int q = nwg / NXCD, r = nwg % NXCD, xcd = wgid % NXCD, off = wgid / NXCD; wgid = (xcd < r ? xcd * (q + 1) : r * (q + 1) + (xcd - r) * q) + off; }
        const int nig = WGM * nN, gid = wgid / nig, fm = gid * WGM, gsz = (nM - fm) < WGM ? (nM - fm) : WGM;
        u.pm = fm + ((wgid % nig) % gsz); u.pn = (wgid % nig) / gsz; return true;
    }
    __device__ __forceinline__ void a_ready(const Unit&) const {}
    __device__ __forceinline__ void done(const Unit&) const {}
};

struct SegOrder {
    int pm0, pn0, c0, pm1, pn1, c1, st;
    __host__ __device__ bool next(int i, Unit& u) const { if (i < c0) { u.pm = pm0; u.pn = pn0 + st * i; return true; } i -= c0; if (i < c1) { u.pm = pm1; u.pn = pn1 + st * i; return true; } return false; }
    __device__ __forceinline__ void a_ready(const Unit&) const {}
    __device__ __forceinline__ void done(const Unit&) const {}
};

typedef float f32x2_cv __attribute__((ext_vector_type(2))); typedef __bf16 bf16x2_cv __attribute__((ext_vector_type(2)));
__device__ __forceinline__ unsigned cvt_pk_bf16(float lo, float hi) { f32x2_cv v = {lo, hi}; bf16x2_cv b = __builtin_convertvector(v, bf16x2_cv); return __builtin_bit_cast(unsigned, b); }
typedef float f32x2 __attribute__((ext_vector_type(2)));
typedef unsigned u32x2 __attribute__((ext_vector_type(2)));
__device__ __forceinline__ u32x4 pack8(f32x4 v0, f32x4 v1) { u32x4 w; w.x = cvt_pk_bf16(v0[0], v0[1]); w.y = cvt_pk_bf16(v0[2], v0[3]); w.z = cvt_pk_bf16(v1[0], v1[1]); w.w = cvt_pk_bf16(v1[2], v1[3]); return w; }
struct EpiInProj {
    static constexpr bool PERM = true, AFTER_DRAIN = false;
    bf16_t *Q, *KT, *VT, *XR, *GR; float qscale;
    __device__ __forceinline__ void operator()(const f32x4 (&acc)[2][2][4][2], const Unit& u, int wr, int wc, int fr, int fq) const {
        const int sec = u.pn >> 1, half = u.pn & 1;
#pragma unroll
        for (int ai = 0; ai < 2; ++ai)
#pragma unroll
            for (int m = 0; m < 4; ++m) {
                const int row = u.pm * BM + ai * HALF + wr * 64 + m * 16 + fr;
                const int b = row >> 12, tok = row & 4095, t = tok >> 6, rr = tok & 63;
#pragma unroll
                for (int bj = 0; bj < 2; ++bj) {
                    f32x4 v0 = acc[ai][bj][m][0], v1 = acc[ai][bj][m][1];
                    const int cs = half * 256 + bj * HALF + wc * 32 + 8 * fq;
                    if (sec == 0) { v0 = v0 * qscale; v1 = v1 * qscale; *(u32x4*)(Q + (size_t)row * 512 + cs) = pack8(v0, v1); }
                    else if (sec == 1) { const int h = half * 2 + bj, s = wc >> 1, chunk = 4 * (wc & 1) + fq;
                        *(u32x4*)(KT + ((((size_t)(b * 4 + h) * 2 + s) * 64 + t) * 8 + chunk) * 512 + rr * 8) = pack8(v0, v1); }
                    else if (sec == 2) { const int h = half * 2 + bj;
                        *(u32x4*)(VT + (((size_t)(b * 4 + h) * 64 + t) * 4 + wc) * 2048 + rr * 32 + 8 * fq) = pack8(v0, v1); }
                    else if (sec == 3) { *(u32x4*)(XR + (size_t)row * 512 + cs) = pack8(v0, v1); }
                    else { *(u32x4*)(GR + (size_t)row * 512 + cs) = pack8(v0, v1); }
                }
            }
    }
};
template <bool WRITE_HB, bool WRITE_F32 = true> struct EpiResid {
    static constexpr bool PERM = false, AFTER_DRAIN = false;
    const float* base; float* out; bf16_t* hb; float* rss; int ldc;
    __device__ __forceinline__ void operator()(const f32x4 (&acc)[2][2][4][2], const Unit& u, int wr, int wc, int fr, int fq) const {
        const int col0 = u.pn * BM + wc * 32 + 4 * fq;
        f32x4 nx[2][2];
        { const size_t off0 = (size_t)(u.pm * BM + wr * 64 + fr) * ldc + col0;
#pragma unroll
          for (int bj = 0; bj < 2; ++bj)
#pragma unroll
              for (int n = 0; n < 2; ++n) nx[bj][n] = *(const f32x4*)(base + off0 + bj * HALF + n * 16); }
#pragma unroll
        for (int gi = 0; gi < 8; ++gi) {
            const int ai = gi >> 2, m = gi & 3;
            const int row = u.pm * BM + ai * HALF + wr * 64 + m * 16 + fr; const size_t off = (size_t)row * ldc + col0; float ss = 0.f;
            f32x4 cur[2][2];
#pragma unroll
            for (int bj = 0; bj < 2; ++bj)
#pragma unroll
                for (int n = 0; n < 2; ++n) cur[bj][n] = nx[bj][n];
            if (gi < 7) { const int ai2 = (gi + 1) >> 2, m2 = (gi + 1) & 3; const size_t off2 = (size_t)(u.pm * BM + ai2 * HALF + wr * 64 + m2 * 16 + fr) * ldc + col0;
#pragma unroll
                for (int bj = 0; bj < 2; ++bj)
#pragma unroll
                    for (int n = 0; n < 2; ++n) nx[bj][n] = *(const f32x4*)(base + off2 + bj * HALF + n * 16); }
#pragma unroll
            for (int bj = 0; bj < 2; ++bj)
#pragma unroll
                for (int n = 0; n < 2; ++n) {
                    const f32x4 o = acc[ai][bj][m][n] + cur[bj][n];
                    if (WRITE_F32) *(f32x4*)(out + off + bj * HALF + n * 16) = o;
                    if (WRITE_HB) { u32x2 w; w.x = cvt_pk_bf16(o[0], o[1]); w.y = cvt_pk_bf16(o[2], o[3]); *(u32x2*)(hb + off + bj * HALF + n * 16) = w; }
                    ss += (o[0] * o[0] + o[1] * o[1]) + (o[2] * o[2] + o[3] * o[3]);
                }
            ss += __shfl_xor(ss, 16); ss += __shfl_xor(ss, 32);
            if (fq == 0) rss[(size_t)row * 16 + u.pn * 4 + wc] = ss;
        }
    }
};
struct EpiGateUp {
    static constexpr bool PERM = true, AFTER_DRAIN = false;
    bf16_t* act; const float* rstd; int ldo;
    __device__ __forceinline__ void operator()(const f32x4 (&acc)[2][2][4][2], const Unit& u, int wr, int wc, int fr, int fq) const {
        const int col0 = u.pn * HALF + wc * 32 + 8 * fq;
        float rs[2][4];
#pragma unroll
        for (int ai = 0; ai < 2; ++ai)
#pragma unroll
            for (int m = 0; m < 4; ++m) rs[ai][m] = rstd[u.pm * BM + ai * HALF + wr * 64 + m * 16 + fr];
#pragma unroll
        for (int ai = 0; ai < 2; ++ai)
#pragma unroll
            for (int m = 0; m < 4; ++m) {
                const int row = u.pm * BM + ai * HALF + wr * 64 + m * 16 + fr;
                const float r_ = rs[ai][m], c1 = r_ * -1.4426950408889634f, r2 = r_ * r_;
                f32x4 o[2];
#pragma unroll
                for (int n = 0; n < 2; ++n) {
                    const f32x4 g = acc[ai][0][m][n], up = acc[ai][1][m][n];
#pragma unroll
                    for (int i = 0; i < 4; ++i) { const float e = __builtin_amdgcn_exp2f(g[i] * c1); o[n][i] = (g[i] * up[i]) * (r2 * __builtin_amdgcn_rcpf(1.0f + e)); }
                }
                *(u32x4*)(act + (size_t)row * ldo + col0) = pack8(o[0], o[1]);
            }
    }
};
struct EpiGateUpL {
    static constexpr bool PERM = true, AFTER_DRAIN = false;
    bf16_t* act; const PG8_LAS float* rl; int pm0; int ldo;
    __device__ __forceinline__ void operator()(const f32x4 (&acc)[2][2][4][2], const Unit& u, int wr, int wc, int fr, int fq) const {
        const int col0 = u.pn * HALF + wc * 32 + 8 * fq;
        float rs[2][4];
#pragma unroll
        for (int ai = 0; ai < 2; ++ai)
#pragma unroll
            for (int m = 0; m < 4; ++m) rs[ai][m] = rl[((u.pm != pm0) ? 256 : 0) + ai * HALF + wr * 64 + m * 16 + fr];
#pragma unroll
        for (int ai = 0; ai < 2; ++ai)
#pragma unroll
            for (int m = 0; m < 4; ++m) {
                const int row = u.pm * BM + ai * HALF + wr * 64 + m * 16 + fr;
                const float r_ = rs[ai][m], c1 = r_ * -1.4426950408889634f, r2 = r_ * r_;
                f32x4 o[2];
#pragma unroll
                for (int n = 0; n < 2; ++n) {
                    const f32x4 g = acc[ai][0][m][n], up = acc[ai][1][m][n];
#pragma unroll
                    for (int i = 0; i < 4; ++i) { const float e = __builtin_amdgcn_exp2f(g[i] * c1); o[n][i] = (g[i] * up[i]) * (r2 * __builtin_amdgcn_rcpf(1.0f + e)); }
                }
                *(u32x4*)(act + (size_t)row * ldo + col0) = pack8(o[0], o[1]);
            }
    }
};

struct EpiDownNorm {
    static constexpr bool PERM = false, AFTER_DRAIN = true;
    const bf16_t* hb; float* out; const float* gain; float* xbuf; unsigned* cnt; int ldc; float eps; const void* cnt_base_probe;
    __device__ __forceinline__ void fused(f32x4 (&acc)[2][2][4][2], const Unit& u, int wr, int wc, int fr, int fq, PG8_LAS unsigned char* lds, int wid, int lane) const {
        PG8_LAS float* P = (PG8_LAS float*)lds;
        PG8_LAS float* Sx = (PG8_LAS float*)(lds + 4096);
        PG8_LAS unsigned* flag = (PG8_LAS unsigned*)(lds + 4096 + 1024);
        const int col0 = u.pn * BM + wc * 32 + 4 * fq;
        u32x2 nx[2][2];
        { const size_t off0 = (size_t)(u.pm * BM + wr * 64 + fr) * ldc + col0;
#pragma unroll
          for (int bj = 0; bj < 2; ++bj)
#pragma unroll
              for (int n = 0; n < 2; ++n) nx[bj][n] = *(const u32x2*)(hb + off0 + bj * HALF + n * 16); }
#pragma unroll
        for (int gi = 0; gi < 8; ++gi) {
            const int ai = gi >> 2, m = gi & 3;
            const int r = ai * HALF + wr * 64 + m * 16 + fr; float ss = 0.f;
            u32x2 cur[2][2];
#pragma unroll
            for (int bj = 0; bj < 2; ++bj)
#pragma unroll
                for (int n = 0; n < 2; ++n) cur[bj][n] = nx[bj][n];
            if (gi < 7) { const int ai2 = (gi + 1) >> 2, m2 = (gi + 1) & 3; const size_t off2 = (size_t)(u.pm * BM + ai2 * HALF + wr * 64 + m2 * 16 + fr) * ldc + col0;
#pragma unroll
                for (int bj = 0; bj < 2; ++bj)
#pragma unroll
                    for (int n = 0; n < 2; ++n) nx[bj][n] = *(const u32x2*)(hb + off2 + bj * HALF + n * 16); }
#pragma unroll
            for (int bj = 0; bj < 2; ++bj)
#pragma unroll
                for (int n = 0; n < 2; ++n) {
                    const u32x2 hv = cur[bj][n];
                    const f32x4 h4 = (f32x4){__uint_as_float(hv.x << 16), __uint_as_float(hv.x & 0xffff0000u), __uint_as_float(hv.y << 16), __uint_as_float(hv.y & 0xffff0000u)};
                    const f32x4 o = acc[ai][bj][m][n] + h4; acc[ai][bj][m][n] = o;
                    ss += (o[0] * o[0] + o[1] * o[1]) + (o[2] * o[2] + o[3] * o[3]);
                }
            ss += __shfl_xor(ss, 16); ss += __shfl_xor(ss, 32);
            if (fq == 0) P[r * 4 + wc] = ss;
        }
        asm volatile("s_waitcnt lgkmcnt(0)" ::: "memory"); __builtin_amdgcn_s_barrier(); asm volatile("" ::: "memory");
        const int row = wid * 32 + (lane & 31);
        if (lane < 32) {
            const float s = (P[row * 4 + 0] + P[row * 4 + 1]) + (P[row * 4 + 2] + P[row * 4 + 3]);
            __hip_atomic_store(xbuf + (size_t)(u.pm * BM + row) * 4 + u.pn, s, __ATOMIC_RELAXED, __HIP_MEMORY_SCOPE_AGENT);
        }
        asm volatile("s_waitcnt vmcnt(0)" ::: "memory");
        if (lane == 0) __hip_atomic_fetch_add(cnt + 64 * u.pm, 1u, __ATOMIC_RELAXED, __HIP_MEMORY_SCOPE_AGENT);
        if (wid == 0) {
            unsigned sp = 0;
            for (;;) {
                if ((unsigned)__builtin_amdgcn_readfirstlane(__hip_atomic_load(cnt + 64 * u.pm, __ATOMIC_RELAXED, __HIP_MEMORY_SCOPE_AGENT)) >= 32u) break;
                if (++sp > (1u << 22)) break;
                __builtin_amdgcn_s_sleep(2);
            }
            __builtin_amdgcn_fence(__ATOMIC_ACQUIRE, "agent");
            if (lane == 0) flag[0] = 0u;
        }
        asm volatile("s_waitcnt vmcnt(0) lgkmcnt(0)" ::: "memory"); __builtin_amdgcn_s_barrier(); asm volatile("" ::: "memory");
        if (lane < 32) {
            const float* slot = xbuf + (size_t)(u.pm * BM + row) * 4;
            const float a = __hip_atomic_load(slot + 0, __ATOMIC_RELAXED, __HIP_MEMORY_SCOPE_AGENT), b = __hip_atomic_load(slot + 1, __ATOMIC_RELAXED, __HIP_MEMORY_SCOPE_AGENT),
                        c = __hip_atomic_load(slot + 2, __ATOMIC_RELAXED, __HIP_MEMORY_SCOPE_AGENT), d = __hip_atomic_load(slot + 3, __ATOMIC_RELAXED, __HIP_MEMORY_SCOPE_AGENT);
            Sx[row] = 1.0f / sqrtf(((a + b) + (c + d)) * (1.0f / 1024.0f) + eps);
        }
        asm volatile("s_waitcnt lgkmcnt(0)" ::: "memory"); __builtin_amdgcn_s_barrier(); asm volatile("" ::: "memory");
        f32x4 gv[2][2];
#pragma unroll
        for (int bj = 0; bj < 2; ++bj)
#pragma unroll
            for (int n = 0; n < 2; ++n) gv[bj][n] = *(const f32x4*)(gain + col0 + bj * HALF + n * 16);
#if defined(REP_PHASE) && (REP_PHASE == 77 || REP_PHASE == 79 || REP_PHASE == 80)
        { const float sc_ = 1.0f + ((const float*)cnt_base_probe)[30000];
#pragma unroll
          for (int bj = 0; bj < 2; ++bj)
#pragma unroll
              for (int n = 0; n < 2; ++n) gv[bj][n] = gv[bj][n] * sc_; }
#endif
#pragma unroll
        for (int ai = 0; ai < 2; ++ai)
#pragma unroll
            for (int m = 0; m < 4; ++m) {
                const int r = ai * HALF + wr * 64 + m * 16 + fr; const float rs = Sx[r]; const size_t off = (size_t)(u.pm * BM + r) * ldc + col0;
#pragma unroll
                for (int bj = 0; bj < 2; ++bj)
#pragma unroll
                    for (int n = 0; n < 2; ++n) *(f32x4*)(out + off + bj * HALF + n * 16) = acc[ai][bj][m][n] * rs * gv[bj][n];
            }
    }
};
struct EpiDownNormStream {
    static constexpr bool PERM = false, AFTER_DRAIN = false;
    const bf16_t* hb; float* out; const float* gain; float* xbuf; unsigned* cnt; int ldc; float eps; const void* cnt_base_probe; PG8_LAS unsigned char* lds_x;
    __device__ __forceinline__ void operator()(const f32x4 (&acc_in)[2][2][4][2], const Unit& u, int wr, int wc, int fr, int fq) const {
        PG8_LAS unsigned char* lds = lds_x; const int lane = threadIdx.x & 63, wid = __builtin_amdgcn_readfirstlane(threadIdx.x >> 6);
        f32x4 acc[2][2][4][2];
#pragma unroll
        for (int a_ = 0; a_ < 2; ++a_)
#pragma unroll
            for (int b_ = 0; b_ < 2; ++b_)
#pragma unroll
                for (int m_ = 0; m_ < 4; ++m_)
#pragma unroll
                    for (int n_ = 0; n_ < 2; ++n_) acc[a_][b_][m_][n_] = acc_in[a_][b_][m_][n_];
        PG8_LAS float* P = (PG8_LAS float*)lds;
        PG8_LAS float* Sx = (PG8_LAS float*)(lds + 4096);
        PG8_LAS unsigned* flag = (PG8_LAS unsigned*)(lds + 4096 + 1024);
        const int col0 = u.pn * BM + wc * 32 + 4 * fq;
        u32x2 nx[2][2];
        { const size_t off0 = (size_t)(u.pm * BM + wr * 64 + fr) * ldc + col0;
#pragma unroll
          for (int bj = 0; bj < 2; ++bj)
#pragma unroll
              for (int n = 0; n < 2; ++n) nx[bj][n] = *(const u32x2*)(hb + off0 + bj * HALF + n * 16); }
#pragma unroll
        for (int gi = 0; gi < 8; ++gi) {
            const int ai = gi >> 2, m = gi & 3;
            const int r = ai * HALF + wr * 64 + m * 16 + fr; float ss = 0.f;
            u32x2 cur[2][2];
#pragma unroll
            for (int bj = 0; bj < 2; ++bj)
#pragma unroll
                for (int n = 0; n < 2; ++n) cur[bj][n] = nx[bj][n];
            if (gi < 7) { const int ai2 = (gi + 1) >> 2, m2 = (gi + 1) & 3; const size_t off2 = (size_t)(u.pm * BM + ai2 * HALF + wr * 64 + m2 * 16 + fr) * ldc + col0;
#pragma unroll
                for (int bj = 0; bj < 2; ++bj)
#pragma unroll
                    for (int n = 0; n < 2; ++n) nx[bj][n] = *(const u32x2*)(hb + off2 + bj * HALF + n * 16); }
#pragma unroll
            for (int bj = 0; bj < 2; ++bj)
#pragma unroll
                for (int n = 0; n < 2; ++n) {
                    const u32x2 hv = cur[bj][n];
                    const f32x4 h4 = (f32x4){__uint_as_float(hv.x << 16), __uint_as_float(hv.x & 0xffff0000u), __uint_as_float(hv.y << 16), __uint_as_float(hv.y & 0xffff0000u)};
                    const f32x4 o = acc[ai][bj][m][n] + h4; acc[ai][bj][m][n] = o;
                    ss += (o[0] * o[0] + o[1] * o[1]) + (o[2] * o[2] + o[3] * o[3]);
                }
            ss += __shfl_xor(ss, 16); ss += __shfl_xor(ss, 32);
            if (fq == 0) P[r * 4 + wc] = ss;
        }
        asm volatile("s_waitcnt lgkmcnt(0)" ::: "memory"); __builtin_amdgcn_s_barrier(); asm volatile("" ::: "memory");
        const int row = wid * 32 + (lane & 31);
        if (lane < 32) {
            const float s = (P[row * 4 + 0] + P[row * 4 + 1]) + (P[row * 4 + 2] + P[row * 4 + 3]);
            __hip_atomic_store(xbuf + (size_t)(u.pm * BM + row) * 4 + u.pn, s, __ATOMIC_RELAXED, __HIP_MEMORY_SCOPE_AGENT);
        }
        asm volatile("s_waitcnt vmcnt(0)" ::: "memory");
        if (lane == 0) __hip_atomic_fetch_add(cnt + 64 * u.pm, 1u, __ATOMIC_RELAXED, __HIP_MEMORY_SCOPE_AGENT);
        if (wid == 0) {
            unsigned sp = 0;
            for (;;) {
                if ((unsigned)__builtin_amdgcn_readfirstlane(__hip_atomic_load(cnt + 64 * u.pm, __ATOMIC_RELAXED, __HIP_MEMORY_SCOPE_AGENT)) >= 32u) break;
                if (++sp > (1u << 22)) break;
                __builtin_amdgcn_s_sleep(2);
            }
            __builtin_amdgcn_fence(__ATOMIC_ACQUIRE, "agent");
            if (lane == 0) flag[0] = 0u;
        }
        asm volatile("s_waitcnt vmcnt(0) lgkmcnt(0)" ::: "memory"); __builtin_amdgcn_s_barrier(); asm volatile("" ::: "memory");
        if (lane < 32) {
            const float* slot = xbuf + (size_t)(u.pm * BM + row) * 4;
            const float a = __hip_atomic_load(slot + 0, __ATOMIC_RELAXED, __HIP_MEMORY_SCOPE_AGENT), b = __hip_atomic_load(slot + 1, __ATOMIC_RELAXED, __HIP_MEMORY_SCOPE_AGENT),
                        c = __hip_atomic_load(slot + 2, __ATOMIC_RELAXED, __HIP_MEMORY_SCOPE_AGENT), d = __hip_atomic_load(slot + 3, __ATOMIC_RELAXED, __HIP_MEMORY_SCOPE_AGENT);
            Sx[row] = 1.0f / sqrtf(((a + b) + (c + d)) * (1.0f / 1024.0f) + eps);
        }
        asm volatile("s_waitcnt lgkmcnt(0)" ::: "memory"); __builtin_amdgcn_s_barrier(); asm volatile("" ::: "memory");
        f32x4 gv[2][2];
#pragma unroll
        for (int bj = 0; bj < 2; ++bj)
#pragma unroll
            for (int n = 0; n < 2; ++n) gv[bj][n] = *(const f32x4*)(gain + col0 + bj * HALF + n * 16);
#if defined(REP_PHASE) && (REP_PHASE == 77 || REP_PHASE == 79 || REP_PHASE == 80)
        { const float sc_ = 1.0f + ((const float*)cnt_base_probe)[30000];
#pragma unroll
          for (int bj = 0; bj < 2; ++bj)
#pragma unroll
              for (int n = 0; n < 2; ++n) gv[bj][n] = gv[bj][n] * sc_; }
#endif
#pragma unroll
        for (int ai = 0; ai < 2; ++ai)
#pragma unroll
            for (int m = 0; m < 4; ++m) {
                const int r = ai * HALF + wr * 64 + m * 16 + fr; const float rs = Sx[r]; const size_t off = (size_t)(u.pm * BM + r) * ldc + col0;
#pragma unroll
                for (int bj = 0; bj < 2; ++bj)
#pragma unroll
                    for (int n = 0; n < 2; ++n) *(f32x4*)(out + off + bj * HALF + n * 16) = acc[ai][bj][m][n] * rs * gv[bj][n];
            }
    }
};
template <class Epi, class Sched, bool ALIGN_EPI = false, bool SP2 = false>
__device__ __forceinline__ void gemm_phase(PG8_LAS unsigned char* lds, const Gemm g, const Sched& S, const Epi& E, const int tid_in = -1) {
    const int tid = (tid_in >= 0) ? tid_in : (int)threadIdx.x, wid = __builtin_amdgcn_readfirstlane(tid >> 6), lane = tid & 63, wr = wid >> 2, wc = wid & 3, fr = lane & 15, fq = lane >> 4;
    const int K = g.K, nt = K / BK;
    unsigned voffA[2], voffB[2];
#pragma unroll
    for (int i = 0; i < 2; ++i) { int R, C; stage_rc(tid * 16 + i * 8192, R, C); const int Rb = Epi::PERM ? ((R & ~31) + perm32(R & 31)) : R;
        voffA[i] = (unsigned)(R * K + C) * 2u; voffB[i] = (unsigned)(Rb * K + C) * 2u; }
    const size_t kstep = (size_t)(BK * 2);
    const size_t hstep = (size_t)HALF * K * 2;
    const size_t tstep = 2 * hstep;
    const unsigned ldsw = (unsigned)wid * 1024u;
    const int aoff = lds_byte(wr * 64 + fr, fq * 8), boff = lds_byte(wc * 32 + fr, fq * 8);
#define PG8_SA(b, h) (((b) * 2 + (h)) * HTB)
#define PG8_SB(b, h) ((4 + (b) * 2 + (h)) * HTB)
#define PG8_STAGE(bufoff, gbase, voff) do { _Pragma("unroll") for (int _i = 0; _i < 2; ++_i) \
        __builtin_amdgcn_global_load_lds((const unsigned*)((const char*)(gbase) + (voff)[_i]), (PG8_LAS unsigned*)(lds + (bufoff) + ldsw + _i * 8192), 16, 0, 0); } while (0)
#define PG8_LDA(dst, b, h) do { _Pragma("unroll") for (int m = 0; m < 4; ++m) _Pragma("unroll") for (int k = 0; k < 2; ++k) dst[m][k] = *(const PG8_LAS bf16x8*)(lds + PG8_SA(b, h) + aoff + m * 2048 + k * 1024); } while (0)
#define PG8_LDB(dst, b, h) do { _Pragma("unroll") for (int n = 0; n < 2; ++n) _Pragma("unroll") for (int k = 0; k < 2; ++k) dst[n][k] = *(const PG8_LAS bf16x8*)(lds + PG8_SB(b, h) + boff + n * 2048 + k * 1024); } while (0)
#define PG8_MMA(ai, bj, At, Bt) do { __builtin_amdgcn_s_setprio(1); _Pragma("unroll") for (int m = 0; m < 4; ++m) _Pragma("unroll") for (int n = 0; n < 2; ++n) _Pragma("unroll") for (int k = 0; k < 2; ++k) \
        acc[ai][bj][m][n] = __builtin_amdgcn_mfma_f32_16x16x32_bf16(Bt[n][k], At[m][k], acc[ai][bj][m][n], 0, 0, 0); __builtin_amdgcn_s_setprio(0); } while (0)
#define PG8_WAIT_V(n) asm volatile("s_waitcnt vmcnt(" #n ")" ::: "memory")
#define PG8_WAIT_L(n) asm volatile("s_waitcnt lgkmcnt(" #n ")" ::: "memory")
#define PG8_BAR __builtin_amdgcn_s_barrier()
#define PG8_SCHED __builtin_amdgcn_sched_barrier(0)
    Unit cur, nxt; int ui = 0;
    if (!S.next(0, cur)) return;
    f32x4 acc[2][2][4][2];
#pragma unroll
    for (int a = 0; a < 2; ++a)
#pragma unroll
        for (int b = 0; b < 2; ++b)
#pragma unroll
            for (int m = 0; m < 4; ++m)
#pragma unroll
                for (int n = 0; n < 2; ++n) acc[a][b][m][n] = (f32x4){0.f, 0.f, 0.f, 0.f};
    bf16x8 At[4][2], B0[2][2], B1[2][2];
    const char* cA = (const char*)g.A + (size_t)cur.pm * tstep; const char* cB = (const char*)g.Bt + (size_t)cur.pn * tstep;
    S.a_ready(cur);
    if constexpr (SP2) {
        PG8_STAGE(PG8_SB(0, 0), cB, voffB); PG8_STAGE(PG8_SB(0, 1), cB + hstep, voffB); PG8_STAGE(PG8_SA(0, 0), cA, voffA); PG8_STAGE(PG8_SA(0, 1), cA + hstep, voffA);
        if (wr == 1) PG8_BAR;
        PG8_WAIT_V(2); PG8_BAR;
        PG8_STAGE(PG8_SB(1, 0), cB + kstep, voffB); PG8_STAGE(PG8_SA(1, 0), cA + kstep, voffA); PG8_STAGE(PG8_SB(1, 1), cB + hstep + kstep, voffB);
        PG8_WAIT_V(6); PG8_BAR;
    } else {
        PG8_STAGE(PG8_SB(0, 0), cB, voffB); PG8_STAGE(PG8_SA(0, 0), cA, voffA); PG8_STAGE(PG8_SB(0, 1), cB + hstep, voffB); PG8_STAGE(PG8_SA(0, 1), cA + hstep, voffA);
        if (wr == 1) PG8_BAR;
        PG8_WAIT_V(4); PG8_BAR;
        PG8_STAGE(PG8_SB(1, 0), cB + kstep, voffB); PG8_STAGE(PG8_SA(1, 0), cA + kstep, voffA); PG8_STAGE(PG8_SB(1, 1), cB + hstep + kstep, voffB);
        PG8_WAIT_V(6); PG8_BAR;
    }
    for (;;) {
        const bool has_next = S.next(ui + 1, nxt);
        const char* nA = has_next ? (const char*)g.A + (size_t)nxt.pm * tstep : cA; const char* nB = has_next ? (const char*)g.Bt + (size_t)nxt.pn * tstep : cB;
        for (int t = 0; t < nt; t += 2) {
            const bool last = (t == nt - 2);
            const char* a1 = cA + (size_t)(t + 1) * kstep;
            const char* a2 = last ? nA : cA + (size_t)(t + 2) * kstep; const char* b2 = last ? nB : cB + (size_t)(t + 2) * kstep;
            const char* a3 = a2 + kstep; const char* b3 = b2 + kstep;
            if (last && has_next) S.a_ready(nxt);
            if constexpr (SP2) {
            PG8_LDB(B0, 0, 0); PG8_LDB(B1, 0, 1); PG8_SCHED; PG8_LDA(At, 0, 0); PG8_STAGE(PG8_SA(1, 1), a1 + hstep, voffA);
            PG8_WAIT_V(8); PG8_WAIT_L(0); PG8_BAR; PG8_MMA(0, 0, At, B0); PG8_MMA(0, 1, At, B1); PG8_BAR; PG8_SCHED;
            PG8_LDA(At, 0, 1); PG8_STAGE(PG8_SB(0, 0), b2, voffB); PG8_STAGE(PG8_SB(0, 1), b2 + hstep, voffB); PG8_STAGE(PG8_SA(0, 0), a2, voffA);
            PG8_WAIT_V(8); PG8_WAIT_L(0); PG8_BAR; PG8_MMA(1, 0, At, B0); PG8_MMA(1, 1, At, B1); PG8_BAR; PG8_SCHED;
            PG8_LDB(B0, 1, 0); PG8_LDB(B1, 1, 1); PG8_SCHED; PG8_LDA(At, 1, 0); PG8_STAGE(PG8_SA(0, 1), a2 + hstep, voffA);
            PG8_WAIT_V(8); PG8_WAIT_L(0); PG8_BAR; PG8_MMA(0, 0, At, B0); PG8_MMA(0, 1, At, B1); PG8_BAR; PG8_SCHED;
            PG8_LDA(At, 1, 1); PG8_STAGE(PG8_SB(1, 0), b3, voffB); PG8_STAGE(PG8_SB(1, 1), b3 + hstep, voffB); PG8_STAGE(PG8_SA(1, 0), a3, voffA);
            PG8_WAIT_V(8); PG8_WAIT_L(0); PG8_BAR; PG8_MMA(1, 0, At, B0); PG8_MMA(1, 1, At, B1); PG8_BAR; PG8_SCHED;
            } else {
            PG8_LDB(B0, 0, 0); PG8_SCHED; PG8_LDA(At, 0, 0); PG8_STAGE(PG8_SA(1, 1), a1 + hstep, voffA);
            PG8_WAIT_L(8); PG8_BAR; PG8_WAIT_L(0); PG8_MMA(0, 0, At, B0); PG8_BAR; PG8_SCHED;
            PG8_LDB(B1, 0, 1); PG8_STAGE(PG8_SB(0, 0), b2, voffB);
            PG8_BAR; PG8_WAIT_L(0); PG8_MMA(0, 1, At, B1); PG8_BAR;
            PG8_LDA(At, 0, 1); PG8_STAGE(PG8_SA(0, 0), a2, voffA);
            PG8_BAR; PG8_WAIT_L(0); PG8_MMA(1, 0, At, B0); PG8_BAR; PG8_SCHED;
            PG8_STAGE(PG8_SB(0, 1), b2 + hstep, voffB);
            PG8_WAIT_V(6); PG8_BAR; PG8_MMA(1, 1, At, B1); PG8_BAR;
            PG8_LDB(B0, 1, 0); PG8_SCHED; PG8_LDA(At, 1, 0); PG8_STAGE(PG8_SA(0, 1), a2 + hstep, voffA);
            PG8_WAIT_L(8); PG8_BAR; PG8_WAIT_L(0); PG8_MMA(0, 0, At, B0); PG8_BAR; PG8_SCHED;
            PG8_LDB(B1, 1, 1); PG8_STAGE(PG8_SB(1, 0), b3, voffB);
            PG8_BAR; PG8_WAIT_L(0); PG8_MMA(0, 1, At, B1); PG8_BAR;
            PG8_LDA(At, 1, 1); PG8_STAGE(PG8_SA(1, 0), a3, voffA);
            PG8_BAR; PG8_WAIT_L(0); PG8_MMA(1, 0, At, B0); PG8_BAR; PG8_SCHED;
            PG8_STAGE(PG8_SB(1, 1), b3 + hstep, voffB);
            PG8_WAIT_V(6); PG8_BAR; PG8_MMA(1, 1, At, B1); PG8_BAR;
            }
        }
        if constexpr (ALIGN_EPI) { if (wr == 0) PG8_BAR; }
        if constexpr (!Epi::AFTER_DRAIN) { E(acc, cur, wr, wc, fr, fq); S.done(cur); }
        if (!has_next) break;
#pragma unroll
        for (int a = 0; a < 2; ++a)
#pragma unroll
            for (int b = 0; b < 2; ++b)
#pragma unroll
                for (int m = 0; m < 4; ++m)
#pragma unroll
                    for (int n = 0; n < 2; ++n) acc[a][b][m][n] = (f32x4){0.f, 0.f, 0.f, 0.f};
        cur = nxt; cA = nA; cB = nB; ++ui;
        if constexpr (ALIGN_EPI) { if (wr == 1) PG8_BAR; }
    }
    PG8_WAIT_V(0);
    if constexpr (!ALIGN_EPI) { if (wr == 0) PG8_BAR; }
    PG8_BAR;
    if constexpr (Epi::AFTER_DRAIN) { E.fused(acc, cur, wr, wc, fr, fq, lds, wid, lane); S.done(cur); }
#undef PG8_SA
#undef PG8_SB
#undef PG8_STAGE
#undef PG8_LDA
#undef PG8_LDB
#undef PG8_MMA
#undef PG8_WAIT_V
#undef PG8_WAIT_L
#undef PG8_BAR
#undef PG8_SCHED
}
}
namespace xb {
#define LAS __attribute__((address_space(3)))
#define XB_TMO      128
#define XB_XCNT(j)  (256  + 64 * (j))
#define XB_XSUB(j)  (1280 + 64 * (j))
#define XB_XGEN(j)  (2304 + 64 * (j))
#define XB_TOP      3328
#define XB_TOPGEN   3392
#define XCD_BAR_WORDS 3456
#define XB_SPIN_CAP (1u << 18)

__device__ __forceinline__ unsigned xb_ld(unsigned* p)              { return __hip_atomic_load(p, __ATOMIC_RELAXED, __HIP_MEMORY_SCOPE_AGENT); }
__device__ __forceinline__ unsigned xb_add(unsigned* p, unsigned v) { return __hip_atomic_fetch_add(p, v, __ATOMIC_RELAXED, __HIP_MEMORY_SCOPE_AGENT); }
__device__ __forceinline__ unsigned xb_xcc_id() { return (unsigned)__builtin_amdgcn_s_getreg((3 << 11) | 20) & 0xFu; }
#define XB_SPIN(cond, bar) do { unsigned _sp = 0; while (cond) { __builtin_amdgcn_s_sleep(1); \
    if ((++_sp & 255u) == 0u) { if (xb_ld(&(bar)[XB_TMO])) break; if (_sp > XB_SPIN_CAP) { atomicAdd(&(bar)[XB_TMO], 1u); break; } } } } while (0)

struct XcdBarrier {
    unsigned* bar; unsigned x;
    volatile LAS unsigned* st;
};

__device__ __forceinline__ XcdBarrier xcd_barrier_post(unsigned* bar, volatile LAS unsigned* st) {
    XcdBarrier b; b.bar = bar; b.x = xb_xcc_id(); b.st = st;
    if (threadIdx.x == 0) st[2] = xb_add(&bar[XB_XCNT(b.x)], 1u);
    return b;
}
__device__ __forceinline__ void xcd_barrier_complete(unsigned* bar, unsigned x, unsigned& nloc, unsigned& nx) {
    const unsigned G = gridDim.x * gridDim.y * gridDim.z;
    unsigned sum, cnt, mine, sp = 0u;
    for (;;) {
        sum = 0u; cnt = 0u; mine = 0u;
#pragma unroll
        for (unsigned j = 0; j < 16; ++j) { const unsigned c = xb_ld(&bar[XB_XCNT(j)]); sum += c; cnt += (c > 0u) ? 1u : 0u; mine = (j == x) ? c : mine; }
        if (sum == G) break;
        __builtin_amdgcn_s_sleep(1);
        if ((++sp & 255u) == 0u) { if (xb_ld(&bar[XB_TMO])) break; if (sp > XB_SPIN_CAP) { atomicAdd(&bar[XB_TMO], 1u); break; } }
    }
    nloc = mine > 0u ? mine : 1u; nx = cnt > 0u ? cnt : 1u;
}

__device__ __forceinline__ void xcd_barrier(const XcdBarrier& b) {
    asm volatile("s_waitcnt vmcnt(0)" ::: "memory");
    __syncthreads();
    if (threadIdx.x == 0) {
        unsigned* bar = b.bar;
        __builtin_amdgcn_s_waitcnt(0);
        unsigned nloc = b.st[0], nx = b.st[1];
        if (nloc == 0u) { xcd_barrier_complete(bar, b.x, nloc, nx); b.st[0] = nloc; b.st[1] = nx; }
        const unsigned old = xb_add(&bar[XB_XSUB(b.x)], 1u);
        const unsigned gen = old / nloc;
        if (old + 1u == (gen + 1u) * nloc) {
            __builtin_amdgcn_fence(__ATOMIC_RELEASE, "agent");
            asm volatile("s_waitcnt vmcnt(0)" ::: "memory");
            const unsigned og = xb_add(&bar[XB_TOP], 1u);
            const unsigned tg = og / nx;
            if (og + 1u == (tg + 1u) * nx) xb_add(&bar[XB_TOPGEN], 1u);
            else XB_SPIN(xb_ld(&bar[XB_TOPGEN]) == tg, bar);
            __builtin_amdgcn_fence(__ATOMIC_ACQUIRE, "agent");
            xb_add(&bar[XB_XGEN(b.x)], 1u);
            asm volatile("s_waitcnt vmcnt(0)" ::: "memory");
        } else {
            XB_SPIN(xb_ld(&bar[XB_XGEN(b.x)]) == gen, bar);
            __builtin_amdgcn_fence(__ATOMIC_ACQUIRE, "agent");
            asm volatile("s_waitcnt vmcnt(0)" ::: "memory");
        }
    }
    __syncthreads();
}

}
namespace mk {
#define LAS __attribute__((address_space(3)))
typedef unsigned short bf16_t;
typedef short bf16x8 __attribute__((ext_vector_type(8)));
typedef short s16x4 __attribute__((ext_vector_type(4)));
typedef float f32x4 __attribute__((ext_vector_type(4)));
typedef float f32x16 __attribute__((ext_vector_type(16)));
typedef unsigned u32x4 __attribute__((ext_vector_type(4)));
typedef unsigned u32x2 __attribute__((ext_vector_type(2)));
constexpr int NB = 8, S = 4096, D = 1024, M = NB * S, NH = 4, DFF = 2816, DIN = 2560, NWAVES = 8;
constexpr float EPS = 1e-6f, LOG2E = 1.4426950408889634f;
constexpr float QSCALE = 0.125f * LOG2E;
constexpr size_t MiB = 1u << 20;
constexpr size_t WS_WIN = 1 * MiB, WS_WOUT = 6 * MiB, WS_WGU = 8 * MiB, WS_WDN = 19 * MiB, WS_RSS1 = 25 * MiB, WS_RSS2 = 27 * MiB, WS_RSTD = 29 * MiB;
constexpr size_t WS_XN = 32 * MiB, WS_Q = 96 * MiB, WS_KT = 128 * MiB, WS_VT = 160 * MiB, WS_XR = 192 * MiB, WS_GR = 224 * MiB, WS_HF = 256 * MiB, WS_MIXED = 320 * MiB, WS_ACT = 96 * MiB, WS_XC = 384 * MiB, WS_OX = 416 * MiB, WS_END = 480 * MiB;
static_assert(WS_ACT + (size_t)M * DFF * 2 <= WS_MIXED, "act overlays Q..HF only");
constexpr int RING_BYTES = 131072, LDS_MISC = 131072, LDS_LST = 147456  , LDS_BYTES = 163840;

__device__ __forceinline__ unsigned cvt_pk_bf16(float lo, float hi) { return pg8::cvt_pk_bf16(lo, hi); }
__device__ __forceinline__ float bf2f(unsigned short b) { return __uint_as_float(((unsigned)b) << 16); }
__device__ __forceinline__ float wave_sum(float v) {
#pragma unroll
    for (int o = 1; o < 64; o <<= 1) v += __shfl_xor(v, o);
    return v;
}
__device__ __forceinline__ float fast_sigmoid(float x) { return __builtin_amdgcn_rcpf(1.0f + __builtin_amdgcn_exp2f(-LOG2E * x)); }

template <int MAP  >
__device__ __forceinline__ void p0_transpose_item(const float* W, int K, int N, bf16_t* WT, const float* gk, LAS float* scr, int item, int lane) {
    const int nblk = N / 32, kb = item / nblk, nb = item % nblk, k0 = 64 * kb, n0 = 32 * nb;
#pragma unroll
    for (int i = 0; i < 8; ++i) { const int kk = 8 * i + (lane >> 3); f32x4 v = __builtin_nontemporal_load((const f32x4*)(W + (size_t)(k0 + kk) * N + n0 + 4 * (lane & 7))); if (gk) v = v * gk[k0 + kk];
        LAS float* d = scr + kk * 33 + 4 * (lane & 7); d[0] = v[0]; d[1] = v[1]; d[2] = v[2]; d[3] = v[3]; }
    asm volatile("s_waitcnt lgkmcnt(0)" ::: "memory");
    const int c = lane & 7;
#pragma unroll
    for (int j = 0; j < 4; ++j) { const int n = (lane >> 3) + 8 * j; const LAS float* s = scr + (8 * c) * 33 + n;
        u32x4 o; o.x = cvt_pk_bf16(s[0 * 33], s[1 * 33]); o.y = cvt_pk_bf16(s[2 * 33], s[3 * 33]); o.z = cvt_pk_bf16(s[4 * 33], s[5 * 33]); o.w = cvt_pk_bf16(s[6 * 33], s[7 * 33]);
        const int f = n0 + n; const int drow = (MAP == 0) ? f : (256 * (f >> 7) + (f & 127) + (MAP == 2 ? 128 : 0));
        *(u32x4*)(WT + (size_t)drow * K + k0 + 8 * c) = o; }
    asm volatile("s_waitcnt lgkmcnt(0)" ::: "memory");
}
template <int NR>
__device__ __forceinline__ void rms_rows_to_bf16(const float* xrow, const float* g, bf16_t* orow, int lane) {
    const f32x4* gr = (const f32x4*)g + lane;
    f32x4 v[NR][4]; float s[NR];
#pragma unroll
    for (int q = 0; q < NR; ++q) { const f32x4* xr = (const f32x4*)(xrow + (size_t)q * D) + lane;
#pragma unroll
        for (int j = 0; j < 4; ++j) v[q][j] = __builtin_nontemporal_load(xr + 64 * j); }
#pragma unroll
    for (int q = 0; q < NR; ++q) { float a = 0.f;
#pragma unroll
        for (int j = 0; j < 4; ++j) a += (v[q][j][0] * v[q][j][0] + v[q][j][1] * v[q][j][1]) + (v[q][j][2] * v[q][j][2] + v[q][j][3] * v[q][j][3]);
        s[q] = a; }
#pragma unroll
    for (int o = 1; o < 64; o <<= 1)
#pragma unroll
        for (int q = 0; q < NR; ++q) s[q] += __shfl_xor(s[q], o);
    f32x4 gg[4];
#pragma unroll
    for (int j = 0; j < 4; ++j) gg[j] = gr[64 * j];
#pragma unroll
    for (int q = 0; q < NR; ++q) { const float rstd = 1.0f / sqrtf(s[q] * (1.f / D) + EPS); u32x2* o8 = (u32x2*)(orow + (size_t)q * D) + lane;
#pragma unroll
        for (int j = 0; j < 4; ++j) { u32x2 w; w.x = cvt_pk_bf16(v[q][j][0] * rstd * gg[j][0], v[q][j][1] * rstd * gg[j][1]); w.y = cvt_pk_bf16(v[q][j][2] * rstd * gg[j][2], v[q][j][3] * rstd * gg[j][3]); o8[64 * j] = w; } }
}

namespace att {
constexpr int NT = S / 64, SLOT = 16384, KSLOT = 8192, LDS_K = 0, LDS_V = 3 * KSLOT, LDS_OST = 0;
constexpr int LDS_WSF = LDS_MISC, LDS_BIAS = LDS_MISC + 2048, LDS_TOT = LDS_MISC + 3072, LDS_CW = LDS_MISC + 5120, LDS_BIAS2 = LDS_MISC + 8704;
constexpr int THR = 8;
typedef LAS const char* lds_cptr;
typedef short v4i16_t __attribute__((ext_vector_type(4)));
__device__ __forceinline__ int crow(int r, int hi) { return (r & 3) + 8 * (r >> 2) + 4 * hi; }
__device__ __forceinline__ void glds16(const void* gsrc, unsigned lds_dst) { unsigned keep;
    asm volatile("s_mov_b32 %0, m0\n\ts_mov_b32 m0, %2\n\ts_nop 0\n\tglobal_load_lds_dwordx4 %1, off\n\ts_mov_b32 m0, %0" : "=&s"(keep) : "v"(gsrc), "s"(lds_dst) : "memory"); }
__device__ __forceinline__ s16x4 vtr(lds_cptr p) { return __builtin_bit_cast(s16x4, __builtin_amdgcn_ds_read_tr16_b64_v4i16((LAS v4i16_t*)p)); }
#define ATT_MX3(a, b, c) __builtin_fmaxf(__builtin_fmaxf((a), (b)), (c))
__device__ __forceinline__ float rowmax(const f32x16& p0, const f32x16& p1) {
    float a = ATT_MX3(p0[0], p0[1], p1[0]), b = ATT_MX3(p0[2], p0[3], p1[1]); a = ATT_MX3(a, p1[2], p1[3]);
#pragma unroll
    for (int r = 4; r < 16; r += 4) { a = ATT_MX3(a, p0[r], p0[r + 1]); b = ATT_MX3(b, p0[r + 2], p0[r + 3]); a = ATT_MX3(a, p1[r], p1[r + 1]); b = ATT_MX3(b, p1[r + 2], p1[r + 3]); }
    float m = __builtin_fmaxf(a, b); auto rr = __builtin_amdgcn_permlane32_swap(__float_as_uint(m), __float_as_uint(m), false, false);
    return __builtin_fmaxf(__uint_as_float(rr[0]), __uint_as_float(rr[1]));
}
#define ATT_WAIT_BAR(N) do { if (ABL == 4) asm volatile("s_waitcnt vmcnt(" #N ") lgkmcnt(0)" ::: "memory"); else asm volatile("s_waitcnt vmcnt(" #N ") lgkmcnt(0)\n\ts_barrier" ::: "memory"); } while (0)
#define ATT_MFMA(a, b, c) __builtin_amdgcn_mfma_f32_32x32x16_bf16(a, b, c, 0, 0, 0)

template <bool FIRST>
__device__ __forceinline__ void tile_h1(int t, lds_cptr kp, const bf16x8 (&qr)[4], f32x16 (&o)[4], u32x4 (&pw)[4], float& mhat, float& l_reg,
                                        LAS float* wsf, const LAS float* btab, int qrow, int qw0, float c_left, float c_right, int r32, int hi) {
    const int relmin = 64 * t - qw0 - 31, relmax = 64 * t + 63 - qw0;
    const bool band = !(relmax <= -91 || relmin >= 91);
    const float cb = band ? 0.f : (relmin >= 91 ? c_right : c_left);
    f32x16 p0, p1;
    const f32x16 z16 = (f32x16){0.f, 0.f, 0.f, 0.f, 0.f, 0.f, 0.f, 0.f, 0.f, 0.f, 0.f, 0.f, 0.f, 0.f, 0.f, 0.f};
#pragma unroll
    for (int d0 = 0; d0 < 4; ++d0) {
        const bf16x8 k0 = *(const LAS bf16x8*)(kp + d0 * 2048), k1 = *(const LAS bf16x8*)(kp + d0 * 2048 + 512);
        if (d0 == 0) { p0 = ATT_MFMA(k0, qr[0], z16); p1 = ATT_MFMA(k1, qr[0], z16); }
        else { p0 = ATT_MFMA(k0, qr[d0], p0); p1 = ATT_MFMA(k1, qr[d0], p1); }
    }
    if (band) {
        const int relb = 64 * t + 4 * hi - qrow + 128;
#pragma unroll
        for (int r = 0; r < 16; ++r) { const int i0 = relb + (r & 3) + 8 * (r >> 2); const int a0 = i0 < 0 ? 0 : (i0 > 255 ? 255 : i0); const int i1 = i0 + 32; const int a1 = i1 < 0 ? 0 : (i1 > 255 ? 255 : i1);
            p0[r] += btab[a0]; p1[r] += btab[a1]; }
    }
    const float rm = rowmax(p0, p1) + cb;
    if (FIRST) { mhat = rm; }
    else if (__builtin_expect(__any(rm - mhat > (float)THR), 0)) {
        const float dl = __builtin_fmaxf(rm - mhat, 0.f); mhat += dl;
        const float f = __builtin_amdgcn_exp2f(-dl); l_reg *= f;
        if (hi == 0) wsf[r32] = f;
        asm volatile("s_waitcnt lgkmcnt(0)" ::: "memory");
        float fr[16];
#pragma unroll
        for (int r = 0; r < 16; ++r) fr[r] = wsf[crow(r, hi)];
#pragma unroll
        for (int db = 0; db < 4; ++db)
#pragma unroll
            for (int r = 0; r < 16; ++r) o[db][r] *= fr[r];
        asm volatile("s_waitcnt lgkmcnt(0)" ::: "memory");
    }
    const float off = cb - mhat;
    float sacc = 0.f;
#pragma unroll
    for (int r = 0; r < 16; ++r) { p0[r] = __builtin_amdgcn_exp2f(p0[r] + off); p1[r] = __builtin_amdgcn_exp2f(p1[r] + off); sacc += p0[r] + p1[r]; }
    l_reg += sacc;
#pragma unroll
    for (int ks = 0; ks < 4; ++ks) { const f32x16& P = (ks < 2) ? p0 : p1; const int b = 8 * (ks & 1);
        pw[ks] = (u32x4){cvt_pk_bf16(P[b], P[b + 1]), cvt_pk_bf16(P[b + 2], P[b + 3]), cvt_pk_bf16(P[b + 4], P[b + 5]), cvt_pk_bf16(P[b + 6], P[b + 7])}; }
}
__device__ __forceinline__ void tile_h2(lds_cptr vp, f32x16 (&o)[4], const u32x4 (&pw)[4]) {
#pragma unroll
    for (int ks = 0; ks < 4; ++ks)
#pragma unroll
        for (int db = 0; db < 4; ++db) {
            const s16x4 lo = vtr(vp + db * 4096 + ks * 1024), h4 = vtr(vp + db * 4096 + ks * 1024 + 512);
            const bf16x8 vf = (bf16x8){lo[0], lo[1], lo[2], lo[3], h4[0], h4[1], h4[2], h4[3]};
            o[db] = ATT_MFMA(__builtin_bit_cast(bf16x8, pw[ks]), vf, o[db]);
        }
}

struct VFrag { s16x4 lo, hi; };
template <int I> __device__ __forceinline__ VFrag vload(lds_cptr vp) {
    constexpr int off_ = (I & 3) * 4096 + (I >> 2) * 1024; VFrag f; f.lo = vtr(vp + off_); f.hi = vtr(vp + off_ + 512); return f;
}
template <int ABL, int MODE, int mp>
__device__ __forceinline__ bool attn_unit(int b, int h, int qb, const bf16_t* Q, const bf16_t* KT, const bf16_t* VT, bf16_t* MIXED, float* OX, LAS unsigned char* lds, float lam, const float* subln_g, const float* rel_bias) {
    const int tid = threadIdx.x, lane = tid & 63, r32 = lane & 31, hi = lane >> 5; const int wid = __builtin_amdgcn_readfirstlane(tid >> 6);
    const size_t rowbase = (size_t)b * S; const int q0 = qb * 256, qw0 = q0 + 32 * wid, qrow = qw0 + r32;
    LAS float* btab = (LAS float*)(lds + LDS_BIAS2); LAS float* wsf = (LAS float*)(lds + LDS_WSF) + wid * 64;
    { const int rel = tid - 256; const int n = rel < 0 ? -rel : rel; int bk; if (n < 8) bk = n; else { bk = 2 + (31 - __clz(n * n)); if (bk > 15) bk = 15; } if (rel > 0) bk += 16;
        btab[tid] = rel_bias[bk * NH + h] * LOG2E; }
    if (tid == 0) *(LAS unsigned*)(lds + LDS_WSF + 2040) = 0u;
    const float c_left = rel_bias[15 * NH + h] * LOG2E, c_right = rel_bias[31 * NH + h] * LOG2E;
    const bf16_t* Qw = Q + (rowbase + qw0) * 512 + h * 128 + mp * 64;
    bf16x8 qr[4];
#pragma unroll
    for (int d0 = 0; d0 < 4; ++d0) qr[d0] = *(const bf16x8*)(Qw + (size_t)r32 * 512 + d0 * 16 + hi * 8);
    const char* ksrc = (const char*)KT + ((size_t)((b * 4 + h) * 2 + mp) * 64) * 8192 + wid * 1024 + lane * 16;
    const char* vsrc = (const char*)VT + ((size_t)(b * 4 + h) * 64) * 16384 + wid * 1024 + lane * 16;
    const unsigned lds0 = (unsigned)(uintptr_t)(unsigned char*)lds;
    const unsigned kdst = lds0 + LDS_K + wid * 1024, vdst = lds0 + LDS_V + wid * 1024;
    const lds_cptr kp0 = (lds_cptr)lds + LDS_K + hi * 1024 + r32 * 16;
    const lds_cptr vp0 = (lds_cptr)lds + LDS_V + ((lane >> 4) & 1) * 32 + (lane & 3) * 8 + (4 * hi + ((lane & 15) >> 2)) * 64;
#define ATT_DMA_TILE(t, ks_, vs_) do { if (ABL == 3) break; glds16(ksrc + (size_t)(t) * 8192, (unsigned)__builtin_amdgcn_readfirstlane(kdst + (ks_))); \
        glds16(vsrc + (size_t)(t) * 16384, (unsigned)__builtin_amdgcn_readfirstlane(vdst + (vs_))); glds16(vsrc + (size_t)(t) * 16384 + 8192, (unsigned)__builtin_amdgcn_readfirstlane(vdst + (vs_) + 8192)); } while (0)
    ATT_DMA_TILE(0, 0, 0); ATT_DMA_TILE(1, KSLOT, SLOT);
    float mhat = 0.f, l_reg = 0.f; f32x16 o[4]; u32x4 pw[4];
#pragma unroll
    for (int db = 0; db < 4; ++db)
#pragma unroll
        for (int r = 0; r < 16; ++r) o[db][r] = 0.f;
    int ksl = 0, ksl2 = 2 * KSLOT, vsl = 0, vsl2 = 2 * SLOT, vprev = 0;
#define ATT_ROT() do { ksl = (ksl == 2 * KSLOT) ? 0 : ksl + KSLOT; ksl2 = (ksl2 == 2 * KSLOT) ? 0 : ksl2 + KSLOT; vprev = vsl; vsl = (vsl + SLOT) & (4 * SLOT - 1); vsl2 = (vsl2 + SLOT) & (4 * SLOT - 1); } while (0)
#define ATT_SB() __builtin_amdgcn_sched_barrier(0)
#define ATT_PIN(x) asm volatile("" : "+v"(x))
#define ATT_F(T0, T1, e) (((e) < 16) ? T0[(e) & 15] : T1[(e) & 15])
#define ATT_KRD(f) (*(const LAS bf16x8*)(kp_ + ((f) >> 1) * 2048 + ((f) & 1) * 512))
    const f32x16 z16 = (f32x16){0.f, 0.f, 0.f, 0.f, 0.f, 0.f, 0.f, 0.f, 0.f, 0.f, 0.f, 0.f, 0.f, 0.f, 0.f, 0.f};
#define ATT_GA(C0, C1, P0, P1, f) do { \
        if (((f) & 1) == 0) C0 = ATT_MFMA(kq[(f) % 3], qr[(f) >> 1], ((f) < 2) ? z16 : C0); else C1 = ATT_MFMA(kq[(f) % 3], qr[(f) >> 1], ((f) < 2) ? z16 : C1); \
        if (ABL != 5 && (f) + 3 < 8) kq[(f) % 3] = ATT_KRD((f) + 3); \
        if (ABL != 6) { sacc += ATT_F(P0, P1, 4 * (f)); sacc += ATT_F(P0, P1, 4 * (f) + 1); sacc += ATT_F(P0, P1, 4 * (f) + 2); sacc += ATT_F(P0, P1, 4 * (f) + 3); ATT_PIN(sacc); } \
        if (ABL != 6) pw[(f) >> 1][2 * ((f) & 1)] = cvt_pk_bf16(ATT_F(P0, P1, 4 * (f)), ATT_F(P0, P1, 4 * (f) + 1)); if (ABL != 6) pw[(f) >> 1][2 * ((f) & 1) + 1] = cvt_pk_bf16(ATT_F(P0, P1, 4 * (f) + 2), ATT_F(P0, P1, 4 * (f) + 3)); ATT_PIN(pw[(f) >> 1]); \
        ATT_SB(); } while (0)
#define ATT_VRD(I) vload<(I) & 15>(vp_)
#define ATT_GBF(I, FILL) do { \
        { const VFrag& vv = vq[(I) % 3]; const bf16x8 vf = (bf16x8){vv.lo[0], vv.lo[1], vv.lo[2], vv.lo[3], vv.hi[0], vv.hi[1], vv.hi[2], vv.hi[3]}; \
          if (ABL != 7) o[(I) & 3] = ATT_MFMA(__builtin_bit_cast(bf16x8, pw[(I) >> 2]), vf, o[(I) & 3]); else asm volatile("" :: "v"(vf)); } \
        if (ABL != 1 && (I) + 3 < 16) vq[(I) % 3] = ATT_VRD((I) + 3); \
        FILL; ATT_SB(); } while (0)
#define ATT_EXF(x) ((ABL == 2) ? (x) : __builtin_amdgcn_exp2f(x))
#define ATT_EX(C0, C1, e) do { if ((e) < 16) { C0[(e) & 15] = ATT_EXF(C0[(e) & 15] + off); } else { C1[(e) & 15] = ATT_EXF(C1[(e) & 15] + off); } } while (0)
#define ATT_EX3(C0, C1, e) do { ATT_EX(C0, C1, e); ATT_EX(C0, C1, (e) + 1); ATT_EX(C0, C1, (e) + 2); ATT_PIN(C0); ATT_PIN(C1); } while (0)
#define ATT_EX2(C0, C1, e) do { ATT_EX(C0, C1, e); ATT_EX(C0, C1, (e) + 1); ATT_PIN(C0); ATT_PIN(C1); } while (0)
#define ATT_MX3(a, b, c) __builtin_fmaxf(__builtin_fmaxf((a), (b)), (c))
#define ATT_BIAS(C0, C1, t) \
        const int relmin_ = 64 * (t) - qw0 - 31, relmax_ = 64 * (t) + 63 - qw0; const bool band_ = !(relmax_ <= -91 || relmin_ >= 91); const float cb_ = band_ ? 0.f : (relmin_ >= 91 ? c_right : c_left); \
        if (band_) { const LAS float* bp_ = btab + (64 * (t) + 4 * hi - qrow + 256);       \
            _Pragma("unroll") for (int r = 0; r < 16; ++r) { C0[r] += bp_[(r & 3) + 8 * (r >> 2)]; C1[r] += bp_[(r & 3) + 8 * (r >> 2) + 32]; } }
#define ATT_MAXP(C0, C1, g) do { if ((g) == 0) { ma_ = ATT_MX3(C0[0], C0[1], C1[0]); mb_ = ATT_MX3(C0[2], C0[3], C1[1]); ma_ = ATT_MX3(ma_, C1[2], C1[3]); } \
        else { ma_ = ATT_MX3(ma_, C0[4 * (g)], C0[4 * (g) + 1]); mb_ = ATT_MX3(mb_, C0[4 * (g) + 2], C0[4 * (g) + 3]); ma_ = ATT_MX3(ma_, C1[4 * (g)], C1[4 * (g) + 1]); mb_ = ATT_MX3(mb_, C1[4 * (g) + 2], C1[4 * (g) + 3]); } \
        ATT_PIN(ma_); ATT_PIN(mb_); } while (0)
#define ATT_DECIDE2(FIRST_) do { float rm_ = __builtin_fmaxf(ma_, mb_); { auto rr = __builtin_amdgcn_permlane32_swap(__float_as_uint(rm_), __float_as_uint(rm_), false, false); rm_ = __builtin_fmaxf(__uint_as_float(rr[0]), __uint_as_float(rr[1])); } \
        rm_ += cb_; resc = false; \
        if (FIRST_) { mhat = rm_; } \
        else if (__builtin_expect(__any(rm_ - mhat > (float)THR), 0)) { const float dl_ = __builtin_fmaxf(rm_ - mhat, 0.f); mhat += dl_; const float f_ = __builtin_amdgcn_exp2f(-dl_); l_reg *= f_; if (hi == 0) wsf[r32] = f_; resc = true; } \
        off = cb_ - mhat; ATT_SB(); } while (0)
#define ATT_RESC() do { if (resc) { asm volatile("s_waitcnt lgkmcnt(0)" ::: "memory"); float fr_[16]; \
        _Pragma("unroll") for (int r = 0; r < 16; ++r) fr_[r] = wsf[crow(r, hi)]; \
        _Pragma("unroll") for (int db = 0; db < 4; ++db) _Pragma("unroll") for (int r = 0; r < 16; ++r) o[db][r] *= fr_[r]; \
        asm volatile("s_waitcnt lgkmcnt(0)" ::: "memory"); } \
        if (MODE == 1 && cb_ != cc) { const float sc_ = __builtin_amdgcn_exp2f(cc - cb_); cc = cb_; l_reg *= sc_;       \
            _Pragma("unroll") for (int db = 0; db < 4; ++db) _Pragma("unroll") for (int r = 0; r < 16; ++r) o[db][r] *= sc_; } } while (0)
#define ATT_EX0(C0, C1, e) do { if ((e) < 16) { C0[(e) & 15] = ATT_EXF(C0[(e) & 15]); } else { C1[(e) & 15] = ATT_EXF(C1[(e) & 15]); } } while (0)
#define ATT_EX0P(C0, C1, e) do { ATT_EX0(C0, C1, e); ATT_EX0(C0, C1, (e) + 1); ATT_PIN(C0); ATT_PIN(C1); } while (0)
#define ATT_STEP(C0, C1, P0, P1, t) do { \
        const lds_cptr kp_ = kp0 + ksl; const lds_cptr vp_ = vp0 + vprev; float sacc = 0.f, ma_, mb_; \
        kq[0] = ATT_KRD(0); kq[1] = ATT_KRD(1); kq[2] = ATT_KRD(2); ATT_SB(); \
        ATT_GA(C0, C1, P0, P1, 0); ATT_GA(C0, C1, P0, P1, 1); ATT_GA(C0, C1, P0, P1, 2); ATT_GA(C0, C1, P0, P1, 3); \
        vq[0] = ATT_VRD(0); vq[1] = ATT_VRD(1); vq[2] = ATT_VRD(2); ATT_SB(); \
        ATT_GA(C0, C1, P0, P1, 4); ATT_GA(C0, C1, P0, P1, 5); ATT_GA(C0, C1, P0, P1, 6); ATT_GA(C0, C1, P0, P1, 7); \
        l_reg += sacc; \
        ATT_BIAS(C0, C1, t) ATT_SB(); \
        if (MODE == 0) { \
        ATT_GBF(0, ATT_MAXP(C0, C1, 0)); ATT_GBF(1, ATT_MAXP(C0, C1, 1)); ATT_GBF(2, ATT_MAXP(C0, C1, 2)); ATT_GBF(3, ATT_MAXP(C0, C1, 3)); \
        ATT_DECIDE2(false); \
        ATT_GBF(4, ATT_EX3(C0, C1, 0)); ATT_GBF(5, ATT_EX3(C0, C1, 3)); ATT_GBF(6, ATT_EX3(C0, C1, 6)); ATT_GBF(7, ATT_EX3(C0, C1, 9)); \
        ATT_GBF(8, ATT_EX3(C0, C1, 12)); ATT_GBF(9, ATT_EX3(C0, C1, 15)); ATT_GBF(10, ATT_EX3(C0, C1, 18)); ATT_GBF(11, ATT_EX3(C0, C1, 21)); \
        ATT_GBF(12, ATT_EX2(C0, C1, 24)); ATT_GBF(13, ATT_EX2(C0, C1, 26)); ATT_GBF(14, ATT_EX2(C0, C1, 28)); ATT_GBF(15, ATT_EX2(C0, C1, 30)); \
        } else { \
        ATT_GBF(0, ATT_EX0P(C0, C1, 0)); ATT_GBF(1, ATT_EX0P(C0, C1, 2)); ATT_GBF(2, ATT_EX0P(C0, C1, 4)); ATT_GBF(3, ATT_EX0P(C0, C1, 6)); ATT_GBF(4, ATT_EX0P(C0, C1, 8)); ATT_GBF(5, ATT_EX0P(C0, C1, 10)); ATT_GBF(6, ATT_EX0P(C0, C1, 12)); ATT_GBF(7, ATT_EX0P(C0, C1, 14)); \
        ATT_GBF(8, ATT_EX0P(C0, C1, 16)); ATT_GBF(9, ATT_EX0P(C0, C1, 18)); ATT_GBF(10, ATT_EX0P(C0, C1, 20)); ATT_GBF(11, ATT_EX0P(C0, C1, 22)); ATT_GBF(12, ATT_EX0P(C0, C1, 24)); ATT_GBF(13, ATT_EX0P(C0, C1, 26)); ATT_GBF(14, ATT_EX0P(C0, C1, 28)); ATT_GBF(15, ATT_EX0P(C0, C1, 30)); } \
        ATT_RESC(); ATT_ROT(); } while (0)
    f32x16 sa0, sa1, sb0, sb1; bf16x8 kq[3]; VFrag vq[3]; float off = 0.f, cc = 0.f; bool resc = false;
    ATT_WAIT_BAR(3); ATT_DMA_TILE(2, ksl2, vsl2);
    { const lds_cptr kp_ = kp0 + ksl;
#pragma unroll
      for (int d0 = 0; d0 < 4; ++d0) { const bf16x8 k0 = ATT_KRD(2 * d0), k1 = ATT_KRD(2 * d0 + 1);
          if (d0 == 0) { sa0 = ATT_MFMA(k0, qr[0], z16); sa1 = ATT_MFMA(k1, qr[0], z16); } else { sa0 = ATT_MFMA(k0, qr[d0], sa0); sa1 = ATT_MFMA(k1, qr[d0], sa1); } }
      float ma_, mb_; ATT_BIAS(sa0, sa1, 0)
      if (MODE == 0) { ATT_MAXP(sa0, sa1, 0); ATT_MAXP(sa0, sa1, 1); ATT_MAXP(sa0, sa1, 2); ATT_MAXP(sa0, sa1, 3); ATT_DECIDE2(true); } else { cc = cb_; off = 0.f; (void)ma_; (void)mb_; }
#pragma unroll
      for (int r = 0; r < 16; ++r) { sa0[r] = __builtin_amdgcn_exp2f(sa0[r] + off); sa1[r] = __builtin_amdgcn_exp2f(sa1[r] + off); }
      ATT_ROT(); }
    for (int t = 1; t < NT - 3; t += 2) {
        ATT_WAIT_BAR(3); ATT_DMA_TILE(t + 2, ksl2, vsl2); ATT_STEP(sb0, sb1, sa0, sa1, t);
        ATT_WAIT_BAR(3); ATT_DMA_TILE(t + 3, ksl2, vsl2); ATT_STEP(sa0, sa1, sb0, sb1, t + 1);
    }
    ATT_WAIT_BAR(3); ATT_DMA_TILE(NT - 1, ksl2, vsl2); ATT_STEP(sb0, sb1, sa0, sa1, NT - 3);
    ATT_WAIT_BAR(3); ATT_STEP(sa0, sa1, sb0, sb1, NT - 2);
    ATT_WAIT_BAR(0); ATT_STEP(sb0, sb1, sa0, sa1, NT - 1);
    { float sacc = 0.f;
#pragma unroll
      for (int r = 0; r < 16; ++r) sacc += sb0[r] + sb1[r];
      l_reg += sacc;
#pragma unroll
      for (int g = 0; g < 16; ++g) pw[g >> 2][g & 3] = cvt_pk_bf16(ATT_F(sb0, sb1, 2 * g), ATT_F(sb0, sb1, 2 * g + 1));
      const lds_cptr vp_ = vp0 + vprev;
#pragma unroll
      for (int ks = 0; ks < 4; ++ks)
#pragma unroll
          for (int db = 0; db < 4; ++db) { const s16x4 lo = vtr(vp_ + db * 4096 + ks * 1024), h4 = vtr(vp_ + db * 4096 + ks * 1024 + 512);
              const bf16x8 vf = (bf16x8){lo[0], lo[1], lo[2], lo[3], h4[0], h4[1], h4[2], h4[3]}; o[db] = ATT_MFMA(__builtin_bit_cast(bf16x8, pw[ks]), vf, o[db]); } }
#undef ATT_STEP
#undef ATT_RESC
#undef ATT_DECIDE2
#undef ATT_MAXP
#undef ATT_BIAS
#undef ATT_EX2
#undef ATT_EX3
#undef ATT_EX
#undef ATT_EX0
#undef ATT_EX0P
#undef ATT_EXF
#undef ATT_GBF
#undef ATT_GA
#undef ATT_VRD
#undef ATT_KRD
#undef ATT_F
#undef ATT_PIN
#undef ATT_SB
    { auto rr = __builtin_amdgcn_permlane32_swap(__float_as_uint(l_reg), __float_as_uint(l_reg), false, false); l_reg = __uint_as_float(rr[0]) + __uint_as_float(rr[1]); }
    LAS unsigned* redo_w = (LAS unsigned*)(lds + LDS_WSF + 2040);
    if (MODE == 1) { const bool bad_ = !(l_reg > 7.8886e-31f && l_reg < 1.2676e30f); if (__any(bad_) && lane == 0) *redo_w = 1u; }
    int lane_e = lane; asm volatile("" : "+v"(lane_e));
    const int r32_e = lane_e & 31, hi_e = lane_e >> 5;
    const float scale_q = (mp == 0 ? 1.0f : lam) * __builtin_amdgcn_rcpf(l_reg);
    if (hi_e == 0) wsf[r32_e] = scale_q;
    asm volatile("s_waitcnt lgkmcnt(0)" ::: "memory");
    float sc[16];
#pragma unroll
    for (int r = 0; r < 16; ++r) sc[r] = wsf[crow(r, hi_e)];
    f32x4* OXw = (f32x4*)OX + (size_t)wid * 16 * 64 + lane_e;
    if (mp == 1) {
#pragma unroll
        for (int db = 0; db < 4; ++db)
#pragma unroll
            for (int q4 = 0; q4 < 4; ++q4) OXw[(db * 4 + q4) * 64] = (f32x4){o[db][4 * q4] * sc[4 * q4], o[db][4 * q4 + 1] * sc[4 * q4 + 1], o[db][4 * q4 + 2] * sc[4 * q4 + 2], o[db][4 * q4 + 3] * sc[4 * q4 + 3]};
        asm volatile("s_waitcnt lgkmcnt(0)\n\ts_barrier" ::: "memory");
    } else {
        float ss[16];
#pragma unroll
        for (int r = 0; r < 16; ++r) ss[r] = 0.f;
#pragma unroll
        for (int db = 0; db < 4; ++db)
#pragma unroll
            for (int q4 = 0; q4 < 4; ++q4) { const f32x4 xv = OXw[(db * 4 + q4) * 64];
#pragma unroll
                for (int e = 0; e < 4; ++e) { const int r = 4 * q4 + e; const float d = o[db][r] * sc[r] - xv[e]; o[db][r] = d; ss[r] += d * d; } }
#pragma unroll
        for (int r = 0; r < 16; ++r) {
#pragma unroll
            for (int x = 1; x < 32; x <<= 1) ss[r] += __shfl_xor(ss[r], x);
            ss[r] = __builtin_amdgcn_rsqf(ss[r] * (1.0f / 128.0f) + EPS) * 0.8f;
        }
        asm volatile("s_waitcnt lgkmcnt(0)\n\ts_barrier" ::: "memory");
        LAS bf16_t* stg = (LAS bf16_t*)(lds + LDS_OST) + wid * 4096;
#pragma unroll
        for (int db = 0; db < 4; ++db) { const float g = subln_g[db * 32 + r32_e];
#pragma unroll
            for (int r = 0; r < 16; ++r) { const unsigned w = cvt_pk_bf16(o[db][r] * ss[r] * g, 0.f); stg[crow(r, hi_e) * 128 + db * 32 + r32_e] = (bf16_t)(w & 0xffffu); } }
        asm volatile("s_waitcnt lgkmcnt(0)" ::: "memory");
        bf16_t* Ow = MIXED + (rowbase + qw0) * 1024 + h * 128;
#pragma unroll
        for (int i = 0; i < 8; ++i) { const int row = i * 4 + (lane_e >> 4), ch = lane_e & 15; const u32x4 v = *(const LAS u32x4*)(stg + row * 128 + ch * 8); *(u32x4*)(Ow + (size_t)row * 1024 + ch * 8) = v; }
    }
    asm volatile("s_waitcnt vmcnt(0) lgkmcnt(0)\n\ts_barrier" ::: "memory");
    const bool redo_ = (MODE == 1) && (*(volatile LAS unsigned*)(lds + LDS_WSF + 2040) != 0u);
    asm volatile("s_waitcnt lgkmcnt(0)\n\ts_barrier" ::: "memory");
    return redo_;
#undef ATT_DMA_TILE
#undef ATT_ROT
}
}

namespace lru {
typedef _Float16 h16x2 __attribute__((ext_vector_type(2))); typedef float f32x2h __attribute__((ext_vector_type(2)));
template <int N> __device__ __forceinline__ float dpp_shr(float v, float ident) {
    return __int_as_float(__builtin_amdgcn_update_dpp(__float_as_int(ident), __float_as_int(v), 0x110 + N, 0xF, 0xF, false));
}
#define LRU_MFMA16(a, b, c) __builtin_amdgcn_mfma_f32_16x16x32_bf16(a, b, c, 0, 0, 0)
__device__ __forceinline__ void lru_rows(bf16x8 (&rowv)[2][7], __amdgpu_buffer_rsrc_t xsrd, int dir, int Pb, int ch0) {
#pragma unroll
    for (int k = 0; k < 7; ++k) {
        const int tt = dir ? (S - Pb - k) : (Pb - 2 + k);
#pragma unroll
        for (int ks = 0; ks < 2; ++ks) rowv[ks][k] = __builtin_bit_cast(bf16x8, __builtin_amdgcn_raw_buffer_load_b128(xsrd, (tt * 512 + ch0 + 32 * ks) * 2, 0, 0));
    }
}
template <int PART  >
__device__ __forceinline__ void lru_item(int b, int cg, const bf16_t* XR, const bf16_t* GR, float* HF, bf16_t* MIXED, bf16_t* XC, unsigned* sib_cnt, LAS unsigned char* lds,
                                         const float* conv_w, const float* conv_b, const float* w_rg, const float* b_rg, const float* w_ig, const float* b_ig, const float* lru_lambda) {
    const int tid = threadIdx.x, lane = tid & 63, p = lane & 15, g = lane >> 4; const int wid = __builtin_amdgcn_readfirstlane(tid >> 6);
    const int n = cg >> 2, e16 = cg & 3, c0 = n * 64 + e16 * 16;
    const size_t rowbase = (size_t)b * S;
    const __amdgpu_buffer_rsrc_t XRb = __builtin_amdgcn_make_buffer_rsrc((void*)(XR + rowbase * 512), (short)0, S * 512 * 2, 0x00020000); const int ch0 = n * 64 + 8 * g;
    (void)HF;
    LAS float* tot = (LAS float*)(lds + att::LDS_TOT);
    bf16x8 idf;
#pragma unroll
    for (int j = 0; j < 8; ++j) idf[j] = ((8 * g + j) == (16 * (e16 & 1) + p)) ? (short)0x3f80 : (short)0;
    int par = 0;
    LAS float* cwl = (LAS float*)(lds + att::LDS_CW);
    if (PART == 1) {
    if (tid < 320) { const int j = tid >> 6, c = tid & 63; cwl[tid] = (j < 4) ? conv_w[j * 512 + n * 64 + c] : conv_b[n * 64 + c]; }
    __syncthreads();
    {
        const int g8 = tid & 7, trow = tid >> 3;
        const int c8 = n * 64 + 8 * g8;
        f32x4 w0[4], w1[4];
#pragma unroll
        for (int j = 0; j < 4; ++j) { w0[j] = *(const LAS f32x4*)(cwl + j * 64 + 8 * g8); w1[j] = *(const LAS f32x4*)(cwl + j * 64 + 8 * g8 + 4); }
        const f32x4 bb0 = *(const LAS f32x4*)(cwl + 256 + 8 * g8), bb1 = *(const LAS f32x4*)(cwl + 256 + 8 * g8 + 4);
        for (int st = 0; st < 16; ++st) {
            const int tok = e16 * 1024 + st * 64 + trow;
            f32x4 a0 = bb0, a1 = bb1;
#pragma unroll
            for (int j = 0; j < 4; ++j) {
                const u32x4 rw = __builtin_amdgcn_raw_buffer_load_b128(XRb, ((tok + j - 2) * 512 + c8) * 2, 0, 0);
                a0 += w0[j] * (f32x4){__uint_as_float(rw[0] << 16), __uint_as_float(rw[0] & 0xffff0000u), __uint_as_float(rw[1] << 16), __uint_as_float(rw[1] & 0xffff0000u)};
                a1 += w1[j] * (f32x4){__uint_as_float(rw[2] << 16), __uint_as_float(rw[2] & 0xffff0000u), __uint_as_float(rw[3] << 16), __uint_as_float(rw[3] & 0xffff0000u)};
            }
            *(u32x4*)(XC + (rowbase + tok) * 512 + c8) = (u32x4){cvt_pk_bf16(a0[0], a0[1]), cvt_pk_bf16(a0[2], a0[3]), cvt_pk_bf16(a1[0], a1[1]), cvt_pk_bf16(a1[2], a1[3])};
        }
        asm volatile("s_waitcnt vmcnt(0)" ::: "memory");
        __syncthreads();
        if (tid == 0) {
            __builtin_amdgcn_fence(__ATOMIC_RELEASE, "agent");
            asm volatile("s_waitcnt vmcnt(0)" ::: "memory");
            __hip_atomic_fetch_add(sib_cnt, 1u, __ATOMIC_RELAXED, __HIP_MEMORY_SCOPE_AGENT);
        }
        __syncthreads();
    }
    return;
    }
    if (tid == 0) {
        unsigned sp = 0;
        while (__hip_atomic_load(sib_cnt, __ATOMIC_RELAXED, __HIP_MEMORY_SCOPE_AGENT) < 4u) { __builtin_amdgcn_s_sleep(2); if (++sp > (1u << 22)) break; }
        __builtin_amdgcn_fence(__ATOMIC_ACQUIRE, "agent");
        asm volatile("s_waitcnt vmcnt(0)" ::: "memory");
    }
    __syncthreads();
#pragma unroll
    for (int dir = 0; dir < 2; ++dir) {
        bf16x8 wrf[2], wif[2];
#pragma unroll
        for (int ks = 0; ks < 2; ++ks) {
            unsigned wr_[4], wi_[4];
#pragma unroll
            for (int j2 = 0; j2 < 4; ++j2) { const int d = 32 * ks + 8 * g + 2 * j2; const size_t i0 = ((size_t)((dir * 8 + n) * 64 + d)) * 64 + e16 * 16 + p;
                wr_[j2] = cvt_pk_bf16(w_rg[i0], w_rg[i0 + 64]); wi_[j2] = cvt_pk_bf16(w_ig[i0], w_ig[i0 + 64]); }
            wrf[ks] = __builtin_bit_cast(bf16x8, (u32x4){wr_[0], wr_[1], wr_[2], wr_[3]}); wif[ks] = __builtin_bit_cast(bf16x8, (u32x4){wi_[0], wi_[1], wi_[2], wi_[3]});
        }
        float br[4], bi[4], sp8[4], carry[4];
#pragma unroll
        for (int r = 0; r < 4; ++r) { const int c = dir * 512 + c0 + 4 * g + r; br[r] = b_rg[c] * -LOG2E; bi[r] = b_ig[c] * -LOG2E; const float lm = lru_lambda[c]; sp8[r] = 8.0f * LOG2E * ((-lm > 20.0f) ? -lm : log1pf(expf(-lm)));     carry[r] = 0.f; }
        LAS u32x4* lst = (LAS u32x4*)(lds + LDS_LST + dir * 8192) + lane;
        lst[0 * 64] = __builtin_bit_cast(u32x4, wrf[0]); lst[1 * 64] = __builtin_bit_cast(u32x4, wrf[1]); lst[2 * 64] = __builtin_bit_cast(u32x4, wif[0]); lst[3 * 64] = __builtin_bit_cast(u32x4, wif[1]);
        lst[4 * 64] = __builtin_bit_cast(u32x4, (f32x4){br[0], br[1], br[2], br[3]}); lst[5 * 64] = __builtin_bit_cast(u32x4, (f32x4){bi[0], bi[1], bi[2], bi[3]}); lst[6 * 64] = __builtin_bit_cast(u32x4, (f32x4){sp8[0], sp8[1], sp8[2], sp8[3]}); lst[7 * 64] = __builtin_bit_cast(u32x4, idf);
        bf16x8 xf[4][2];
#define LRU_XLOAD(PB_) do { _Pragma("unroll") for (int i = 0; i < 4; ++i) { const int tok_ = dir ? (S - 1 - ((PB_) + i)) : ((PB_) + i); \
            _Pragma("unroll") for (int ks = 0; ks < 2; ++ks) xf[i][ks] = *(const bf16x8*)(XC + (rowbase + tok_) * 512 + ch0 + 32 * ks); } } while (0)
        LRU_XLOAD(wid * 64 + 4 * p);
        for (int sc = 0; sc < 8; ++sc) {
            const int P0 = sc * 512 + wid * 64, Pb = P0 + 4 * p;
            f32x4 ar[4], ai[4], ax[4];
            {
                int zoff = 0; asm volatile("" : "+v"(zoff));
                const LAS u32x4* lsi = (const LAS u32x4*)(lds + LDS_LST + dir * 8192) + lane + zoff;
                const bf16x8 wrf0 = __builtin_bit_cast(bf16x8, lsi[0 * 64]), wrf1 = __builtin_bit_cast(bf16x8, lsi[1 * 64]), wif0 = __builtin_bit_cast(bf16x8, lsi[2 * 64]), wif1 = __builtin_bit_cast(bf16x8, lsi[3 * 64]), idf_ = __builtin_bit_cast(bf16x8, lsi[7 * 64]);
                const f32x4 z = (f32x4){0.f, 0.f, 0.f, 0.f};
#pragma unroll
                for (int i = 0; i < 4; ++i) {
                    ar[i] = LRU_MFMA16(wrf0, xf[i][0], z); ar[i] = LRU_MFMA16(wrf1, xf[i][1], ar[i]);
                    ai[i] = LRU_MFMA16(wif0, xf[i][0], z); ai[i] = LRU_MFMA16(wif1, xf[i][1], ai[i]);
                    ax[i] = LRU_MFMA16(idf_, (e16 & 2) ? xf[i][1] : xf[i][0], z);
                }
                __builtin_amdgcn_sched_barrier(0);
                if (sc < 7) LRU_XLOAD(Pb + 512);
            }
            float hh[4][4], cpp[4][4], Al[4], Hl[4];
            int zoff2 = 0; asm volatile("" : "+v"(zoff2));
            const LAS f32x4* lsg = (const LAS f32x4*)(lds + LDS_LST + dir * 8192) + lane + zoff2;
            const f32x4 brv = lsg[4 * 64], biv = lsg[5 * 64], spv = lsg[6 * 64];
#pragma unroll
            for (int r = 0; r < 4; ++r) {
                float h = 0.f, cp = 1.f;
#pragma unroll
                for (int i = 0; i < 4; ++i) {
                    const float rg = __builtin_amdgcn_rcpf(1.0f + __builtin_amdgcn_exp2f(ar[i][r] * -LOG2E + brv[r])), ig = __builtin_amdgcn_rcpf(1.0f + __builtin_amdgcn_exp2f(ai[i][r] * -LOG2E + biv[r]));
                    const float a_ = __builtin_amdgcn_exp2f(-rg * spv[r]);
                    const float om = __builtin_fmaf(-a_, a_, 1.0f);
                    const float u_ = __builtin_amdgcn_sqrtf(om) * (ig * ax[i][r]);
                    h = a_ * h + u_; cp = a_ * cp; hh[i][r] = h; cpp[i][r] = cp;
                }
                Al[r] = cp; Hl[r] = h;
            }
#define LRU_KS(NN) asm volatile("s_nop 1\n\t" \
        "v_fmac_f32_dpp %0, %0, %4 row_shr:" #NN " row_mask:0xf bank_mask:0xf\n\tv_fmac_f32_dpp %1, %1, %5 row_shr:" #NN " row_mask:0xf bank_mask:0xf\n\t" \
        "v_fmac_f32_dpp %2, %2, %6 row_shr:" #NN " row_mask:0xf bank_mask:0xf\n\tv_fmac_f32_dpp %3, %3, %7 row_shr:" #NN " row_mask:0xf bank_mask:0xf\n\t" \
        "v_mul_f32_dpp %4, %4, %4 row_shr:" #NN " row_mask:0xf bank_mask:0xf\n\tv_mul_f32_dpp %5, %5, %5 row_shr:" #NN " row_mask:0xf bank_mask:0xf\n\t" \
        "v_mul_f32_dpp %6, %6, %6 row_shr:" #NN " row_mask:0xf bank_mask:0xf\n\tv_mul_f32_dpp %7, %7, %7 row_shr:" #NN " row_mask:0xf bank_mask:0xf\n\ts_nop 1" \
        : "+v"(Hl[0]), "+v"(Hl[1]), "+v"(Hl[2]), "+v"(Hl[3]), "+v"(Al[0]), "+v"(Al[1]), "+v"(Al[2]), "+v"(Al[3]))
            LRU_KS(1); LRU_KS(2); LRU_KS(4); LRU_KS(8);
#undef LRU_KS
            float Aex[4], Hex[4];
#pragma unroll
            for (int r = 0; r < 4; ++r) { Aex[r] = dpp_shr<1>(Al[r], 1.0f); Hex[r] = dpp_shr<1>(Hl[r], 0.0f); }
            if (p == 15) {
#pragma unroll
                for (int r = 0; r < 4; ++r) { tot[((par * 8 + wid) * 16 + 4 * g + r) * 2] = Al[r]; tot[((par * 8 + wid) * 16 + 4 * g + r) * 2 + 1] = Hl[r]; }
            }
            asm volatile("s_waitcnt lgkmcnt(0)\n\ts_barrier" ::: "memory");
            float cin[4];
#pragma unroll
            for (int r = 0; r < 4; ++r) cin[r] = 0.f;
#pragma unroll
            for (int w = 0; w < 8; ++w) {
                const f32x4 t0 = *(const LAS f32x4*)(tot + ((par * 8 + w) * 16 + 4 * g) * 2), t1 = *(const LAS f32x4*)(tot + ((par * 8 + w) * 16 + 4 * g) * 2 + 4);
                const float Aw[4] = {t0[0], t0[2], t1[0], t1[2]}, Hw[4] = {t0[1], t0[3], t1[1], t1[3]};
#pragma unroll
                for (int r = 0; r < 4; ++r) { if (w == wid) cin[r] = carry[r]; carry[r] = Aw[r] * carry[r] + Hw[r]; }
            }
            par ^= 1;
            f32x4 hfv[4]; u32x2 gv[4];
            if (dir) {
#pragma unroll
                for (int i = 0; i < 4; ++i) { const int tok = S - 1 - (Pb + i); gv[i] = *(const u32x2*)(GR + (rowbase + tok) * 512 + c0 + 4 * g);
                    const u32x2 hw = *(const LAS u32x2*)(lds + ((((63 - (8 * sc + wid)) * 4 + (3 - i)) * 16 + (15 - p)) * 32 + 8 * g));
                    const unsigned hx_ = hw[0], hy_ = hw[1];
                    const h16x2 h01 = __builtin_bit_cast(h16x2, hx_), h23 = __builtin_bit_cast(h16x2, hy_);
                    hfv[i] = (f32x4){(float)h01[0], (float)h01[1], (float)h23[0], (float)h23[1]}; }
            }
            float cl[4];
#pragma unroll
            for (int r = 0; r < 4; ++r) cl[r] = Aex[r] * cin[r] + Hex[r];
#pragma unroll
            for (int i = 0; i < 4; ++i) {
                const int P = Pb + i; const int tok = dir ? (S - 1 - P) : P;
                f32x4 hv;
#pragma unroll
                for (int r = 0; r < 4; ++r) hv[r] = hh[i][r] + cpp[i][r] * cl[r];
                if (dir == 0) { const h16x2 h01 = __builtin_convertvector((f32x2h){hv[0], hv[1]}, h16x2), h23 = __builtin_convertvector((f32x2h){hv[2], hv[3]}, h16x2);
                    *(LAS u32x2*)(lds + ((((8 * sc + wid) * 4 + i) * 16 + p) * 32 + 8 * g)) = (u32x2){__builtin_bit_cast(unsigned, h01), __builtin_bit_cast(unsigned, h23)}; }
                else {
                    const float gr4[4] = {__uint_as_float(gv[i].x << 16), __uint_as_float(gv[i].x & 0xffff0000u), __uint_as_float(gv[i].y << 16), __uint_as_float(gv[i].y & 0xffff0000u)};
                    float y[4];
#pragma unroll
                    for (int r = 0; r < 4; ++r) { const float x = gr4[r]; const float gl = x * fast_sigmoid(1.5957691216057308f * (x + 0.044715f * x * x * x)); y[r] = gl * (hv[r] + hfv[i][r]); }
                    u32x2 w; w.x = cvt_pk_bf16(y[0], y[1]); w.y = cvt_pk_bf16(y[2], y[3]);
                    *(u32x2*)(MIXED + (rowbase + tok) * 1024 + 512 + c0 + 4 * g) = w;
                }
            }
        }
        __syncthreads();
    }
}
}
struct Args { const float* in[22]; float* out; unsigned char* ws; int ph_lo, ph_hi; };
constexpr int N_PHASES = 6;

__global__ void __launch_bounds__(NWAVES * 64, 2) mk_fwd(Args args) {
    extern __shared__ __attribute__((aligned(16))) unsigned char lds_raw[];
    LAS unsigned char* lds = (LAS unsigned char*)lds_raw;
    const int tid = threadIdx.x, lane = tid & 63; const int wave = __builtin_amdgcn_readfirstlane(tid >> 6);
    const int G = gridDim.x, bx = blockIdx.x; const int vcu = (G % 8 == 0) ? (bx % 8) * (G / 8) + bx / 8 : bx;
    unsigned char* ws = args.ws;
    const float* x = args.in[0]; float* out = args.out;
    bf16_t* WIN = (bf16_t*)(ws + WS_WIN); bf16_t* WOUT = (bf16_t*)(ws + WS_WOUT); bf16_t* WGU = (bf16_t*)(ws + WS_WGU); bf16_t* WDN = (bf16_t*)(ws + WS_WDN);
    float* RSS1 = (float*)(ws + WS_RSS1); float* RSS2 = (float*)(ws + WS_RSS2);
    bf16_t* XN = (bf16_t*)(ws + WS_XN); bf16_t* HB = XN;
    bf16_t* Qb = (bf16_t*)(ws + WS_Q); bf16_t* KT = (bf16_t*)(ws + WS_KT); bf16_t* VT = (bf16_t*)(ws + WS_VT); bf16_t* XR = (bf16_t*)(ws + WS_XR); bf16_t* GR = (bf16_t*)(ws + WS_GR);
    float* HF = (float*)(ws + WS_HF); bf16_t* MIXED = (bf16_t*)(ws + WS_MIXED); bf16_t* ACT = (bf16_t*)(ws + WS_ACT);
    const int lo = args.ph_lo, hi = args.ph_hi;
    volatile LAS unsigned* bst = (volatile LAS unsigned*)(lds + LDS_MISC + 8192);
    if (tid == 0) { bst[0] = 0u; bst[1] = 0u; bst[2] = 0u; }
    __syncthreads();
    xb::XcdBarrier bar = xb::xcd_barrier_post((unsigned*)ws, bst);
    if (lo > 1000) cooperative_groups::this_grid().sync();
#define IN(k) (lo <= (k) && (k) < hi)
#ifndef REP_PHASE
#define REP_PHASE -1
#endif
#define REPS(k) ((REP_PHASE == (k)) ? 2 : 1)
#define REPSYNC(k, rep) do { if ((rep) + 1 < REPS(k)) xb::xcd_barrier(bar); } while (0)
#define SEAM(k) do { if (IN(k) && IN((k) + 1)) { xb::xcd_barrier(bar); } } while (0)

    if (IN(0)) for (int rep = 0; rep < REPS(0); ++rep) {
        LAS float* scr = (LAS float*)(lds + wave * 16384);
        const int gw = vcu * NWAVES + wave, NGW = G * NWAVES;
        constexpr int I_IN = (D / 64) * (DIN / 32), I_OUT = (D / 64) * (D / 32), I_G = (D / 64) * (DFF / 32), I_DN = (DFF / 64) * (D / 32);
        constexpr int NITEMS = I_IN + I_OUT + 2 * I_G + I_DN;
        for (int it = gw; it < NITEMS; it += NGW) {
            int r = it;
            if (r < I_IN) { p0_transpose_item<0>(args.in[2], D, DIN, WIN, nullptr, scr, r, lane); continue; } r -= I_IN;
            if (r < I_OUT) { p0_transpose_item<0>(args.in[16], D, D, WOUT, nullptr, scr, r, lane); continue; } r -= I_OUT;
            if (r < I_G) { p0_transpose_item<1>(args.in[18], D, DFF, WGU, args.in[17], scr, r, lane); continue; } r -= I_G;
            if (r < I_G) { p0_transpose_item<2>(args.in[19], D, DFF, WGU, args.in[17], scr, r, lane); continue; } r -= I_G;
            p0_transpose_item<0>(args.in[20], DFF, D, WDN, nullptr, scr, r, lane);
        }
        for (int m = gw * 4; m < M; m += NGW * 4) rms_rows_to_bf16<4>(x + (size_t)m * D, args.in[1], XN + (size_t)m * D, lane);
        REPSYNC(0, rep);
    }
    SEAM(0);
    if (IN(1)) for (int rep = 0; rep < REPS(1); ++rep) {
        pg8::Gemm g{XN, WIN, M, DIN, D}; pg8::StaticOrder So; So.init(M, DIN, G, bx); So.rep = (REP_PHASE == 10) ? 2 : 1;
        pg8::EpiInProj E{Qb, KT, VT, XR, GR, QSCALE};
        pg8::gemm_phase<pg8::EpiInProj, pg8::StaticOrder, true, true>(lds, g, So, E);
        REPSYNC(1, rep);
    }
    SEAM(1);
    if (IN(2)) {
        float lam;
        { float s1 = 0.f, s2 = 0.f; for (int i = 0; i < 64; ++i) { s1 += args.in[3][i] * args.in[4][i]; s2 += args.in[5][i] * args.in[6][i]; } lam = expf(s1) - expf(s2) + 0.2f; }
#if REP_PHASE == 79
        { const long long pr0 = wall_clock64();
          for (int rnd = 0; rnd * G + vcu < NB * NH * 32; ++rnd) { (void)att::attn_unit<ATT_PROBE, 0, 1>(vcu >> 5, rnd, (vcu & 31) >> 1, Qb, KT, VT, (bf16_t*)(ws + WS_XC), (float*)(ws + WS_OX) + (size_t)vcu * 32768, lds, lam, args.in[7], args.in[8]); }
          __syncthreads();
          if (bx == 0 && tid == 0) { const long long dr = wall_clock64() - pr0; ((float*)ws)[30000] = (float)dr * 2.0e-6f; } }
#endif
#if REP_PHASE == 77 || REP_PHASE == 78
        const long long pc0 = clock64(), pr0 = wall_clock64();
#endif
        for (int it = vcu; it < NB * 32; it += G) {
            const int b_ = it >> 5, cg = it & 31;
            lru::lru_item<1>(b_, cg, XR, GR, HF, MIXED, (bf16_t*)(ws + WS_XC), (unsigned*)ws + 16384 + 64 * (it >> 2), lds, args.in[9], args.in[10], args.in[11], args.in[12], args.in[13], args.in[14], args.in[15]);
        }
        for (int rep = 0; rep < REPS(20); ++rep)
        for (int pr = vcu; pr < NB * NH * 16; pr += G) {
            int b_, h_, qb_; if (G == 256) { const int l = vcu & 31, rp = pr / G; b_ = vcu >> 5; h_ = 2 * rp + (l >> 4); qb_ = l & 15; } else { qb_ = pr & 15; h_ = (pr >> 4) & 3; b_ = pr >> 6; }
            const float* const* kin = (const float* const*)__builtin_amdgcn_kernarg_segment_ptr(); asm volatile("" : "+s"(kin));
            unsigned char* ws2 = *(unsigned char* const*)((const char*)kin + 23 * 8);
            const bf16_t* Qb2 = (const bf16_t*)(ws2 + WS_Q); const bf16_t* KT2 = (const bf16_t*)(ws2 + WS_KT); const bf16_t* VT2 = (const bf16_t*)(ws2 + WS_VT); bf16_t* MX2 = (bf16_t*)(ws2 + WS_MIXED);
            float* OXc = (float*)(ws2 + WS_OX) + ((size_t)vcu * 2 + (size_t)(pr / G)) * 32768; const float* sg2 = kin[7]; const float* rb2 = kin[8];
            if (att::attn_unit<0, 1, 1>(b_, h_, qb_, Qb2, KT2, VT2, MX2, OXc, lds, lam, sg2, rb2))
                (void)att::attn_unit<0, 0, 1>(b_, h_, qb_, Qb2, KT2, VT2, MX2, OXc, lds, lam, sg2, rb2);
            if (att::attn_unit<0, 1, 0>(b_, h_, qb_, Qb2, KT2, VT2, MX2, OXc, lds, lam, sg2, rb2))
                (void)att::attn_unit<0, 0, 0>(b_, h_, qb_, Qb2, KT2, VT2, MX2, OXc, lds, lam, sg2, rb2);
        }
        for (int it = vcu; it < NB * 32; it += G) {
            const int b_ = it >> 5, cg = it & 31;
            lru::lru_item<2>(b_, cg, XR, GR, HF, MIXED, (bf16_t*)(ws + WS_XC), (unsigned*)ws + 16384 + 64 * (it >> 2), lds, args.in[9], args.in[10], args.in[11], args.in[12], args.in[13], args.in[14], args.in[15]);
        }
    }
#if REP_PHASE == 78
    if (IN(2) && bx == 0 && tid == 0) { const long long dc = clock64() - pc0_, dr = wall_clock64() - pr0_; ((float*)ws)[30000] = (float)dc / ((float)dr * 10.0f) * 0.05f; }
#endif
    SEAM(2);
    if (IN(3)) for (int rep = 0; rep < REPS(3); ++rep) {
        pg8::Gemm g{MIXED, WOUT, M, D, D}; pg8::StaticOrder So; So.init(M, D, G, bx);
        pg8::EpiResid<true, false> E{x, out, HB, RSS1, D};
        pg8::gemm_phase<pg8::EpiResid<true, false>, pg8::StaticOrder, true, true>(lds, g, So, E);
        REPSYNC(3, rep);
    }
    SEAM(3);
    if (IN(4)) for (int rep = 0; rep < REPS(4); ++rep) {
        float* RSTD = (float*)(ws + WS_RSTD);
        for (int r = vcu * 128 + (tid >> 2); r < M; r += G * 128) {
            const f32x4 sv = *(const f32x4*)(RSS1 + (size_t)r * 16 + 4 * (tid & 3)); float s = (sv[0] + sv[1]) + (sv[2] + sv[3]);
            s += __shfl_xor(s, 1); s += __shfl_xor(s, 2);
            if ((tid & 3) == 0) RSTD[r] = __builtin_amdgcn_rsqf(s * (1.0f / D) + EPS);
        }
        xb::xcd_barrier(bar);
        pg8::Gemm g{HB, WGU, M, 2 * DFF, D}; pg8::StaticOrder So; So.init(M, 2 * DFF, G, bx); So.rep = (REP_PHASE == 40) ? 2 : 1;
        pg8::EpiGateUp E{ACT, RSTD, DFF};
        pg8::gemm_phase<pg8::EpiGateUp, pg8::StaticOrder, true, true>(lds, g, So, E);
        REPSYNC(4, rep);
    }
    SEAM(4);
    if (IN(5)) for (int rep = 0; rep < REPS(5); ++rep) {
        if (G == 256) {
#pragma unroll 1
            for (int half = 0; half < 2; ++half) {
                const size_t r0 = (size_t)half * (M / 2);
                pg8::Gemm g{ACT + r0 * DFF, WDN, M / 2, D, DFF}; pg8::StaticOrder So; So.init(M / 2, D, G, bx);
                pg8::EpiDownNorm E{HB + r0 * D, out + r0 * D, args.in[21], RSS2 + r0 * 4, (unsigned*)ws + 4096 + 64 * 64 * half, D, EPS, ws};
                pg8::gemm_phase<pg8::EpiDownNorm, pg8::StaticOrder, false, true>(lds, g, So, E);
                __syncthreads();
            }
        }
        REPSYNC(5, rep);
    }
#if REP_PHASE == 99
    for (int i = 0; i < 20; ++i) xb::xcd_barrier(bar);
#endif
#undef IN
#undef SEAM
}
}
namespace dbg {
using namespace mk;
__global__ void __launch_bounds__(256) k_unpack_proj(const bf16_t* Qb, const bf16_t* KT, const bf16_t* VT, const bf16_t* XR, const bf16_t* GR, float* q, float* k, float* v, float* xr, float* gr) {
    const size_t idx = (size_t)blockIdx.x * 256 + threadIdx.x;
    const int c = (int)(idx & 511); const int row = (int)(idx >> 9); const int b = row >> 12, tok = row & 4095, t = tok >> 6, rr = tok & 63;
    q[idx] = bf2f(Qb[idx]) * (1.0f / QSCALE);
    { const int h = c >> 7, w = c & 127, s = w >> 6, d = w & 63, chunk = d >> 3, j = d & 7;
      k[idx] = bf2f(KT[((((size_t)(b * 4 + h) * 2 + s) * 64 + t) * 8 + chunk) * 512 + rr * 8 + j]); }
    { const int h = c >> 7, dv = c & 127, db = dv >> 5, cc = dv & 31;
      v[idx] = bf2f(VT[(((size_t)(b * 4 + h) * 64 + t) * 4 + db) * 2048 + rr * 32 + cc]); }
    xr[idx] = bf2f(XR[idx]); gr[idx] = bf2f(GR[idx]);
}
__global__ void __launch_bounds__(256) k_unpack_bf16(const bf16_t* src, float* dst) { const size_t idx = (size_t)blockIdx.x * 256 + threadIdx.x; dst[idx] = bf2f(src[idx]); }
}

#ifndef STAGE
#define STAGE 4
#endif
static void mk_launch_phases(const mk::Args& a0, int lo, int hi, int grid, hipStream_t stream, bool coop) {
    mk::Args a = a0; a.ph_lo = lo; a.ph_hi = hi;
    if (coop) { void* args[] = {&a}; hipError_t e = hipLaunchCooperativeKernel((const void*)mk::mk_fwd, dim3(grid), dim3(mk::NWAVES * 64), args, mk::LDS_BYTES, stream);
        if (e != hipSuccess) fprintf(stderr, "cooperative launch failed: %s (grid %d)\n", hipGetErrorString(e), grid); }
    else { hipLaunchKernelGGL(mk::mk_fwd, dim3(grid), dim3(mk::NWAVES * 64), mk::LDS_BYTES, stream, a); }
}

extern "C" void kernel_launch(void* const* d_in, const int* in_sizes, int n_in, void* d_out, int out_size, void* d_ws, size_t ws_size, hipStream_t stream) {
    static int grid = 0;
    if (grid == 0) {
        int dev = 0, cus = 0, per_cu = 0;
        hipGetDevice(&dev); hipDeviceGetAttribute(&cus, hipDeviceAttributeMultiprocessorCount, dev);
        if (hipFuncSetAttribute((const void*)mk::mk_fwd, hipFuncAttributeMaxDynamicSharedMemorySize, mk::LDS_BYTES) != hipSuccess) { fprintf(stderr, "hipFuncSetAttribute failed\n"); grid = -1; return; }
        if (hipOccupancyMaxActiveBlocksPerMultiprocessor(&per_cu, (const void*)mk::mk_fwd, mk::NWAVES * 64, mk::LDS_BYTES) != hipSuccess || per_cu < 1) { fprintf(stderr, "occupancy query: %d\n", per_cu); per_cu = 1; }
        (void)hipGetLastError();
        grid = cus * 1;
        if (n_in != 22 || ws_size < 512u * mk::MiB) fprintf(stderr, "kernel_launch: unexpected n_in %d / ws_size %zu\n", n_in, ws_size);
    }
    if (grid < 0) return;
    if (hipMemsetAsync(d_ws, 0, 131072, stream) != hipSuccess) { fprintf(stderr, "memset failed\n"); return; }
    mk::Args a{};
    for (int i = 0; i < 22; ++i) a.in[i] = (const float*)d_in[i];
    a.out = (float*)d_out; a.ws = (unsigned char*)d_ws;
    char* ws = (char*)d_ws; const size_t MiB = 1u << 20;
#if STAGE == 4
    mk_launch_phases(a, 0, mk::N_PHASES, grid, stream, true);
#elif STAGE == 3
    for (int p = 0; p < mk::N_PHASES; ++p) mk_launch_phases(a, p, p + 1, grid, stream, false);
#elif STAGE == 1
    for (int p = 0; p < 2; ++p) mk_launch_phases(a, p, p + 1, grid, stream, false);
    float* q = (float*)(ws + 32 * MiB), *k = (float*)(ws + 256 * MiB), *v = (float*)(ws + 320 * MiB), *xr = (float*)(ws + 384 * MiB), *gr = (float*)(ws + 448 * MiB);
    dbg::k_unpack_proj<<<mk::M * 512 / 256, 256, 0, stream>>>((const mk::bf16_t*)(ws + mk::WS_Q), (const mk::bf16_t*)(ws + mk::WS_KT), (const mk::bf16_t*)(ws + mk::WS_VT), (const mk::bf16_t*)(ws + mk::WS_XR), (const mk::bf16_t*)(ws + mk::WS_GR), q, k, v, xr, gr);
    float* mixed = (float*)(ws + 96 * MiB);
    nv::naive_mid(d_in, q, k, v, xr, gr, mixed, stream);
    nv::naive_tail(d_in, mixed, (float*)d_out, (float*)(ws + 0), (float*)(ws + 128 * MiB), stream);
#elif STAGE == 2
    for (int p = 0; p < 3; ++p) mk_launch_phases(a, p, p + 1, grid, stream, false);
    float* mixed = (float*)(ws + 0);
    dbg::k_unpack_bf16<<<mk::M * 1024 / 256, 256, 0, stream>>>((const mk::bf16_t*)(ws + mk::WS_MIXED), mixed);
    nv::naive_tail(d_in, mixed, (float*)d_out, (float*)(ws + 0), (float*)(ws + 128 * MiB), stream);
#endif
}
```

```cpp
#include <hip/hip_runtime.h>
#include <hip/hip_cooperative_groups.h>
#include <cstdio>
#include <cstdint>
#include <cmath>
#define STAGE 4
namespace pg8 {
#define PG8_LAS __attribute__((address_space(3)))
typedef unsigned short bf16_t;
typedef short bf16x8 __attribute__((ext_vector_type(8)));
typedef float f32x4 __attribute__((ext_vector_type(4)));
typedef unsigned u32x4 __attribute__((ext_vector_type(4)));
constexpr int BM = 256, BK = 64, HALF = 128, HTB = HALF * BK * 2  , STAGE_BYTES = 8 * HTB, NXCD = 8, WGM = 8;

__host__ __device__ __forceinline__ int lds_byte(int r, int c) { const int st = (r >> 4) * 2 + (c >> 5), rr = r & 15, cc = c & 31, ob = rr * 64 + cc * 2; return st * 1024 + (ob ^ (((ob >> 9) & 1) << 5)); }
__host__ __device__ __forceinline__ void stage_rc(int b, int& R, int& C) { const int st = b / 1024, sb = b % 1024, swz = sb ^ (((sb >> 9) & 1) << 5); R = (st >> 1) * 16 + swz / 64; C = (st & 1) * 32 + (swz % 64) / 2; }
__host__ __device__ __forceinline__ int perm32(int rho) { const int n = rho >> 4, i = rho & 15; return 8 * (i >> 2) + 4 * n + (i & 3); }

struct Unit { int pm, pn; };
struct Gemm { const bf16_t* A; const bf16_t* Bt; int M, N, K; };

struct StaticOrder {
    int nM, nN, nwg, G, c, rep;
    __host__ __device__ void init(int M, int N, int G_, int c_) { nM = M / BM; nN = N / BM; nwg = nM * nN; G = G_; c = c_; rep = 1; }
    __host__ __device__ bool next(int i, Unit& u) const {
        const long L = (long)(i / rep) * G + c; if (L >= nwg) return false;
        int wgid = (int)L; { const int q = nwg / NXCD, r = nwg % NXCD, xcd = wgid % NXCD, off = wgid / NXCD; wgid = (xcd < r ? xcd * (q + 1) : r * (q + 1) + (xcd - r) * q) + off; }
        const int nig = WGM * nN, gid = wgid / nig, fm = gid * WGM, gsz = (nM - fm) < WGM ? (nM - fm) : WGM;
        u.pm = fm + ((wgid % nig) % gsz); u.pn = (wgid % nig) / gsz; return true;
    }
    __device__ __forceinline__ void a_ready(const Unit&) const {}
    __device__ __forceinline__ void done(const Unit&) const {}
};

struct SegOrder {
    int pm0, pn0, c0, pm1, pn1, c1, st;
    __host__ __device__ bool next(int i, Unit& u) const { if (i < c0) { u.pm = pm0; u.pn = pn0 + st * i; return true; } i -= c0; if (i < c1) { u.pm = pm1; u.pn = pn1 + st * i; return true; } return false; }
    __device__ __forceinline__ void a_ready(const Unit&) const {}
    __device__ __forceinline__ void done(const Unit&) const {}
};

__host__ __device__ __forceinline__ long t512(long row, int col) { return (((row >> 4) * 16 + (col >> 5)) << 9) + ((row & 15) << 5) + (col & 31); }
__host__ __device__ __forceinline__ long tK(long row, int col, int K) { return (((row >> 4) * (K >> 5) + (col >> 5)) << 9) + ((row & 15) << 5) + (col & 31); }

typedef float f32x2_cv __attribute__((ext_vector_type(2))); typedef __bf16 bf16x2_cv __attribute__((ext_vector_type(2)));
__device__ __forceinline__ unsigned cvt_pk_bf16(float lo, float hi) { f32x2_cv v = {lo, hi}; bf16x2_cv b = __builtin_convertvector(v, bf16x2_cv); return __builtin_bit_cast(unsigned, b); }
typedef float f32x2 __attribute__((ext_vector_type(2)));
typedef unsigned u32x2 __attribute__((ext_vector_type(2)));
__device__ __forceinline__ u32x4 pack8(f32x4 v0, f32x4 v1) { u32x4 w; w.x = cvt_pk_bf16(v0[0], v0[1]); w.y = cvt_pk_bf16(v0[2], v0[3]); w.z = cvt_pk_bf16(v1[0], v1[1]); w.w = cvt_pk_bf16(v1[2], v1[3]); return w; }
struct EpiInProj {
    static constexpr bool PERM = true, AFTER_DRAIN = false;
    bf16_t *Q, *KT, *VT, *XR, *GR; float qscale; const PG8_LAS float* rl;
    __device__ __forceinline__ void operator()(const f32x4 (&acc)[2][2][4][2], const Unit& u, int wr, int wc, int fr, int fq) const {
        const int sec = u.pn >> 1, half = u.pn & 1;
#pragma unroll
        for (int ai = 0; ai < 2; ++ai)
#pragma unroll
            for (int m = 0; m < 4; ++m) {
                const int row = u.pm * BM + ai * HALF + wr * 64 + m * 16 + fr;
                const int b = row >> 12, tok = row & 4095, t = tok >> 6, rr = tok & 63;
                const float rs_ = rl[((u.pm >> 3) & 1) * 256 + ai * HALF + wr * 64 + m * 16 + fr];
#pragma unroll
                for (int bj = 0; bj < 2; ++bj) {
                    f32x4 v0 = acc[ai][bj][m][0] * rs_, v1 = acc[ai][bj][m][1] * rs_;
                    const int cs = half * 256 + bj * HALF + wc * 32 + 8 * fq;
                    if (sec == 0) { v0 = v0 * qscale; v1 = v1 * qscale; *(u32x4*)(Q + t512(row, cs)) = pack8(v0, v1); }
                    else if (sec == 1) { const int h = half * 2 + bj, s = wc >> 1, chunk = 4 * (wc & 1) + fq;
                        *(u32x4*)(KT + ((((size_t)(b * 4 + h) * 2 + s) * 64 + t) * 8 + chunk) * 512 + rr * 8) = pack8(v0, v1); }
                    else if (sec == 2) { const int h = half * 2 + bj;
                        *(u32x4*)(VT + (((size_t)(b * 4 + h) * 64 + t) * 4 + wc) * 2048 + rr * 32 + 8 * fq) = pack8(v0, v1); }
                    else if (sec == 3) { *(u32x4*)(XR + t512(row, cs)) = pack8(v0, v1); }
                    else {
#pragma unroll
                        for (int i = 0; i < 4; ++i) {
                            { const float x = v0[i]; const float z = (x * (-1.5957691216057308f * 1.4426950408889634f)) * (x * x * 0.044715f + 1.0f); v0[i] = x * __builtin_amdgcn_rcpf(1.0f + __builtin_amdgcn_exp2f(z)); }
                            { const float x = v1[i]; const float z = (x * (-1.5957691216057308f * 1.4426950408889634f)) * (x * x * 0.044715f + 1.0f); v1[i] = x * __builtin_amdgcn_rcpf(1.0f + __builtin_amdgcn_exp2f(z)); } }
                        *(u32x4*)(GR + t512(row, cs)) = pack8(v0, v1); }
                }
            }
    }
};
template <bool WRITE_HB, bool WRITE_F32 = true> struct EpiResid {
    static constexpr bool PERM = true, AFTER_DRAIN = false;
    const bf16_t* base; float* out; bf16_t* hb; float* rss; int ldc;
    __device__ __forceinline__ void operator()(const f32x4 (&acc)[2][2][4][2], const Unit& u, int wr, int wc, int fr, int fq) const {
        const int col0 = u.pn * BM + wc * 32 + 8 * fq;
        u32x4 nx[2];
        { const size_t off0 = (size_t)(u.pm * BM + wr * 64 + fr) * ldc + col0;
#pragma unroll
          for (int bj = 0; bj < 2; ++bj) nx[bj] = *(const u32x4*)(base + off0 + bj * HALF); }
#pragma unroll
        for (int gi = 0; gi < 8; ++gi) {
            const int ai = gi >> 2, m = gi & 3;
            const int row = u.pm * BM + ai * HALF + wr * 64 + m * 16 + fr; const size_t off = (size_t)row * ldc + col0; float ss = 0.f;
            f32x4 cur[2][2];
#pragma unroll
            for (int bj = 0; bj < 2; ++bj) { const unsigned w0 = nx[bj][0], w1 = nx[bj][1], w2 = nx[bj][2], w3 = nx[bj][3];
                cur[bj][0] = (f32x4){__uint_as_float(w0 << 16), __uint_as_float(w0 & 0xffff0000u), __uint_as_float(w1 << 16), __uint_as_float(w1 & 0xffff0000u)};
                cur[bj][1] = (f32x4){__uint_as_float(w2 << 16), __uint_as_float(w2 & 0xffff0000u), __uint_as_float(w3 << 16), __uint_as_float(w3 & 0xffff0000u)}; }
            if (gi < 7) { const int ai2 = (gi + 1) >> 2, m2 = (gi + 1) & 3; const size_t off2 = (size_t)(u.pm * BM + ai2 * HALF + wr * 64 + m2 * 16 + fr) * ldc + col0;
#pragma unroll
                for (int bj = 0; bj < 2; ++bj) nx[bj] = *(const u32x4*)(base + off2 + bj * HALF); }
#pragma unroll
            for (int bj = 0; bj < 2; ++bj) {
                const f32x4 o0 = acc[ai][bj][m][0] + cur[bj][0], o1 = acc[ai][bj][m][1] + cur[bj][1];
                if (WRITE_F32) { *(f32x4*)(out + off + bj * HALF) = o0; *(f32x4*)(out + off + bj * HALF + 4) = o1; }
                if (WRITE_HB) *(u32x4*)(hb + tK(row, col0 + bj * HALF, ldc)) = pack8(o0, o1);
                ss += ((o0[0] * o0[0] + o0[1] * o0[1]) + (o0[2] * o0[2] + o0[3] * o0[3])) + ((o1[0] * o1[0] + o1[1] * o1[1]) + (o1[2] * o1[2] + o1[3] * o1[3]));
            }
            ss += __shfl_xor(ss, 16); ss += __shfl_xor(ss, 32);
            if (fq == 0) rss[(size_t)row * 16 + u.pn * 4 + wc] = ss;
        }
    }
};
struct EpiGateUp {
    static constexpr bool PERM = true, AFTER_DRAIN = false;
    bf16_t* act; const PG8_LAS float* rl; int ldo;
    __device__ __forceinline__ void operator()(const f32x4 (&acc)[2][2][4][2], const Unit& u, int wr, int wc, int fr, int fq) const {
        const int col0 = u.pn * HALF + wc * 32 + 8 * fq;
        float rs[2][4];
#pragma unroll
        for (int ai = 0; ai < 2; ++ai)
#pragma unroll
            for (int m = 0; m < 4; ++m) rs[ai][m] = rl[((u.pm >> 3) & 1) * 256 + ai * HALF + wr * 64 + m * 16 + fr];
#pragma unroll
        for (int ai = 0; ai < 2; ++ai)
#pragma unroll
            for (int m = 0; m < 4; ++m) {
                const int row = u.pm * BM + ai * HALF + wr * 64 + m * 16 + fr;
                const float r_ = rs[ai][m], c1 = r_ * -1.4426950408889634f, r2 = r_ * r_;
                f32x4 o[2];
#pragma unroll
                for (int n = 0; n < 2; ++n) {
                    const f32x4 g = acc[ai][0][m][n], up = acc[ai][1][m][n];
#pragma unroll
                    for (int i = 0; i < 4; ++i) { const float e = __builtin_amdgcn_exp2f(g[i] * c1); o[n][i] = (g[i] * up[i]) * (r2 * __builtin_amdgcn_rcpf(1.0f + e)); }
                }
                *(u32x4*)(act + tK(row, col0, ldo)) = pack8(o[0], o[1]);
            }
    }
};
struct EpiGateUpL {
    static constexpr bool PERM = true, AFTER_DRAIN = false;
    bf16_t* act; const PG8_LAS float* rl; int pm0; int ldo;
    __device__ __forceinline__ void operator()(const f32x4 (&acc)[2][2][4][2], const Unit& u, int wr, int wc, int fr, int fq) const {
        const int col0 = u.pn * HALF + wc * 32 + 8 * fq;
        float rs[2][4];
#pragma unroll
        for (int ai = 0; ai < 2; ++ai)
#pragma unroll
            for (int m = 0; m < 4; ++m) rs[ai][m] = rl[((u.pm != pm0) ? 256 : 0) + ai * HALF + wr * 64 + m * 16 + fr];
#pragma unroll
        for (int ai = 0; ai < 2; ++ai)
#pragma unroll
            for (int m = 0; m < 4; ++m) {
                const int row = u.pm * BM + ai * HALF + wr * 64 + m * 16 + fr;
                const float r_ = rs[ai][m], c1 = r_ * -1.4426950408889634f, r2 = r_ * r_;
                f32x4 o[2];
#pragma unroll
                for (int n = 0; n < 2; ++n) {
                    const f32x4 g = acc[ai][0][m][n], up = acc[ai][1][m][n];
#pragma unroll
                    for (int i = 0; i < 4; ++i) { const float e = __builtin_amdgcn_exp2f(g[i] * c1); o[n][i] = (g[i] * up[i]) * (r2 * __builtin_amdgcn_rcpf(1.0f + e)); }
                }
                *(u32x4*)(act + tK(row, col0, ldo)) = pack8(o[0], o[1]);
            }
    }
};

struct EpiDownNorm {
    static constexpr bool PERM = true, AFTER_DRAIN = true;
    const bf16_t* hb; float* out; const float* gain; float* xbuf; unsigned* cnt; int ldc; float eps; const void* cnt_base_probe;
    __device__ __forceinline__ void fused(f32x4 (&acc)[2][2][4][2], const Unit& u, int wr, int wc, int fr, int fq, PG8_LAS unsigned char* lds, int wid, int lane) const {
        PG8_LAS float* P = (PG8_LAS float*)lds;
        PG8_LAS float* Sx = (PG8_LAS float*)(lds + 4096);
        PG8_LAS unsigned* flag = (PG8_LAS unsigned*)(lds + 4096 + 1024);
        const int col0 = u.pn * BM + wc * 32 + 8 * fq;
        u32x4 nx[2];
        { const size_t off0 = (size_t)(u.pm * BM + wr * 64 + fr) * ldc + col0;
#pragma unroll
          for (int bj = 0; bj < 2; ++bj) nx[bj] = *(const u32x4*)(hb + tK(u.pm * BM + wr * 64 + fr, col0 + bj * HALF, ldc)); (void)off0; }
#pragma unroll
        for (int gi = 0; gi < 8; ++gi) {
            const int ai = gi >> 2, m = gi & 3;
            const int r = ai * HALF + wr * 64 + m * 16 + fr; float ss = 0.f;
            u32x4 cur[2];
#pragma unroll
            for (int bj = 0; bj < 2; ++bj) cur[bj] = nx[bj];
            if (gi < 7) { const int ai2 = (gi + 1) >> 2, m2 = (gi + 1) & 3; const size_t off2 = (size_t)(u.pm * BM + ai2 * HALF + wr * 64 + m2 * 16 + fr) * ldc + col0;
#pragma unroll
                for (int bj = 0; bj < 2; ++bj) nx[bj] = *(const u32x4*)(hb + tK(u.pm * BM + ai2 * HALF + wr * 64 + m2 * 16 + fr, col0 + bj * HALF, ldc)); (void)off2; }
#pragma unroll
            for (int bj = 0; bj < 2; ++bj)
#pragma unroll
                for (int n = 0; n < 2; ++n) {
                    const unsigned hx = n ? cur[bj][2] : cur[bj][0], hy = n ? cur[bj][3] : cur[bj][1];
                    const f32x4 h4 = (f32x4){__uint_as_float(hx << 16), __uint_as_float(hx & 0xffff0000u), __uint_as_float(hy << 16), __uint_as_float(hy & 0xffff0000u)};
                    const f32x4 o = acc[ai][bj][m][n] + h4; acc[ai][bj][m][n] = o;
                    ss += (o[0] * o[0] + o[1] * o[1]) + (o[2] * o[2] + o[3] * o[3]);
                }
            ss += __shfl_xor(ss, 16); ss += __shfl_xor(ss, 32);
            if (fq == 0) P[r * 4 + wc] = ss;
        }
        asm volatile("s_waitcnt lgkmcnt(0)" ::: "memory"); __builtin_amdgcn_s_barrier(); asm volatile("" ::: "memory");
        const int row = wid * 32 + (lane & 31);
        if (lane < 32) {
            const float s = (P[row * 4 + 0] + P[row * 4 + 1]) + (P[row * 4 + 2] + P[row * 4 + 3]);
            __hip_atomic_store(xbuf + (size_t)(u.pm * BM + row) * 4 + u.pn, s, __ATOMIC_RELAXED, __HIP_MEMORY_SCOPE_AGENT);
        }
        asm volatile("s_waitcnt vmcnt(0)" ::: "memory");
        if (lane == 0) __hip_atomic_fetch_add(cnt + 64 * u.pm, 1u, __ATOMIC_RELAXED, __HIP_MEMORY_SCOPE_AGENT);
        if (wid == 0) {
            unsigned sp = 0;
            for (;;) {
                if ((unsigned)__builtin_amdgcn_readfirstlane(__hip_atomic_load(cnt + 64 * u.pm, __ATOMIC_RELAXED, __HIP_MEMORY_SCOPE_AGENT)) >= 32u) break;
                if (++sp > (1u << 22)) break;
                __builtin_amdgcn_s_sleep(2);
            }
            __builtin_amdgcn_fence(__ATOMIC_ACQUIRE, "agent");
            if (lane == 0) flag[0] = 0u;
        }
        asm volatile("s_waitcnt vmcnt(0) lgkmcnt(0)" ::: "memory"); __builtin_amdgcn_s_barrier(); asm volatile("" ::: "memory");
        if (lane < 32) {
            const float* slot = xbuf + (size_t)(u.pm * BM + row) * 4;
            const float a = __hip_atomic_load(slot + 0, __ATOMIC_RELAXED, __HIP_MEMORY_SCOPE_AGENT), b = __hip_atomic_load(slot + 1, __ATOMIC_RELAXED, __HIP_MEMORY_SCOPE_AGENT),
                        c = __hip_atomic_load(slot + 2, __ATOMIC_RELAXED, __HIP_MEMORY_SCOPE_AGENT), d = __hip_atomic_load(slot + 3, __ATOMIC_RELAXED, __HIP_MEMORY_SCOPE_AGENT);
            Sx[row] = 1.0f / sqrtf(((a + b) + (c + d)) * (1.0f / 1024.0f) + eps);
        }
        asm volatile("s_waitcnt lgkmcnt(0)" ::: "memory"); __builtin_amdgcn_s_barrier(); asm volatile("" ::: "memory");
        f32x4 gv[2][2];
#pragma unroll
        for (int bj = 0; bj < 2; ++bj)
#pragma unroll
            for (int n = 0; n < 2; ++n) gv[bj][n] = *(const f32x4*)(gain + col0 + bj * HALF + n * 4);
#if defined(REP_PHASE) && (REP_PHASE == 77 || REP_PHASE == 79 || REP_PHASE == 80)
        { const float sc_ = 1.0f + ((const float*)cnt_base_probe)[30000];
#pragma unroll
          for (int bj = 0; bj < 2; ++bj)
#pragma unroll
              for (int n = 0; n < 2; ++n) gv[bj][n] = gv[bj][n] * sc_; }
#endif
#pragma unroll
        for (int ai = 0; ai < 2; ++ai)
#pragma unroll
            for (int m = 0; m < 4; ++m) {
                const int r = ai * HALF + wr * 64 + m * 16 + fr; const float rs = Sx[r]; const size_t off = (size_t)(u.pm * BM + r) * ldc + col0;
#pragma unroll
                for (int bj = 0; bj < 2; ++bj)
#pragma unroll
                    for (int n = 0; n < 2; ++n) *(f32x4*)(out + off + bj * HALF + n * 4) = acc[ai][bj][m][n] * rs * gv[bj][n];
            }
    }
};
struct EpiDownNormStream {
    static constexpr bool PERM = false, AFTER_DRAIN = false;
    const bf16_t* hb; float* out; const float* gain; float* xbuf; unsigned* cnt; int ldc; float eps; const void* cnt_base_probe; PG8_LAS unsigned char* lds_x;
    __device__ __forceinline__ void operator()(const f32x4 (&acc_in)[2][2][4][2], const Unit& u, int wr, int wc, int fr, int fq) const {
        PG8_LAS unsigned char* lds = lds_x; const int lane = threadIdx.x & 63, wid = __builtin_amdgcn_readfirstlane(threadIdx.x >> 6);
        f32x4 acc[2][2][4][2];
#pragma unroll
        for (int a_ = 0; a_ < 2; ++a_)
#pragma unroll
            for (int b_ = 0; b_ < 2; ++b_)
#pragma unroll
                for (int m_ = 0; m_ < 4; ++m_)
#pragma unroll
                    for (int n_ = 0; n_ < 2; ++n_) acc[a_][b_][m_][n_] = acc_in[a_][b_][m_][n_];
        PG8_LAS float* P = (PG8_LAS float*)lds;
        PG8_LAS float* Sx = (PG8_LAS float*)(lds + 4096);
        PG8_LAS unsigned* flag = (PG8_LAS unsigned*)(lds + 4096 + 1024);
        const int col0 = u.pn * BM + wc * 32 + 4 * fq;
        u32x2 nx[2][2];
        { const size_t off0 = (size_t)(u.pm * BM + wr * 64 + fr) * ldc + col0;
#pragma unroll
          for (int bj = 0; bj < 2; ++bj)
#pragma unroll
              for (int n = 0; n < 2; ++n) nx[bj][n] = *(const u32x2*)(hb + off0 + bj * HALF + n * 16); }
#pragma unroll
        for (int gi = 0; gi < 8; ++gi) {
            const int ai = gi >> 2, m = gi & 3;
            const int r = ai * HALF + wr * 64 + m * 16 + fr; float ss = 0.f;
            u32x2 cur[2][2];
#pragma unroll
            for (int bj = 0; bj < 2; ++bj)
#pragma unroll
                for (int n = 0; n < 2; ++n) cur[bj][n] = nx[bj][n];
            if (gi < 7) { const int ai2 = (gi + 1) >> 2, m2 = (gi + 1) & 3; const size_t off2 = (size_t)(u.pm * BM + ai2 * HALF + wr * 64 + m2 * 16 + fr) * ldc + col0;
#pragma unroll
                for (int bj = 0; bj < 2; ++bj)
#pragma unroll
                    for (int n = 0; n < 2; ++n) nx[bj][n] = *(const u32x2*)(hb + off2 + bj * HALF + n * 16); }
#pragma unroll
            for (int bj = 0; bj < 2; ++bj)
#pragma unroll
                for (int n = 0; n < 2; ++n) {
                    const u32x2 hv = cur[bj][n];
                    const f32x4 h4 = (f32x4){__uint_as_float(hv.x << 16), __uint_as_float(hv.x & 0xffff0000u), __uint_as_float(hv.y << 16), __uint_as_float(hv.y & 0xffff0000u)};
                    const f32x4 o = acc[ai][bj][m][n] + h4; acc[ai][bj][m][n] = o;
                    ss += (o[0] * o[0] + o[1] * o[1]) + (o[2] * o[2] + o[3] * o[3]);
                }
            ss += __shfl_xor(ss, 16); ss += __shfl_xor(ss, 32);
            if (fq == 0) P[r * 4 + wc] = ss;
        }
        asm volatile("s_waitcnt lgkmcnt(0)" ::: "memory"); __builtin_amdgcn_s_barrier(); asm volatile("" ::: "memory");
        const int row = wid * 32 + (lane & 31);
        if (lane < 32) {
            const float s = (P[row * 4 + 0] + P[row * 4 + 1]) + (P[row * 4 + 2] + P[row * 4 + 3]);
            __hip_atomic_store(xbuf + (size_t)(u.pm * BM + row) * 4 + u.pn, s, __ATOMIC_RELAXED, __HIP_MEMORY_SCOPE_AGENT);
        }
        asm volatile("s_waitcnt vmcnt(0)" ::: "memory");
        if (lane == 0) __hip_atomic_fetch_add(cnt + 64 * u.pm, 1u, __ATOMIC_RELAXED, __HIP_MEMORY_SCOPE_AGENT);
        if (wid == 0) {
            unsigned sp = 0;
            for (;;) {
                if ((unsigned)__builtin_amdgcn_readfirstlane(__hip_atomic_load(cnt + 64 * u.pm, __ATOMIC_RELAXED, __HIP_MEMORY_SCOPE_AGENT)) >= 32u) break;
                if (++sp > (1u << 22)) break;
                __builtin_amdgcn_s_sleep(2);
            }
            __builtin_amdgcn_fence(__ATOMIC_ACQUIRE, "agent");
            if (lane == 0) flag[0] = 0u;
        }
        asm volatile("s_waitcnt vmcnt(0) lgkmcnt(0)" ::: "memory"); __builtin_amdgcn_s_barrier(); asm volatile("" ::: "memory");
        if (lane < 32) {
            const float* slot = xbuf + (size_t)(u.pm * BM + row) * 4;
            const float a = __hip_atomic_load(slot + 0, __ATOMIC_RELAXED, __HIP_MEMORY_SCOPE_AGENT), b = __hip_atomic_load(slot + 1, __ATOMIC_RELAXED, __HIP_MEMORY_SCOPE_AGENT),
                        c = __hip_atomic_load(slot + 2, __ATOMIC_RELAXED, __HIP_MEMORY_SCOPE_AGENT), d = __hip_atomic_load(slot + 3, __ATOMIC_RELAXED, __HIP_MEMORY_SCOPE_AGENT);
            Sx[row] = 1.0f / sqrtf(((a + b) + (c + d)) * (1.0f / 1024.0f) + eps);
        }
        asm volatile("s_waitcnt lgkmcnt(0)" ::: "memory"); __builtin_amdgcn_s_barrier(); asm volatile("" ::: "memory");
        f32x4 gv[2][2];
#pragma unroll
        for (int bj = 0; bj < 2; ++bj)
#pragma unroll
            for (int n = 0; n < 2; ++n) gv[bj][n] = *(const f32x4*)(gain + col0 + bj * HALF + n * 16);
#if defined(REP_PHASE) && (REP_PHASE == 77 || REP_PHASE == 79 || REP_PHASE == 80)
        { const float sc_ = 1.0f + ((const float*)cnt_base_probe)[30000];
#pragma unroll
          for (int bj = 0; bj < 2; ++bj)
#pragma unroll
              for (int n = 0; n < 2; ++n) gv[bj][n] = gv[bj][n] * sc_; }
#endif
#pragma unroll
        for (int ai = 0; ai < 2; ++ai)
#pragma unroll
            for (int m = 0; m < 4; ++m) {
                const int r = ai * HALF + wr * 64 + m * 16 + fr; const float rs = Sx[r]; const size_t off = (size_t)(u.pm * BM + r) * ldc + col0;
#pragma unroll
                for (int bj = 0; bj < 2; ++bj)
#pragma unroll
                    for (int n = 0; n < 2; ++n) *(f32x4*)(out + off + bj * HALF + n * 16) = acc[ai][bj][m][n] * rs * gv[bj][n];
            }
    }
};
struct NoPre { enum { ON = 0 }; __device__ __forceinline__ void issue() {} __device__ __forceinline__ void finish() {} };
template <class Epi, class Sched, bool ALIGN_EPI = false, bool SP2 = false, bool TA = false, class Pre = NoPre>
__device__ __forceinline__ void gemm_phase(PG8_LAS unsigned char* lds, const Gemm g, const Sched& S, const Epi& E, const int tid_in = -1, Pre* pre = nullptr) {
    const int tid = (tid_in >= 0) ? tid_in : (int)threadIdx.x, wid = __builtin_amdgcn_readfirstlane(tid >> 6), lane = tid & 63, wr = wid >> 2, wc = wid & 3, fr = lane & 15, fq = lane >> 4;
    const int K = g.K, nt = K / BK;
    unsigned voffA[2], voffB[2];
#pragma unroll
    for (int i = 0; i < 2; ++i) { int R, C; stage_rc(tid * 16 + i * 8192, R, C); const int Rb = Epi::PERM ? ((R & ~31) + perm32(R & 31)) : R;
        voffA[i] = TA ? (unsigned)((((R >> 4) * (K >> 5) + (C >> 5)) << 10) + ((R & 15) << 6) + ((C & 31) << 1)) : (unsigned)(R * K + C) * 2u; voffB[i] = (unsigned)(Rb * K + C) * 2u; }
    const size_t kstep = (size_t)(BK * 2);
    const size_t kstepA = TA ? (size_t)2048 : kstep;
    const size_t hstep = (size_t)HALF * K * 2;
    const size_t tstep = 2 * hstep;
    const unsigned ldsw = (unsigned)wid * 1024u;
    const int aoff = lds_byte(wr * 64 + fr, fq * 8), boff = lds_byte(wc * 32 + fr, fq * 8);
#define PG8_SA(b, h) (((b) * 2 + (h)) * HTB)
#define PG8_SB(b, h) ((4 + (b) * 2 + (h)) * HTB)
#define PG8_STAGE(bufoff, gbase, voff) do { _Pragma("unroll") for (int _i = 0; _i < 2; ++_i) \
        __builtin_amdgcn_global_load_lds((const unsigned*)((const char*)(gbase) + (voff)[_i]), (PG8_LAS unsigned*)(lds + (bufoff) + ldsw + _i * 8192), 16, 0, 0); } while (0)
#define PG8_LDA(dst, b, h) do { _Pragma("unroll") for (int m = 0; m < 4; ++m) _Pragma("unroll") for (int k = 0; k < 2; ++k) dst[m][k] = *(const PG8_LAS bf16x8*)(lds + PG8_SA(b, h) + aoff + m * 2048 + k * 1024); } while (0)
#define PG8_LDB(dst, b, h) do { _Pragma("unroll") for (int n = 0; n < 2; ++n) _Pragma("unroll") for (int k = 0; k < 2; ++k) dst[n][k] = *(const PG8_LAS bf16x8*)(lds + PG8_SB(b, h) + boff + n * 2048 + k * 1024); } while (0)
#define PG8_MMA(ai, bj, At, Bt) do { __builtin_amdgcn_s_setprio(1); _Pragma("unroll") for (int m = 0; m < 4; ++m) _Pragma("unroll") for (int n = 0; n < 2; ++n) _Pragma("unroll") for (int k = 0; k < 2; ++k) \
        acc[ai][bj][m][n] = __builtin_amdgcn_mfma_f32_16x16x32_bf16(Bt[n][k], At[m][k], acc[ai][bj][m][n], 0, 0, 0); __builtin_amdgcn_s_setprio(0); } while (0)
#define PG8_WAIT_V(n) asm volatile("s_waitcnt vmcnt(" #n ")" ::: "memory")
#define PG8_WAIT_L(n) asm volatile("s_waitcnt lgkmcnt(" #n ")" ::: "memory")
#define PG8_BAR __builtin_amdgcn_s_barrier()
#define PG8_SCHED __builtin_amdgcn_sched_barrier(0)
    Unit cur, nxt; int ui = 0;
    if (!S.next(0, cur)) return;
    f32x4 acc[2][2][4][2];
#pragma unroll
    for (int a = 0; a < 2; ++a)
#pragma unroll
        for (int b = 0; b < 2; ++b)
#pragma unroll
            for (int m = 0; m < 4; ++m)
#pragma unroll
                for (int n = 0; n < 2; ++n) acc[a][b][m][n] = (f32x4){0.f, 0.f, 0.f, 0.f};
    bf16x8 At[4][2], B0[2][2], B1[2][2];
    const char* cA = (const char*)g.A + (size_t)cur.pm * tstep; const char* cB = (const char*)g.Bt + (size_t)cur.pn * tstep;
    S.a_ready(cur);
    if constexpr (SP2) {
        if constexpr (Pre::ON) pre->issue();
        PG8_STAGE(PG8_SB(0, 0), cB, voffB); PG8_STAGE(PG8_SB(0, 1), cB + hstep, voffB); PG8_STAGE(PG8_SA(0, 0), cA, voffA); PG8_STAGE(PG8_SA(0, 1), cA + hstep, voffA);
        if (wr == 1) PG8_BAR;
        PG8_WAIT_V(2); PG8_BAR;
        if constexpr (Pre::ON) pre->finish();
        PG8_STAGE(PG8_SB(1, 0), cB + kstep, voffB); PG8_STAGE(PG8_SA(1, 0), cA + kstepA, voffA); PG8_STAGE(PG8_SB(1, 1), cB + hstep + kstep, voffB);
        PG8_WAIT_V(6); PG8_BAR;
    } else {
        PG8_STAGE(PG8_SB(0, 0), cB, voffB); PG8_STAGE(PG8_SA(0, 0), cA, voffA); PG8_STAGE(PG8_SB(0, 1), cB + hstep, voffB); PG8_STAGE(PG8_SA(0, 1), cA + hstep, voffA);
        if (wr == 1) PG8_BAR;
        PG8_WAIT_V(4); PG8_BAR;
        PG8_STAGE(PG8_SB(1, 0), cB + kstep, voffB); PG8_STAGE(PG8_SA(1, 0), cA + kstepA, voffA); PG8_STAGE(PG8_SB(1, 1), cB + hstep + kstep, voffB);
        PG8_WAIT_V(6); PG8_BAR;
    }
    for (;;) {
        const bool has_next = S.next(ui + 1, nxt);
        const char* nA = has_next ? (const char*)g.A + (size_t)nxt.pm * tstep : cA; const char* nB = has_next ? (const char*)g.Bt + (size_t)nxt.pn * tstep : cB;
        for (int t = 0; t < nt; t += 2) {
            const bool last = (t == nt - 2);
            const char* a1 = cA + (size_t)(t + 1) * kstepA;
            const char* a2 = last ? nA : cA + (size_t)(t + 2) * kstepA; const char* b2 = last ? nB : cB + (size_t)(t + 2) * kstep;
            const char* a3 = a2 + kstepA; const char* b3 = b2 + kstep;
            if (last && has_next) S.a_ready(nxt);
            if constexpr (SP2) {
            PG8_LDB(B0, 0, 0); PG8_LDB(B1, 0, 1); PG8_SCHED; PG8_LDA(At, 0, 0); PG8_STAGE(PG8_SA(1, 1), a1 + hstep, voffA);
            PG8_WAIT_V(8); PG8_WAIT_L(0); PG8_BAR; PG8_MMA(0, 0, At, B0); PG8_MMA(0, 1, At, B1); PG8_BAR; PG8_SCHED;
            PG8_LDA(At, 0, 1); PG8_STAGE(PG8_SB(0, 0), b2, voffB); PG8_STAGE(PG8_SB(0, 1), b2 + hstep, voffB); PG8_STAGE(PG8_SA(0, 0), a2, voffA);
            PG8_WAIT_V(8); PG8_WAIT_L(0); PG8_BAR; PG8_MMA(1, 0, At, B0); PG8_MMA(1, 1, At, B1); PG8_BAR; PG8_SCHED;
            PG8_LDB(B0, 1, 0); PG8_LDB(B1, 1, 1); PG8_SCHED; PG8_LDA(At, 1, 0); PG8_STAGE(PG8_SA(0, 1), a2 + hstep, voffA);
            PG8_WAIT_V(8); PG8_WAIT_L(0); PG8_BAR; PG8_MMA(0, 0, At, B0); PG8_MMA(0, 1, At, B1); PG8_BAR; PG8_SCHED;
            PG8_LDA(At, 1, 1); PG8_STAGE(PG8_SB(1, 0), b3, voffB); PG8_STAGE(PG8_SB(1, 1), b3 + hstep, voffB); PG8_STAGE(PG8_SA(1, 0), a3, voffA);
            PG8_WAIT_V(8); PG8_WAIT_L(0); PG8_BAR; PG8_MMA(1, 0, At, B0); PG8_MMA(1, 1, At, B1); PG8_BAR; PG8_SCHED;
            } else {
            PG8_LDB(B0, 0, 0); PG8_SCHED; PG8_LDA(At, 0, 0); PG8_STAGE(PG8_SA(1, 1), a1 + hstep, voffA);
            PG8_WAIT_L(8); PG8_BAR; PG8_WAIT_L(0); PG8_MMA(0, 0, At, B0); PG8_BAR; PG8_SCHED;
            PG8_LDB(B1, 0, 1); PG8_STAGE(PG8_SB(0, 0), b2, voffB);
            PG8_BAR; PG8_WAIT_L(0); PG8_MMA(0, 1, At, B1); PG8_BAR;
            PG8_LDA(At, 0, 1); PG8_STAGE(PG8_SA(0, 0), a2, voffA);
            PG8_BAR; PG8_WAIT_L(0); PG8_MMA(1, 0, At, B0); PG8_BAR; PG8_SCHED;
            PG8_STAGE(PG8_SB(0, 1), b2 + hstep, voffB);
            PG8_WAIT_V(6); PG8_BAR; PG8_MMA(1, 1, At, B1); PG8_BAR;
            PG8_LDB(B0, 1, 0); PG8_SCHED; PG8_LDA(At, 1, 0); PG8_STAGE(PG8_SA(0, 1), a2 + hstep, voffA);
            PG8_WAIT_L(8); PG8_BAR; PG8_WAIT_L(0); PG8_MMA(0, 0, At, B0); PG8_BAR; PG8_SCHED;
            PG8_LDB(B1, 1, 1); PG8_STAGE(PG8_SB(1, 0), b3, voffB);
            PG8_BAR; PG8_WAIT_L(0); PG8_MMA(0, 1, At, B1); PG8_BAR;
            PG8_LDA(At, 1, 1); PG8_STAGE(PG8_SA(1, 0), a3, voffA);
            PG8_BAR; PG8_WAIT_L(0); PG8_MMA(1, 0, At, B0); PG8_BAR; PG8_SCHED;
            PG8_STAGE(PG8_SB(1, 1), b3 + hstep, voffB);
            PG8_WAIT_V(6); PG8_BAR; PG8_MMA(1, 1, At, B1); PG8_BAR;
            }
        }
        if constexpr (ALIGN_EPI) { if (wr == 0) PG8_BAR; }
        if constexpr (!Epi::AFTER_DRAIN) { E(acc, cur, wr, wc, fr, fq); S.done(cur); }
        if (!has_next) break;
#pragma unroll
        for (int a = 0; a < 2; ++a)
#pragma unroll
            for (int b = 0; b < 2; ++b)
#pragma unroll
                for (int m = 0; m < 4; ++m)
#pragma unroll
                    for (int n = 0; n < 2; ++n) acc[a][b][m][n] = (f32x4){0.f, 0.f, 0.f, 0.f};
        cur = nxt; cA = nA; cB = nB; ++ui;
        if constexpr (ALIGN_EPI) { if (wr == 1) PG8_BAR; }
    }
    PG8_WAIT_V(0);
    if constexpr (!ALIGN_EPI) { if (wr == 0) PG8_BAR; }
    PG8_BAR;
    if constexpr (Epi::AFTER_DRAIN) { E.fused(acc, cur, wr, wc, fr, fq, lds, wid, lane); S.done(cur); }
#undef PG8_SA
#undef PG8_SB
#undef PG8_STAGE
#undef PG8_LDA
#undef PG8_LDB
#undef PG8_MMA
#undef PG8_WAIT_V
#undef PG8_WAIT_L
#undef PG8_BAR
#undef PG8_SCHED
}
}
namespace xb {
#define LAS __attribute__((address_space(3)))
#define XB_TMO      128
#define XB_XCNT(j)  (256  + 64 * (j))
#define XB_XSUB(j)  (1280 + 64 * (j))
#define XB_XGEN(j)  (2304 + 64 * (j))
#define XB_TOP      3328
#define XB_TOPGEN   3392
#define XCD_BAR_WORDS 3456
#define XB_SPIN_CAP (1u << 18)

__device__ __forceinline__ unsigned xb_ld(unsigned* p)              { return __hip_atomic_load(p, __ATOMIC_RELAXED, __HIP_MEMORY_SCOPE_AGENT); }
__device__ __forceinline__ unsigned xb_add(unsigned* p, unsigned v) { return __hip_atomic_fetch_add(p, v, __ATOMIC_RELAXED, __HIP_MEMORY_SCOPE_AGENT); }
__device__ __forceinline__ unsigned xb_xcc_id() { return (unsigned)__builtin_amdgcn_s_getreg((3 << 11) | 20) & 0xFu; }
#define XB_SPIN(cond, bar) do { unsigned _sp = 0; while (cond) { __builtin_amdgcn_s_sleep(1); \
    if ((++_sp & 255u) == 0u) { if (xb_ld(&(bar)[XB_TMO])) break; if (_sp > XB_SPIN_CAP) { atomicAdd(&(bar)[XB_TMO], 1u); break; } } } } while (0)

struct XcdBarrier {
    unsigned* bar; unsigned x;
    volatile LAS unsigned* st;
};

__device__ __forceinline__ XcdBarrier xcd_barrier_post(unsigned* bar, volatile LAS unsigned* st) {
    XcdBarrier b; b.bar = bar; b.x = xb_xcc_id(); b.st = st;
    if (threadIdx.x == 0) st[2] = xb_add(&bar[XB_XCNT(b.x)], 1u);
    return b;
}
__device__ __forceinline__ void xcd_barrier_complete(unsigned* bar, unsigned x, unsigned& nloc, unsigned& nx) {
    const unsigned G = gridDim.x * gridDim.y * gridDim.z;
    unsigned sum, cnt, mine, sp = 0u;
    for (;;) {
        sum = 0u; cnt = 0u; mine = 0u;
#pragma unroll
        for (unsigned j = 0; j < 16; ++j) { const unsigned c = xb_ld(&bar[XB_XCNT(j)]); sum += c; cnt += (c > 0u) ? 1u : 0u; mine = (j == x) ? c : mine; }
        if (sum == G) break;
        __builtin_amdgcn_s_sleep(1);
        if ((++sp & 255u) == 0u) { if (xb_ld(&bar[XB_TMO])) break; if (sp > XB_SPIN_CAP) { atomicAdd(&bar[XB_TMO], 1u); break; } }
    }
    nloc = mine > 0u ? mine : 1u; nx = cnt > 0u ? cnt : 1u;
}

__device__ __forceinline__ void xcd_barrier(const XcdBarrier& b) {
    asm volatile("s_waitcnt vmcnt(0)" ::: "memory");
    __syncthreads();
    if (threadIdx.x == 0) {
        unsigned* bar = b.bar;
        __builtin_amdgcn_s_waitcnt(0);
        unsigned nloc = b.st[0], nx = b.st[1];
        if (nloc == 0u) { xcd_barrier_complete(bar, b.x, nloc, nx); b.st[0] = nloc; b.st[1] = nx; }
        const unsigned old = xb_add(&bar[XB_XSUB(b.x)], 1u);
        const unsigned gen = old / nloc;
        if (old + 1u == (gen + 1u) * nloc) {
            __builtin_amdgcn_fence(__ATOMIC_RELEASE, "agent");
            asm volatile("s_waitcnt vmcnt(0)" ::: "memory");
            const unsigned og = xb_add(&bar[XB_TOP], 1u);
            const unsigned tg = og / nx;
            if (og + 1u == (tg + 1u) * nx) xb_add(&bar[XB_TOPGEN], 1u);
            else XB_SPIN(xb_ld(&bar[XB_TOPGEN]) == tg, bar);
            __builtin_amdgcn_fence(__ATOMIC_ACQUIRE, "agent");
            xb_add(&bar[XB_XGEN(b.x)], 1u);
            asm volatile("s_waitcnt vmcnt(0)" ::: "memory");
        } else {
            XB_SPIN(xb_ld(&bar[XB_XGEN(b.x)]) == gen, bar);
            __builtin_amdgcn_fence(__ATOMIC_ACQUIRE, "agent");
            asm volatile("s_waitcnt vmcnt(0)" ::: "memory");
        }
    }
    __syncthreads();
}

template <class F>
__device__ __forceinline__ void xcd_barrier_shadow(const XcdBarrier& b, const F& work) {
    asm volatile("s_waitcnt vmcnt(0)" ::: "memory");
    __syncthreads();
    const int wv = __builtin_amdgcn_readfirstlane((int)threadIdx.x >> 6);
    if (wv != 0) work(wv);
    else if (threadIdx.x == 0) {
        unsigned* bar = b.bar;
        __builtin_amdgcn_s_waitcnt(0);
        unsigned nloc = b.st[0], nx = b.st[1];
        if (nloc == 0u) { xcd_barrier_complete(bar, b.x, nloc, nx); b.st[0] = nloc; b.st[1] = nx; }
        const unsigned old = xb_add(&bar[XB_XSUB(b.x)], 1u);
        const unsigned gen = old / nloc;
        if (old + 1u == (gen + 1u) * nloc) {
            __builtin_amdgcn_fence(__ATOMIC_RELEASE, "agent");
            asm volatile("s_waitcnt vmcnt(0)" ::: "memory");
            const unsigned og = xb_add(&bar[XB_TOP], 1u);
            const unsigned tg = og / nx;
            if (og + 1u == (tg + 1u) * nx) xb_add(&bar[XB_TOPGEN], 1u);
            else XB_SPIN(xb_ld(&bar[XB_TOPGEN]) == tg, bar);
            __builtin_amdgcn_fence(__ATOMIC_ACQUIRE, "agent");
            xb_add(&bar[XB_XGEN(b.x)], 1u);
            asm volatile("s_waitcnt vmcnt(0)" ::: "memory");
        } else {
            XB_SPIN(xb_ld(&bar[XB_XGEN(b.x)]) == gen, bar);
            __builtin_amdgcn_fence(__ATOMIC_ACQUIRE, "agent");
            asm volatile("s_waitcnt vmcnt(0)" ::: "memory");
        }
    }
    __syncthreads();
}

__device__ __forceinline__ void group_barrier(unsigned* cnt, unsigned target, bool same_l2, unsigned* bar) {
    asm volatile("s_waitcnt vmcnt(0)" ::: "memory");
    __syncthreads();
    if (threadIdx.x == 0) {
        __builtin_amdgcn_s_waitcnt(0);
        if (!same_l2) { __builtin_amdgcn_fence(__ATOMIC_RELEASE, "agent"); asm volatile("s_waitcnt vmcnt(0)" ::: "memory"); }
        xb_add(cnt, 1u);
        XB_SPIN(xb_ld(cnt) < target, bar);
        __builtin_amdgcn_fence(__ATOMIC_ACQUIRE, "agent");
        asm volatile("s_waitcnt vmcnt(0)" ::: "memory");
    }
    __syncthreads();
}

template <class F>
__device__ __forceinline__ void local_barrier_shadow(unsigned* cnt, unsigned target, unsigned* bar, const F& work) {
    asm volatile("s_waitcnt vmcnt(0)" ::: "memory");
    __syncthreads();
    const int wv = __builtin_amdgcn_readfirstlane((int)threadIdx.x >> 6);
    if (wv != 0) work(wv);
    else if (threadIdx.x == 0) {
        __builtin_amdgcn_s_waitcnt(0);
        xb_add(cnt, 1u);
        XB_SPIN(xb_ld(cnt) < target, bar);
        __builtin_amdgcn_fence(__ATOMIC_ACQUIRE, "agent");
        asm volatile("s_waitcnt vmcnt(0)" ::: "memory");
    }
    __syncthreads();
}

}
namespace mk {
#define LAS __attribute__((address_space(3)))
typedef unsigned short bf16_t;
typedef short bf16x8 __attribute__((ext_vector_type(8)));
typedef short s16x4 __attribute__((ext_vector_type(4)));
typedef float f32x4 __attribute__((ext_vector_type(4)));
typedef float f32x16 __attribute__((ext_vector_type(16)));
typedef unsigned u32x4 __attribute__((ext_vector_type(4)));
typedef unsigned u32x2 __attribute__((ext_vector_type(2)));
constexpr int NB = 8, S = 4096, D = 1024, M = NB * S, NH = 4, DFF = 2816, DIN = 2560, NWAVES = 8;
constexpr float EPS = 1e-6f, LOG2E = 1.4426950408889634f;
constexpr float QSCALE = 0.125f * LOG2E;
constexpr size_t MiB = 1u << 20;
constexpr size_t WS_WIN = 1 * MiB, WS_WOUT = 6 * MiB, WS_WGU = 8 * MiB, WS_WDN = 19 * MiB, WS_RSS1 = 25 * MiB, WS_RSS2 = 27 * MiB, WS_RSTD = 29 * MiB, WS_RSTD0 = 30 * MiB  , WS_HB = 384 * MiB  ;
constexpr size_t WS_XN = 32 * MiB, WS_Q = 96 * MiB, WS_KT = 128 * MiB, WS_VT = 160 * MiB, WS_XR = 192 * MiB, WS_GR = 224 * MiB, WS_HF = 256 * MiB, WS_MIXED = 320 * MiB, WS_ACT = 96 * MiB, WS_XC = 384 * MiB, WS_OX = 416 * MiB, WS_END = 480 * MiB;
static_assert(WS_ACT + (size_t)M * DFF * 2 <= WS_MIXED, "act overlays Q..HF only");
constexpr int RING_BYTES = 131072, LDS_MISC = 131072, LDS_LST = 147456  , LDS_BYTES = 163840;

__device__ __forceinline__ unsigned cvt_pk_bf16(float lo, float hi) { return pg8::cvt_pk_bf16(lo, hi); }
__device__ __forceinline__ float bf2f(unsigned short b) { return __uint_as_float(((unsigned)b) << 16); }
__device__ __forceinline__ float wave_sum(float v) {
#pragma unroll
    for (int o = 1; o < 64; o <<= 1) v += __shfl_xor(v, o);
    return v;
}
__device__ __forceinline__ float fast_sigmoid(float x) { return __builtin_amdgcn_rcpf(1.0f + __builtin_amdgcn_exp2f(-LOG2E * x)); }

template <int MAP  >
__device__ __forceinline__ void p0_transpose_item(const float* W, int K, int N, bf16_t* WT, const float* gk, LAS float* scr, int item, int lane) {
    const int nblk = N / 32, kb = item / nblk, nb = item % nblk, k0 = 64 * kb, n0 = 32 * nb;
#pragma unroll
    for (int i = 0; i < 8; ++i) { const int kk = 8 * i + (lane >> 3); f32x4 v = __builtin_nontemporal_load((const f32x4*)(W + (size_t)(k0 + kk) * N + n0 + 4 * (lane & 7))); if (gk) v = v * gk[k0 + kk];
        LAS float* d = scr + kk * 33 + 4 * (lane & 7); d[0] = v[0]; d[1] = v[1]; d[2] = v[2]; d[3] = v[3]; }
    asm volatile("s_waitcnt lgkmcnt(0)" ::: "memory");
    const int c = lane & 7;
#pragma unroll
    for (int j = 0; j < 4; ++j) { const int n = (lane >> 3) + 8 * j; const LAS float* s = scr + (8 * c) * 33 + n;
        u32x4 o; o.x = cvt_pk_bf16(s[0 * 33], s[1 * 33]); o.y = cvt_pk_bf16(s[2 * 33], s[3 * 33]); o.z = cvt_pk_bf16(s[4 * 33], s[5 * 33]); o.w = cvt_pk_bf16(s[6 * 33], s[7 * 33]);
        const int f = n0 + n; const int drow = (MAP == 0) ? f : (256 * (f >> 7) + (f & 127) + (MAP == 2 ? 128 : 0));
        *(u32x4*)(WT + (size_t)drow * K + k0 + 8 * c) = o; }
    asm volatile("s_waitcnt lgkmcnt(0)" ::: "memory");
}
__device__ __forceinline__ void p0_item_load(const float* W, int K, int N, const float* gk, int item, int lane, f32x4 (&v)[8]) {
    const int nblk = N / 32, kb = item / nblk, nb = item % nblk, k0 = 64 * kb, n0 = 32 * nb; (void)K;
#pragma unroll
    for (int i = 0; i < 8; ++i) { const int kk = 8 * i + (lane >> 3); v[i] = __builtin_nontemporal_load((const f32x4*)(W + (size_t)(k0 + kk) * N + n0 + 4 * (lane & 7))); if (gk) v[i] = v[i] * gk[k0 + kk]; }
}
template <int MAP>
__device__ __forceinline__ void p0_item_finish(int K, int N, bf16_t* WT, LAS float* scr, int item, int lane, const f32x4 (&v)[8]) {
    const int nblk = N / 32, kb = item / nblk, nb = item % nblk, k0 = 64 * kb, n0 = 32 * nb;
#pragma unroll
    for (int i = 0; i < 8; ++i) { const int kk = 8 * i + (lane >> 3); LAS float* d = scr + kk * 33 + 4 * (lane & 7); d[0] = v[i][0]; d[1] = v[i][1]; d[2] = v[i][2]; d[3] = v[i][3]; }
    asm volatile("s_waitcnt lgkmcnt(0)" ::: "memory");
    const int c = lane & 7;
#pragma unroll
    for (int j = 0; j < 4; ++j) { const int n = (lane >> 3) + 8 * j; const LAS float* s = scr + (8 * c) * 33 + n;
        u32x4 o; o.x = cvt_pk_bf16(s[0 * 33], s[1 * 33]); o.y = cvt_pk_bf16(s[2 * 33], s[3 * 33]); o.z = cvt_pk_bf16(s[4 * 33], s[5 * 33]); o.w = cvt_pk_bf16(s[6 * 33], s[7 * 33]);
        const int f = n0 + n; const int drow = (MAP == 0) ? f : (256 * (f >> 7) + (f & 127) + (MAP == 2 ? 128 : 0));
        *(u32x4*)(WT + (size_t)drow * K + k0 + 8 * c) = o; }
    asm volatile("s_waitcnt lgkmcnt(0)" ::: "memory");
}
template <int NR>
__device__ __forceinline__ void rms_rows_to_bf16(const float* xrow, float* rstd_out, bf16_t* orow, int lane) {
    f32x4 v[NR][4]; float s[NR];
#pragma unroll
    for (int q = 0; q < NR; ++q) { const f32x4* xr = (const f32x4*)(xrow + (size_t)q * D) + lane;
#pragma unroll
        for (int j = 0; j < 4; ++j) v[q][j] = __builtin_nontemporal_load(xr + 64 * j); }
#pragma unroll
    for (int q = 0; q < NR; ++q) { float a = 0.f;
#pragma unroll
        for (int j = 0; j < 4; ++j) a += (v[q][j][0] * v[q][j][0] + v[q][j][1] * v[q][j][1]) + (v[q][j][2] * v[q][j][2] + v[q][j][3] * v[q][j][3]);
        s[q] = a; }
#pragma unroll
    for (int o = 1; o < 64; o <<= 1)
#pragma unroll
        for (int q = 0; q < NR; ++q) s[q] += __shfl_xor(s[q], o);
#pragma unroll
    for (int q = 0; q < NR; ++q) { if (lane == 0) rstd_out[q] = 1.0f / sqrtf(s[q] * (1.f / D) + EPS); u32x2* o8 = (u32x2*)(orow + (size_t)q * D) + lane;
#pragma unroll
        for (int j = 0; j < 4; ++j) { u32x2 w; w.x = cvt_pk_bf16(v[q][j][0], v[q][j][1]); w.y = cvt_pk_bf16(v[q][j][2], v[q][j][3]); o8[64 * j] = w; } }
}

namespace att {
constexpr int NT = S / 64, SLOT = 16384, KSLOT = 8192, LDS_K = 0, LDS_V = 3 * KSLOT, LDS_OST = 3 * KSLOT + 2 * 16384;
constexpr int LDS_WSF = LDS_MISC, LDS_BIAS = LDS_MISC + 2048, LDS_TOT = LDS_MISC + 3072, LDS_CW = LDS_MISC + 5120, LDS_BIAS2 = LDS_MISC + 8704;
constexpr int THR = 8;
typedef LAS const char* lds_cptr;
typedef short v4i16_t __attribute__((ext_vector_type(4)));
__device__ __forceinline__ int crow(int r, int hi) { return (r & 3) + 8 * (r >> 2) + 4 * hi; }
__device__ __forceinline__ void glds16(const void* gsrc, unsigned lds_dst) { unsigned keep;
    asm volatile("s_mov_b32 %0, m0\n\ts_mov_b32 m0, %2\n\ts_nop 0\n\tglobal_load_lds_dwordx4 %1, off\n\ts_mov_b32 m0, %0" : "=&s"(keep) : "v"(gsrc), "s"(lds_dst) : "memory"); }
__device__ __forceinline__ s16x4 vtr(lds_cptr p) { return __builtin_bit_cast(s16x4, __builtin_amdgcn_ds_read_tr16_b64_v4i16((LAS v4i16_t*)p)); }
#define ATT_MX3(a, b, c) __builtin_fmaxf(__builtin_fmaxf((a), (b)), (c))
__device__ __forceinline__ float rowmax(const f32x16& p0, const f32x16& p1) {
    float a = ATT_MX3(p0[0], p0[1], p1[0]), b = ATT_MX3(p0[2], p0[3], p1[1]); a = ATT_MX3(a, p1[2], p1[3]);
#pragma unroll
    for (int r = 4; r < 16; r += 4) { a = ATT_MX3(a, p0[r], p0[r + 1]); b = ATT_MX3(b, p0[r + 2], p0[r + 3]); a = ATT_MX3(a, p1[r], p1[r + 1]); b = ATT_MX3(b, p1[r + 2], p1[r + 3]); }
    float m = __builtin_fmaxf(a, b); auto rr = __builtin_amdgcn_permlane32_swap(__float_as_uint(m), __float_as_uint(m), false, false);
    return __builtin_fmaxf(__uint_as_float(rr[0]), __uint_as_float(rr[1]));
}
#define ATT_WAIT_BAR(N) do { if (ABL == 4) asm volatile("s_waitcnt vmcnt(" #N ") lgkmcnt(0)" ::: "memory"); else asm volatile("s_waitcnt vmcnt(" #N ") lgkmcnt(0)\n\ts_barrier" ::: "memory"); } while (0)
#define ATT_MFMA(a, b, c) __builtin_amdgcn_mfma_f32_32x32x16_bf16(a, b, c, 0, 0, 0)

template <bool FIRST>
__device__ __forceinline__ void tile_h1(int t, lds_cptr kp, const bf16x8 (&qr)[4], f32x16 (&o)[4], u32x4 (&pw)[4], float& mhat, float& l_reg,
                                        LAS float* wsf, const LAS float* btab, int qrow, int qw0, float c_left, float c_right, int r32, int hi) {
    const int relmin = 64 * t - qw0 - 31, relmax = 64 * t + 63 - qw0;
    const bool band = !(relmax <= -91 || relmin >= 91);
    const float cb = band ? 0.f : (relmin >= 91 ? c_right : c_left);
    f32x16 p0, p1;
    const f32x16 z16 = (f32x16){0.f, 0.f, 0.f, 0.f, 0.f, 0.f, 0.f, 0.f, 0.f, 0.f, 0.f, 0.f, 0.f, 0.f, 0.f, 0.f};
#pragma unroll
    for (int d0 = 0; d0 < 4; ++d0) {
        const bf16x8 k0 = *(const LAS bf16x8*)(kp + d0 * 2048), k1 = *(const LAS bf16x8*)(kp + d0 * 2048 + 512);
        if (d0 == 0) { p0 = ATT_MFMA(k0, qr[0], z16); p1 = ATT_MFMA(k1, qr[0], z16); }
        else { p0 = ATT_MFMA(k0, qr[d0], p0); p1 = ATT_MFMA(k1, qr[d0], p1); }
    }
    if (band) {
        const int relb = 64 * t + 4 * hi - qrow + 128;
#pragma unroll
        for (int r = 0; r < 16; ++r) { const int i0 = relb + (r & 3) + 8 * (r >> 2); const int a0 = i0 < 0 ? 0 : (i0 > 255 ? 255 : i0); const int i1 = i0 + 32; const int a1 = i1 < 0 ? 0 : (i1 > 255 ? 255 : i1);
            p0[r] += btab[a0]; p1[r] += btab[a1]; }
    }
    const float rm = rowmax(p0, p1) + cb;
    if (FIRST) { mhat = rm; }
    else if (__builtin_expect(__any(rm - mhat > (float)THR), 0)) {
        const float dl = __builtin_fmaxf(rm - mhat, 0.f); mhat += dl;
        const float f = __builtin_amdgcn_exp2f(-dl); l_reg *= f;
        if (hi == 0) wsf[r32] = f;
        asm volatile("s_waitcnt lgkmcnt(0)" ::: "memory");
        float fr[16];
#pragma unroll
        for (int r = 0; r < 16; ++r) fr[r] = wsf[crow(r, hi)];
#pragma unroll
        for (int db = 0; db < 4; ++db)
#pragma unroll
            for (int r = 0; r < 16; ++r) o[db][r] *= fr[r];
        asm volatile("s_waitcnt lgkmcnt(0)" ::: "memory");
    }
    const float off = cb - mhat;
    float sacc = 0.f;
#pragma unroll
    for (int r = 0; r < 16; ++r) { p0[r] = __builtin_amdgcn_exp2f(p0[r] + off); p1[r] = __builtin_amdgcn_exp2f(p1[r] + off); sacc += p0[r] + p1[r]; }
    l_reg += sacc;
#pragma unroll
    for (int ks = 0; ks < 4; ++ks) { const f32x16& P = (ks < 2) ? p0 : p1; const int b = 8 * (ks & 1);
        pw[ks] = (u32x4){cvt_pk_bf16(P[b], P[b + 1]), cvt_pk_bf16(P[b + 2], P[b + 3]), cvt_pk_bf16(P[b + 4], P[b + 5]), cvt_pk_bf16(P[b + 6], P[b + 7])}; }
}
__device__ __forceinline__ void tile_h2(lds_cptr vp, f32x16 (&o)[4], const u32x4 (&pw)[4]) {
#pragma unroll
    for (int ks = 0; ks < 4; ++ks)
#pragma unroll
        for (int db = 0; db < 4; ++db) {
            const s16x4 lo = vtr(vp + db * 4096 + ks * 1024), h4 = vtr(vp + db * 4096 + ks * 1024 + 512);
            const bf16x8 vf = (bf16x8){lo[0], lo[1], lo[2], lo[3], h4[0], h4[1], h4[2], h4[3]};
            o[db] = ATT_MFMA(__builtin_bit_cast(bf16x8, pw[ks]), vf, o[db]);
        }
}

struct VFrag { s16x4 lo, hi; };
template <int I> __device__ __forceinline__ VFrag vload(lds_cptr vp) {
    constexpr int off_ = (I & 3) * 4096 + (I >> 2) * 1024; VFrag f; f.lo = vtr(vp + off_); f.hi = vtr(vp + off_ + 512); return f;
}
__device__ __forceinline__ void attn_prefetch(int b, int h, int qb, int mp, const bf16_t* Q, const bf16_t* KT, const bf16_t* VT, LAS unsigned char* lds, bf16x8 (&qr)[4]) {
    const int tid = threadIdx.x, lane = tid & 63, r32 = lane & 31, hi = lane >> 5; const int wid = __builtin_amdgcn_readfirstlane(tid >> 6);
    const size_t rowbase = (size_t)b * S; const int qw0 = qb * 256 + 32 * wid;
    const char* ksrc = (const char*)KT + ((size_t)((b * 4 + h) * 2 + mp) * 64) * 8192 + wid * 1024 + lane * 16;
    const char* vsrc = (const char*)VT + ((size_t)(b * 4 + h) * 64) * 16384 + wid * 1024 + lane * 16;
    const unsigned lds0 = (unsigned)(uintptr_t)(unsigned char*)lds;
    const unsigned kdst = lds0 + LDS_K + wid * 1024, vdst = lds0 + LDS_V + wid * 1024;
    glds16(vsrc, (unsigned)__builtin_amdgcn_readfirstlane(vdst)); glds16(vsrc + 8192, (unsigned)__builtin_amdgcn_readfirstlane(vdst + 8192));
    glds16(vsrc + 16384, (unsigned)__builtin_amdgcn_readfirstlane(vdst + SLOT)); glds16(vsrc + 16384 + 8192, (unsigned)__builtin_amdgcn_readfirstlane(vdst + SLOT + 8192));
    glds16(ksrc + 8192, (unsigned)__builtin_amdgcn_readfirstlane(kdst + KSLOT)); glds16(ksrc, (unsigned)__builtin_amdgcn_readfirstlane(kdst));
    const int qcol = h * 128 + mp * 64 + hi * 8;
#pragma unroll
    for (int d0 = 0; d0 < 4; ++d0) qr[d0] = *(const bf16x8*)(Q + pg8::t512((long)(rowbase + qw0 + r32), qcol + d0 * 16));
}
template <int ABL, int MODE, int mp>
__device__ __forceinline__ bool attn_unit(int b, int h, int qb, const bf16_t* Q, const bf16_t* KT, const bf16_t* VT, bf16_t* MIXED, float* OX, LAS unsigned char* lds, float lam, const float* subln_g, const float* rel_bias,
                                          bf16x8 (&qr)[4], const bool PRE, const bool NXT, const int hn, const int mpn, const bool NEWHEAD) {
    const int tid = threadIdx.x, lane = tid & 63, r32 = lane & 31, hi = lane >> 5; const int wid = __builtin_amdgcn_readfirstlane(tid >> 6);
    const size_t rowbase = (size_t)b * S; const int q0 = qb * 256, qw0 = q0 + 32 * wid, qrow = qw0 + r32;
    LAS float* btab = (LAS float*)(lds + LDS_BIAS2); LAS float* wsf = (LAS float*)(lds + LDS_WSF) + wid * 64;
    if (NEWHEAD) { const int rel = tid - 256; const int n = rel < 0 ? -rel : rel; int bk; if (n < 8) bk = n; else { bk = 2 + (31 - __clz(n * n)); if (bk > 15) bk = 15; } if (rel > 0) bk += 16;
        btab[tid] = rel_bias[bk * NH + h] * LOG2E; }
    if (tid == 0) *(LAS unsigned*)(lds + LDS_WSF + 2040) = 0u;
    const float c_left = rel_bias[15 * NH + h] * LOG2E, c_right = rel_bias[31 * NH + h] * LOG2E;
    const int qcol = h * 128 + mp * 64 + hi * 8;
    if (!PRE) {
#pragma unroll
        for (int d0 = 0; d0 < 4; ++d0) qr[d0] = *(const bf16x8*)(Q + pg8::t512((long)(rowbase + qw0 + r32), qcol + d0 * 16)); }
    const char* ksrc = (const char*)KT + ((size_t)((b * 4 + h) * 2 + mp) * 64) * 8192 + wid * 1024 + lane * 16;
    const char* vsrc = (const char*)VT + ((size_t)(b * 4 + h) * 64) * 16384 + wid * 1024 + lane * 16;
    const unsigned lds0 = (unsigned)(uintptr_t)(unsigned char*)lds;
    const unsigned kdst = lds0 + LDS_K + wid * 1024, vdst = lds0 + LDS_V + wid * 1024;
    const lds_cptr kp0 = (lds_cptr)lds + LDS_K + hi * 1024 + r32 * 16;
    const lds_cptr vp0 = (lds_cptr)lds + LDS_V + ((lane >> 4) & 1) * 32 + (lane & 3) * 8 + (4 * hi + ((lane & 15) >> 2)) * 64;
#define ATT_DMA_TILE(t, ks_, vs_) do { if (ABL == 3) break; glds16(ksrc + (size_t)(t) * 8192, (unsigned)__builtin_amdgcn_readfirstlane(kdst + (ks_))); \
        glds16(vsrc + (size_t)(t) * 16384, (unsigned)__builtin_amdgcn_readfirstlane(vdst + (vs_))); glds16(vsrc + (size_t)(t) * 16384 + 8192, (unsigned)__builtin_amdgcn_readfirstlane(vdst + (vs_) + 8192)); } while (0)
    if (!PRE) { asm volatile("s_waitcnt vmcnt(0)" ::: "memory"); ATT_DMA_TILE(0, 0, 0); ATT_DMA_TILE(1, KSLOT, SLOT); }
    float mhat = 0.f, l_reg = 0.f; f32x16 o[4]; u32x4 pw[4];
#pragma unroll
    for (int db = 0; db < 4; ++db)
#pragma unroll
        for (int r = 0; r < 16; ++r) o[db][r] = 0.f;
    int ksl = 0, ksl2 = 2 * KSLOT, vsl = 0, vsl2 = 2 * SLOT, vprev = 0;
#define ATT_ROT() do { ksl = (ksl == 2 * KSLOT) ? 0 : ksl + KSLOT; ksl2 = (ksl2 == 2 * KSLOT) ? 0 : ksl2 + KSLOT; vprev = vsl; vsl = (vsl + SLOT) & (4 * SLOT - 1); vsl2 = (vsl2 + SLOT) & (4 * SLOT - 1); } while (0)
#define ATT_SB() __builtin_amdgcn_sched_barrier(0)
#define ATT_PIN(x) asm volatile("" : "+v"(x))
#define ATT_F(T0, T1, e) (((e) < 16) ? T0[(e) & 15] : T1[(e) & 15])
#define ATT_KRD(f) (*(const LAS bf16x8*)(kp_ + ((f) >> 1) * 2048 + ((f) & 1) * 512))
    const f32x16 z16 = (f32x16){0.f, 0.f, 0.f, 0.f, 0.f, 0.f, 0.f, 0.f, 0.f, 0.f, 0.f, 0.f, 0.f, 0.f, 0.f, 0.f};
#define ATT_GA(C0, C1, P0, P1, f) do { \
        if (((f) & 1) == 0) C0 = ATT_MFMA(kq[(f) % 3], qr[(f) >> 1], ((f) < 2) ? z16 : C0); else C1 = ATT_MFMA(kq[(f) % 3], qr[(f) >> 1], ((f) < 2) ? z16 : C1); \
        if (ABL != 5 && (f) + 3 < 8) kq[(f) % 3] = ATT_KRD((f) + 3); \
        if (ABL != 6) { sacc += ATT_F(P0, P1, 4 * (f)); sacc += ATT_F(P0, P1, 4 * (f) + 1); sacc += ATT_F(P0, P1, 4 * (f) + 2); sacc += ATT_F(P0, P1, 4 * (f) + 3); ATT_PIN(sacc); } \
        if (ABL != 6) pw[(f) >> 1][2 * ((f) & 1)] = cvt_pk_bf16(ATT_F(P0, P1, 4 * (f)), ATT_F(P0, P1, 4 * (f) + 1)); if (ABL != 6) pw[(f) >> 1][2 * ((f) & 1) + 1] = cvt_pk_bf16(ATT_F(P0, P1, 4 * (f) + 2), ATT_F(P0, P1, 4 * (f) + 3)); ATT_PIN(pw[(f) >> 1]); \
        ATT_SB(); } while (0)
#define ATT_VRD(I) vload<(I) & 15>(vp_)
#define ATT_GBF(I, FILL) do { \
        { const VFrag& vv = vq[(I) % 3]; const bf16x8 vf = (bf16x8){vv.lo[0], vv.lo[1], vv.lo[2], vv.lo[3], vv.hi[0], vv.hi[1], vv.hi[2], vv.hi[3]}; \
          if (ABL != 7) o[(I) & 3] = ATT_MFMA(__builtin_bit_cast(bf16x8, pw[(I) >> 2]), vf, o[(I) & 3]); else asm volatile("" :: "v"(vf)); } \
        if (ABL != 1 && (I) + 3 < 16) vq[(I) % 3] = ATT_VRD((I) + 3); \
        FILL; ATT_SB(); } while (0)
#define ATT_EXF(x) ((ABL == 2) ? (x) : __builtin_amdgcn_exp2f(x))
#define ATT_EX(C0, C1, e) do { if ((e) < 16) { C0[(e) & 15] = ATT_EXF(C0[(e) & 15] + off); } else { C1[(e) & 15] = ATT_EXF(C1[(e) & 15] + off); } } while (0)
#define ATT_EX3(C0, C1, e) do { ATT_EX(C0, C1, e); ATT_EX(C0, C1, (e) + 1); ATT_EX(C0, C1, (e) + 2); ATT_PIN(C0); ATT_PIN(C1); } while (0)
#define ATT_EX2(C0, C1, e) do { ATT_EX(C0, C1, e); ATT_EX(C0, C1, (e) + 1); ATT_PIN(C0); ATT_PIN(C1); } while (0)
#define ATT_MX3(a, b, c) __builtin_fmaxf(__builtin_fmaxf((a), (b)), (c))
#define ATT_BIAS(C0, C1, t) \
        const int relmin_ = 64 * (t) - qw0 - 31, relmax_ = 64 * (t) + 63 - qw0; const bool band_ = !(relmax_ <= -91 || relmin_ >= 91); const float cb_ = band_ ? 0.f : (relmin_ >= 91 ? c_right : c_left); \
        if (band_) { const LAS float* bp_ = btab + (64 * (t) + 4 * hi - qrow + 256);       \
            _Pragma("unroll") for (int r = 0; r < 16; ++r) { C0[r] += bp_[(r & 3) + 8 * (r >> 2)]; C1[r] += bp_[(r & 3) + 8 * (r >> 2) + 32]; } }
#define ATT_MAXP(C0, C1, g) do { if ((g) == 0) { ma_ = ATT_MX3(C0[0], C0[1], C1[0]); mb_ = ATT_MX3(C0[2], C0[3], C1[1]); ma_ = ATT_MX3(ma_, C1[2], C1[3]); } \
        else { ma_ = ATT_MX3(ma_, C0[4 * (g)], C0[4 * (g) + 1]); mb_ = ATT_MX3(mb_, C0[4 * (g) + 2], C0[4 * (g) + 3]); ma_ = ATT_MX3(ma_, C1[4 * (g)], C1[4 * (g) + 1]); mb_ = ATT_MX3(mb_, C1[4 * (g) + 2], C1[4 * (g) + 3]); } \
        ATT_PIN(ma_); ATT_PIN(mb_); } while (0)
#define ATT_DECIDE2(FIRST_) do { float rm_ = __builtin_fmaxf(ma_, mb_); { auto rr = __builtin_amdgcn_permlane32_swap(__float_as_uint(rm_), __float_as_uint(rm_), false, false); rm_ = __builtin_fmaxf(__uint_as_float(rr[0]), __uint_as_float(rr[1])); } \
        rm_ += cb_; resc = false; \
        if (FIRST_) { mhat = rm_; } \
        else if (__builtin_expect(__any(rm_ - mhat > (float)THR), 0)) { const float dl_ = __builtin_fmaxf(rm_ - mhat, 0.f); mhat += dl_; const float f_ = __builtin_amdgcn_exp2f(-dl_); l_reg *= f_; if (hi == 0) wsf[r32] = f_; resc = true; } \
        off = cb_ - mhat; ATT_SB(); } while (0)
#define ATT_RESC() do { if (resc) { asm volatile("s_waitcnt lgkmcnt(0)" ::: "memory"); float fr_[16]; \
        _Pragma("unroll") for (int r = 0; r < 16; ++r) fr_[r] = wsf[crow(r, hi)]; \
        _Pragma("unroll") for (int db = 0; db < 4; ++db) _Pragma("unroll") for (int r = 0; r < 16; ++r) o[db][r] *= fr_[r]; \
        asm volatile("s_waitcnt lgkmcnt(0)" ::: "memory"); } \
        if (MODE == 1 && cb_ != cc) { const float sc_ = __builtin_amdgcn_exp2f(cc - cb_); cc = cb_; l_reg *= sc_;       \
            _Pragma("unroll") for (int db = 0; db < 4; ++db) _Pragma("unroll") for (int r = 0; r < 16; ++r) o[db][r] *= sc_; } } while (0)
#define ATT_EX0(C0, C1, e) do { if ((e) < 16) { C0[(e) & 15] = ATT_EXF(C0[(e) & 15]); } else { C1[(e) & 15] = ATT_EXF(C1[(e) & 15]); } } while (0)
#define ATT_EX0P(C0, C1, e) do { ATT_EX0(C0, C1, e); ATT_EX0(C0, C1, (e) + 1); ATT_PIN(C0); ATT_PIN(C1); } while (0)
#define ATT_STEP(C0, C1, P0, P1, t) do { \
        const lds_cptr kp_ = kp0 + ksl; const lds_cptr vp_ = vp0 + vprev; float sacc = 0.f, ma_, mb_; \
        kq[0] = ATT_KRD(0); kq[1] = ATT_KRD(1); kq[2] = ATT_KRD(2); ATT_SB(); \
        ATT_GA(C0, C1, P0, P1, 0); ATT_GA(C0, C1, P0, P1, 1); ATT_GA(C0, C1, P0, P1, 2); ATT_GA(C0, C1, P0, P1, 3); \
        vq[0] = ATT_VRD(0); vq[1] = ATT_VRD(1); vq[2] = ATT_VRD(2); ATT_SB(); \
        ATT_GA(C0, C1, P0, P1, 4); ATT_GA(C0, C1, P0, P1, 5); ATT_GA(C0, C1, P0, P1, 6); ATT_GA(C0, C1, P0, P1, 7); \
        l_reg += sacc; \
        ATT_BIAS(C0, C1, t) ATT_SB(); \
        if (MODE == 0) { \
        ATT_GBF(0, ATT_MAXP(C0, C1, 0)); ATT_GBF(1, ATT_MAXP(C0, C1, 1)); ATT_GBF(2, ATT_MAXP(C0, C1, 2)); ATT_GBF(3, ATT_MAXP(C0, C1, 3)); \
        ATT_DECIDE2(false); \
        ATT_GBF(4, ATT_EX3(C0, C1, 0)); ATT_GBF(5, ATT_EX3(C0, C1, 3)); ATT_GBF(6, ATT_EX3(C0, C1, 6)); ATT_GBF(7, ATT_EX3(C0, C1, 9)); \
        ATT_GBF(8, ATT_EX3(C0, C1, 12)); ATT_GBF(9, ATT_EX3(C0, C1, 15)); ATT_GBF(10, ATT_EX3(C0, C1, 18)); ATT_GBF(11, ATT_EX3(C0, C1, 21)); \
        ATT_GBF(12, ATT_EX2(C0, C1, 24)); ATT_GBF(13, ATT_EX2(C0, C1, 26)); ATT_GBF(14, ATT_EX2(C0, C1, 28)); ATT_GBF(15, ATT_EX2(C0, C1, 30)); \
        } else { \
        ATT_GBF(0, ATT_EX0P(C0, C1, 0)); ATT_GBF(1, ATT_EX0P(C0, C1, 2)); ATT_GBF(2, ATT_EX0P(C0, C1, 4)); ATT_GBF(3, ATT_EX0P(C0, C1, 6)); ATT_GBF(4, ATT_EX0P(C0, C1, 8)); ATT_GBF(5, ATT_EX0P(C0, C1, 10)); ATT_GBF(6, ATT_EX0P(C0, C1, 12)); ATT_GBF(7, ATT_EX0P(C0, C1, 14)); \
        ATT_GBF(8, ATT_EX0P(C0, C1, 16)); ATT_GBF(9, ATT_EX0P(C0, C1, 18)); ATT_GBF(10, ATT_EX0P(C0, C1, 20)); ATT_GBF(11, ATT_EX0P(C0, C1, 22)); ATT_GBF(12, ATT_EX0P(C0, C1, 24)); ATT_GBF(13, ATT_EX0P(C0, C1, 26)); ATT_GBF(14, ATT_EX0P(C0, C1, 28)); ATT_GBF(15, ATT_EX0P(C0, C1, 30)); } \
        ATT_RESC(); ATT_ROT(); } while (0)
    f32x16 sa0, sa1, sb0, sb1; bf16x8 kq[3]; VFrag vq[3]; float off = 0.f, cc = 0.f; bool resc = false;
    if (PRE) { ATT_WAIT_BAR(0); } else { ATT_WAIT_BAR(3); } ATT_DMA_TILE(2, ksl2, vsl2);
    { const lds_cptr kp_ = kp0 + ksl;
#pragma unroll
      for (int d0 = 0; d0 < 4; ++d0) { const bf16x8 k0 = ATT_KRD(2 * d0), k1 = ATT_KRD(2 * d0 + 1);
          if (d0 == 0) { sa0 = ATT_MFMA(k0, qr[0], z16); sa1 = ATT_MFMA(k1, qr[0], z16); } else { sa0 = ATT_MFMA(k0, qr[d0], sa0); sa1 = ATT_MFMA(k1, qr[d0], sa1); } }
      float ma_, mb_; ATT_BIAS(sa0, sa1, 0)
      if (MODE == 0) { ATT_MAXP(sa0, sa1, 0); ATT_MAXP(sa0, sa1, 1); ATT_MAXP(sa0, sa1, 2); ATT_MAXP(sa0, sa1, 3); ATT_DECIDE2(true); } else { cc = cb_; off = 0.f; (void)ma_; (void)mb_; }
#pragma unroll
      for (int r = 0; r < 16; ++r) { sa0[r] = __builtin_amdgcn_exp2f(sa0[r] + off); sa1[r] = __builtin_amdgcn_exp2f(sa1[r] + off); }
      ATT_ROT(); }
    for (int t = 1; t < NT - 3; t += 2) {
        ATT_WAIT_BAR(3); ATT_DMA_TILE(t + 2, ksl2, vsl2); ATT_STEP(sb0, sb1, sa0, sa1, t);
        ATT_WAIT_BAR(3); ATT_DMA_TILE(t + 3, ksl2, vsl2); ATT_STEP(sa0, sa1, sb0, sb1, t + 1);
    }
    ATT_WAIT_BAR(3); ATT_DMA_TILE(NT - 1, ksl2, vsl2); ATT_STEP(sb0, sb1, sa0, sa1, NT - 3);
    ATT_WAIT_BAR(3); ATT_STEP(sa0, sa1, sb0, sb1, NT - 2);
    ATT_WAIT_BAR(0); ATT_STEP(sb0, sb1, sa0, sa1, NT - 1);
    const char* ksrc_n = (const char*)KT + ((size_t)((b * 4 + hn) * 2 + mpn) * 64) * 8192 + wid * 1024 + lane * 16;
    if (NXT && ABL != 3) {
        const char* vsrc_n = (const char*)VT + ((size_t)(b * 4 + hn) * 64) * 16384 + wid * 1024 + lane * 16;
        glds16(vsrc_n, (unsigned)__builtin_amdgcn_readfirstlane(vdst)); glds16(vsrc_n + 8192, (unsigned)__builtin_amdgcn_readfirstlane(vdst + 8192));
        glds16(vsrc_n + 16384, (unsigned)__builtin_amdgcn_readfirstlane(vdst + SLOT)); glds16(vsrc_n + 16384 + 8192, (unsigned)__builtin_amdgcn_readfirstlane(vdst + SLOT + 8192));
        glds16(ksrc_n + 8192, (unsigned)__builtin_amdgcn_readfirstlane(kdst + KSLOT));
        const int qcoln = hn * 128 + mpn * 64 + hi * 8;
#pragma unroll
        for (int d0 = 0; d0 < 4; ++d0) qr[d0] = *(const bf16x8*)(Q + pg8::t512((long)(rowbase + qw0 + r32), qcoln + d0 * 16));
    }
    f32x4 xvp[16];
    if (mp == 0) { int lane_p = lane; asm volatile("" : "+v"(lane_p)); const f32x4* OXr = (const f32x4*)OX + (size_t)wid * 16 * 64 + lane_p;
#pragma unroll
        for (int k = 0; k < 16; ++k) xvp[k] = OXr[k * 64]; }
    { float sacc = 0.f;
#pragma unroll
      for (int r = 0; r < 16; ++r) sacc += sb0[r] + sb1[r];
      l_reg += sacc;
#pragma unroll
      for (int g = 0; g < 16; ++g) pw[g >> 2][g & 3] = cvt_pk_bf16(ATT_F(sb0, sb1, 2 * g), ATT_F(sb0, sb1, 2 * g + 1));
      const lds_cptr vp_ = vp0 + vprev;
#pragma unroll
      for (int ks = 0; ks < 4; ++ks)
#pragma unroll
          for (int db = 0; db < 4; ++db) { const s16x4 lo = vtr(vp_ + db * 4096 + ks * 1024), h4 = vtr(vp_ + db * 4096 + ks * 1024 + 512);
              const bf16x8 vf = (bf16x8){lo[0], lo[1], lo[2], lo[3], h4[0], h4[1], h4[2], h4[3]}; o[db] = ATT_MFMA(__builtin_bit_cast(bf16x8, pw[ks]), vf, o[db]); } }
#undef ATT_STEP
#undef ATT_RESC
#undef ATT_DECIDE2
#undef ATT_MAXP
#undef ATT_BIAS
#undef ATT_EX2
#undef ATT_EX3
#undef ATT_EX
#undef ATT_EX0
#undef ATT_EX0P
#undef ATT_EXF
#undef ATT_GBF
#undef ATT_GA
#undef ATT_VRD
#undef ATT_KRD
#undef ATT_F
#undef ATT_PIN
#undef ATT_SB
    { auto rr = __builtin_amdgcn_permlane32_swap(__float_as_uint(l_reg), __float_as_uint(l_reg), false, false); l_reg = __uint_as_float(rr[0]) + __uint_as_float(rr[1]); }
    LAS unsigned* redo_w = (LAS unsigned*)(lds + LDS_WSF + 2040);
    if (MODE == 1) { const bool bad_ = !(l_reg > 7.8886e-31f && l_reg < 1.2676e30f); if (__any(bad_) && lane == 0) *redo_w = 1u; }
    int lane_e = lane; asm volatile("" : "+v"(lane_e));
    const int r32_e = lane_e & 31, hi_e = lane_e >> 5;
    const float scale_q = (mp == 0 ? 1.0f : lam) * __builtin_amdgcn_rcpf(l_reg);
    if (hi_e == 0) wsf[r32_e] = scale_q;
    asm volatile("s_waitcnt lgkmcnt(0)" ::: "memory");
    float sc[16];
#pragma unroll
    for (int r = 0; r < 16; ++r) sc[r] = wsf[crow(r, hi_e)];
    f32x4* OXw = (f32x4*)OX + (size_t)wid * 16 * 64 + lane_e;
    if (mp == 1) {
#pragma unroll
        for (int db = 0; db < 4; ++db)
#pragma unroll
            for (int q4 = 0; q4 < 4; ++q4) OXw[(db * 4 + q4) * 64] = (f32x4){o[db][4 * q4] * sc[4 * q4], o[db][4 * q4 + 1] * sc[4 * q4 + 1], o[db][4 * q4 + 2] * sc[4 * q4 + 2], o[db][4 * q4 + 3] * sc[4 * q4 + 3]};
    } else {
        float ss[16];
#pragma unroll
        for (int r = 0; r < 16; ++r) ss[r] = 0.f;
#pragma unroll
        for (int db = 0; db < 4; ++db)
#pragma unroll
            for (int q4 = 0; q4 < 4; ++q4) { const f32x4 xv = xvp[db * 4 + q4];
#pragma unroll
                for (int e = 0; e < 4; ++e) { const int r = 4 * q4 + e; const float d = o[db][r] * sc[r] - xv[e]; o[db][r] = d; ss[r] += d * d; } }
#pragma unroll
        for (int r = 0; r < 16; ++r) {
#pragma unroll
            for (int x = 1; x < 32; x <<= 1) ss[r] += __shfl_xor(ss[r], x);
            ss[r] = __builtin_amdgcn_rsqf(ss[r] * (1.0f / 128.0f) + EPS) * 0.8f;
        }
        asm volatile("s_waitcnt lgkmcnt(0)\n\ts_barrier" ::: "memory");
        LAS bf16_t* stg = (LAS bf16_t*)(lds + LDS_OST) + wid * 4096;
#pragma unroll
        for (int db = 0; db < 4; ++db) { const float g = subln_g[db * 32 + r32_e];
#pragma unroll
            for (int r = 0; r < 16; ++r) { const unsigned w = cvt_pk_bf16(o[db][r] * ss[r] * g, 0.f); stg[crow(r, hi_e) * 128 + db * 32 + r32_e] = (bf16_t)(w & 0xffffu); } }
        asm volatile("s_waitcnt lgkmcnt(0)" ::: "memory");
        bf16_t* Ow = MIXED + (rowbase + qw0) * 1024 + h * 128;
#pragma unroll
        for (int i = 0; i < 8; ++i) { const int row = i * 4 + (lane_e >> 4), ch = lane_e & 15; const u32x4 v = *(const LAS u32x4*)(stg + row * 128 + ch * 8); *(u32x4*)(Ow + (size_t)row * 1024 + ch * 8) = v; }
    }
    asm volatile("s_waitcnt lgkmcnt(0)\n\ts_barrier" ::: "memory");
    if (NXT && ABL != 3) glds16(ksrc_n, (unsigned)__builtin_amdgcn_readfirstlane(kdst));
    const bool redo_ = (MODE == 1) && (*(volatile LAS unsigned*)(lds + LDS_WSF + 2040) != 0u);
    asm volatile("s_waitcnt lgkmcnt(0)\n\ts_barrier" ::: "memory");
    return redo_;
#undef ATT_DMA_TILE
#undef ATT_ROT
}
}

namespace lru {
typedef _Float16 h16x2 __attribute__((ext_vector_type(2))); typedef float f32x2h __attribute__((ext_vector_type(2)));
template <int N> __device__ __forceinline__ float dpp_shr(float v, float ident) {
    return __int_as_float(__builtin_amdgcn_update_dpp(__float_as_int(ident), __float_as_int(v), 0x110 + N, 0xF, 0xF, false));
}
#define LRU_MFMA16(a, b, c) __builtin_amdgcn_mfma_f32_16x16x32_bf16(a, b, c, 0, 0, 0)
__device__ __forceinline__ void lru_rows(bf16x8 (&rowv)[2][7], __amdgpu_buffer_rsrc_t xsrd, int dir, int Pb, int ch0) {
#pragma unroll
    for (int k = 0; k < 7; ++k) {
        const int tt = dir ? (S - Pb - k) : (Pb - 2 + k);
#pragma unroll
        for (int ks = 0; ks < 2; ++ks) rowv[ks][k] = __builtin_bit_cast(bf16x8, __builtin_amdgcn_raw_buffer_load_b128(xsrd, (tt * 512 + ch0 + 32 * ks) * 2, 0, 0));
    }
}
__device__ __forceinline__ void lru_setup(int dir, int cg, LAS unsigned char* lds, int lane, const float* w_rg, const float* b_rg, const float* w_ig, const float* b_ig, const float* lru_lambda) {
    const int p = lane & 15, g = lane >> 4, n = cg >> 2, e16 = cg & 3, c0 = n * 64 + e16 * 16;
    bf16x8 idf;
#pragma unroll
    for (int j = 0; j < 8; ++j) idf[j] = ((8 * g + j) == (16 * (e16 & 1) + p)) ? (short)0x3f80 : (short)0;
    bf16x8 wrf[2], wif[2];
#pragma unroll
    for (int ks = 0; ks < 2; ++ks) {
        unsigned wr_[4], wi_[4];
#pragma unroll
        for (int j2 = 0; j2 < 4; ++j2) { const int d = 32 * ks + 8 * g + 2 * j2; const size_t i0 = ((size_t)((dir * 8 + n) * 64 + d)) * 64 + e16 * 16 + p;
            wr_[j2] = cvt_pk_bf16(w_rg[i0], w_rg[i0 + 64]); wi_[j2] = cvt_pk_bf16(w_ig[i0], w_ig[i0 + 64]); }
        wrf[ks] = __builtin_bit_cast(bf16x8, (u32x4){wr_[0], wr_[1], wr_[2], wr_[3]}); wif[ks] = __builtin_bit_cast(bf16x8, (u32x4){wi_[0], wi_[1], wi_[2], wi_[3]});
    }
    float br[4], bi[4], sp8[4];
#pragma unroll
    for (int r = 0; r < 4; ++r) { const int c = dir * 512 + c0 + 4 * g + r; br[r] = b_rg[c] * -LOG2E; bi[r] = b_ig[c] * -LOG2E; const float lm = lru_lambda[c]; sp8[r] = 8.0f * LOG2E * ((-lm > 20.0f) ? -lm : log1pf(expf(-lm)));     }
    LAS u32x4* lst = (LAS u32x4*)(lds + LDS_LST + dir * 8192) + lane;
    lst[0 * 64] = __builtin_bit_cast(u32x4, wrf[0]); lst[1 * 64] = __builtin_bit_cast(u32x4, wrf[1]); lst[2 * 64] = __builtin_bit_cast(u32x4, wif[0]); lst[3 * 64] = __builtin_bit_cast(u32x4, wif[1]);
    lst[4 * 64] = __builtin_bit_cast(u32x4, (f32x4){br[0], br[1], br[2], br[3]}); lst[5 * 64] = __builtin_bit_cast(u32x4, (f32x4){bi[0], bi[1], bi[2], bi[3]}); lst[6 * 64] = __builtin_bit_cast(u32x4, (f32x4){sp8[0], sp8[1], sp8[2], sp8[3]}); lst[7 * 64] = __builtin_bit_cast(u32x4, idf);
}
template <int PART  >
__device__ __forceinline__ void lru_item(int b, int cg, const bf16_t* XR, const bf16_t* GR, float* HF, bf16_t* MIXED, bf16_t* XC, unsigned* sib_cnt, LAS unsigned char* lds,
                                         const float* conv_w, const float* conv_b, const float* w_rg, const float* b_rg, const float* w_ig, const float* b_ig, const float* lru_lambda, const bool preset = false) {
    const int tid = threadIdx.x, lane = tid & 63, p = lane & 15, g = lane >> 4; const int wid = __builtin_amdgcn_readfirstlane(tid >> 6);
    const int n = cg >> 2, e16 = cg & 3, c0 = n * 64 + e16 * 16;
    const size_t rowbase = (size_t)b * S;
    const __amdgpu_buffer_rsrc_t XRb = __builtin_amdgcn_make_buffer_rsrc((void*)(XR + rowbase * 512), (short)0, S * 512 * 2, 0x00020000); const __amdgpu_buffer_rsrc_t XCb = __builtin_amdgcn_make_buffer_rsrc((void*)(XC + rowbase * 512), (short)0, S * 512 * 2, 0x00020000); const int ch0 = n * 64 + 8 * g;
    (void)HF;
    LAS float* tot = (LAS float*)(lds + att::LDS_TOT);
    bf16x8 idf;
#pragma unroll
    for (int j = 0; j < 8; ++j) idf[j] = ((8 * g + j) == (16 * (e16 & 1) + p)) ? (short)0x3f80 : (short)0;
    int par = 0;
    LAS float* cwl = (LAS float*)(lds + att::LDS_CW);
    if (PART == 1) {
    if (!preset) { if (tid < 320) { const int j = tid >> 6, c = tid & 63; cwl[tid] = (j < 4) ? conv_w[j * 512 + n * 64 + c] : conv_b[n * 64 + c]; }
    __syncthreads(); }
    {
        const int g8 = tid & 7, tg = tid >> 3;
        const int c8 = n * 64 + 8 * g8, tok0 = e16 * 1024 + tg * 16;
        f32x4 w0[4], w1[4];
#pragma unroll
        for (int j = 0; j < 4; ++j) { w0[j] = *(const LAS f32x4*)(cwl + j * 64 + 8 * g8); w1[j] = *(const LAS f32x4*)(cwl + j * 64 + 8 * g8 + 4); }
        const f32x4 bb0 = *(const LAS f32x4*)(cwl + 256 + 8 * g8), bb1 = *(const LAS f32x4*)(cwl + 256 + 8 * g8 + 4);
        u32x4 rw[19];
#pragma unroll
        for (int k = 0; k < 19; ++k) rw[k] = __builtin_amdgcn_raw_buffer_load_b128(XRb, (int)pg8::t512(tok0 + k - 2, c8) * 2, 0, 0);
#pragma unroll
        for (int k = 0; k < 16; ++k) {
            f32x4 a0 = bb0, a1 = bb1;
#pragma unroll
            for (int j = 0; j < 4; ++j) { const u32x4 r_ = rw[k + j];
                a0 += w0[j] * (f32x4){__uint_as_float(r_[0] << 16), __uint_as_float(r_[0] & 0xffff0000u), __uint_as_float(r_[1] << 16), __uint_as_float(r_[1] & 0xffff0000u)};
                a1 += w1[j] * (f32x4){__uint_as_float(r_[2] << 16), __uint_as_float(r_[2] & 0xffff0000u), __uint_as_float(r_[3] << 16), __uint_as_float(r_[3] & 0xffff0000u)}; }
            __builtin_amdgcn_raw_buffer_store_b128((u32x4){cvt_pk_bf16(a0[0], a0[1]), cvt_pk_bf16(a0[2], a0[3]), cvt_pk_bf16(a1[0], a1[1]), cvt_pk_bf16(a1[2], a1[3])}, XCb, (int)(((tok0 + k) * 512 + c8) * 2), 0, 16);
        }
        asm volatile("s_waitcnt vmcnt(0)" ::: "memory");
        __syncthreads();
        if (tid == 0) __hip_atomic_fetch_add(sib_cnt, 1u, __ATOMIC_RELAXED, __HIP_MEMORY_SCOPE_AGENT);
        __syncthreads();
    }
    return;
    }
    if (tid == 0) {
        unsigned sp = 0;
        while (__hip_atomic_load(sib_cnt, __ATOMIC_RELAXED, __HIP_MEMORY_SCOPE_AGENT) < 4u) { __builtin_amdgcn_s_sleep(2); if (++sp > (1u << 22)) break; }
        __builtin_amdgcn_fence(__ATOMIC_ACQUIRE, "agent");
        asm volatile("s_waitcnt vmcnt(0)" ::: "memory");
    }
    __syncthreads();
#pragma unroll
    for (int dir = 0; dir < 2; ++dir) {
        if (!preset) lru_setup(dir, cg, lds, lane, w_rg, b_rg, w_ig, b_ig, lru_lambda);
        float carry[4] = {0.f, 0.f, 0.f, 0.f};
        bf16x8 xf[4][2];
#define LRU_XLOAD(PB_) do { _Pragma("unroll") for (int i = 0; i < 4; ++i) { const int tok_ = dir ? (S - 1 - ((PB_) + i)) : ((PB_) + i); \
            _Pragma("unroll") for (int ks = 0; ks < 2; ++ks) xf[i][ks] = *(const bf16x8*)(XC + (rowbase + tok_) * 512 + ch0 + 32 * ks); } } while (0)
        LRU_XLOAD(wid * 64 + 4 * p);
        for (int sc = 0; sc < 8; ++sc) {
            const int P0 = sc * 512 + wid * 64, Pb = P0 + 4 * p;
            f32x4 ar[4], ai[4], ax[4];
            {
                int zoff = 0; asm volatile("" : "+v"(zoff));
                const LAS u32x4* lsi = (const LAS u32x4*)(lds + LDS_LST + dir * 8192) + lane + zoff;
                const bf16x8 wrf0 = __builtin_bit_cast(bf16x8, lsi[0 * 64]), wrf1 = __builtin_bit_cast(bf16x8, lsi[1 * 64]), wif0 = __builtin_bit_cast(bf16x8, lsi[2 * 64]), wif1 = __builtin_bit_cast(bf16x8, lsi[3 * 64]), idf_ = __builtin_bit_cast(bf16x8, lsi[7 * 64]);
                const f32x4 z = (f32x4){0.f, 0.f, 0.f, 0.f};
#pragma unroll
                for (int i = 0; i < 4; ++i) {
                    ar[i] = LRU_MFMA16(wrf0, xf[i][0], z); ar[i] = LRU_MFMA16(wrf1, xf[i][1], ar[i]);
                    ai[i] = LRU_MFMA16(wif0, xf[i][0], z); ai[i] = LRU_MFMA16(wif1, xf[i][1], ai[i]);
                    ax[i] = LRU_MFMA16(idf_, (e16 & 2) ? xf[i][1] : xf[i][0], z);
                }
                __builtin_amdgcn_sched_barrier(0);
                if (sc < 7) LRU_XLOAD(Pb + 512);
            }
            float hh[4][4], cpp[4][4], Al[4], Hl[4];
            int zoff2 = 0; asm volatile("" : "+v"(zoff2));
            const LAS f32x4* lsg = (const LAS f32x4*)(lds + LDS_LST + dir * 8192) + lane + zoff2;
            const f32x4 brv = lsg[4 * 64], biv = lsg[5 * 64], spv = lsg[6 * 64];
#pragma unroll
            for (int r = 0; r < 4; r += 2) {
                f32x2h h = (f32x2h){0.f, 0.f}, cp = (f32x2h){1.f, 1.f};
                const f32x2h br2 = (f32x2h){brv[r], brv[r + 1]}, bi2 = (f32x2h){biv[r], biv[r + 1]}, sp2 = (f32x2h){spv[r], spv[r + 1]}, one2 = (f32x2h){1.f, 1.f}, nl2 = (f32x2h){-LOG2E, -LOG2E};
#pragma unroll
                for (int i = 0; i < 4; ++i) {
                    const f32x2h zr = (f32x2h){ar[i][r], ar[i][r + 1]} * nl2 + br2, zi = (f32x2h){ai[i][r], ai[i][r + 1]} * nl2 + bi2;
                    const f32x2h dr = (f32x2h){__builtin_amdgcn_exp2f(zr[0]), __builtin_amdgcn_exp2f(zr[1])} + one2, di = (f32x2h){__builtin_amdgcn_exp2f(zi[0]), __builtin_amdgcn_exp2f(zi[1])} + one2;
                    const f32x2h rg = (f32x2h){__builtin_amdgcn_rcpf(dr[0]), __builtin_amdgcn_rcpf(dr[1])}, ig = (f32x2h){__builtin_amdgcn_rcpf(di[0]), __builtin_amdgcn_rcpf(di[1])};
                    const f32x2h c_ = -(rg * sp2);
                    const f32x2h a_ = (f32x2h){__builtin_amdgcn_exp2f(c_[0]), __builtin_amdgcn_exp2f(c_[1])};
                    const f32x2h om = one2 - a_ * a_;
                    const f32x2h u_ = (f32x2h){__builtin_amdgcn_sqrtf(om[0]), __builtin_amdgcn_sqrtf(om[1])} * (ig * (f32x2h){ax[i][r], ax[i][r + 1]});
                    h = a_ * h + u_; cp = a_ * cp; hh[i][r] = h[0]; hh[i][r + 1] = h[1]; cpp[i][r] = cp[0]; cpp[i][r + 1] = cp[1];
                }
                Al[r] = cp[0]; Al[r + 1] = cp[1]; Hl[r] = h[0]; Hl[r + 1] = h[1];
            }
#define LRU_KS(NN) asm volatile("s_nop 1\n\t" \
        "v_fmac_f32_dpp %0, %0, %4 row_shr:" #NN " row_mask:0xf bank_mask:0xf\n\tv_fmac_f32_dpp %1, %1, %5 row_shr:" #NN " row_mask:0xf bank_mask:0xf\n\t" \
        "v_fmac_f32_dpp %2, %2, %6 row_shr:" #NN " row_mask:0xf bank_mask:0xf\n\tv_fmac_f32_dpp %3, %3, %7 row_shr:" #NN " row_mask:0xf bank_mask:0xf\n\t" \
        "v_mul_f32_dpp %4, %4, %4 row_shr:" #NN " row_mask:0xf bank_mask:0xf\n\tv_mul_f32_dpp %5, %5, %5 row_shr:" #NN " row_mask:0xf bank_mask:0xf\n\t" \
        "v_mul_f32_dpp %6, %6, %6 row_shr:" #NN " row_mask:0xf bank_mask:0xf\n\tv_mul_f32_dpp %7, %7, %7 row_shr:" #NN " row_mask:0xf bank_mask:0xf\n\ts_nop 1" \
        : "+v"(Hl[0]), "+v"(Hl[1]), "+v"(Hl[2]), "+v"(Hl[3]), "+v"(Al[0]), "+v"(Al[1]), "+v"(Al[2]), "+v"(Al[3]))
            LRU_KS(1); LRU_KS(2); LRU_KS(4); LRU_KS(8);
#undef LRU_KS
            float Aex[4], Hex[4];
#pragma unroll
            for (int r = 0; r < 4; ++r) { Aex[r] = dpp_shr<1>(Al[r], 1.0f); Hex[r] = dpp_shr<1>(Hl[r], 0.0f); }
            if (p == 15) {
#pragma unroll
                for (int r = 0; r < 4; ++r) { tot[((par * 8 + wid) * 16 + 4 * g + r) * 2] = Al[r]; tot[((par * 8 + wid) * 16 + 4 * g + r) * 2 + 1] = Hl[r]; }
            }
            asm volatile("s_waitcnt lgkmcnt(0)\n\ts_barrier" ::: "memory");
            float cin[4];
#pragma unroll
            for (int r = 0; r < 4; ++r) cin[r] = 0.f;
#pragma unroll
            for (int w = 0; w < 8; ++w) {
                const f32x4 t0 = *(const LAS f32x4*)(tot + ((par * 8 + w) * 16 + 4 * g) * 2), t1 = *(const LAS f32x4*)(tot + ((par * 8 + w) * 16 + 4 * g) * 2 + 4);
                const float Aw[4] = {t0[0], t0[2], t1[0], t1[2]}, Hw[4] = {t0[1], t0[3], t1[1], t1[3]};
#pragma unroll
                for (int r = 0; r < 4; ++r) { if (w == wid) cin[r] = carry[r]; carry[r] = Aw[r] * carry[r] + Hw[r]; }
            }
            par ^= 1;
            f32x4 hfv[4]; u32x2 gv[4];
            if (dir) {
#pragma unroll
                for (int i = 0; i < 4; ++i) { const int tok = S - 1 - (Pb + i); gv[i] = *(const u32x2*)(GR + pg8::t512((long)(rowbase + tok), c0 + 4 * g));
                    const u32x2 hw = *(const LAS u32x2*)(lds + ((((63 - (8 * sc + wid)) * 4 + (3 - i)) * 16 + (15 - p)) * 32 + 8 * g));
                    const unsigned hx_ = hw[0], hy_ = hw[1];
                    const h16x2 h01 = __builtin_bit_cast(h16x2, hx_), h23 = __builtin_bit_cast(h16x2, hy_);
                    hfv[i] = (f32x4){(float)h01[0], (float)h01[1], (float)h23[0], (float)h23[1]}; }
            }
            float cl[4];
#pragma unroll
            for (int r = 0; r < 4; ++r) cl[r] = Aex[r] * cin[r] + Hex[r];
#pragma unroll
            for (int i = 0; i < 4; ++i) {
                const int P = Pb + i; const int tok = dir ? (S - 1 - P) : P;
                f32x4 hv;
#pragma unroll
                for (int r = 0; r < 4; ++r) hv[r] = hh[i][r] + cpp[i][r] * cl[r];
                if (dir == 0) { const h16x2 h01 = __builtin_convertvector((f32x2h){hv[0], hv[1]}, h16x2), h23 = __builtin_convertvector((f32x2h){hv[2], hv[3]}, h16x2);
                    *(LAS u32x2*)(lds + ((((8 * sc + wid) * 4 + i) * 16 + p) * 32 + 8 * g)) = (u32x2){__builtin_bit_cast(unsigned, h01), __builtin_bit_cast(unsigned, h23)}; }
                else {
                    const float gr4[4] = {__uint_as_float(gv[i].x << 16), __uint_as_float(gv[i].x & 0xffff0000u), __uint_as_float(gv[i].y << 16), __uint_as_float(gv[i].y & 0xffff0000u)};
                    float y[4];
#pragma unroll
                    for (int r = 0; r < 4; ++r) y[r] = gr4[r] * (hv[r] + hfv[i][r]);
                    u32x2 w; w.x = cvt_pk_bf16(y[0], y[1]); w.y = cvt_pk_bf16(y[2], y[3]);
                    *(u32x2*)(MIXED + (rowbase + tok) * 1024 + 512 + c0 + 4 * g) = w;
                }
            }
        }
        __syncthreads();
    }
}
}
struct Args { const float* in[22]; float* out; unsigned char* ws; int ph_lo, ph_hi; };
constexpr int N_PHASES = 6;

__global__ void __launch_bounds__(NWAVES * 64, 2) mk_fwd(Args args) {
    extern __shared__ __attribute__((aligned(16))) unsigned char lds_raw[];
    LAS unsigned char* lds = (LAS unsigned char*)lds_raw;
    const int tid = threadIdx.x, lane = tid & 63; const int wave = __builtin_amdgcn_readfirstlane(tid >> 6);
    const int G = gridDim.x, bx = blockIdx.x; const int vcu = (G % 8 == 0) ? (bx % 8) * (G / 8) + bx / 8 : bx;
    unsigned char* ws = args.ws;
    const float* x = args.in[0]; float* out = args.out;
    bf16_t* WIN = (bf16_t*)(ws + WS_WIN); bf16_t* WOUT = (bf16_t*)(ws + WS_WOUT); bf16_t* WGU = (bf16_t*)(ws + WS_WGU); bf16_t* WDN = (bf16_t*)(ws + WS_WDN);
    float* RSS1 = (float*)(ws + WS_RSS1); float* RSS2 = (float*)(ws + WS_RSS2);
    bf16_t* XN = (bf16_t*)(ws + WS_XN); bf16_t* HB = (bf16_t*)(ws + WS_HB);
    bf16_t* Qb = (bf16_t*)(ws + WS_Q); bf16_t* KT = (bf16_t*)(ws + WS_KT); bf16_t* VT = (bf16_t*)(ws + WS_VT); bf16_t* XR = (bf16_t*)(ws + WS_XR); bf16_t* GR = (bf16_t*)(ws + WS_GR);
    float* HF = (float*)(ws + WS_HF); bf16_t* MIXED = (bf16_t*)(ws + WS_MIXED); bf16_t* ACT = (bf16_t*)(ws + WS_ACT);
    const int lo = args.ph_lo, hi = args.ph_hi;
    volatile LAS unsigned* bst = (volatile LAS unsigned*)(lds + LDS_MISC + 8192);
    if (tid == 0) { bst[0] = 0u; bst[1] = 0u; bst[2] = 0u; bst[5] = 0u; }
    __syncthreads();
    xb::XcdBarrier bar = xb::xcd_barrier_post((unsigned*)ws, bst);
    if (tid == 0) ((unsigned*)ws)[24576 + bx] = bar.x;
    if (lo > 1000) cooperative_groups::this_grid().sync();
#define IN(k) (lo <= (k) && (k) < hi)
#ifndef REP_PHASE
#define REP_PHASE -1
#endif
#define REPS(k) ((REP_PHASE == (k)) ? 2 : 1)
#define REPSYNC(k, rep) do { if ((rep) + 1 < REPS(k)) xb::xcd_barrier(bar); } while (0)
#define SHADOW_CONV(k) [&](int wv) { LAS float* scr_ = (LAS float*)(lds + wv * 16384); const int lane_ = (int)threadIdx.x & 63; const int sw = vcu * 7 + (wv - 1), NSW = G * 7; \
        constexpr int J_OUT = (D / 64) * (D / 32), J_G = (D / 64) * (DFF / 32), J_DN = (DFF / 64) * (D / 32); \
        if ((k) == 0) {     \
            f32x4 va_[8], vb_[8]; const int itA = sw, itB = sw + NSW, JT = J_OUT + J_G + J_DN; \
            _Pragma("unroll") for (int q_ = 0; q_ < 2; ++q_) { const int it = q_ ? itB : itA; f32x4 (&vv_)[8] = q_ ? vb_ : va_; if (it < JT) { \
                if (it < J_OUT) p0_item_load(args.in[16], D, D, nullptr, it, lane_, vv_); else if (it < J_OUT + J_G) p0_item_load(args.in[19], D, DFF, args.in[17], it - J_OUT, lane_, vv_); else p0_item_load(args.in[20], DFF, D, nullptr, it - J_OUT - J_G, lane_, vv_); } } \
            _Pragma("unroll") for (int q_ = 0; q_ < 2; ++q_) { const int it = q_ ? itB : itA; const f32x4 (&vv_)[8] = q_ ? vb_ : va_; if (it < JT) { \
                if (it < J_OUT) p0_item_finish<0>(D, D, WOUT, scr_, it, lane_, vv_); else if (it < J_OUT + J_G) p0_item_finish<2>(D, DFF, WGU, scr_, it - J_OUT, lane_, vv_); else p0_item_finish<0>(DFF, D, WDN, scr_, it - J_OUT - J_G, lane_, vv_); } } \
            static_assert(J_OUT + J_G + J_DN <= 2 * 256 * 7, "two items per wave"); } \
        f32x4 vg_[8]; if ((k) == 1 && sw < J_G) p0_item_load(args.in[18], D, DFF, args.in[17], sw, lane_, vg_);     \
        if ((k) == 1 && G == 256 && wv == 3) { float s1_ = 0.f, s2_ = 0.f; for (int i = 0; i < 64; ++i) { s1_ += args.in[3][i] * args.in[4][i]; s2_ += args.in[5][i] * args.in[6][i]; } \
            if (lane_ == 0) *(LAS float*)(lds + LDS_MISC + 2044) = expf(s1_) - expf(s2_) + 0.2f; }     \
        if ((k) == 1 && G == 256 && wv >= 4) { LAS float* cwl_ = (LAS float*)(lds + att::LDS_CW); const int n_ = (vcu & 31) >> 2; \
            for (int q = (wv - 4) * 64 + lane_; q < 320; q += 256) { const int j = q >> 6, c = q & 63; cwl_[q] = (j < 4) ? args.in[9][j * 512 + n_ * 64 + c] : args.in[10][n_ * 64 + c]; } }     \
        if ((k) == 1 && G == 256 && wv <= 2) lru::lru_setup(wv - 1, vcu & 31, lds, lane_, args.in[11], args.in[12], args.in[13], args.in[14], args.in[15]);     \
        if ((k) == 1 && sw < J_G) p0_item_finish<1>(D, DFF, WGU, scr_, sw, lane_, vg_); \
        static_assert(J_G <= 256 * 7, "one gate-row item per wave"); \
        asm volatile("s_waitcnt vmcnt(0) lgkmcnt(0)" ::: "memory"); }
#define SEAM(k) do { if (IN(k) && IN((k) + 1)) { if ((k) < 4 && lo == 0 && hi == N_PHASES) xb::xcd_barrier_shadow(bar, SHADOW_CONV(k)); else xb::xcd_barrier(bar); } } while (0)

    if (IN(0)) for (int rep = 0; rep < REPS(0); ++rep) {
        LAS float* scr = (LAS float*)(lds + wave * 16384);
        const int gw = vcu * NWAVES + wave, NGW = G * NWAVES;
        constexpr int I_IN = (D / 64) * (DIN / 32), I_OUT = (D / 64) * (D / 32), I_G = (D / 64) * (DFF / 32), I_DN = (DFF / 64) * (D / 32);
        constexpr int NITEMS = I_IN + I_OUT + 2 * I_G + I_DN;
        (void)NITEMS;
        for (int it = gw; it < I_IN; it += NGW) p0_transpose_item<0>(args.in[2], D, DIN, WIN, args.in[1], scr, it, lane);
        for (int m = gw * 4; m < M; m += NGW * 4) rms_rows_to_bf16<4>(x + (size_t)m * D, (float*)(ws + WS_RSTD0) + m, XN + (size_t)m * D, lane);
        REPSYNC(0, rep);
    }
    SEAM(0);
    if (tid == 0 && lo == 0 && hi == N_PHASES && G == 256) { const int x_ = bx & 7, jl = (bx >> 3) & 7; unsigned same = 1u;
        for (int k = 0; k < 4; ++k) same &= (xb::xb_ld((unsigned*)ws + 24576 + (((jl + 8 * k) << 3) + x_)) == bar.x) ? 1u : 0u;
        bst[3] = same; }
    if (lo == 0 && hi == N_PHASES && G == 256) { int ok_ = 1; if (tid < 256) ok_ = (xb::xb_ld((unsigned*)ws + 24576 + tid) == xb::xb_ld((unsigned*)ws + 24576 + (tid & 7))) ? 1 : 0;
        if (!ok_) bst[5] = 1u; __syncthreads(); if (tid == 0) bst[4] = (bst[5] == 0u) ? 1u : 0u; }
    if (IN(1)) for (int rep = 0; rep < REPS(1); ++rep) {
        pg8::Gemm g{XN, WIN, M, DIN, D}; pg8::StaticOrder So; So.init(M, DIN, G, bx); So.rep = (REP_PHASE == 10) ? 2 : 1;
        LAS float* rst1 = (LAS float*)(lds + LDS_MISC + 11264);
        struct P1Pre { enum { ON = 1 }; const float* src; LAS float* dst; float v;
            __device__ __forceinline__ void issue() { v = *src; } __device__ __forceinline__ void finish() { *dst = v; } };
        pg8::Unit u0; (void)So.next(0, u0); const int pmA1 = u0.pm & ~8;
        P1Pre pre1{(const float*)(ws + WS_RSTD0) + (pmA1 + 8 * (tid >> 8)) * 256 + (tid & 255), rst1 + tid, 0.f};
        pg8::EpiInProj E{Qb, KT, VT, XR, GR, QSCALE, rst1};
        pg8::gemm_phase<pg8::EpiInProj, pg8::StaticOrder, true, true, false, P1Pre>(lds, g, So, E, -1, &pre1);
        REPSYNC(1, rep);
    }
    if (IN(1) && IN(2)) { if (lo == 0 && hi == N_PHASES && G == 256 && bst[4] != 0u) xb::local_barrier_shadow((unsigned*)ws + 20480 + 64 * (bx & 7), 32u, (unsigned*)ws, SHADOW_CONV(1)); else SEAM(1); }
    if (IN(2)) {
        float lam;
        const bool preset2 = (G == 256 && lo == 0 && hi == N_PHASES);
        if (preset2) lam = *(const LAS float*)(lds + LDS_MISC + 2044); else
        { float s1 = 0.f, s2 = 0.f; for (int i = 0; i < 64; ++i) { s1 += args.in[3][i] * args.in[4][i]; s2 += args.in[5][i] * args.in[6][i]; } lam = expf(s1) - expf(s2) + 0.2f; }
#if REP_PHASE == 79
        { const long long pr0 = wall_clock64();
          for (int rnd = 0; rnd * G + vcu < NB * NH * 32; ++rnd) { (void)att::attn_unit<ATT_PROBE, 0, 1>(vcu >> 5, rnd, (vcu & 31) >> 1, Qb, KT, VT, (bf16_t*)(ws + WS_XC), (float*)(ws + WS_OX) + (size_t)vcu * 32768, lds, lam, args.in[7], args.in[8]); }
          __syncthreads();
          if (bx == 0 && tid == 0) { const long long dr = wall_clock64() - pr0; ((float*)ws)[30000] = (float)dr * 2.0e-6f; } }
#endif
#if REP_PHASE == 77 || REP_PHASE == 78
        const long long pc0 = clock64(), pr0 = wall_clock64();
#endif
        pg8::bf16x8 qfr[4];
#pragma unroll
        for (int d0 = 0; d0 < 4; ++d0) qfr[d0] = (pg8::bf16x8){0, 0, 0, 0, 0, 0, 0, 0};
        if (G == 256) { const int l = vcu & 31; att::attn_prefetch(vcu >> 5, l >> 4, l & 15, 1, Qb, KT, VT, lds, qfr); }
        for (int it = vcu; it < NB * 32; it += G) {
            const int b_ = it >> 5, cg = it & 31;
            lru::lru_item<1>(b_, cg, XR, GR, HF, MIXED, (bf16_t*)(ws + WS_XC), (unsigned*)ws + 16384 + 64 * (it >> 2), lds, args.in[9], args.in[10], args.in[11], args.in[12], args.in[13], args.in[14], args.in[15], preset2);
        }
        const bool pre_ok = (G == 256);
        for (int rep = 0; rep < REPS(20); ++rep)
        for (int pr = vcu; pr < NB * NH * 16; pr += G) {
            int b_, h_, qb_; if (G == 256) { const int l = vcu & 31, rp = pr / G; b_ = vcu >> 5; h_ = 2 * rp + (l >> 4); qb_ = l & 15; } else { qb_ = pr & 15; h_ = (pr >> 4) & 3; b_ = pr >> 6; }
            const float* const* kin = (const float* const*)__builtin_amdgcn_kernarg_segment_ptr(); asm volatile("" : "+s"(kin));
            unsigned char* ws2 = *(unsigned char* const*)((const char*)kin + 23 * 8);
            const bf16_t* Qb2 = (const bf16_t*)(ws2 + WS_Q); const bf16_t* KT2 = (const bf16_t*)(ws2 + WS_KT); const bf16_t* VT2 = (const bf16_t*)(ws2 + WS_VT); bf16_t* MX2 = (bf16_t*)(ws2 + WS_MIXED);
            float* OXc = (float*)(ws2 + WS_OX) + ((size_t)vcu * 2 + (size_t)(pr / G)) * 32768; const float* sg2 = kin[7]; const float* rb2 = kin[8];
            const bool first_ = (pr == vcu), more_ = (pr + G < NB * NH * 16); const int hnx = (G == 256) ? h_ + 2 : ((((pr + G) >> 4) & 3));
            if (att::attn_unit<0, 1, 1>(b_, h_, qb_, Qb2, KT2, VT2, MX2, OXc, lds, lam, sg2, rb2, qfr, pre_ok, true, h_, 0, true))
                (void)att::attn_unit<0, 0, 1>(b_, h_, qb_, Qb2, KT2, VT2, MX2, OXc, lds, lam, sg2, rb2, qfr, false, true, h_, 0, true);
            if (att::attn_unit<0, 1, 0>(b_, h_, qb_, Qb2, KT2, VT2, MX2, OXc, lds, lam, sg2, rb2, qfr, true, more_ && pre_ok, hnx, 1, false))
                (void)att::attn_unit<0, 0, 0>(b_, h_, qb_, Qb2, KT2, VT2, MX2, OXc, lds, lam, sg2, rb2, qfr, false, more_ && pre_ok, hnx, 1, false);
        }
        for (int it = vcu; it < NB * 32; it += G) {
            const int b_ = it >> 5, cg = it & 31;
            lru::lru_item<2>(b_, cg, XR, GR, HF, MIXED, (bf16_t*)(ws + WS_XC), (unsigned*)ws + 16384 + 64 * (it >> 2), lds, args.in[9], args.in[10], args.in[11], args.in[12], args.in[13], args.in[14], args.in[15], G == 256 && lo == 0 && hi == N_PHASES);
        }
    }
#if REP_PHASE == 78
    if (IN(2) && bx == 0 && tid == 0) { const long long dc = clock64() - pc0_, dr = wall_clock64() - pr0_; ((float*)ws)[30000] = (float)dc / ((float)dr * 10.0f) * 0.05f; }
#endif
    SEAM(2);
    if (IN(3)) for (int rep = 0; rep < REPS(3); ++rep) {
        pg8::Gemm g{MIXED, WOUT, M, D, D}; pg8::StaticOrder So; So.init(M, D, G, bx);
        pg8::EpiResid<true, false> E{XN, out, HB, RSS1, D};
        pg8::gemm_phase<pg8::EpiResid<true, false>, pg8::StaticOrder, true, true>(lds, g, So, E);
        REPSYNC(3, rep);
    }
    if (IN(3) && IN(4)) { if (lo == 0 && hi == N_PHASES && G == 256) xb::group_barrier((unsigned*)ws + 12288 + 64 * ((bx & 7) * 8 + ((bx >> 3) & 7)) + 16, 4u, bst[3] != 0u, (unsigned*)ws); else xb::xcd_barrier(bar); }
    if (IN(4)) for (int rep = 0; rep < REPS(4); ++rep) {
        LAS float* rstl = (LAS float*)(lds + LDS_MISC + 11264);
        struct P4Pre { enum { ON = 1 }; const float* rp_; LAS float* dst; f32x4 s0, s1, s2, s3;
            __device__ __forceinline__ void issue() { s0 = *(const f32x4*)(rp_); s1 = *(const f32x4*)(rp_ + 4); s2 = *(const f32x4*)(rp_ + 8); s3 = *(const f32x4*)(rp_ + 12); }
            __device__ __forceinline__ void finish() {
                const float s = (((s0[0] + s0[1]) + (s0[2] + s0[3])) + ((s1[0] + s1[1]) + (s1[2] + s1[3]))) + (((s2[0] + s2[1]) + (s2[2] + s2[3])) + ((s3[0] + s3[1]) + (s3[2] + s3[3])));
                *dst = __builtin_amdgcn_rsqf(s * (1.0f / D) + EPS); } };
        pg8::Gemm g{HB, WGU, M, 2 * DFF, D}; pg8::StaticOrder So; So.init(M, 2 * DFF, G, bx); So.rep = (REP_PHASE == 40) ? 2 : 1;
        pg8::Unit u0; (void)So.next(0, u0); const int pmA4 = u0.pm & ~8;
        P4Pre pre4{RSS1 + ((size_t)((pmA4 + 8 * (tid >> 8)) * 256 + (tid & 255))) * 16, rstl + tid, {}, {}, {}, {}};
        pg8::EpiGateUp E{ACT, rstl, DFF};
        pg8::gemm_phase<pg8::EpiGateUp, pg8::StaticOrder, true, true, true, P4Pre>(lds, g, So, E, -1, &pre4);
        REPSYNC(4, rep);
    }
    if (IN(4) && IN(5)) { if (lo == 0 && hi == N_PHASES && G == 256) xb::group_barrier((unsigned*)ws + 12288 + 64 * ((bx & 7) * 8 + ((bx >> 3) & 7)), 4u, bst[3] != 0u, (unsigned*)ws); else xb::xcd_barrier(bar); }
    if (IN(5)) for (int rep = 0; rep < REPS(5); ++rep) {
        if (G == 256) {
#pragma unroll 1
            for (int half = 0; half < 2; ++half) {
                pg8::Gemm g{ACT, WDN, M, D, DFF}; const pg8::SegOrder So{16 * (bx & 7) + 8 * half + ((bx >> 3) & 7), bx >> 6, 1, 0, 0, 0, 0};
                pg8::EpiDownNorm E{HB, out, args.in[21], RSS2, (unsigned*)ws + 4096, D, EPS, ws};
                pg8::gemm_phase<pg8::EpiDownNorm, pg8::SegOrder, false, true, true>(lds, g, So, E);
                __syncthreads();
            }
        }
        REPSYNC(5, rep);
    }
#if REP_PHASE == 99
    for (int i = 0; i < 20; ++i) xb::xcd_barrier(bar);
#endif
#undef IN
#undef SEAM
}
}
namespace dbg {
using namespace mk;
__global__ void __launch_bounds__(256) k_unpack_proj(const bf16_t* Qb, const bf16_t* KT, const bf16_t* VT, const bf16_t* XR, const bf16_t* GR, float* q, float* k, float* v, float* xr, float* gr) {
    const size_t idx = (size_t)blockIdx.x * 256 + threadIdx.x;
    const int c = (int)(idx & 511); const int row = (int)(idx >> 9); const int b = row >> 12, tok = row & 4095, t = tok >> 6, rr = tok & 63;
    q[idx] = bf2f(Qb[idx]) * (1.0f / QSCALE);
    { const int h = c >> 7, w = c & 127, s = w >> 6, d = w & 63, chunk = d >> 3, j = d & 7;
      k[idx] = bf2f(KT[((((size_t)(b * 4 + h) * 2 + s) * 64 + t) * 8 + chunk) * 512 + rr * 8 + j]); }
    { const int h = c >> 7, dv = c & 127, db = dv >> 5, cc = dv & 31;
      v[idx] = bf2f(VT[(((size_t)(b * 4 + h) * 64 + t) * 4 + db) * 2048 + rr * 32 + cc]); }
    xr[idx] = bf2f(XR[idx]); gr[idx] = bf2f(GR[idx]);
}
__global__ void __launch_bounds__(256) k_unpack_bf16(const bf16_t* src, float* dst) { const size_t idx = (size_t)blockIdx.x * 256 + threadIdx.x; dst[idx] = bf2f(src[idx]); }
}

#ifndef STAGE
#define STAGE 4
#endif
static void mk_launch_phases(const mk::Args& a0, int lo, int hi, int grid, hipStream_t stream, bool coop) {
    mk::Args a = a0; a.ph_lo = lo; a.ph_hi = hi;
    if (coop) { void* args[] = {&a}; hipError_t e = hipLaunchCooperativeKernel((const void*)mk::mk_fwd, dim3(grid), dim3(mk::NWAVES * 64), args, mk::LDS_BYTES, stream);
        if (e != hipSuccess) fprintf(stderr, "cooperative launch failed: %s (grid %d)\n", hipGetErrorString(e), grid); }
    else { hipLaunchKernelGGL(mk::mk_fwd, dim3(grid), dim3(mk::NWAVES * 64), mk::LDS_BYTES, stream, a); }
}

extern "C" void kernel_launch(void* const* d_in, const int* in_sizes, int n_in, void* d_out, int out_size, void* d_ws, size_t ws_size, hipStream_t stream) {
    static int grid = 0;
    if (grid == 0) {
        int dev = 0, cus = 0, per_cu = 0;
        hipGetDevice(&dev); hipDeviceGetAttribute(&cus, hipDeviceAttributeMultiprocessorCount, dev);
        if (hipFuncSetAttribute((const void*)mk::mk_fwd, hipFuncAttributeMaxDynamicSharedMemorySize, mk::LDS_BYTES) != hipSuccess) { fprintf(stderr, "hipFuncSetAttribute failed\n"); grid = -1; return; }
        if (hipOccupancyMaxActiveBlocksPerMultiprocessor(&per_cu, (const void*)mk::mk_fwd, mk::NWAVES * 64, mk::LDS_BYTES) != hipSuccess || per_cu < 1) { fprintf(stderr, "occupancy query: %d\n", per_cu); per_cu = 1; }
        (void)hipGetLastError();
        grid = cus * 1;
        if (n_in != 22 || ws_size < 512u * mk::MiB) fprintf(stderr, "kernel_launch: unexpected n_in %d / ws_size %zu\n", n_in, ws_size);
    }
    if (grid < 0) return;
    if (hipMemsetAsync(d_ws, 0, 131072, stream) != hipSuccess) { fprintf(stderr, "memset failed\n"); return; }
    mk::Args a{};
    for (int i = 0; i < 22; ++i) a.in[i] = (const float*)d_in[i];
    a.out = (float*)d_out; a.ws = (unsigned char*)d_ws;
    char* ws = (char*)d_ws; const size_t MiB = 1u << 20;
#if STAGE == 4
    mk_launch_phases(a, 0, mk::N_PHASES, grid, stream, true);
#elif STAGE == 3
    for (int p = 0; p < mk::N_PHASES; ++p) mk_launch_phases(a, p, p + 1, grid, stream, false);
#elif STAGE == 1
    for (int p = 0; p < 2; ++p) mk_launch_phases(a, p, p + 1, grid, stream, false);
    float* q = (float*)(ws + 32 * MiB), *k = (float*)(ws + 256 * MiB), *v = (float*)(ws + 320 * MiB), *xr = (float*)(ws + 384 * MiB), *gr = (float*)(ws + 448 * MiB);
    dbg::k_unpack_proj<<<mk::M * 512 / 256, 256, 0, stream>>>((const mk::bf16_t*)(ws + mk::WS_Q), (const mk::bf16_t*)(ws + mk::WS_KT), (const mk::bf16_t*)(ws + mk::WS_VT), (const mk::bf16_t*)(ws + mk::WS_XR), (const mk::bf16_t*)(ws + mk::WS_GR), q, k, v, xr, gr);
    float* mixed = (float*)(ws + 96 * MiB);
    nv::naive_mid(d_in, q, k, v, xr, gr, mixed, stream);
    nv::naive_tail(d_in, mixed, (float*)d_out, (float*)(ws + 0), (float*)(ws + 128 * MiB), stream);
#elif STAGE == 2
    for (int p = 0; p < 3; ++p) mk_launch_phases(a, p, p + 1, grid, stream, false);
    float* mixed = (float*)(ws + 0);
    dbg::k_unpack_bf16<<<mk::M * 1024 / 256, 256, 0, stream>>>((const mk::bf16_t*)(ws + mk::WS_MIXED), mixed);
    nv::naive_tail(d_in, mixed, (float*)d_out, (float*)(ws + 0), (float*)(ws + 128 * MiB), stream);
#endif
}
```
